# Optimizing an MI355X kernel written in HIP

```python
import jax, jax.numpy as jnp
from jax import lax
import numpy as np

D_MODEL = 4096
BATCH = 8
SEQ = 2048
DEPTH = 2

HEAD_DIM = 128
N_HEADS_A = 16
N_HEADS_B = 16
DILATED_PATTERNS = ((128, 1), (512, 4), (2048, 16))
MOBA_BLOCK = 256
MOBA_TOPK = 3
MOBA_QCHUNK = 16
N_HEADS_C = 16
SB_QBLOCK = 128
N_HEADS_D = 8
DQK_D = 128
DV_D = 256
MLSTM_CHUNK = 64
CONV_D = 4
D_FF = 11008
FFN_CONV = 3
LN_EPS = 1e-5
ALPHA = (2 * DEPTH) ** 0.25
BETA = (8 * DEPTH) ** -0.25
N_EVEN = (DEPTH + 1) // 2
N_ODD = DEPTH // 2

W_A = N_HEADS_A * HEAD_DIM
W_B = N_HEADS_B * HEAD_DIM
W_C = N_HEADS_C * HEAD_DIM
QK_D = N_HEADS_D * DQK_D
W_D = N_HEADS_D * DV_D
IN_AB = 3 * (W_A + W_B)
IN_CD = 3 * W_C + 2 * QK_D + 2 * W_D + 2 * N_HEADS_D
MIX_AB = W_A + W_B
MIX_CD = W_C + W_D

kernel_name = "hybrid_dilated_moba_stickbreak_mlstm"


def _split(t, sizes):
    return jnp.split(t, [int(s) for s in np.cumsum(sizes)[:-1]], axis=-1)


def layer_norm(x, g, b):
    xf = x.astype(jnp.float32)
    mu = xf.mean(-1, keepdims=True)
    var = jnp.mean(jnp.square(xf - mu), -1, keepdims=True)
    return ((xf - mu) * lax.rsqrt(var + LN_EPS)).astype(x.dtype) * g + b


def causal_dwconv(x, w, b):
    K, S = w.shape[0], x.shape[1]
    xp = jnp.pad(x, ((0, 0), (K - 1, 0), (0, 0)))
    return sum(w[k] * xp[:, k:k + S] for k in range(K)) + b


def dilated_branch(q, k, v, window, dilation):
    Bsz, S, H, Dh = q.shape
    L = S // dilation
    nw = window // dilation
    blk = nw
    nb = -(-L // blk)
    Lp = nb * blk

    def strided(t):
        t = t.reshape(Bsz, L, dilation, H, Dh).transpose(0, 2, 3, 1, 4)
        return jnp.pad(t, ((0, 0), (0, 0), (0, 0), (0, Lp - L), (0, 0)))

    def band(t):
        tp = jnp.pad(t, ((0, 0), (0, 0), (0, 0), (blk, 0), (0, 0)))
        tp = tp.reshape(Bsz, dilation, H, nb + 1, blk, Dh)
        return jnp.concatenate([tp[:, :, :, :-1], tp[:, :, :, 1:]], axis=4)

    qb = strided(q).reshape(Bsz, dilation, H, nb, blk, Dh)
    kb, vb = band(strided(k)), band(strided(v))
    s = jnp.einsum('bdhnqe,bdhnke->bdhnqk', qb, kb).astype(jnp.float32) * (Dh ** -0.5)
    qi = jnp.arange(blk)[:, None]
    ki = jnp.arange(2 * blk)[None, :] - blk
    dist = qi - ki
    kpos = jnp.arange(nb)[:, None, None] * blk + ki[None]
    valid = (dist >= 0) & (dist <= nw) & (kpos >= 0)
    s = jnp.where(valid, s, -jnp.inf)
    mx = s.max(-1)
    p = jnp.exp(s - mx[..., None])
    den = p.sum(-1)
    num = jnp.einsum('bdhnqk,bdhnke->bdhnqe', p.astype(vb.dtype), vb)

    def unstrided(t):
        rest = t.shape[5:]
        t = t.reshape(Bsz, dilation, H, Lp, *rest)[:, :, :, :L]
        t = jnp.moveaxis(t, 3, 1)
        return t.reshape(Bsz, S, H, *rest)

    return unstrided(num), unstrided(den), unstrided(mx)


def dilated_attention(q, k, v):
    outs = [dilated_branch(q, k, v, w, d) for (w, d) in DILATED_PATTERNS]
    m = jnp.max(jnp.stack([o[2] for o in outs]), axis=0)
    num = sum(o[0].astype(jnp.float32) * jnp.exp(o[2] - m)[..., None] for o in outs)
    den = sum(o[1] * jnp.exp(o[2] - m) for o in outs)
    return (num / den[..., None]).astype(q.dtype)


def moba_attention(q, k, v):
    Bsz, S, H, Dh = q.shape
    nblk = -(-S // MOBA_BLOCK)
    Sp = nblk * MOBA_BLOCK
    topk = min(MOBA_TOPK, nblk)
    pad = lambda t: jnp.pad(t, ((0, 0), (0, Sp - S), (0, 0), (0, 0))).transpose(0, 2, 1, 3)
    qh = pad(q)
    kh = pad(k).reshape(Bsz, H, nblk, MOBA_BLOCK, Dh)
    vh = pad(v).reshape(Bsz, H, nblk, MOBA_BLOCK, Dh)
    kmean = kh.mean(axis=3)
    bidx = jnp.arange(Bsz)[:, None, None, None]
    hidx = jnp.arange(H)[None, :, None, None]
    scale = Dh ** -0.5

    def chunk(ci):
        t0 = ci * MOBA_QCHUNK
        qc = lax.dynamic_slice_in_dim(qh, t0, MOBA_QCHUNK, axis=2)
        own = t0 // MOBA_BLOCK
        gate = jnp.einsum('bhqe,bhne->bhqn', qc, kmean).astype(jnp.float32)
        gate = jnp.where(jnp.arange(nblk) < own, gate, -jnp.inf)
        _, idx = lax.top_k(gate, topk)
        sel_ok = idx < own
        ksel = kh[bidx, hidx, idx]
        vsel = vh[bidx, hidx, idx].reshape(Bsz, H, MOBA_QCHUNK, topk * MOBA_BLOCK, Dh)
        s_sel = jnp.einsum('bhqe,bhqjke->bhqjk', qc, ksel).reshape(Bsz, H, MOBA_QCHUNK, topk * MOBA_BLOCK)
        s_sel = jnp.where(jnp.repeat(sel_ok, MOBA_BLOCK, axis=-1), s_sel.astype(jnp.float32), -jnp.inf)
        ko = lax.dynamic_index_in_dim(kh, own, axis=2, keepdims=False)
        vo = lax.dynamic_index_in_dim(vh, own, axis=2, keepdims=False)
        s_own = jnp.einsum('bhqe,bhke->bhqk', qc, ko).astype(jnp.float32)
        qpos = t0 + jnp.arange(MOBA_QCHUNK)
        kpos = own * MOBA_BLOCK + jnp.arange(MOBA_BLOCK)
        s_own = jnp.where(kpos[None, :] <= qpos[:, None], s_own, -jnp.inf)
        p = jax.nn.softmax(jnp.concatenate([s_sel, s_own], axis=-1) * scale, axis=-1)
        p_sel, p_own = p[..., :topk * MOBA_BLOCK], p[..., topk * MOBA_BLOCK:]
        return (jnp.einsum('bhqk,bhqke->bhqe', p_sel.astype(v.dtype), vsel)
                + jnp.einsum('bhqk,bhke->bhqe', p_own.astype(v.dtype), vo))

    out = lax.map(chunk, jnp.arange(Sp // MOBA_QCHUNK))
    out = out.transpose(1, 0, 3, 2, 4).reshape(Bsz, Sp, H, Dh)[:, :S]
    return out.astype(q.dtype)


def stick_breaking_attention(q, k, v):
    Bsz, S, H, Dh = q.shape
    qh, kh, vh = (t.transpose(0, 2, 1, 3) for t in (q, k, v))
    kpos = jnp.arange(S)

    def block(bi):
        t0 = bi * SB_QBLOCK
        qc = lax.dynamic_slice_in_dim(qh, t0, SB_QBLOCK, axis=2)
        z = jnp.einsum('bhqe,bhke->bhqk', qc, kh).astype(jnp.float32) * (Dh ** -0.5)
        qpos = t0 + jnp.arange(SB_QBLOCK)
        causal = kpos[None, :] < qpos[:, None]
        sp = jnp.where(causal, jax.nn.softplus(z), 0.0)
        rc = lax.cumsum(sp, axis=3, reverse=True)
        A = jnp.exp(jnp.where(causal, z - rc, -jnp.inf))
        return jnp.einsum('bhqk,bhke->bhqe', A.astype(v.dtype), vh)

    out = lax.map(block, jnp.arange(S // SB_QBLOCK))
    return out.transpose(1, 0, 3, 2, 4).reshape(Bsz, S, H, Dh).astype(q.dtype)


def mlstm_chunkwise(q, k, v, i_pre, f_pre):
    f32 = jnp.float32
    Bsz, S, H, Dk = q.shape
    Dv = v.shape[-1]
    L = MLSTM_CHUNK
    nc = S // L
    q, v = q.astype(f32), v.astype(f32)
    k = k.astype(f32) * (Dk ** -0.5)
    log_f = jax.nn.log_sigmoid(f_pre.astype(f32))
    log_i = i_pre.astype(f32)

    def to_chunks(t):
        t = t.reshape(Bsz, nc, L, H, *t.shape[3:])
        return jnp.moveaxis(t, [1, 3], [0, 2])

    tri = jnp.tril(jnp.ones((L, L), dtype=bool))

    def step(carry, xs):
        C, n, m = carry
        qc, kc, vc, lic, lfc = xs
        b = jnp.cumsum(lfc, axis=-1)
        g = b[..., -1]
        Dm = jnp.where(tri, b[..., :, None] - b[..., None, :] + lic[..., None, :], -jnp.inf)
        inter = b + m[..., None]
        m_t = jnp.maximum(inter, Dm.max(-1))
        P = jnp.exp(Dm - m_t[..., None])
        w_inter = jnp.exp(inter - m_t)
        Sqk = jnp.einsum('bhte,bhse->bhts', qc, kc) * P
        num = (w_inter[..., None] * jnp.einsum('bhve,bhte->bhtv', C, qc)
               + jnp.einsum('bhts,bhsv->bhtv', Sqk, vc))
        den = w_inter * jnp.einsum('bhe,bhte->bht', n, qc) + Sqk.sum(-1)
        h = num / jnp.maximum(jnp.abs(den), jnp.exp(-m_t))[..., None]
        dec = g[..., None] - b + lic
        m_new = jnp.maximum(g + m, dec.max(-1))
        wk = jnp.exp(dec - m_new[..., None])
        sc = jnp.exp(g + m - m_new)
        C_new = sc[..., None, None] * C + jnp.einsum('bhs,bhsv,bhse->bhve', wk, vc, kc)
        n_new = sc[..., None] * n + jnp.einsum('bhs,bhse->bhe', wk, kc)
        return (C_new, n_new, m_new), h

    init = (jnp.zeros((Bsz, H, Dv, Dk), f32), jnp.zeros((Bsz, H, Dk), f32), jnp.zeros((Bsz, H), f32))
    xs = (to_chunks(q), to_chunks(k), to_chunks(v), to_chunks(log_i), to_chunks(log_f))
    _, h = lax.scan(step, init, xs)
    return jnp.moveaxis(h, [0, 2], [1, 3]).reshape(Bsz, S, H, Dv)


def mixer_ab(x, w_in, w_out):
    Bsz, S, _ = x.shape
    qa, ka, va, qb, kb, vb = _split(x @ w_in, [W_A, W_A, W_A, W_B, W_B, W_B])
    heads = lambda t: t.reshape(Bsz, S, -1, HEAD_DIM)
    ya = dilated_attention(heads(qa), heads(ka), heads(va)).reshape(Bsz, S, W_A)
    yb = moba_attention(heads(qb), heads(kb), heads(vb)).reshape(Bsz, S, W_B)
    return jnp.concatenate([ya, yb], axis=-1).astype(x.dtype) @ w_out


def mixer_cd(x, w_in, b_if, conv_w, conv_b, norm_g, w_out):
    Bsz, S, _ = x.shape
    qc, kc, vc, qkd, vd, od, gd = _split(x @ w_in, [W_C, W_C, W_C, 2 * QK_D, W_D, W_D, 2 * N_HEADS_D])
    hc = lambda t: t.reshape(Bsz, S, N_HEADS_C, HEAD_DIM)
    yc = stick_breaking_attention(hc(qc), hc(kc), hc(vc)).reshape(Bsz, S, W_C)
    qkd = jax.nn.silu(causal_dwconv(qkd, conv_w, conv_b))
    qd, kd = _split(qkd, [QK_D, QK_D])
    gates = gd + b_if
    h = mlstm_chunkwise(qd.reshape(Bsz, S, N_HEADS_D, DQK_D), kd.reshape(Bsz, S, N_HEADS_D, DQK_D),
                        vd.reshape(Bsz, S, N_HEADS_D, DV_D), gates[..., :N_HEADS_D], gates[..., N_HEADS_D:])
    mu = h.mean(-1, keepdims=True)
    var = jnp.mean(jnp.square(h - mu), -1, keepdims=True)
    h = ((h - mu) * lax.rsqrt(var + LN_EPS)).reshape(Bsz, S, W_D) * norm_g
    yd = jax.nn.sigmoid(od.astype(jnp.float32)) * h
    return jnp.concatenate([yc, yd.astype(x.dtype)], axis=-1).astype(x.dtype) @ w_out


def conv_ffn(x, w_up, w_gate, conv_w, conv_b, w_down):
    u = x @ w_up
    g = causal_dwconv(x @ w_gate, conv_w, conv_b)
    return (jax.nn.silu(g) * u) @ w_down


def setup_inputs(seed: int = 0) -> dict:
    key = jax.random.key(seed)
    ks = jax.random.split(key, 18)
    nrm = lambda k, shape, scale: jax.random.normal(k, shape, jnp.float32) * scale
    NE, NO = N_EVEN, N_ODD
    x = nrm(ks[0], (BATCH, SEQ, D_MODEL), 1.0)
    w_in_ab = nrm(ks[1], (NE, D_MODEL, IN_AB), D_MODEL ** -0.5)
    w_out_ab = nrm(ks[2], (NE, MIX_AB, D_MODEL), BETA * MIX_AB ** -0.5)
    w_in_cd = nrm(ks[3], (NO, D_MODEL, IN_CD), D_MODEL ** -0.5)
    b_if_cd = jnp.concatenate([
        nrm(ks[4], (NO, N_HEADS_D), 0.1),
        jnp.broadcast_to(jnp.linspace(3.0, 6.0, N_HEADS_D), (NO, N_HEADS_D)) + nrm(ks[5], (NO, N_HEADS_D), 0.1)], axis=-1)
    conv_cd = nrm(ks[6], (NO, CONV_D, 2 * QK_D), CONV_D ** -0.5)
    conv_cd_b = nrm(ks[7], (NO, 2 * QK_D), 0.02)
    norm_cd_g = 1.0 + nrm(ks[8], (NO, W_D), 0.02)
    w_out_cd = nrm(ks[9], (NO, MIX_CD, D_MODEL), BETA * MIX_CD ** -0.5)
    ffn_w_up = nrm(ks[10], (DEPTH, D_MODEL, D_FF), D_MODEL ** -0.5)
    ffn_w_gate = nrm(ks[11], (DEPTH, D_MODEL, D_FF), D_MODEL ** -0.5)
    ffn_conv = nrm(ks[12], (DEPTH, FFN_CONV, D_FF), FFN_CONV ** -0.5)
    ffn_conv_b = nrm(ks[13], (DEPTH, D_FF), 0.02)
    ffn_w_down = nrm(ks[14], (DEPTH, D_FF, D_MODEL), BETA * D_FF ** -0.5)
    ln_g = 1.0 + nrm(ks[15], (DEPTH, 2, D_MODEL), 0.02)
    ln_b = nrm(ks[16], (DEPTH, 2, D_MODEL), 0.02)
    return {"x": x, "w_in_ab": w_in_ab, "w_out_ab": w_out_ab, "w_in_cd": w_in_cd,
            "b_if_cd": b_if_cd, "conv_cd": conv_cd, "conv_cd_b": conv_cd_b, "norm_cd_g": norm_cd_g,
            "w_out_cd": w_out_cd, "ffn_w_up": ffn_w_up, "ffn_w_gate": ffn_w_gate, "ffn_conv": ffn_conv,
            "ffn_conv_b": ffn_conv_b, "ffn_w_down": ffn_w_down, "ln_g": ln_g, "ln_b": ln_b}


def reference(x, w_in_ab, w_out_ab, w_in_cd, b_if_cd, conv_cd, conv_cd_b, norm_cd_g, w_out_cd,
              ffn_w_up, ffn_w_gate, ffn_conv, ffn_conv_b, ffn_w_down, ln_g, ln_b):
    for l in range(DEPTH):
        j = l // 2
        if l % 2 == 0:
            y = mixer_ab(x, w_in_ab[j], w_out_ab[j])
        else:
            y = mixer_cd(x, w_in_cd[j], b_if_cd[j], conv_cd[j], conv_cd_b[j], norm_cd_g[j], w_out_cd[j])
        x = layer_norm(ALPHA * x + y, ln_g[l, 0], ln_b[l, 0])
        y = conv_ffn(x, ffn_w_up[l], ffn_w_gate[l], ffn_conv[l], ffn_conv_b[l], ffn_w_down[l])
        x = layer_norm(ALPHA * x + y, ln_g[l, 1], ln_b[l, 1])
    return x
```

```cpp
#include <hip/hip_runtime.h>
#include <cstdio>
#include <cstdint>

#define LAS __attribute__((address_space(3)))
#define GAS __attribute__((address_space(1)))
typedef unsigned short bf16;
typedef short bf16x8 __attribute__((ext_vector_type(8)));
typedef short s16x4 __attribute__((ext_vector_type(4)));
typedef float f32x16 __attribute__((ext_vector_type(16)));
typedef float f32x4 __attribute__((ext_vector_type(4)));
typedef float f32x2 __attribute__((ext_vector_type(2)));
typedef unsigned u32x4 __attribute__((ext_vector_type(4)));
typedef unsigned u32x2 __attribute__((ext_vector_type(2)));

#ifndef SKIP_MIX
#define SKIP_MIX 0
#endif
#ifndef PH_MASK
#define PH_MASK 0xFFFF
#endif
#define PH(x) if constexpr ((PH_MASK & (x)) != 0)

constexpr int BATCH = 8, SEQ = 2048, DM = 4096, M = BATCH * SEQ;
constexpr int DFF = 11008, N_AB = 12288, N_CD = 12304, N_CDP = 12544;
constexpr float ALPHA = 1.4142135623730951f;
constexpr float LN_EPS = 1e-5f;
constexpr int NWAVES = 8;

constexpr size_t MiB = 1u << 20;
constexpr size_t WS_CTL = 0, CTL_ZERO_BYTES = 1 * MiB;
constexpr size_t WS_KMEAN = 1 * MiB;
constexpr size_t WS_GATES = 2 * MiB;
constexpr size_t WS_A2 = 3 * MiB;
constexpr size_t WS_M2 = 3 * MiB + 512 * 1024;
constexpr size_t WS_NM = 4 * MiB;
constexpr size_t WS_W_INAB = 8 * MiB, WS_W_OUTAB = 104 * MiB, WS_W_UG0 = 136 * MiB, WS_W_DN0 = 308 * MiB;
constexpr size_t WS_W_INCD = 394 * MiB, WS_W_OUTCD = 492 * MiB, WS_W_UG1 = 524 * MiB, WS_W_DN1 = 696 * MiB;
constexpr size_t WS_XB = 782 * MiB;
constexpr size_t WS_R = 910 * MiB;
constexpr size_t WS_QKV = WS_R, WS_Y = WS_R + 384 * MiB, WS_QKDC = WS_R + 512 * MiB, WS_HD = WS_R + 576 * MiB;
constexpr size_t WS_U = WS_R, WS_G = WS_R + 344 * MiB;
constexpr size_t WS_END = WS_R + 688 * MiB;
static_assert((size_t)M * DFF * 2 == 344 * MiB, "u/g size");
constexpr int CW_BAR = 4096;

constexpr int RING_BYTES = 131072;
constexpr int MISC_OFF = RING_BYTES + 320;
constexpr int LDS_BYTES = 147456;

#define LDS_WAIT() asm volatile("s_waitcnt lgkmcnt(0)" ::: "memory")
#define VM_WAIT() asm volatile("s_waitcnt vmcnt(0)" ::: "memory")
#define SBAR() __builtin_amdgcn_sched_barrier(0)
#define WG_BAR() do { asm volatile("" ::: "memory"); __builtin_amdgcn_s_barrier(); asm volatile("" ::: "memory"); } while (0)

__device__ __forceinline__ unsigned cvtpk(float lo, float hi) { unsigned r; asm volatile("v_cvt_pk_bf16_f32 %0, %1, %2" : "=v"(r) : "v"(lo), "v"(hi)); return r; }
__device__ __forceinline__ float bf_lo(unsigned w) { return __uint_as_float(w << 16); }
__device__ __forceinline__ float bf_hi(unsigned w) { return __uint_as_float(w & 0xffff0000u); }
__device__ __forceinline__ float wave_sum(float v) {
#pragma unroll
    for (int o = 1; o < 64; o <<= 1) v += __shfl_xor(v, o);
    return v;
}
__device__ __forceinline__ float silu_f(float y) { return y * __builtin_amdgcn_rcpf(1.0f + __builtin_amdgcn_exp2f(-1.4426950408889634f * y)); }

namespace pg8 {
typedef unsigned short bf16_t;
constexpr int BM = 256, BK = 64, HALF = 128, HTB = HALF * BK * 2, STAGE_BYTES = 8 * HTB, NXCD = 8, WGM = 8;
__host__ __device__ __forceinline__ int lds_byte(int r, int c) { const int st = (r >> 4) * 2 + (c >> 5), rr = r & 15, cc = c & 31, ob = rr * 64 + cc * 2; return st * 1024 + (ob ^ (((ob >> 9) & 1) << 5)); }
__host__ __device__ __forceinline__ void stage_rc(int b, int& R, int& C) { const int st = b / 1024, sb = b % 1024, swz = sb ^ (((sb >> 9) & 1) << 5); R = (st >> 1) * 16 + swz / 64; C = (st & 1) * 32 + (swz % 64) / 2; }
__host__ __device__ __forceinline__ int perm32(int rho) { const int n = rho >> 4, i = rho & 15; return 8 * (i >> 2) + 4 * n + (i & 3); }
struct Unit { int pm, pn; };
struct Gemm { const bf16_t* A; const bf16_t* Bt; int M, N, K; };
struct StaticOrder {
    int nM, nN, nwg, G, c;
    __host__ __device__ void init(int M_, int N_, int G_, int c_) { nM = M_ / BM; nN = N_ / BM; nwg = nM * nN; G = G_; c = c_; }
    __host__ __device__ bool next(int i, Unit& u) const {
        const long L = (long)i * G + c; if (L >= nwg) return false;
        int wgid = (int)L; { const int q = nwg / NXCD, r = nwg % NXCD, xcd = wgid % NXCD, off = wgid / NXCD; wgid = (xcd < r ? xcd * (q + 1) : r * (q + 1) + (xcd - r) * q) + off; }
        const int nig = WGM * nN, gid = wgid / nig, fm = gid * WGM, gsz = (nM - fm) < WGM ? (nM - fm) : WGM;
        u.pm = fm + ((wgid % nig) % gsz); u.pn = (wgid % nig) / gsz; return true;
    }
    __device__ __forceinline__ void a_ready(const Unit&) const {}
    __device__ __forceinline__ void done(const Unit&) const {}
};
struct EpiBf16 {
    static constexpr bool PERM = true, AFTER_DRAIN = false;
    bf16_t* O; int ldc; int split_cols; size_t split_stride; float* gates; int gate_pn;
    __device__ __forceinline__ void operator()(const f32x4 (&acc)[2][2][4][2], const Unit& u, int wr, int wc, int fr, int fq) const {
        const int row0 = u.pm * BM + wr * 64 + fr;
        if (u.pn == gate_pn) {
            if (wc == 0 && fq < 2) {
#pragma unroll
                for (int ai = 0; ai < 2; ++ai)
#pragma unroll
                    for (int m = 0; m < 4; ++m) { float* gp = gates + (size_t)(row0 + ai * HALF + m * 16) * 16 + 8 * fq;
                        *(GAS f32x4*)gp = acc[ai][0][m][0]; *(GAS f32x4*)(gp + 4) = acc[ai][0][m][1]; }
            }
            return;
        }
        int colt = u.pn * BM; bf16_t* base = O;
        if (split_cols) { const int t = colt / split_cols; base += (size_t)t * split_stride; colt -= t * split_cols; }
        const int col0 = colt + wc * 32 + 8 * fq;
#pragma unroll
        for (int ai = 0; ai < 2; ++ai)
#pragma unroll
            for (int m = 0; m < 4; ++m) { bf16_t* rowp = base + (size_t)(row0 + ai * HALF + m * 16) * ldc + col0;
#pragma unroll
                for (int bj = 0; bj < 2; ++bj) { const f32x4 v0 = acc[ai][bj][m][0], v1 = acc[ai][bj][m][1];
                    u32x4 w; w.x = cvtpk(v0[0], v0[1]); w.y = cvtpk(v0[2], v0[3]); w.z = cvtpk(v1[0], v1[1]); w.w = cvtpk(v1[2], v1[3]);
                    *(u32x4*)(rowp + bj * HALF) = w; } }
    }
};
struct EpiResid {
    static constexpr bool PERM = false, AFTER_DRAIN = false;
    const float* base; float* out; int ldc; float alpha;
    __device__ __forceinline__ void operator()(const f32x4 (&acc)[2][2][4][2], const Unit& u, int wr, int wc, int fr, int fq) const {
        const int row0 = u.pm * BM + wr * 64 + fr, col0 = u.pn * BM + wc * 32 + 4 * fq;
#pragma unroll
        for (int ai = 0; ai < 2; ++ai)
#pragma unroll
            for (int m = 0; m < 4; ++m) { const size_t off = (size_t)(row0 + ai * HALF + m * 16) * ldc + col0;
                f32x4 bs[2][2];
#pragma unroll
                for (int bj = 0; bj < 2; ++bj)
#pragma unroll
                    for (int n = 0; n < 2; ++n) bs[bj][n] = *(const f32x4*)(base + off + bj * HALF + n * 16);
#pragma unroll
                for (int bj = 0; bj < 2; ++bj)
#pragma unroll
                    for (int n = 0; n < 2; ++n) *(f32x4*)(out + off + bj * HALF + n * 16) = bs[bj][n] * alpha + acc[ai][bj][m][n];
                asm volatile("" ::: "memory"); }
    }
};

template <class Epi, class Sched, bool ALIGN_EPI = false, bool SP2 = false>
__device__ __forceinline__ void gemm_phase(LAS unsigned char* lds, const Gemm g, const Sched& S, const Epi& E) {
    int tid_ = threadIdx.x; asm volatile("" : "+v"(tid_));
    const int tid = tid_, wid = __builtin_amdgcn_readfirstlane(tid >> 6), lane = tid & 63, wr = wid >> 2, wc = wid & 3, fr = lane & 15, fq = lane >> 4;
    const int K = g.K, nt = K / BK;
    unsigned voffA[2], voffB[2];
#pragma unroll
    for (int i = 0; i < 2; ++i) { int R, C; stage_rc(tid * 16 + i * 8192, R, C); const int Rb = Epi::PERM ? ((R & ~31) + perm32(R & 31)) : R;
        voffA[i] = (unsigned)(R * K + C) * 2u; voffB[i] = (unsigned)(Rb * K + C) * 2u; }
    const size_t kstep = (size_t)(BK * 2);
    const size_t hstep = (size_t)HALF * K * 2;
    const size_t tstep = 2 * hstep;
    const unsigned ldsw = (unsigned)wid * 1024u;
    const int aoff = lds_byte(wr * 64 + fr, fq * 8), boff = lds_byte(wc * 32 + fr, fq * 8);
#define PG8_SA(b, h) (((b) * 2 + (h)) * HTB)
#define PG8_SB(b, h) ((4 + (b) * 2 + (h)) * HTB)
#define PG8_STAGE(bufoff, gbase, voff) do { _Pragma("unroll") for (int _i = 0; _i < 2; ++_i) \
        __builtin_amdgcn_global_load_lds((const unsigned*)((const char*)(gbase) + (voff)[_i]), (LAS unsigned*)(lds + (bufoff) + ldsw + _i * 8192), 16, 0, 0); } while (0)
#define PG8_LDA(dst, b, h) do { _Pragma("unroll") for (int m = 0; m < 4; ++m) _Pragma("unroll") for (int k = 0; k < 2; ++k) dst[m][k] = *(const LAS bf16x8*)(lds + PG8_SA(b, h) + aoff + m * 2048 + k * 1024); } while (0)
#define PG8_LDB(dst, b, h) do { _Pragma("unroll") for (int n = 0; n < 2; ++n) _Pragma("unroll") for (int k = 0; k < 2; ++k) dst[n][k] = *(const LAS bf16x8*)(lds + PG8_SB(b, h) + boff + n * 2048 + k * 1024); } while (0)
#define PG8_MMA(ai, bj, At, Bt) do { __builtin_amdgcn_s_setprio(1); _Pragma("unroll") for (int m = 0; m < 4; ++m) _Pragma("unroll") for (int n = 0; n < 2; ++n) _Pragma("unroll") for (int k = 0; k < 2; ++k) \
        acc[ai][bj][m][n] = __builtin_amdgcn_mfma_f32_16x16x32_bf16(Bt[n][k], At[m][k], acc[ai][bj][m][n], 0, 0, 0); __builtin_amdgcn_s_setprio(0); } while (0)
#define PG8_WAIT_V(n) asm volatile("s_waitcnt vmcnt(" #n ")" ::: "memory")
#define PG8_WAIT_L(n) asm volatile("s_waitcnt lgkmcnt(" #n ")" ::: "memory")
#define PG8_BAR __builtin_amdgcn_s_barrier()
#define PG8_SCHED __builtin_amdgcn_sched_barrier(0)
    Unit cur, nxt; int ui = 0;
    if (!S.next(0, cur)) return;
    f32x4 acc[2][2][4][2];
#pragma unroll
    for (int a = 0; a < 2; ++a)
#pragma unroll
        for (int b = 0; b < 2; ++b)
#pragma unroll
            for (int m = 0; m < 4; ++m)
#pragma unroll
                for (int n = 0; n < 2; ++n) acc[a][b][m][n] = (f32x4){0.f, 0.f, 0.f, 0.f};
    bf16x8 At[4][2], B0[2][2], B1[2][2];
    const char* cA = (const char*)g.A + (size_t)cur.pm * tstep; const char* cB = (const char*)g.Bt + (size_t)cur.pn * tstep;
    S.a_ready(cur);
    if constexpr (SP2) {
        PG8_STAGE(PG8_SB(0, 0), cB, voffB); PG8_STAGE(PG8_SB(0, 1), cB + hstep, voffB); PG8_STAGE(PG8_SA(0, 0), cA, voffA); PG8_STAGE(PG8_SA(0, 1), cA + hstep, voffA);
        if (wr == 1) PG8_BAR;
        PG8_WAIT_V(2); PG8_BAR;
        PG8_STAGE(PG8_SB(1, 0), cB + kstep, voffB); PG8_STAGE(PG8_SA(1, 0), cA + kstep, voffA); PG8_STAGE(PG8_SB(1, 1), cB + hstep + kstep, voffB);
        PG8_WAIT_V(6); PG8_BAR;
    } else {
        PG8_STAGE(PG8_SB(0, 0), cB, voffB); PG8_STAGE(PG8_SA(0, 0), cA, voffA); PG8_STAGE(PG8_SB(0, 1), cB + hstep, voffB); PG8_STAGE(PG8_SA(0, 1), cA + hstep, voffA);
        if (wr == 1) PG8_BAR;
        PG8_WAIT_V(4); PG8_BAR;
        PG8_STAGE(PG8_SB(1, 0), cB + kstep, voffB); PG8_STAGE(PG8_SA(1, 0), cA + kstep, voffA); PG8_STAGE(PG8_SB(1, 1), cB + hstep + kstep, voffB);
        PG8_WAIT_V(6); PG8_BAR;
    }
    for (;;) {
        const bool has_next = S.next(ui + 1, nxt);
        const char* nA = has_next ? (const char*)g.A + (size_t)nxt.pm * tstep : cA; const char* nB = has_next ? (const char*)g.Bt + (size_t)nxt.pn * tstep : cB;
        for (int t = 0; t < nt; t += 2) {
            const bool last = (t == nt - 2);
            const char* a1 = cA + (size_t)(t + 1) * kstep;
            const char* a2 = last ? nA : cA + (size_t)(t + 2) * kstep; const char* b2 = last ? nB : cB + (size_t)(t + 2) * kstep;
            const char* a3 = a2 + kstep; const char* b3 = b2 + kstep;
            if (last && has_next) S.a_ready(nxt);
            if constexpr (SP2) {
            PG8_LDB(B0, 0, 0); PG8_LDB(B1, 0, 1); PG8_SCHED; PG8_LDA(At, 0, 0); PG8_STAGE(PG8_SA(1, 1), a1 + hstep, voffA);
            PG8_WAIT_V(8); PG8_WAIT_L(0); PG8_BAR; PG8_MMA(0, 0, At, B0); PG8_MMA(0, 1, At, B1); PG8_BAR; PG8_SCHED;
            PG8_LDA(At, 0, 1); PG8_STAGE(PG8_SB(0, 0), b2, voffB); PG8_STAGE(PG8_SB(0, 1), b2 + hstep, voffB); PG8_STAGE(PG8_SA(0, 0), a2, voffA);
            PG8_WAIT_V(8); PG8_WAIT_L(0); PG8_BAR; PG8_MMA(1, 0, At, B0); PG8_MMA(1, 1, At, B1); PG8_BAR; PG8_SCHED;
            PG8_LDB(B0, 1, 0); PG8_LDB(B1, 1, 1); PG8_SCHED; PG8_LDA(At, 1, 0); PG8_STAGE(PG8_SA(0, 1), a2 + hstep, voffA);
            PG8_WAIT_V(8); PG8_WAIT_L(0); PG8_BAR; PG8_MMA(0, 0, At, B0); PG8_MMA(0, 1, At, B1); PG8_BAR; PG8_SCHED;
            PG8_LDA(At, 1, 1); PG8_STAGE(PG8_SB(1, 0), b3, voffB); PG8_STAGE(PG8_SB(1, 1), b3 + hstep, voffB); PG8_STAGE(PG8_SA(1, 0), a3, voffA);
            PG8_WAIT_V(8); PG8_WAIT_L(0); PG8_BAR; PG8_MMA(1, 0, At, B0); PG8_MMA(1, 1, At, B1); PG8_BAR; PG8_SCHED;
            } else {
            PG8_LDB(B0, 0, 0); PG8_SCHED; PG8_LDA(At, 0, 0); PG8_STAGE(PG8_SA(1, 1), a1 + hstep, voffA);
            PG8_WAIT_L(8); PG8_BAR; PG8_WAIT_L(0); PG8_MMA(0, 0, At, B0); PG8_BAR; PG8_SCHED;
            PG8_LDB(B1, 0, 1); PG8_STAGE(PG8_SB(0, 0), b2, voffB);
            PG8_BAR; PG8_WAIT_L(0); PG8_MMA(0, 1, At, B1); PG8_BAR;
            PG8_LDA(At, 0, 1); PG8_STAGE(PG8_SA(0, 0), a2, voffA);
            PG8_BAR; PG8_WAIT_L(0); PG8_MMA(1, 0, At, B0); PG8_BAR; PG8_SCHED;
            PG8_STAGE(PG8_SB(0, 1), b2 + hstep, voffB);
            PG8_WAIT_V(6); PG8_BAR; PG8_MMA(1, 1, At, B1); PG8_BAR;
            PG8_LDB(B0, 1, 0); PG8_SCHED; PG8_LDA(At, 1, 0); PG8_STAGE(PG8_SA(0, 1), a2 + hstep, voffA);
            PG8_WAIT_L(8); PG8_BAR; PG8_WAIT_L(0); PG8_MMA(0, 0, At, B0); PG8_BAR; PG8_SCHED;
            PG8_LDB(B1, 1, 1); PG8_STAGE(PG8_SB(1, 0), b3, voffB);
            PG8_BAR; PG8_WAIT_L(0); PG8_MMA(0, 1, At, B1); PG8_BAR;
            PG8_LDA(At, 1, 1); PG8_STAGE(PG8_SA(1, 0), a3, voffA);
            PG8_BAR; PG8_WAIT_L(0); PG8_MMA(1, 0, At, B0); PG8_BAR; PG8_SCHED;
            PG8_STAGE(PG8_SB(1, 1), b3 + hstep, voffB);
            PG8_WAIT_V(6); PG8_BAR; PG8_MMA(1, 1, At, B1); PG8_BAR;
            }
        }
        if constexpr (ALIGN_EPI) { if (wr == 0) PG8_BAR; }
        if constexpr (!Epi::AFTER_DRAIN) { E(acc, cur, wr, wc, fr, fq); S.done(cur); }
        if (!has_next) break;
#pragma unroll
        for (int a = 0; a < 2; ++a)
#pragma unroll
            for (int b = 0; b < 2; ++b)
#pragma unroll
                for (int m = 0; m < 4; ++m)
#pragma unroll
                    for (int n = 0; n < 2; ++n) acc[a][b][m][n] = (f32x4){0.f, 0.f, 0.f, 0.f};
        cur = nxt; cA = nA; cB = nB; ++ui;
        if constexpr (ALIGN_EPI) { if (wr == 1) PG8_BAR; }
    }
    PG8_WAIT_V(0);
    if constexpr (!ALIGN_EPI) { if (wr == 0) PG8_BAR; }
    PG8_BAR;
#undef PG8_SA
#undef PG8_SB
#undef PG8_STAGE
#undef PG8_LDA
#undef PG8_LDB
#undef PG8_MMA
#undef PG8_WAIT_V
#undef PG8_WAIT_L
#undef PG8_BAR
#undef PG8_SCHED
}
}

#define XB_TMO      128
#define XB_XCNT(j)  (256  + 64 * (j))
#define XB_XSUB(j)  (1280 + 64 * (j))
#define XB_XGEN(j)  (2304 + 64 * (j))
#define XB_TOP      3328
#define XB_TOPGEN   3392
#define XCD_BAR_WORDS 3456
#define XB_SPIN_CAP (1u << 18)
__device__ __forceinline__ unsigned xb_ld(unsigned* p)              { return __hip_atomic_load((GAS unsigned*)p, __ATOMIC_RELAXED, __HIP_MEMORY_SCOPE_AGENT); }
__device__ __forceinline__ unsigned xb_add(unsigned* p, unsigned v) { return __hip_atomic_fetch_add((GAS unsigned*)p, v, __ATOMIC_RELAXED, __HIP_MEMORY_SCOPE_AGENT); }
__device__ __forceinline__ unsigned xb_xcc_id() { return (unsigned)__builtin_amdgcn_s_getreg((3 << 11) | 20) & 0xFu; }
#define XB_SPIN(cond, bar) do { unsigned _sp = 0; while (cond) { __builtin_amdgcn_s_sleep(1); \
    if ((++_sp & 255u) == 0u) { if (xb_ld(&(bar)[XB_TMO])) break; if (_sp > XB_SPIN_CAP) { (void)xb_add(&(bar)[XB_TMO], 1u); break; } } } } while (0)
struct XcdBarrier { unsigned* bar; unsigned x; volatile LAS unsigned* st; };
__device__ __forceinline__ XcdBarrier xcd_barrier_post(unsigned* bar, volatile LAS unsigned* st) {
    XcdBarrier b; b.bar = bar; b.x = xb_xcc_id(); b.st = st;
    if (threadIdx.x == 0) (void)xb_add(&bar[XB_XCNT(b.x)], 1u);
    return b;
}
__device__ __forceinline__ void xcd_barrier_complete(unsigned* bar, unsigned x, unsigned& nloc, unsigned& nx) {
    const unsigned G = gridDim.x * gridDim.y * gridDim.z;
    unsigned sum, cnt, mine, sp = 0u;
    for (;;) {
        sum = 0u; cnt = 0u; mine = 0u;
#pragma unroll
        for (unsigned j = 0; j < 16; ++j) { const unsigned c = xb_ld(&bar[XB_XCNT(j)]); sum += c; cnt += (c > 0u) ? 1u : 0u; mine = (j == x) ? c : mine; }
        if (sum == G) break;
        __builtin_amdgcn_s_sleep(1);
        if ((++sp & 255u) == 0u) { if (xb_ld(&bar[XB_TMO])) break; if (sp > XB_SPIN_CAP) { (void)xb_add(&bar[XB_TMO], 1u); break; } }
    }
    nloc = mine > 0u ? mine : 1u; nx = cnt > 0u ? cnt : 1u;
}
__device__ __forceinline__ void xcd_barrier(const XcdBarrier& b) {
    asm volatile("s_waitcnt vmcnt(0)" ::: "memory");
    __syncthreads();
    if (threadIdx.x == 0) {
        unsigned* bar = b.bar; unsigned bx = b.x;
        asm volatile("" : "+s"(bar), "+s"(bx));
        __builtin_amdgcn_s_waitcnt(0);
        unsigned nloc = b.st[0], nx = b.st[1];
        if (nloc == 0u) { xcd_barrier_complete(bar, bx, nloc, nx); b.st[0] = nloc; b.st[1] = nx; }
        const unsigned old = xb_add(&bar[XB_XSUB(bx)], 1u);
        const unsigned gen = old / nloc;
        if (old + 1u == (gen + 1u) * nloc) {
            __builtin_amdgcn_fence(__ATOMIC_RELEASE, "agent");
            asm volatile("s_waitcnt vmcnt(0)" ::: "memory");
            const unsigned og = xb_add(&bar[XB_TOP], 1u);
            const unsigned tg = og / nx;
            if (og + 1u == (tg + 1u) * nx) xb_add(&bar[XB_TOPGEN], 1u);
            else XB_SPIN(xb_ld(&bar[XB_TOPGEN]) == tg, bar);
            __builtin_amdgcn_fence(__ATOMIC_ACQUIRE, "agent");
            xb_add(&bar[XB_XGEN(bx)], 1u);
            asm volatile("s_waitcnt vmcnt(0)" ::: "memory");
        } else {
            XB_SPIN(xb_ld(&bar[XB_XGEN(bx)]) == gen, bar);
            __builtin_amdgcn_fence(__ATOMIC_ACQUIRE, "agent");
            asm volatile("s_waitcnt vmcnt(0)" ::: "memory");
        }
    }
    __syncthreads();
}

namespace att {
constexpr int D = 128, SHM = 16384;
constexpr int OFF_V = 0, OFF_K = 2 * SHM, OFF_WS = 4 * SHM, OFF_AUX = 4 * SHM + 2048, LDS_USED = 4 * SHM + 2048 + 8192;
constexpr float SCALE = 0.08838834764831845f;
constexpr float C2 = 1.4426950408889634f * SCALE;
constexpr float THR = 8.f;
enum { MODE_DIL = 0, MODE_MOBA = 1, MODE_SB = 2, MODE_ML = 3 };
#define KSWZ(row, colB) ((row) * 256 + ((colB) ^ (((row) & 7) << 4)))
__device__ __forceinline__ int v_st(int k, int c) { const int kk = (k & ~0xC) | ((k & 4) << 1) | ((k & 8) >> 1); return ((kk >> 3) * 4 + (c >> 5)) * 512 + ((kk & 7) * 32 + (c & 31)) * 2; }
__device__ __forceinline__ int v_rd_base(int lane) { return ((lane & 3) << 3) | (((lane >> 2) & 3) << 6) | (((lane >> 4) & 1) << 5) | (((lane >> 5) & 1) << 8); }
__device__ __forceinline__ int crow(int r, int hi) { return (r & 3) + 8 * (r >> 2) + 4 * hi; }
__device__ __forceinline__ void mask_tile(f32x16& p0, f32x16& p1, int dq) {
    const float NEG = -__builtin_inff();
#pragma unroll
    for (int r = 0; r < 16; ++r) {
        const int c = (r & 3) + 8 * (r >> 2);
        if (dq - c < 0) p0[r] = NEG;
        if (dq - c - 32 < 0) p1[r] = NEG;
    }
}
__device__ __forceinline__ void partialSM(f32x16& p0, f32x16& p1, float& m_reg, float& mn, float& alpha) {
    float pmax = p0[0];
#pragma unroll
    for (int r = 1; r < 16; ++r) pmax = fmaxf(pmax, p0[r]);
#pragma unroll
    for (int r = 0; r < 16; ++r) pmax = fmaxf(pmax, p1[r]);
    { auto rr = __builtin_amdgcn_permlane32_swap(__float_as_uint(pmax), __float_as_uint(pmax), false, false);
      pmax = fmaxf(__uint_as_float(rr[0]), __uint_as_float(rr[1])); }
    if (__builtin_expect(__all((pmax - m_reg) * SCALE <= THR), 1)) { mn = m_reg; alpha = 1.f; }
    else { mn = fmaxf(m_reg, pmax); alpha = __builtin_amdgcn_exp2f((m_reg - mn) * C2); m_reg = mn; }
    const float mnL = -mn * C2;
#pragma unroll
    for (int r = 0; r < 16; ++r) p0[r] = fmaf(p0[r], C2, mnL);
#pragma unroll
    for (int r = 0; r < 16; ++r) p1[r] = fmaf(p1[r], C2, mnL);
#pragma unroll
    for (int r = 0; r < 16; ++r) p0[r] = __builtin_amdgcn_exp2f(p0[r]);
#pragma unroll
    for (int r = 0; r < 16; ++r) p1[r] = __builtin_amdgcn_exp2f(p1[r]);
}
#define ATT_PK4(P, B_, OUT) do { unsigned a0 = cvtpk(P[B_+0], P[B_+1]), a1 = cvtpk(P[B_+2], P[B_+3]);                          \
        unsigned b0 = cvtpk(P[B_+4], P[B_+5]), b1 = cvtpk(P[B_+6], P[B_+7]);                                             \
        auto r0 = __builtin_amdgcn_permlane32_swap(a0, b0, false, false); auto r1 = __builtin_amdgcn_permlane32_swap(a1, b1, false, false); \
        u32x4 w = {r0[0], r1[0], r0[1], r1[1]}; OUT = *reinterpret_cast<bf16x8*>(&w); } while (0)
__device__ __forceinline__ void pack_p(const f32x16& p0, const f32x16& p1, bf16x8& pa0, bf16x8& pa1, bf16x8& pa2, bf16x8& pa3) {
    ATT_PK4(p0, 0, pa0); ATT_PK4(p0, 8, pa1); ATT_PK4(p1, 0, pa2); ATT_PK4(p1, 8, pa3);
}
__device__ __forceinline__ float pair_sum(float v) {
    auto rr = __builtin_amdgcn_permlane32_swap(__float_as_uint(v), __float_as_uint(v), false, false);
    return __uint_as_float(rr[0]) + __uint_as_float(rr[1]);
}
__device__ __forceinline__ void qkt(f32x16& p0, f32x16& p1, const LAS char* Kb, int r32, int hi, const bf16x8* qr) {
#pragma unroll
    for (int r = 0; r < 16; ++r) { p0[r] = 0.f; p1[r] = 0.f; }
    const LAS char* kb[4];
#pragma unroll
    for (int dd = 0; dd < 4; ++dd) kb[dd] = Kb + KSWZ(r32, (dd * 16 + hi * 8) * 2);
#pragma unroll
    for (int d0 = 0; d0 < 8; ++d0) { const LAS char* a = kb[d0 & 3] + (d0 >> 2) * 128;
        const bf16x8 b0 = *reinterpret_cast<const LAS bf16x8*>(a);
        const bf16x8 b1 = *reinterpret_cast<const LAS bf16x8*>(a + 32 * 256);
        p0 = __builtin_amdgcn_mfma_f32_32x32x16_bf16(b0, qr[d0], p0, 0, 0, 0);
        p1 = __builtin_amdgcn_mfma_f32_32x32x16_bf16(b1, qr[d0], p1, 0, 0, 0); }
}
__device__ __forceinline__ void pv_tile(f32x16* o, int vb0, bf16x8 pa0, bf16x8 pa1, bf16x8 pa2, bf16x8 pa3) {
#define TRRD(dst, off) asm volatile("ds_read_b64_tr_b16 %0, %1 offset:%2" : "=&v"(dst) : "v"(vb0), "i"(off) : "memory")
#define PV_D0(d0) do { s16x4 l0, l1, l2, l3, h0, h1, h2, h3; constexpr int b_ = (d0) * 512; \
        TRRD(l0, b_); TRRD(h0, b_ + 2048); TRRD(l1, b_ + 4096); TRRD(h1, b_ + 6144); TRRD(l2, b_ + 8192); TRRD(h2, b_ + 10240); TRRD(l3, b_ + 12288); TRRD(h3, b_ + 14336); \
        asm volatile("s_waitcnt lgkmcnt(0)" ::: "memory"); SBAR();   \
        o[d0] = __builtin_amdgcn_mfma_f32_32x32x16_bf16(pa0, (bf16x8){l0[0], l0[1], l0[2], l0[3], h0[0], h0[1], h0[2], h0[3]}, o[d0], 0, 0, 0);   \
        o[d0] = __builtin_amdgcn_mfma_f32_32x32x16_bf16(pa1, (bf16x8){l1[0], l1[1], l1[2], l1[3], h1[0], h1[1], h1[2], h1[3]}, o[d0], 0, 0, 0);   \
        o[d0] = __builtin_amdgcn_mfma_f32_32x32x16_bf16(pa2, (bf16x8){l2[0], l2[1], l2[2], l2[3], h2[0], h2[1], h2[2], h2[3]}, o[d0], 0, 0, 0);   \
        o[d0] = __builtin_amdgcn_mfma_f32_32x32x16_bf16(pa3, (bf16x8){l3[0], l3[1], l3[2], l3[3], h3[0], h3[1], h3[2], h3[3]}, o[d0], 0, 0, 0); } while (0)
    PV_D0(0); PV_D0(1); PV_D0(2); PV_D0(3);
#undef PV_D0
#undef TRRD
}

template <int MODE>
__device__ __forceinline__ void attn_block(const bf16* __restrict__ Qp, int ldq, const bf16* __restrict__ Kp, int ldk, const bf16* __restrict__ Vp, int ldv, bf16* __restrict__ Op, int ldo,
                                           int qb, LAS char* lds, const float* __restrict__ aux0, const float* __restrict__ aux1, const float* __restrict__ aux2) {
    int tid_ = threadIdx.x; asm volatile("" : "+v"(tid_));
    const int tid = tid_, wid = __builtin_amdgcn_readfirstlane(tid >> 6), lane = tid & 63, r32 = lane & 31, hi = lane >> 5;
    const int P0 = qb * 256, qlo = P0 + wid * 32, qpos = qlo + r32;
    const int NT = 4 * qb + 4;
    LAS char* V_lds = lds + OFF_V; LAS char* K_lds = lds + OFF_K;
    LAS float* wsf = (LAS float*)(lds + OFF_WS) + wid * 64; LAS float* li_l = wsf; LAS float* al_l = wsf + 32;
    LAS float* aux = (LAS float*)(lds + OFF_AUX);
    bf16x8 qr[8];
#pragma unroll
    for (int d0 = 0; d0 < 8; ++d0) qr[d0] = *reinterpret_cast<const bf16x8*>(Qp + (size_t)qpos * ldq + d0 * 16 + hi * 8);
    unsigned kso[2], vso[2];
#pragma unroll
    for (int i = 0; i < 2; ++i) { const int pc = 2 * wid + i, krow = pc * 4 + (lane >> 4), kch = (lane & 15) ^ (krow & 7);
        kso[i] = (unsigned)(krow * ldk + kch * 8) * 2u;
        const int kk = wid * 8 + ((lane & 31) >> 2), vk = (kk & ~0xC) | ((kk & 4) << 1) | ((kk & 8) >> 1), vc = (2 * i + (lane >> 5)) * 32 + (lane & 3) * 8;
        vso[i] = (unsigned)(vk * ldv + vc) * 2u; }
    const int vb0 = (int)(unsigned)(size_t)V_lds + v_rd_base(lane);
    float m_reg = -1e30f, l_reg = 0.f, Rsum = 0.f, den = 0.f, M2row = 0.f, nmrow = 1.f; unsigned sel = 0u;
    if constexpr (MODE == MODE_ML) { for (int i = tid; i < P0 + 256; i += 512) aux[i] = aux0[i]; M2row = aux1[qpos]; nmrow = aux2[qpos]; }
    if constexpr (MODE == MODE_MOBA) { for (int i = tid; i < qb * 128; i += 512) aux[i] = aux0[i]; }
#define TJ(i) ((MODE == MODE_SB) ? (NT - 1 - (i)) : (i))
#define SLOAD(kb_, bf) do { const char* kg_ = (const char*)(Kp + (size_t)(kb_) * ldk); const char* vg_ = (const char*)(Vp + (size_t)(kb_) * ldv); \
        _Pragma("unroll") for (int i_ = 0; i_ < 2; ++i_) { \
            __builtin_amdgcn_global_load_lds((const unsigned*)(kg_ + kso[i_]), (LAS unsigned*)(K_lds + (bf) * SHM + (2 * wid + i_) * 1024), 16, 0, 0); \
            __builtin_amdgcn_global_load_lds((const unsigned*)(vg_ + vso[i_]), (LAS unsigned*)(V_lds + (bf) * SHM + (2 * wid + i_) * 1024), 16, 0, 0); } } while (0)
    SLOAD(TJ(0) * 64, 0); VM_WAIT(); LDS_WAIT(); WG_BAR();
    if constexpr (MODE == MODE_MOBA) {
        if (qb <= 3) sel = (1u << qb) - 1u;
        else {
            float g[7];
#pragma unroll
            for (int n = 0; n < 7; ++n) { g[n] = -__builtin_inff();
                if (n < qb) { float s = 0.f;
#pragma unroll
                    for (int d0 = 0; d0 < 8; ++d0) { const LAS f32x4* kp = (const LAS f32x4*)(aux + n * 128 + d0 * 16 + hi * 8); const f32x4 k0 = kp[0], k1 = kp[1];
                        const u32x4 qw = *reinterpret_cast<const u32x4*>(&qr[d0]);
                        s = fmaf(bf_lo(qw.x), k0[0], s); s = fmaf(bf_hi(qw.x), k0[1], s); s = fmaf(bf_lo(qw.y), k0[2], s); s = fmaf(bf_hi(qw.y), k0[3], s);
                        s = fmaf(bf_lo(qw.z), k1[0], s); s = fmaf(bf_hi(qw.z), k1[1], s); s = fmaf(bf_lo(qw.w), k1[2], s); s = fmaf(bf_hi(qw.w), k1[3], s); }
                    g[n] = pair_sum(s); } }
#pragma unroll
            for (int k = 0; k < 3; ++k) { float best = -__builtin_inff(); int bi = 0;
#pragma unroll
                for (int n = 0; n < 7; ++n) if (g[n] > best) { best = g[n]; bi = n; }
                sel |= 1u << bi;
#pragma unroll
                for (int n = 0; n < 7; ++n) g[n] = (bi == n) ? -__builtin_inff() : g[n]; }
        }
    }
    f32x16 o[4];
#pragma unroll
    for (int d_ = 0; d_ < 4; ++d_)
#pragma unroll
        for (int r = 0; r < 16; ++r) o[d_][r] = 0.f;
    for (int i = 0; i < NT; ++i) {
        const int tj = TJ(i), kb = tj * 64, buf = i & 1;
        if (i + 1 < NT) SLOAD(TJ(i + 1) * 64, buf ^ 1);
        SBAR();
        bool act = (MODE == MODE_SB) ? (kb <= qlo + 30) : (kb <= qlo + 31);
        if constexpr (MODE == MODE_MOBA) { const int n = tj >> 2; if (n != qb) act = act && __any((int)((sel >> n) & 1u)); }
        if (act) {
            f32x16 p0, p1; bf16x8 pa0, pa1, pa2, pa3;
            qkt(p0, p1, K_lds + buf * SHM, r32, hi, qr);
            const int dq = qpos - kb - 4 * hi;
            if constexpr (MODE == MODE_DIL || MODE == MODE_MOBA) {
                if constexpr (MODE == MODE_DIL) {
#pragma unroll
                    for (int r = 0; r < 16; ++r) { const int c = (r & 3) + 8 * (r >> 2);
                        { const unsigned ud = (unsigned)(dq - c); const int cnt = (int)(ud <= 128u) + (int)(((ud & 3u) == 0u) & (ud <= 512u)) + (int)((ud & 0x8000000Fu) == 0u);
                          p0[r] += __builtin_amdgcn_logf((float)cnt) * (1.0f / C2); }
                        { const unsigned ud = (unsigned)(dq - c - 32); const int cnt = (int)(ud <= 128u) + (int)(((ud & 3u) == 0u) & (ud <= 512u)) + (int)((ud & 0x8000000Fu) == 0u);
                          p1[r] += __builtin_amdgcn_logf((float)cnt) * (1.0f / C2); } }
                } else {
                    const int n = tj >> 2;
                    if (n == qb) { if (kb + 63 > qlo) mask_tile(p0, p1, dq); }
                    else if (!((sel >> n) & 1u)) {
#pragma unroll
                        for (int r = 0; r < 16; ++r) { p0[r] = -__builtin_inff(); p1[r] = -__builtin_inff(); } }
                }
                float mn, alpha;
                partialSM(p0, p1, m_reg, mn, alpha);
                float ps = 0.f;
#pragma unroll
                for (int r = 0; r < 16; ++r) ps += p0[r];
#pragma unroll
                for (int r = 0; r < 16; ++r) ps += p1[r];
                ps = pair_sum(ps);
                l_reg = l_reg * alpha + ps;
                pack_p(p0, p1, pa0, pa1, pa2, pa3);
                if (__any(alpha < 1.f)) { if (hi == 0) al_l[r32] = alpha; LDS_WAIT();
#pragma unroll
                    for (int d_ = 0; d_ < 4; ++d_)
#pragma unroll
                        for (int r = 0; r < 16; ++r) o[d_][r] *= al_l[crow(r, hi)]; }
            } else if constexpr (MODE == MODE_ML) {
                float dsum = 0.f;
#pragma unroll
                for (int r4 = 0; r4 < 4; ++r4) {
                    const f32x4 a0 = *(const LAS f32x4*)(aux + kb + 8 * r4 + 4 * hi), a1 = *(const LAS f32x4*)(aux + kb + 32 + 8 * r4 + 4 * hi);
#pragma unroll
                    for (int j = 0; j < 4; ++j) { const int r = 4 * r4 + j, c = 8 * r4 + j;
                        float s0 = p0[r] * SCALE * __builtin_amdgcn_exp2f(a0[j] - M2row); s0 = (dq - c < 0) ? 0.f : s0;
                        float s1 = p1[r] * SCALE * __builtin_amdgcn_exp2f(a1[j] - M2row); s1 = (dq - c - 32 < 0) ? 0.f : s1;
                        p0[r] = s0; p1[r] = s1; dsum += s0 + s1; } }
                den += dsum;
                pack_p(p0, p1, pa0, pa1, pa2, pa3);
            } else {
                f32x16 z0, z1; float gs[8];
#pragma unroll
                for (int r = 0; r < 16; ++r) { const int c = (r & 3) + 8 * (r >> 2);
                    { const float z2 = p0[r] * C2; const float sp = fmaxf(z2, 0.f) + __builtin_amdgcn_logf(1.0f + __builtin_amdgcn_exp2f(-fabsf(z2)));
                      z0[r] = z2; const float spm = ((dq - 1 - c) >= 0) ? sp : 0.f; p0[r] = spm; if ((r & 3) == 0) gs[r >> 2] = spm; else gs[r >> 2] += spm; }
                    { const float z2 = p1[r] * C2; const float sp = fmaxf(z2, 0.f) + __builtin_amdgcn_logf(1.0f + __builtin_amdgcn_exp2f(-fabsf(z2)));
                      z1[r] = z2; const float spm = ((dq - 1 - c - 32) >= 0) ? sp : 0.f; p1[r] = spm; if ((r & 3) == 0) gs[4 + (r >> 2)] = spm; else gs[4 + (r >> 2)] += spm; } }
                float aft[8]; float run = 0.f;
#pragma unroll
                for (int i2 = 7; i2 >= 0; --i2) { const float pg = __shfl_xor(gs[i2], 32); aft[i2] = run + (hi == 0 ? pg : 0.f); run += gs[i2] + pg; }
#pragma unroll
                for (int i2 = 0; i2 < 8; ++i2) { float suf = Rsum + aft[i2];
#pragma unroll
                    for (int j = 3; j >= 0; --j) { const int r = 4 * (i2 & 3) + j, c = 8 * (i2 & 3) + j + ((i2 >> 2) ? 32 : 0);
                        const bool ok = (dq - 1 - c) >= 0;
                        if (i2 >> 2) { suf += p1[r]; p1[r] = ok ? __builtin_amdgcn_exp2f(z1[r] - suf) : 0.f; }
                        else { suf += p0[r]; p0[r] = ok ? __builtin_amdgcn_exp2f(z0[r] - suf) : 0.f; } } }
                Rsum += run;
                pack_p(p0, p1, pa0, pa1, pa2, pa3);
            }
            SBAR();
            pv_tile(o, vb0 + buf * SHM, pa0, pa1, pa2, pa3);
        }
        SBAR();
        VM_WAIT(); LDS_WAIT(); WG_BAR();
    }
    if constexpr (MODE == MODE_DIL || MODE == MODE_MOBA) { if (hi == 0) li_l[r32] = l_reg; }
    if constexpr (MODE == MODE_ML) { const float dt = pair_sum(den); if (hi == 0) li_l[r32] = fmaxf(fabsf(dt), nmrow); }
    LDS_WAIT();
    bf16* Ow = Op + (size_t)qlo * ldo;
#pragma unroll
    for (int r = 0; r < 16; ++r) { const int orow = crow(r, hi);
        float rl = 1.f; if constexpr (MODE != MODE_SB) rl = __builtin_amdgcn_rcpf(li_l[orow]);
#pragma unroll
        for (int d0 = 0; d0 < 4; ++d0) { const float v = o[d0][r] * rl; const float vn = __shfl_xor(v, 1);
            if ((r32 & 1) == 0) *(unsigned*)(Ow + (size_t)orow * ldo + d0 * 32 + r32) = cvtpk(v, vn); } }
    LDS_WAIT();
#undef TJ
#undef SLOAD
}
}

struct Args { const float* in[16]; float* out; unsigned char* ws; };
static_assert(sizeof(Args) == 18 * 8, "Args has no padding");

struct Frame {
    LAS unsigned char* lds; int tid, lane, wave, vcu, G, gw, NGW;
};

__device__ __forceinline__ void tr_item(const float* __restrict__ W, int K, int N, bf16* __restrict__ WT, int item, int nblk, LAS unsigned* scr, int lane) {
    const int kb = item / nblk, nb = item - kb * nblk, k0 = kb * 64, n0 = nb * 64;
    const int nq = lane & 15, kr = lane >> 4;
    const bool inb = (n0 + 4 * nq) < N;
    f32x4 a[8], b[8];
#pragma unroll
    for (int s = 0; s < 8; ++s) { const int kp = 4 * s + kr; const float* p = W + (size_t)(k0 + 2 * kp) * N + n0 + 4 * nq;
        if (inb) { a[s] = *(const f32x4*)p; b[s] = *(const f32x4*)(p + N); } else { a[s] = (f32x4){0.f, 0.f, 0.f, 0.f}; b[s] = (f32x4){0.f, 0.f, 0.f, 0.f}; } }
#pragma unroll
    for (int s = 0; s < 8; ++s) { const int kp = 4 * s + kr;
#pragma unroll
        for (int i = 0; i < 4; ++i) scr[(4 * nq + i) * 33 + kp] = cvtpk(a[s][i], b[s][i]); }
    LDS_WAIT();
#pragma unroll
    for (int jj = 0; jj < 8; ++jj) { const int n = (lane >> 3) + 8 * jj, c = lane & 7; const LAS unsigned* s = scr + n * 33 + 4 * c;
        u32x4 o; o.x = s[0]; o.y = s[1]; o.z = s[2]; o.w = s[3];
        *(u32x4*)(WT + (size_t)(n0 + n) * K + k0 + 8 * c) = o; }
    LDS_WAIT();
}

__device__ __forceinline__ void prologue(const Frame& F_, const Args& a) {
    Frame F = F_; asm volatile("" : "+v"(F.lane), "+v"(F.tid), "+s"(F.gw), "+s"(F.vcu), "+s"(F.wave));
    unsigned char* ws = a.ws;
    LAS unsigned* scr = (LAS unsigned*)(F.lds + F.wave * 8448);
    constexpr int I_INAB = 64 * 192, I_OUT = 64 * 64, I_INCD = 64 * 196, I_UP = 64 * 172, I_DN = 172 * 64;
    constexpr int TOTAL = I_INAB + I_OUT + I_INCD + I_OUT + 4 * I_UP + 2 * I_DN;
    for (int it = F.gw; it < TOTAL; it += F.NGW) {
        int r = it; const float* W; int K, N, nblk; bf16* WT;
        if (r < I_INAB) { W = a.in[1]; K = DM; N = N_AB; nblk = 192; WT = (bf16*)(ws + WS_W_INAB); }
        else if ((r -= I_INAB) < I_OUT) { W = a.in[2]; K = DM; N = DM; nblk = 64; WT = (bf16*)(ws + WS_W_OUTAB); }
        else if ((r -= I_OUT) < I_INCD) { W = a.in[3]; K = DM; N = N_CD; nblk = 196; WT = (bf16*)(ws + WS_W_INCD); }
        else if ((r -= I_INCD) < I_OUT) { W = a.in[8]; K = DM; N = DM; nblk = 64; WT = (bf16*)(ws + WS_W_OUTCD); }
        else if ((r -= I_OUT) < I_UP) { W = a.in[9]; K = DM; N = DFF; nblk = 172; WT = (bf16*)(ws + WS_W_UG0); }
        else if ((r -= I_UP) < I_UP) { W = a.in[10]; K = DM; N = DFF; nblk = 172; WT = (bf16*)(ws + WS_W_UG0) + (size_t)DFF * DM; }
        else if ((r -= I_UP) < I_DN) { W = a.in[13]; K = DFF; N = DM; nblk = 64; WT = (bf16*)(ws + WS_W_DN0); }
        else if ((r -= I_DN) < I_UP) { W = a.in[9] + (size_t)DM * DFF; K = DM; N = DFF; nblk = 172; WT = (bf16*)(ws + WS_W_UG1); }
        else if ((r -= I_UP) < I_UP) { W = a.in[10] + (size_t)DM * DFF; K = DM; N = DFF; nblk = 172; WT = (bf16*)(ws + WS_W_UG1) + (size_t)DFF * DM; }
        else { r -= I_UP; W = a.in[13] + (size_t)DFF * DM; K = DFF; N = DM; nblk = 64; WT = (bf16*)(ws + WS_W_DN1); }
        tr_item(W, K, N, WT, r, nblk, scr, F.lane);
    }
    const f32x4* x4 = (const f32x4*)a.in[0]; u32x2* xb = (u32x2*)(ws + WS_XB);
    for (size_t i = (size_t)F.gw * 64 + F.lane; i < (size_t)M * DM / 4; i += (size_t)F.NGW * 64) { const f32x4 v = x4[i]; u32x2 o; o.x = cvtpk(v[0], v[1]); o.y = cvtpk(v[2], v[3]); xb[i] = o; }
}

__device__ __forceinline__ void ln_phase(const Frame& F_, const float* z, float* xo, bf16* xb, const float* g, const float* b) {
    Frame F = F_; asm volatile("" : "+v"(F.lane), "+v"(F.tid), "+s"(F.gw), "+s"(F.vcu), "+s"(F.wave));
    for (int m = F.gw; m < M; m += F.NGW) {
        const f32x4* zr = (const f32x4*)(z + (size_t)m * DM) + F.lane;
        f32x4 v[16]; float s = 0.f;
#pragma unroll
        for (int j = 0; j < 16; ++j) { v[j] = zr[64 * j]; s += (v[j][0] + v[j][1]) + (v[j][2] + v[j][3]); }
        const float mean = wave_sum(s) * (1.f / DM); float s2 = 0.f;
#pragma unroll
        for (int j = 0; j < 16; ++j) { v[j] = v[j] - mean; s2 += (v[j][0] * v[j][0] + v[j][1] * v[j][1]) + (v[j][2] * v[j][2] + v[j][3] * v[j][3]); }
        const float rstd = 1.f / sqrtf(wave_sum(s2) * (1.f / DM) + LN_EPS);
        f32x4* xr = (f32x4*)(xo + (size_t)m * DM) + F.lane; u32x2* br = (u32x2*)((xb ? xb : (bf16*)xo) + (size_t)m * DM) + F.lane;
        const f32x4* g4 = (const f32x4*)g + F.lane; const f32x4* b4 = (const f32x4*)b + F.lane;
#pragma unroll
        for (int j = 0; j < 16; ++j) { const f32x4 o = v[j] * rstd * g4[64 * j] + b4[64 * j]; xr[64 * j] = o;
            if (xb) { u32x2 w; w.x = cvtpk(o[0], o[1]); w.y = cvtpk(o[2], o[3]); br[64 * j] = w; } }
    }
}

__device__ __forceinline__ void ffn_act_phase(const Frame& F_, bf16* U, const bf16* Gb, const float* cw  , const float* cb) {
    Frame F = F_; asm volatile("" : "+v"(F.lane), "+v"(F.tid), "+s"(F.gw), "+s"(F.vcu), "+s"(F.wave));
    constexpr int NCH = DFF / 8, NCB = (NCH + 63) / 64, NITEM = (M / 32) * NCB;
    for (int it = F.gw; it < NITEM; it += F.NGW) {
        const int rb = it / NCB, cbk = it - rb * NCB, ch = cbk * 64 + F.lane;
        if (ch >= NCH) continue;
        const int c0 = ch * 8, r0 = rb * 32;
        float w0[8], w1[8], w2[8], bb[8];
#pragma unroll
        for (int q = 0; q < 2; ++q) { const f32x4 t0 = *(const f32x4*)(cw + c0 + 4 * q), t1 = *(const f32x4*)(cw + DFF + c0 + 4 * q), t2 = *(const f32x4*)(cw + 2 * DFF + c0 + 4 * q), t3 = *(const f32x4*)(cb + c0 + 4 * q);
#pragma unroll
            for (int j = 0; j < 4; ++j) { w0[4 * q + j] = t0[j]; w1[4 * q + j] = t1[j]; w2[4 * q + j] = t2[j]; bb[4 * q + j] = t3[j]; } }
        u32x4 gm2 = {0u, 0u, 0u, 0u}, gm1 = {0u, 0u, 0u, 0u};
        if ((r0 & (SEQ - 1)) != 0) { gm2 = *(const u32x4*)(Gb + (size_t)(r0 - 2) * DFF + c0); gm1 = *(const u32x4*)(Gb + (size_t)(r0 - 1) * DFF + c0); }
        for (int t8 = 0; t8 < 32; t8 += 8) {
            u32x4 gv[8], uv[8];
#pragma unroll
            for (int t = 0; t < 8; ++t) { gv[t] = *(const u32x4*)(Gb + (size_t)(r0 + t8 + t) * DFF + c0); uv[t] = *(const u32x4*)(U + (size_t)(r0 + t8 + t) * DFF + c0); }
#pragma unroll
            for (int t = 0; t < 8; ++t) { u32x4 ov;
#pragma unroll
                for (int q = 0; q < 4; ++q) {
                    const float y0 = w0[2 * q] * bf_lo(gm2[q]) + w1[2 * q] * bf_lo(gm1[q]) + w2[2 * q] * bf_lo(gv[t][q]) + bb[2 * q];
                    const float y1 = w0[2 * q + 1] * bf_hi(gm2[q]) + w1[2 * q + 1] * bf_hi(gm1[q]) + w2[2 * q + 1] * bf_hi(gv[t][q]) + bb[2 * q + 1];
                    ov[q] = cvtpk(silu_f(y0) * bf_lo(uv[t][q]), silu_f(y1) * bf_hi(uv[t][q])); }
                *(u32x4*)(U + (size_t)(r0 + t8 + t) * DFF + c0) = ov; gm2 = gm1; gm1 = gv[t]; }
        }
    }
}

__device__ __forceinline__ void kmean_phase(const Frame& F_, const bf16* QKV, float* kmean) {
    Frame F = F_; asm volatile("" : "+v"(F.lane), "+v"(F.tid), "+s"(F.gw), "+s"(F.vcu), "+s"(F.wave));
    LAS float* red = (LAS float*)F.lds;
    for (int it = F.vcu; it < 256; it += F.G) {
        const int b = it >> 5, n = (it >> 2) & 7, cbk = it & 3;
        const bf16* src = QKV + (size_t)(b * SEQ + n * 256 + F.wave * 32) * N_AB + 8192 + cbk * 512 + F.lane * 8;
        float acc[8];
#pragma unroll
        for (int j = 0; j < 8; ++j) acc[j] = 0.f;
        for (int r8 = 0; r8 < 32; r8 += 8) { u32x4 v[8];
#pragma unroll
            for (int r = 0; r < 8; ++r) v[r] = *(const u32x4*)(src + (size_t)(r8 + r) * N_AB);
#pragma unroll
            for (int r = 0; r < 8; ++r)
#pragma unroll
                for (int q = 0; q < 4; ++q) { acc[2 * q] += bf_lo(v[r][q]); acc[2 * q + 1] += bf_hi(v[r][q]); } }
#pragma unroll
        for (int j = 0; j < 8; ++j) red[F.wave * 512 + F.lane * 8 + j] = acc[j];
        LDS_WAIT(); WG_BAR();
        float s = 0.f;
#pragma unroll
        for (int w = 0; w < 8; ++w) s += red[w * 512 + F.tid];
        const int col = cbk * 512 + F.tid, h = col >> 7, d = col & 127;
        kmean[((size_t)(b * 16 + h) * 8 + n) * 128 + d] = s * (1.f / 256.f);
        LDS_WAIT(); WG_BAR();
    }
}

__device__ __forceinline__ void cd_pre_phase(const Frame& F_, const bf16* QKV, bf16* QKDC, const float* cw  , const float* cb, const float* gates, const float* bif, float* A2, float* M2, float* NM) {
    Frame F = F_; asm volatile("" : "+v"(F.lane), "+v"(F.tid), "+s"(F.gw), "+s"(F.vcu), "+s"(F.wave));
    for (int it = F.gw; it < (M / 32) * 4; it += F.NGW) {
        const int rb = it >> 2, cbk = it & 3, c0 = cbk * 512 + F.lane * 8, r0 = rb * 32;
        float w[4][8], bb[8];
#pragma unroll
        for (int q = 0; q < 2; ++q) { const f32x4 t3 = *(const f32x4*)(cb + c0 + 4 * q);
#pragma unroll
            for (int j = 0; j < 4; ++j) bb[4 * q + j] = t3[j];
#pragma unroll
            for (int k = 0; k < 4; ++k) { const f32x4 t = *(const f32x4*)(cw + k * 2048 + c0 + 4 * q);
#pragma unroll
                for (int j = 0; j < 4; ++j) w[k][4 * q + j] = t[j]; } }
        const bf16* src = QKV + 6144 + c0;
        u32x4 x3 = {0u, 0u, 0u, 0u}, x2 = x3, x1 = x3;
        if ((r0 & (SEQ - 1)) != 0) { x3 = *(const u32x4*)(src + (size_t)(r0 - 3) * N_AB); x2 = *(const u32x4*)(src + (size_t)(r0 - 2) * N_AB); x1 = *(const u32x4*)(src + (size_t)(r0 - 1) * N_AB); }
        for (int t8 = 0; t8 < 32; t8 += 8) {
            u32x4 xv[8];
#pragma unroll
            for (int t = 0; t < 8; ++t) xv[t] = *(const u32x4*)(src + (size_t)(r0 + t8 + t) * N_AB);
#pragma unroll
            for (int t = 0; t < 8; ++t) { u32x4 ov;
#pragma unroll
                for (int q = 0; q < 4; ++q) {
                    const float y0 = w[0][2 * q] * bf_lo(x3[q]) + w[1][2 * q] * bf_lo(x2[q]) + w[2][2 * q] * bf_lo(x1[q]) + w[3][2 * q] * bf_lo(xv[t][q]) + bb[2 * q];
                    const float y1 = w[0][2 * q + 1] * bf_hi(x3[q]) + w[1][2 * q + 1] * bf_hi(x2[q]) + w[2][2 * q + 1] * bf_hi(x1[q]) + w[3][2 * q + 1] * bf_hi(xv[t][q]) + bb[2 * q + 1];
                    ov[q] = cvtpk(silu_f(y0), silu_f(y1)); }
                *(u32x4*)(QKDC + (size_t)(r0 + t8 + t) * 2048 + c0) = ov; x3 = x2; x2 = x1; x1 = xv[t]; }
        }
    }
    for (int sq = F.gw; sq < 64; sq += F.NGW) {
        const int b = sq >> 3, h = sq & 7; const float bi = bif[h], bfv = bif[8 + h];
        const float* gp = gates + (size_t)(b * SEQ + F.lane * 32) * 16;
        float lf[32], ai[32]; float run = 0.f;
#pragma unroll
        for (int t = 0; t < 32; ++t) { const float f = gp[t * 16 + 8 + h] + bfv; ai[t] = gp[t * 16 + h] + bi;
            const float ls = fminf(f, 0.f) - log1pf(expf(-fabsf(f)));
            run += ls; lf[t] = run; }
        float incl = run;
#pragma unroll
        for (int o = 1; o < 64; o <<= 1) { const float t = __shfl_up(incl, o); if (F.lane >= o) incl += t; }
        const float base = incl - run; float mx = -__builtin_inff();
#pragma unroll
        for (int t = 0; t < 32; ++t) { lf[t] += base; ai[t] -= lf[t]; mx = fmaxf(mx, ai[t]); }
        float minc = mx;
#pragma unroll
        for (int o = 1; o < 64; o <<= 1) { const float t = __shfl_up(minc, o); if (F.lane >= o) minc = fmaxf(minc, t); }
        float mprev = __shfl_up(minc, 1); if (F.lane == 0) mprev = -__builtin_inff();
        float cm = fmaxf(mprev, 0.f);
        float* a2o = A2 + (size_t)sq * SEQ + F.lane * 32; float* m2o = M2 + (size_t)sq * SEQ + F.lane * 32; float* nmo = NM + (size_t)sq * SEQ + F.lane * 32;
#pragma unroll
        for (int t = 0; t < 32; ++t) { cm = fmaxf(cm, ai[t]); a2o[t] = ai[t] * 1.4426950408889634f; m2o[t] = cm * 1.4426950408889634f; nmo[t] = expf(-lf[t] - cm); }
    }
}

__device__ __forceinline__ void cd_post_phase(const Frame& F_, const bf16* HD, const bf16* QKV, bf16* Y, const float* ng) {
    Frame F = F_; asm volatile("" : "+v"(F.lane), "+v"(F.tid), "+s"(F.gw), "+s"(F.vcu), "+s"(F.wave));
    for (int it = F.gw; it < M * 8; it += F.NGW) {
        const int m = it >> 3, h = it & 7, c = h * 256 + F.lane * 4;
        const u32x2 hv = *(const u32x2*)(HD + (size_t)m * 2048 + c); const u32x2 ov = *(const u32x2*)(QKV + (size_t)m * N_AB + 10240 + c);
        const f32x4 g = *(const f32x4*)(ng + c);
        float v0 = bf_lo(hv.x), v1 = bf_hi(hv.x), v2 = bf_lo(hv.y), v3 = bf_hi(hv.y);
        const float mean = wave_sum((v0 + v1) + (v2 + v3)) * (1.f / 256.f);
        v0 -= mean; v1 -= mean; v2 -= mean; v3 -= mean;
        const float rstd = 1.f / sqrtf(wave_sum((v0 * v0 + v1 * v1) + (v2 * v2 + v3 * v3)) * (1.f / 256.f) + LN_EPS);
        const float o0 = bf_lo(ov.x), o1 = bf_hi(ov.x), o2 = bf_lo(ov.y), o3 = bf_hi(ov.y);
        const float y0 = v0 * rstd * g[0] * __builtin_amdgcn_rcpf(1.f + __builtin_amdgcn_exp2f(-1.4426950408889634f * o0));
        const float y1 = v1 * rstd * g[1] * __builtin_amdgcn_rcpf(1.f + __builtin_amdgcn_exp2f(-1.4426950408889634f * o1));
        const float y2 = v2 * rstd * g[2] * __builtin_amdgcn_rcpf(1.f + __builtin_amdgcn_exp2f(-1.4426950408889634f * o2));
        const float y3 = v3 * rstd * g[3] * __builtin_amdgcn_rcpf(1.f + __builtin_amdgcn_exp2f(-1.4426950408889634f * o3));
        u32x2 w; w.x = cvtpk(y0, y1); w.y = cvtpk(y2, y3);
        *(u32x2*)(Y + (size_t)m * DM + 2048 + c) = w;
    }
}

__global__ void __launch_bounds__(NWAVES * 64, 2) mk_fwd(Args args) {
    extern __shared__ __attribute__((aligned(16))) unsigned char lds_raw[];
    Frame F;
    F.lds = (LAS unsigned char*)lds_raw;
    F.tid = threadIdx.x; F.lane = F.tid & 63; F.wave = __builtin_amdgcn_readfirstlane(F.tid >> 6);
    F.G = gridDim.x; { const int bx = blockIdx.x; F.vcu = (F.G % 8 == 0) ? (bx % 8) * (F.G / 8) + bx / 8 : bx; }
    F.gw = F.vcu * NWAVES + F.wave; F.NGW = F.G * NWAVES;
    unsigned char* ws = args.ws;
    volatile LAS unsigned* MISC = (volatile LAS unsigned*)(F.lds + MISC_OFF);
    for (int u = F.tid; u < (LDS_BYTES - RING_BYTES) / 4; u += NWAVES * 64) ((LAS unsigned*)(F.lds + RING_BYTES))[u] = 0u;
    __syncthreads();
    XcdBarrier bar = xcd_barrier_post((unsigned*)(ws + WS_CTL) + CW_BAR, MISC + 8);
#define GRID_BAR() xcd_barrier(bar)

    bf16* XB = (bf16*)(ws + WS_XB); bf16* QKV = (bf16*)(ws + WS_QKV); bf16* Y = (bf16*)(ws + WS_Y); bf16* QKDC = (bf16*)(ws + WS_QKDC); bf16* HD = (bf16*)(ws + WS_HD);
    bf16* U = (bf16*)(ws + WS_U); bf16* Gb = (bf16*)(ws + WS_G);
    float* KMEAN = (float*)(ws + WS_KMEAN); float* GATES = (float*)(ws + WS_GATES); float* A2 = (float*)(ws + WS_A2); float* M2 = (float*)(ws + WS_M2); float* NMv = (float*)(ws + WS_NM);
    float* OUT = args.out;

    PH(1) prologue(F, args);
    GRID_BAR();

    for (int layer = 0; layer < 2; ++layer) {
        {
            pg8::Gemm g{XB, (const bf16*)(ws + (layer == 0 ? WS_W_INAB : WS_W_INCD)), M, layer == 0 ? N_AB : N_CDP, DM};
            pg8::StaticOrder S; S.init(g.M, g.N, F.G, (int)blockIdx.x);
            pg8::EpiBf16 E{QKV, N_AB, 0, 0, GATES, layer == 0 ? -1 : 48};
            PH(2) pg8::gemm_phase<pg8::EpiBf16, pg8::StaticOrder, true, true>(F.lds, g, S, E);
        }
        GRID_BAR();
        if (layer == 0) { PH(4) kmean_phase(F, QKV, KMEAN); }
        else PH(8) cd_pre_phase(F, QKV, QKDC, args.in[5], args.in[6], GATES, args.in[4], A2, M2, NMv);
        GRID_BAR();
#if !SKIP_MIX
        if (layer == 0) {
            for (int it = F.vcu; it < 512; it += F.G) { const int bh = it >> 2, pr = it & 3, b = bh >> 4, h = bh & 15;
                const bf16* base = QKV + (size_t)b * SEQ * N_AB + h * 128; bf16* ob = Y + (size_t)b * SEQ * DM + h * 128;
                for (int ps = 0; ps < 2; ++ps) PH(16) att::attn_block<att::MODE_DIL>(base, N_AB, base + 2048, N_AB, base + 4096, N_AB, ob, DM, ps ? 7 - pr : pr, (LAS char*)F.lds, nullptr, nullptr, nullptr); }
            for (int it = F.vcu; it < 512; it += F.G) { const int bh = it >> 2, pr = it & 3, b = bh >> 4, h = bh & 15;
                const bf16* base = QKV + (size_t)b * SEQ * N_AB + 6144 + h * 128; bf16* ob = Y + (size_t)b * SEQ * DM + 2048 + h * 128;
                for (int ps = 0; ps < 2; ++ps) PH(32) att::attn_block<att::MODE_MOBA>(base, N_AB, base + 2048, N_AB, base + 4096, N_AB, ob, DM, ps ? 7 - pr : pr, (LAS char*)F.lds, KMEAN + (size_t)bh * 1024, nullptr, nullptr); }
        } else {
            for (int it = F.vcu; it < 512; it += F.G) { const int bh = it >> 2, pr = it & 3, b = bh >> 4, h = bh & 15;
                const bf16* base = QKV + (size_t)b * SEQ * N_AB + h * 128; bf16* ob = Y + (size_t)b * SEQ * DM + h * 128;
                for (int ps = 0; ps < 2; ++ps) PH(64) att::attn_block<att::MODE_SB>(base, N_AB, base + 2048, N_AB, base + 4096, N_AB, ob, DM, ps ? 7 - pr : pr, (LAS char*)F.lds, nullptr, nullptr, nullptr); }
            for (int it = F.vcu; it < 512; it += F.G) { const int bv = it >> 2, pr = it & 3, b = bv >> 4, vh = bv & 15, h = vh >> 1, half = vh & 1;
                const bf16* qd = QKDC + (size_t)b * SEQ * 2048 + h * 128; const bf16* vd = QKV + (size_t)b * SEQ * N_AB + 8192 + h * 256 + half * 128;
                bf16* ob = HD + (size_t)b * SEQ * 2048 + h * 256 + half * 128; const size_t so = (size_t)(b * 8 + h) * SEQ;
                for (int ps = 0; ps < 2; ++ps) PH(128) att::attn_block<att::MODE_ML>(qd, 2048, qd + 1024, 2048, vd, N_AB, ob, 2048, ps ? 7 - pr : pr, (LAS char*)F.lds, A2 + so, M2 + so, NMv + so); }
            GRID_BAR();
            PH(256) cd_post_phase(F, HD, QKV, Y, args.in[7]);
        }
#else
        { u32x4* y4 = (u32x4*)Y; for (size_t i = (size_t)F.gw * 64 + F.lane; i < (size_t)M * DM / 8; i += (size_t)F.NGW * 64) y4[i] = (u32x4){0u, 0u, 0u, 0u}; }
#endif
        GRID_BAR();
        {
            pg8::Gemm g{Y, (const bf16*)(ws + (layer == 0 ? WS_W_OUTAB : WS_W_OUTCD)), M, DM, DM};
            pg8::StaticOrder S; S.init(g.M, g.N, F.G, (int)blockIdx.x);
            pg8::EpiResid E{layer == 0 ? args.in[0] : OUT, OUT, DM, ALPHA};
            PH(512) pg8::gemm_phase<pg8::EpiResid, pg8::StaticOrder, true, true>(F.lds, g, S, E);
        }
        GRID_BAR();
        PH(1024) ln_phase(F, OUT, OUT, XB, args.in[14] + (size_t)(layer * 2) * DM, args.in[15] + (size_t)(layer * 2) * DM);
        GRID_BAR();
        {
            pg8::Gemm g{XB, (const bf16*)(ws + (layer == 0 ? WS_W_UG0 : WS_W_UG1)), M, 2 * DFF, DM};
            pg8::StaticOrder S; S.init(g.M, g.N, F.G, (int)blockIdx.x);
            pg8::EpiBf16 E{U, DFF, DFF, (size_t)(WS_G - WS_U) / 2, nullptr, -1};
            PH(2048) pg8::gemm_phase<pg8::EpiBf16, pg8::StaticOrder, true, true>(F.lds, g, S, E);
        }
        GRID_BAR();
        PH(4096) ffn_act_phase(F, U, Gb, args.in[11] + (size_t)layer * 3 * DFF, args.in[12] + (size_t)layer * DFF);
        GRID_BAR();
        {
            pg8::Gemm g{U, (const bf16*)(ws + (layer == 0 ? WS_W_DN0 : WS_W_DN1)), M, DM, DFF};
            pg8::StaticOrder S; S.init(g.M, g.N, F.G, (int)blockIdx.x);
            pg8::EpiResid E{OUT, OUT, DM, ALPHA};
            PH(8192) pg8::gemm_phase<pg8::EpiResid, pg8::StaticOrder, true, true>(F.lds, g, S, E);
        }
        GRID_BAR();
        PH(1024) ln_phase(F, OUT, OUT, layer == 0 ? XB : nullptr, args.in[14] + (size_t)(layer * 2 + 1) * DM, args.in[15] + (size_t)(layer * 2 + 1) * DM);
        if (layer == 0) GRID_BAR();
    }
}

extern "C" void kernel_launch(void* const* d_in, const int* in_sizes, int n_in, void* d_out, int out_size, void* d_ws, size_t ws_size, hipStream_t stream) {
    static int grid = 0;
    if (grid == 0) {
        if (n_in != 16 || in_sizes[0] != M * DM || out_size != M * DM || ws_size < WS_END) { fprintf(stderr, "kernel_launch: unexpected shapes (n_in %d, in0 %d, out %d, ws %zu < %zu)\n", n_in, n_in > 0 ? in_sizes[0] : -1, out_size, ws_size, (size_t)WS_END); grid = -1; return; }
        int dev = 0, cus = 0;
        if (hipGetDevice(&dev) != hipSuccess || hipDeviceGetAttribute(&cus, hipDeviceAttributeMultiprocessorCount, dev) != hipSuccess) { grid = -1; return; }
        if (hipFuncSetAttribute((const void*)mk_fwd, hipFuncAttributeMaxDynamicSharedMemorySize, LDS_BYTES) != hipSuccess) { fprintf(stderr, "kernel_launch: hipFuncSetAttribute failed\n"); grid = -1; return; }
        int per_cu = 0;
        if (hipOccupancyMaxActiveBlocksPerMultiprocessor(&per_cu, (const void*)mk_fwd, NWAVES * 64, LDS_BYTES) != hipSuccess || per_cu < 1) fprintf(stderr, "kernel_launch: occupancy query says %d\n", per_cu);
        (void)hipGetLastError();
        grid = cus;
    }
    if (grid < 0) return;
    if (hipMemsetAsync((char*)d_ws + WS_CTL, 0, CTL_ZERO_BYTES, stream) != hipSuccess) return;
    Args a{};
    for (int i = 0; i < 16; ++i) a.in[i] = (const float*)d_in[i];
    a.out = (float*)d_out; a.ws = (unsigned char*)d_ws;
    hipLaunchKernelGGL(mk_fwd, dim3(grid), dim3(NWAVES * 64), LDS_BYTES, stream, a);
}
```

```cpp
#include <hip/hip_runtime.h>
#include <cstdio>
#include <cstdint>

#define LAS __attribute__((address_space(3)))
#define GAS __attribute__((address_space(1)))
typedef unsigned short bf16;
typedef short bf16x8 __attribute__((ext_vector_type(8)));
typedef short s16x4 __attribute__((ext_vector_type(4)));
typedef float f32x16 __attribute__((ext_vector_type(16)));
typedef float f32x4 __attribute__((ext_vector_type(4)));
typedef float f32x2 __attribute__((ext_vector_type(2)));
typedef unsigned u32x4 __attribute__((ext_vector_type(4)));
typedef unsigned u32x2 __attribute__((ext_vector_type(2)));

#ifndef SKIP_MIX
#define SKIP_MIX 0
#endif
#ifndef SELFCHECK
#define SELFCHECK 0
#endif
#ifndef PH_MASK
#define PH_MASK 0xFFFF
#endif
#define PH(x) if constexpr ((PH_MASK & (x)) != 0)
#ifndef REP_MASK
#define REP_MASK 0
#endif
#define RP(x) _Pragma("unroll 1") for (int rep_ = 0; rep_ < (((REP_MASK) & (x)) ? 2 : 1); ++rep_)

constexpr int BATCH = 8, SEQ = 2048, DM = 4096, M = BATCH * SEQ;
constexpr int DFF = 11008, N_AB = 12288, N_CD = 12304, N_CDP = 12544;
constexpr float ALPHA = 1.4142135623730951f;
constexpr float LN_EPS = 1e-5f;
constexpr int NWAVES = 8;

constexpr size_t MiB = 1u << 20;
constexpr size_t WS_CTL = 0, CTL_ZERO_BYTES = 1 * MiB;
constexpr size_t WS_KMEAN = 1 * MiB;
constexpr size_t WS_GATES = 2 * MiB;
constexpr size_t WS_A2 = 3 * MiB;
constexpr size_t WS_M2 = 3 * MiB + 512 * 1024;
constexpr size_t WS_NM = 4 * MiB;
constexpr size_t WS_W_INAB = 8 * MiB, WS_W_OUTAB = 104 * MiB, WS_W_UG0 = 136 * MiB, WS_W_DN0 = 308 * MiB;
constexpr size_t WS_W_INCD = 394 * MiB, WS_W_OUTCD = 492 * MiB, WS_W_UG1 = 524 * MiB, WS_W_DN1 = 696 * MiB;
constexpr size_t WS_XB = 782 * MiB;
constexpr size_t WS_R = 910 * MiB;
constexpr size_t WS_QKV = WS_R, WS_Y = WS_R + 384 * MiB, WS_QKDC = WS_R + 512 * MiB, WS_HD = WS_R + 576 * MiB;
constexpr size_t WS_U = WS_R, WS_G = WS_R + 344 * MiB;
constexpr size_t WS_END = WS_R + 688 * MiB;
static_assert((size_t)M * DFF * 2 == 344 * MiB, "u/g size");
constexpr int CW_BAR = 4096;

constexpr int RING_BYTES = 131072;
constexpr int MISC_OFF = RING_BYTES + 320;
constexpr int LDS_BYTES = 147456;

#define LDS_WAIT() asm volatile("s_waitcnt lgkmcnt(0)" ::: "memory")
#define VM_WAIT() asm volatile("s_waitcnt vmcnt(0)" ::: "memory")
#define SBAR() __builtin_amdgcn_sched_barrier(0)
#define WG_BAR() do { asm volatile("" ::: "memory"); __builtin_amdgcn_s_barrier(); asm volatile("" ::: "memory"); } while (0)

__device__ __forceinline__ unsigned cvtpk(float lo, float hi) { unsigned r; asm volatile("v_cvt_pk_bf16_f32 %0, %1, %2" : "=v"(r) : "v"(lo), "v"(hi)); return r; }
__device__ __forceinline__ float bf_lo(unsigned w) { return __uint_as_float(w << 16); }
__device__ __forceinline__ float bf_hi(unsigned w) { return __uint_as_float(w & 0xffff0000u); }
__device__ __forceinline__ float wave_sum(float v) {
#pragma unroll
    for (int o = 1; o < 64; o <<= 1) v += __shfl_xor(v, o);
    return v;
}
__device__ __forceinline__ float silu_f(float y) { return y * __builtin_amdgcn_rcpf(1.0f + __builtin_amdgcn_exp2f(-1.4426950408889634f * y)); }

namespace pg8 {
typedef unsigned short bf16_t;
constexpr int BM = 256, BK = 64, HALF = 128, HTB = HALF * BK * 2, STAGE_BYTES = 8 * HTB, NXCD = 8, WGM = 8;
__host__ __device__ __forceinline__ int lds_byte(int r, int c) { const int st = (r >> 4) * 2 + (c >> 5), rr = r & 15, cc = c & 31, ob = rr * 64 + cc * 2; return st * 1024 + (ob ^ (((ob >> 9) & 1) << 5)); }
__host__ __device__ __forceinline__ void stage_rc(int b, int& R, int& C) { const int st = b / 1024, sb = b % 1024, swz = sb ^ (((sb >> 9) & 1) << 5); R = (st >> 1) * 16 + swz / 64; C = (st & 1) * 32 + (swz % 64) / 2; }
__host__ __device__ __forceinline__ int perm32(int rho) { const int n = rho >> 4, i = rho & 15; return 8 * (i >> 2) + 4 * n + (i & 3); }
struct Unit { int pm, pn; };
struct Gemm { const bf16_t* A; const bf16_t* Bt; int M, N, K; };
struct StaticOrder {
    int nM, nN, nwg, G, c;
    __host__ __device__ void init(int M_, int N_, int G_, int c_) { nM = M_ / BM; nN = N_ / BM; nwg = nM * nN; G = G_; c = c_; }
    __host__ __device__ bool next(int i, Unit& u) const {
        const long L = (long)i * G + c; if (L >= nwg) return false;
        int wgid = (int)L; { const int q = nwg / NXCD, r = nwg % NXCD, xcd = wgid % NXCD, off = wgid / NXCD; wgid = (xcd < r ? xcd * (q + 1) : r * (q + 1) + (xcd - r) * q) + off; }
        const int nig = WGM * nN, gid = wgid / nig, fm = gid * WGM, gsz = (nM - fm) < WGM ? (nM - fm) : WGM;
        u.pm = fm + ((wgid % nig) % gsz); u.pn = (wgid % nig) / gsz; return true;
    }
    __device__ __forceinline__ void a_ready(const Unit&) const {}
    __device__ __forceinline__ void done(const Unit&) const {}
};
struct EpiBf16 {
    static constexpr bool PERM = true, AFTER_DRAIN = false;
    bf16_t* O; int ldc; int split_cols; size_t split_stride; float* gates; int gate_pn;
    __device__ __forceinline__ void operator()(const f32x4 (&acc)[2][2][4][2], const Unit& u, int wr_, int wc_, int fr_, int fq_) const {
        int tid_ = threadIdx.x; asm volatile("" : "+v"(tid_));
        const int wid = __builtin_amdgcn_readfirstlane(tid_ >> 6), wr = wid >> 2, wc = wid & 3, fr = tid_ & 15, fq = (tid_ & 63) >> 4;
        const int row0 = u.pm * BM + wr * 64 + fr;
        if (u.pn == gate_pn) {
            if (wc == 0 && fq < 2) {
#pragma unroll
                for (int ai = 0; ai < 2; ++ai)
#pragma unroll
                    for (int m = 0; m < 4; ++m) { float* gp = gates + (size_t)(row0 + ai * HALF + m * 16) * 16 + 8 * fq;
                        *(GAS f32x4*)gp = acc[ai][0][m][0]; *(GAS f32x4*)(gp + 4) = acc[ai][0][m][1]; }
            }
            return;
        }
        int colt = u.pn * BM; bf16_t* base = O;
        if (split_cols) { const int t = colt / split_cols; base += (size_t)t * split_stride; colt -= t * split_cols; }
        const int col0 = colt + wc * 32 + 8 * fq;
#pragma unroll
        for (int ai = 0; ai < 2; ++ai)
#pragma unroll
            for (int m = 0; m < 4; ++m) { bf16_t* rowp = base + (size_t)(row0 + ai * HALF + m * 16) * ldc + col0;
#pragma unroll
                for (int bj = 0; bj < 2; ++bj) { const f32x4 v0 = acc[ai][bj][m][0], v1 = acc[ai][bj][m][1];
                    u32x4 w; w.x = cvtpk(v0[0], v0[1]); w.y = cvtpk(v0[2], v0[3]); w.z = cvtpk(v1[0], v1[1]); w.w = cvtpk(v1[2], v1[3]);
                    *(u32x4*)(rowp + bj * HALF) = w; } }
    }
};
struct EpiResid {
    static constexpr bool PERM = false, AFTER_DRAIN = false;
    const float* base; float* out; int ldc; float alpha;
    __device__ __forceinline__ void operator()(const f32x4 (&acc)[2][2][4][2], const Unit& u, int wr_, int wc_, int fr_, int fq_) const {
        int tid_ = threadIdx.x; asm volatile("" : "+v"(tid_));
        const int wid = __builtin_amdgcn_readfirstlane(tid_ >> 6), wr = wid >> 2, wc = wid & 3, fr = tid_ & 15, fq = (tid_ & 63) >> 4;
        const int row0 = u.pm * BM + wr * 64 + fr, col0 = u.pn * BM + wc * 32 + 4 * fq;
#pragma unroll
        for (int ai = 0; ai < 2; ++ai)
#pragma unroll
            for (int m = 0; m < 4; ++m) { const size_t off = (size_t)(row0 + ai * HALF + m * 16) * ldc + col0;
                f32x4 bs[2][2];
#pragma unroll
                for (int bj = 0; bj < 2; ++bj)
#pragma unroll
                    for (int n = 0; n < 2; ++n) bs[bj][n] = *(const f32x4*)(base + off + bj * HALF + n * 16);
#pragma unroll
                for (int bj = 0; bj < 2; ++bj)
#pragma unroll
                    for (int n = 0; n < 2; ++n) *(f32x4*)(out + off + bj * HALF + n * 16) = bs[bj][n] * alpha + acc[ai][bj][m][n];
                asm volatile("" ::: "memory"); }
    }
};


__device__ __forceinline__ float dpp_ror1(float x) { return __int_as_float(__builtin_amdgcn_update_dpp(0, __float_as_int(x), 0x121, 0xF, 0xF, false)); }
__device__ __forceinline__ float dpp_ror2(float x) { return __int_as_float(__builtin_amdgcn_update_dpp(0, __float_as_int(x), 0x122, 0xF, 0xF, false)); }
struct EpiFfnAct {
    static constexpr bool PERM = true, AFTER_DRAIN = false;
    bf16_t* H; const float* cw; const float* cb; float* EG0; float* EU0; float* EGL; LAS float* edge;
    __device__ __forceinline__ void operator()(const f32x4 (&acc)[2][2][4][2], const Unit& u, int wr_, int wc_, int fr_, int fq_) const {
        int tid_ = threadIdx.x; asm volatile("" : "+v"(tid_));
        const int wid = __builtin_amdgcn_readfirstlane(tid_ >> 6), wr = wid >> 2, wc = wid & 3, fr = tid_ & 15, fq = (tid_ & 63) >> 4;
        const int ch0 = u.pn * 128 + wc * 32 + fq * 8, row0 = u.pm * BM + wr * 64 + fr;
        if (fr >= 14) {
#pragma unroll
            for (int ai = 0; ai < 2; ++ai) { LAS float* e = edge + ((((ai * 2 + wr) * 4 + wc) * 4 + fq) * 2 + (fr - 14)) * 8; *(LAS f32x4*)e = acc[ai][1][3][0]; *(LAS f32x4*)(e + 4) = acc[ai][1][3][1]; }
            if (wr == 1) { float* p = EGL + (size_t)(u.pm * 2 + (fr - 14)) * DFF + ch0; *(GAS f32x4*)p = acc[1][1][3][0]; *(GAS f32x4*)(p + 4) = acc[1][1][3][1]; }
        }
        if (wr == 0 && fr < 2) { float* pg = EG0 + (size_t)(u.pm * 2 + fr) * DFF + ch0; float* pu = EU0 + (size_t)(u.pm * 2 + fr) * DFF + ch0;
            *(GAS f32x4*)pg = acc[0][1][0][0]; *(GAS f32x4*)(pg + 4) = acc[0][1][0][1]; *(GAS f32x4*)pu = acc[0][0][0][0]; *(GAS f32x4*)(pu + 4) = acc[0][0][0][1]; }
        asm volatile("s_waitcnt lgkmcnt(0)" ::: "memory"); __builtin_amdgcn_s_barrier(); asm volatile("" ::: "memory");
        float w0[8], w1[8], w2[8], bb[8];
#pragma unroll
        for (int q = 0; q < 2; ++q) { const f32x4 t0 = *(const f32x4*)(cw + ch0 + 4 * q), t1 = *(const f32x4*)(cw + DFF + ch0 + 4 * q), t2 = *(const f32x4*)(cw + 2 * DFF + ch0 + 4 * q), t3 = *(const f32x4*)(cb + ch0 + 4 * q);
#pragma unroll
            for (int j = 0; j < 4; ++j) { w0[4 * q + j] = t0[j]; w1[4 * q + j] = t1[j]; w2[4 * q + j] = t2[j]; bb[4 * q + j] = t3[j]; } }
#pragma unroll
        for (int ai = 0; ai < 2; ++ai) {
            f32x4 e14[2] = {(f32x4){0.f, 0.f, 0.f, 0.f}, (f32x4){0.f, 0.f, 0.f, 0.f}}, e15[2] = {(f32x4){0.f, 0.f, 0.f, 0.f}, (f32x4){0.f, 0.f, 0.f, 0.f}};
            if (wr == 1 || ai == 1) { const int sa = (wr == 1) ? ai : 0, sw = (wr == 1) ? 0 : 1; const LAS float* e = edge + (((sa * 2 + sw) * 4 + wc) * 4 + fq) * 16;
                e14[0] = *(const LAS f32x4*)e; e14[1] = *(const LAS f32x4*)(e + 4); e15[0] = *(const LAS f32x4*)(e + 8); e15[1] = *(const LAS f32x4*)(e + 12); }
#pragma unroll
            for (int m = 0; m < 4; ++m) {
                float hv[8];
#pragma unroll
                for (int n = 0; n < 2; ++n)
#pragma unroll
                    for (int j = 0; j < 4; ++j) { const int c = 4 * n + j; const float gc = acc[ai][1][m][n][j]; const float r1 = dpp_ror1(gc), r2 = dpp_ror2(gc);
                        float q1, q2;
                        if (m == 0) { q1 = e15[n][j]; q2 = (fr == 0) ? e14[n][j] : e15[n][j]; }
                        else { const float gp = acc[ai][1][m - 1][n][j]; q1 = dpp_ror1(gp); q2 = dpp_ror2(gp); }
                        const float p1 = (fr == 0) ? q1 : r1, p2 = (fr < 2) ? q2 : r2;
                        const float y = w0[c] * p2 + w1[c] * p1 + w2[c] * gc + bb[c];
                        hv[c] = silu_f(y) * acc[ai][0][m][n][j]; }
                if (!(ai == 0 && m == 0 && wr == 0 && fr < 2)) { u32x4 w; w.x = cvtpk(hv[0], hv[1]); w.y = cvtpk(hv[2], hv[3]); w.z = cvtpk(hv[4], hv[5]); w.w = cvtpk(hv[6], hv[7]);
                    *(u32x4*)(H + (size_t)(row0 + ai * HALF + m * 16) * DFF + ch0) = w; }
            }
        }
    }
};

template <class Epi, class Sched, bool ALIGN_EPI = false, bool SP2 = false>
__device__ __forceinline__ void gemm_phase(LAS unsigned char* lds, const Gemm g, const Sched& S, const Epi& E) {
    int tid_ = threadIdx.x; asm volatile("" : "+v"(tid_));
    const int tid = tid_, wid = __builtin_amdgcn_readfirstlane(tid >> 6), lane = tid & 63, wr = wid >> 2, wc = wid & 3, fr = lane & 15, fq = lane >> 4;
    const int K = g.K, nt = K / BK;
    unsigned voffA[2], voffB[2];
#pragma unroll
    for (int i = 0; i < 2; ++i) { int R, C; stage_rc(tid * 16 + i * 8192, R, C); const int Rb = Epi::PERM ? ((R & ~31) + perm32(R & 31)) : R;
        voffA[i] = (unsigned)(R * K + C) * 2u; voffB[i] = (unsigned)(Rb * K + C) * 2u; }
    const size_t kstep = (size_t)(BK * 2);
    const size_t hstep = (size_t)HALF * K * 2;
    const size_t tstep = 2 * hstep;
    const unsigned ldsw = (unsigned)wid * 1024u;
    const int aoff = lds_byte(wr * 64 + fr, fq * 8), boff = lds_byte(wc * 32 + fr, fq * 8);
#define PG8_SA(b, h) (((b) * 2 + (h)) * HTB)
#define PG8_SB(b, h) ((4 + (b) * 2 + (h)) * HTB)
#define PG8_STAGE(bufoff, gbase, voff) do { _Pragma("unroll") for (int _i = 0; _i < 2; ++_i) \
        __builtin_amdgcn_global_load_lds((const unsigned*)((const char*)(gbase) + (voff)[_i]), (LAS unsigned*)(lds + (bufoff) + ldsw + _i * 8192), 16, 0, 0); } while (0)
#define PG8_LDA(dst, b, h) do { _Pragma("unroll") for (int m = 0; m < 4; ++m) _Pragma("unroll") for (int k = 0; k < 2; ++k) dst[m][k] = *(const LAS bf16x8*)(lds + PG8_SA(b, h) + aoff + m * 2048 + k * 1024); } while (0)
#define PG8_LDB(dst, b, h) do { _Pragma("unroll") for (int n = 0; n < 2; ++n) _Pragma("unroll") for (int k = 0; k < 2; ++k) dst[n][k] = *(const LAS bf16x8*)(lds + PG8_SB(b, h) + boff + n * 2048 + k * 1024); } while (0)
#define PG8_MMA(ai, bj, At, Bt) do { __builtin_amdgcn_s_setprio(1); _Pragma("unroll") for (int m = 0; m < 4; ++m) _Pragma("unroll") for (int n = 0; n < 2; ++n) _Pragma("unroll") for (int k = 0; k < 2; ++k) \
        acc[ai][bj][m][n] = __builtin_amdgcn_mfma_f32_16x16x32_bf16(Bt[n][k], At[m][k], acc[ai][bj][m][n], 0, 0, 0); __builtin_amdgcn_s_setprio(0); } while (0)
#define PG8_WAIT_V(n) asm volatile("s_waitcnt vmcnt(" #n ")" ::: "memory")
#define PG8_WAIT_L(n) asm volatile("s_waitcnt lgkmcnt(" #n ")" ::: "memory")
#define PG8_BAR __builtin_amdgcn_s_barrier()
#define PG8_SCHED __builtin_amdgcn_sched_barrier(0)
    Unit cur, nxt; int ui = 0;
    if (!S.next(0, cur)) return;
    f32x4 acc[2][2][4][2];
#pragma unroll
    for (int a = 0; a < 2; ++a)
#pragma unroll
        for (int b = 0; b < 2; ++b)
#pragma unroll
            for (int m = 0; m < 4; ++m)
#pragma unroll
                for (int n = 0; n < 2; ++n) acc[a][b][m][n] = (f32x4){0.f, 0.f, 0.f, 0.f};
    bf16x8 At[4][2], B0[2][2], B1[2][2];
    const char* cA = (const char*)g.A + (size_t)cur.pm * tstep; const char* cB = (const char*)g.Bt + (size_t)cur.pn * tstep;
    S.a_ready(cur);
    if constexpr (SP2) {
        PG8_STAGE(PG8_SB(0, 0), cB, voffB); PG8_STAGE(PG8_SB(0, 1), cB + hstep, voffB); PG8_STAGE(PG8_SA(0, 0), cA, voffA); PG8_STAGE(PG8_SA(0, 1), cA + hstep, voffA);
        if (wr == 1) PG8_BAR;
        PG8_WAIT_V(2); PG8_BAR;
        PG8_STAGE(PG8_SB(1, 0), cB + kstep, voffB); PG8_STAGE(PG8_SA(1, 0), cA + kstep, voffA); PG8_STAGE(PG8_SB(1, 1), cB + hstep + kstep, voffB);
        PG8_WAIT_V(6); PG8_BAR;
    } else {
        PG8_STAGE(PG8_SB(0, 0), cB, voffB); PG8_STAGE(PG8_SA(0, 0), cA, voffA); PG8_STAGE(PG8_SB(0, 1), cB + hstep, voffB); PG8_STAGE(PG8_SA(0, 1), cA + hstep, voffA);
        if (wr == 1) PG8_BAR;
        PG8_WAIT_V(4); PG8_BAR;
        PG8_STAGE(PG8_SB(1, 0), cB + kstep, voffB); PG8_STAGE(PG8_SA(1, 0), cA + kstep, voffA); PG8_STAGE(PG8_SB(1, 1), cB + hstep + kstep, voffB);
        PG8_WAIT_V(6); PG8_BAR;
    }
    for (;;) {
        const bool has_next = S.next(ui + 1, nxt);
        const char* nA = has_next ? (const char*)g.A + (size_t)nxt.pm * tstep : cA; const char* nB = has_next ? (const char*)g.Bt + (size_t)nxt.pn * tstep : cB;
        for (int t = 0; t < nt; t += 2) {
            const bool last = (t == nt - 2);
            const char* a1 = cA + (size_t)(t + 1) * kstep;
            const char* a2 = last ? nA : cA + (size_t)(t + 2) * kstep; const char* b2 = last ? nB : cB + (size_t)(t + 2) * kstep;
            const char* a3 = a2 + kstep; const char* b3 = b2 + kstep;
            if (last && has_next) S.a_ready(nxt);
            if constexpr (SP2) {
            PG8_LDB(B0, 0, 0); PG8_LDB(B1, 0, 1); PG8_SCHED; PG8_LDA(At, 0, 0); PG8_STAGE(PG8_SA(1, 1), a1 + hstep, voffA);
            PG8_WAIT_V(8); PG8_WAIT_L(0); PG8_BAR; PG8_MMA(0, 0, At, B0); PG8_MMA(0, 1, At, B1); PG8_BAR; PG8_SCHED;
            PG8_LDA(At, 0, 1); PG8_STAGE(PG8_SB(0, 0), b2, voffB); PG8_STAGE(PG8_SB(0, 1), b2 + hstep, voffB); PG8_STAGE(PG8_SA(0, 0), a2, voffA);
            PG8_WAIT_V(8); PG8_WAIT_L(0); PG8_BAR; PG8_MMA(1, 0, At, B0); PG8_MMA(1, 1, At, B1); PG8_BAR; PG8_SCHED;
            PG8_LDB(B0, 1, 0); PG8_LDB(B1, 1, 1); PG8_SCHED; PG8_LDA(At, 1, 0); PG8_STAGE(PG8_SA(0, 1), a2 + hstep, voffA);
            PG8_WAIT_V(8); PG8_WAIT_L(0); PG8_BAR; PG8_MMA(0, 0, At, B0); PG8_MMA(0, 1, At, B1); PG8_BAR; PG8_SCHED;
            PG8_LDA(At, 1, 1); PG8_STAGE(PG8_SB(1, 0), b3, voffB); PG8_STAGE(PG8_SB(1, 1), b3 + hstep, voffB); PG8_STAGE(PG8_SA(1, 0), a3, voffA);
            PG8_WAIT_V(8); PG8_WAIT_L(0); PG8_BAR; PG8_MMA(1, 0, At, B0); PG8_MMA(1, 1, At, B1); PG8_BAR; PG8_SCHED;
            } else {
            PG8_LDB(B0, 0, 0); PG8_SCHED; PG8_LDA(At, 0, 0); PG8_STAGE(PG8_SA(1, 1), a1 + hstep, voffA);
            PG8_WAIT_L(8); PG8_BAR; PG8_WAIT_L(0); PG8_MMA(0, 0, At, B0); PG8_BAR; PG8_SCHED;
            PG8_LDB(B1, 0, 1); PG8_STAGE(PG8_SB(0, 0), b2, voffB);
            PG8_BAR; PG8_WAIT_L(0); PG8_MMA(0, 1, At, B1); PG8_BAR;
            PG8_LDA(At, 0, 1); PG8_STAGE(PG8_SA(0, 0), a2, voffA);
            PG8_BAR; PG8_WAIT_L(0); PG8_MMA(1, 0, At, B0); PG8_BAR; PG8_SCHED;
            PG8_STAGE(PG8_SB(0, 1), b2 + hstep, voffB);
            PG8_WAIT_V(6); PG8_BAR; PG8_MMA(1, 1, At, B1); PG8_BAR;
            PG8_LDB(B0, 1, 0); PG8_SCHED; PG8_LDA(At, 1, 0); PG8_STAGE(PG8_SA(0, 1), a2 + hstep, voffA);
            PG8_WAIT_L(8); PG8_BAR; PG8_WAIT_L(0); PG8_MMA(0, 0, At, B0); PG8_BAR; PG8_SCHED;
            PG8_LDB(B1, 1, 1); PG8_STAGE(PG8_SB(1, 0), b3, voffB);
            PG8_BAR; PG8_WAIT_L(0); PG8_MMA(0, 1, At, B1); PG8_BAR;
            PG8_LDA(At, 1, 1); PG8_STAGE(PG8_SA(1, 0), a3, voffA);
            PG8_BAR; PG8_WAIT_L(0); PG8_MMA(1, 0, At, B0); PG8_BAR; PG8_SCHED;
            PG8_STAGE(PG8_SB(1, 1), b3 + hstep, voffB);
            PG8_WAIT_V(6); PG8_BAR; PG8_MMA(1, 1, At, B1); PG8_BAR;
            }
        }
        if constexpr (ALIGN_EPI) { if (wr == 0) PG8_BAR; }
        if constexpr (!Epi::AFTER_DRAIN) { E(acc, cur, wr, wc, fr, fq); S.done(cur); }
        if (!has_next) break;
#pragma unroll
        for (int a = 0; a < 2; ++a)
#pragma unroll
            for (int b = 0; b < 2; ++b)
#pragma unroll
                for (int m = 0; m < 4; ++m)
#pragma unroll
                    for (int n = 0; n < 2; ++n) acc[a][b][m][n] = (f32x4){0.f, 0.f, 0.f, 0.f};
        cur = nxt; cA = nA; cB = nB; ++ui;
        if constexpr (ALIGN_EPI) { if (wr == 1) PG8_BAR; }
    }
    PG8_WAIT_V(0);
    if constexpr (!ALIGN_EPI) { if (wr == 0) PG8_BAR; }
    PG8_BAR;
#undef PG8_SA
#undef PG8_SB
#undef PG8_STAGE
#undef PG8_LDA
#undef PG8_LDB
#undef PG8_MMA
#undef PG8_WAIT_V
#undef PG8_WAIT_L
#undef PG8_BAR
#undef PG8_SCHED
}
}

#define XB_TMO      128
#define XB_XCNT(j)  (256  + 64 * (j))
#define XB_XSUB(j)  (1280 + 64 * (j))
#define XB_XGEN(j)  (2304 + 64 * (j))
#define XB_TOP      3328
#define XB_TOPGEN   3392
#define XCD_BAR_WORDS 3456
#define XB_SPIN_CAP (1u << 18)
__device__ __forceinline__ unsigned xb_ld(unsigned* p)              { return __hip_atomic_load((GAS unsigned*)p, __ATOMIC_RELAXED, __HIP_MEMORY_SCOPE_AGENT); }
__device__ __forceinline__ unsigned xb_add(unsigned* p, unsigned v) { return __hip_atomic_fetch_add((GAS unsigned*)p, v, __ATOMIC_RELAXED, __HIP_MEMORY_SCOPE_AGENT); }
__device__ __forceinline__ unsigned xb_xcc_id() { return (unsigned)__builtin_amdgcn_s_getreg((3 << 11) | 20) & 0xFu; }
#define XB_SPIN(cond, bar) do { unsigned _sp = 0; while (cond) { __builtin_amdgcn_s_sleep(1); \
    if ((++_sp & 255u) == 0u) { if (xb_ld(&(bar)[XB_TMO])) break; if (_sp > XB_SPIN_CAP) { (void)xb_add(&(bar)[XB_TMO], 1u); break; } } } } while (0)
struct XcdBarrier { unsigned* bar; unsigned x; volatile LAS unsigned* st; };
__device__ __forceinline__ XcdBarrier xcd_barrier_post(unsigned* bar, volatile LAS unsigned* st) {
    XcdBarrier b; b.bar = bar; b.x = xb_xcc_id(); b.st = st;
    if (threadIdx.x == 0) (void)xb_add(&bar[XB_XCNT(b.x)], 1u);
    return b;
}
__device__ __forceinline__ void xcd_barrier_complete(unsigned* bar, unsigned x, unsigned& nloc, unsigned& nx) {
    const unsigned G = gridDim.x * gridDim.y * gridDim.z;
    unsigned sum, cnt, mine, sp = 0u;
    for (;;) {
        sum = 0u; cnt = 0u; mine = 0u;
#pragma unroll
        for (unsigned j = 0; j < 16; ++j) { const unsigned c = xb_ld(&bar[XB_XCNT(j)]); sum += c; cnt += (c > 0u) ? 1u : 0u; mine = (j == x) ? c : mine; }
        if (sum == G) break;
        __builtin_amdgcn_s_sleep(1);
        if ((++sp & 255u) == 0u) { if (xb_ld(&bar[XB_TMO])) break; if (sp > XB_SPIN_CAP) { (void)xb_add(&bar[XB_TMO], 1u); break; } }
    }
    nloc = mine > 0u ? mine : 1u; nx = cnt > 0u ? cnt : 1u;
}
__device__ __forceinline__ void xcd_barrier(const XcdBarrier& b) {
    asm volatile("s_waitcnt vmcnt(0)" ::: "memory");
    __syncthreads();
    if (threadIdx.x == 0) {
        unsigned* bar = b.bar; unsigned bx = b.x;
        asm volatile("" : "+s"(bar), "+s"(bx));
        __builtin_amdgcn_s_waitcnt(0);
        unsigned nloc = b.st[0], nx = b.st[1];
        if (nloc == 0u) { xcd_barrier_complete(bar, bx, nloc, nx); b.st[0] = nloc; b.st[1] = nx; }
        const unsigned old = xb_add(&bar[XB_XSUB(bx)], 1u);
        const unsigned gen = old / nloc;
        if (old + 1u == (gen + 1u) * nloc) {
            __builtin_amdgcn_fence(__ATOMIC_RELEASE, "agent");
            asm volatile("s_waitcnt vmcnt(0)" ::: "memory");
            const unsigned og = xb_add(&bar[XB_TOP], 1u);
            const unsigned tg = og / nx;
            if (og + 1u == (tg + 1u) * nx) xb_add(&bar[XB_TOPGEN], 1u);
            else XB_SPIN(xb_ld(&bar[XB_TOPGEN]) == tg, bar);
            __builtin_amdgcn_fence(__ATOMIC_ACQUIRE, "agent");
            xb_add(&bar[XB_XGEN(bx)], 1u);
            asm volatile("s_waitcnt vmcnt(0)" ::: "memory");
        } else {
            XB_SPIN(xb_ld(&bar[XB_XGEN(bx)]) == gen, bar);
            __builtin_amdgcn_fence(__ATOMIC_ACQUIRE, "agent");
            asm volatile("s_waitcnt vmcnt(0)" ::: "memory");
        }
    }
    __syncthreads();
}

namespace att {
constexpr int D = 128, SHM = 16384;
constexpr int OFF_V = 0, OFF_K = 2 * SHM, OFF_WS = 4 * SHM, OFF_AUX = 4 * SHM + 2048, LDS_USED = 4 * SHM + 2048 + 8192;
constexpr float SCALE = 0.08838834764831845f;
constexpr float C2 = 1.4426950408889634f * SCALE;
constexpr float THR = 8.f;
enum { MODE_DIL = 0, MODE_MOBA = 1, MODE_SB = 2, MODE_ML = 3 };
#define KSWZ(row, colB) ((row) * 256 + ((colB) ^ (((row) & 7) << 4)))
__device__ __forceinline__ int v_st(int k, int c) { const int kk = (k & ~0xC) | ((k & 4) << 1) | ((k & 8) >> 1); return ((kk >> 3) * 4 + (c >> 5)) * 512 + ((kk & 7) * 32 + (c & 31)) * 2; }
__device__ __forceinline__ int v_rd_base(int lane) { return ((lane & 3) << 3) | (((lane >> 2) & 3) << 6) | (((lane >> 4) & 1) << 5) | (((lane >> 5) & 1) << 8); }
__device__ __forceinline__ int crow(int r, int hi) { return (r & 3) + 8 * (r >> 2) + 4 * hi; }
__device__ __forceinline__ void mask_tile(f32x16& p0, f32x16& p1, int dq) {
    const float NEG = -__builtin_inff();
#pragma unroll
    for (int r = 0; r < 16; ++r) {
        const int c = (r & 3) + 8 * (r >> 2);
        if (dq - c < 0) p0[r] = NEG;
        if (dq - c - 32 < 0) p1[r] = NEG;
    }
}
__device__ __forceinline__ void partialSM(f32x16& p0, f32x16& p1, float& m_reg, float& mn, float& alpha) {
    float pmax = p0[0];
#pragma unroll
    for (int r = 1; r < 16; ++r) pmax = fmaxf(pmax, p0[r]);
#pragma unroll
    for (int r = 0; r < 16; ++r) pmax = fmaxf(pmax, p1[r]);
    { auto rr = __builtin_amdgcn_permlane32_swap(__float_as_uint(pmax), __float_as_uint(pmax), false, false);
      pmax = fmaxf(__uint_as_float(rr[0]), __uint_as_float(rr[1])); }
    if (__builtin_expect(__all((pmax - m_reg) * SCALE <= THR), 1)) { mn = m_reg; alpha = 1.f; }
    else { mn = fmaxf(m_reg, pmax); alpha = __builtin_amdgcn_exp2f((m_reg - mn) * C2); m_reg = mn; }
    const float mnL = -mn * C2;
#pragma unroll
    for (int r = 0; r < 16; ++r) p0[r] = fmaf(p0[r], C2, mnL);
#pragma unroll
    for (int r = 0; r < 16; ++r) p1[r] = fmaf(p1[r], C2, mnL);
#pragma unroll
    for (int r = 0; r < 16; ++r) p0[r] = __builtin_amdgcn_exp2f(p0[r]);
#pragma unroll
    for (int r = 0; r < 16; ++r) p1[r] = __builtin_amdgcn_exp2f(p1[r]);
}
#define ATT_PK4(P, B_, OUT) do { unsigned a0 = cvtpk(P[B_+0], P[B_+1]), a1 = cvtpk(P[B_+2], P[B_+3]);                          \
        unsigned b0 = cvtpk(P[B_+4], P[B_+5]), b1 = cvtpk(P[B_+6], P[B_+7]);                                             \
        auto r0 = __builtin_amdgcn_permlane32_swap(a0, b0, false, false); auto r1 = __builtin_amdgcn_permlane32_swap(a1, b1, false, false); \
        u32x4 w = {r0[0], r1[0], r0[1], r1[1]}; OUT = *reinterpret_cast<bf16x8*>(&w); } while (0)
__device__ __forceinline__ void pack_p(const f32x16& p0, const f32x16& p1, bf16x8& pa0, bf16x8& pa1, bf16x8& pa2, bf16x8& pa3) {
    ATT_PK4(p0, 0, pa0); ATT_PK4(p0, 8, pa1); ATT_PK4(p1, 0, pa2); ATT_PK4(p1, 8, pa3);
}
__device__ __forceinline__ float pair_sum(float v) {
    auto rr = __builtin_amdgcn_permlane32_swap(__float_as_uint(v), __float_as_uint(v), false, false);
    return __uint_as_float(rr[0]) + __uint_as_float(rr[1]);
}
__device__ __forceinline__ void qkt(f32x16& p0, f32x16& p1, const LAS char* Kb, int r32, int hi, const bf16x8* qr) {
#pragma unroll
    for (int r = 0; r < 16; ++r) { p0[r] = 0.f; p1[r] = 0.f; }
    const LAS char* kb[4];
#pragma unroll
    for (int dd = 0; dd < 4; ++dd) kb[dd] = Kb + KSWZ(r32, (dd * 16 + hi * 8) * 2);
#pragma unroll
    for (int d0 = 0; d0 < 8; ++d0) { const LAS char* a = kb[d0 & 3] + (d0 >> 2) * 128;
        const bf16x8 b0 = *reinterpret_cast<const LAS bf16x8*>(a);
        const bf16x8 b1 = *reinterpret_cast<const LAS bf16x8*>(a + 32 * 256);
        p0 = __builtin_amdgcn_mfma_f32_32x32x16_bf16(b0, qr[d0], p0, 0, 0, 0);
        p1 = __builtin_amdgcn_mfma_f32_32x32x16_bf16(b1, qr[d0], p1, 0, 0, 0); }
}
__device__ __forceinline__ void pv_tile(f32x16* o, int vb0, bf16x8 pa0, bf16x8 pa1, bf16x8 pa2, bf16x8 pa3) {
#define TRRD(dst, off) asm volatile("ds_read_b64_tr_b16 %0, %1 offset:%2" : "=&v"(dst) : "v"(vb0), "i"(off) : "memory")
#define PV_D0(d0) do { s16x4 l0, l1, l2, l3, h0, h1, h2, h3; constexpr int b_ = (d0) * 512; \
        TRRD(l0, b_); TRRD(h0, b_ + 2048); TRRD(l1, b_ + 4096); TRRD(h1, b_ + 6144); TRRD(l2, b_ + 8192); TRRD(h2, b_ + 10240); TRRD(l3, b_ + 12288); TRRD(h3, b_ + 14336); \
        asm volatile("s_waitcnt lgkmcnt(0)" ::: "memory"); SBAR();   \
        o[d0] = __builtin_amdgcn_mfma_f32_32x32x16_bf16(pa0, (bf16x8){l0[0], l0[1], l0[2], l0[3], h0[0], h0[1], h0[2], h0[3]}, o[d0], 0, 0, 0);   \
        o[d0] = __builtin_amdgcn_mfma_f32_32x32x16_bf16(pa1, (bf16x8){l1[0], l1[1], l1[2], l1[3], h1[0], h1[1], h1[2], h1[3]}, o[d0], 0, 0, 0);   \
        o[d0] = __builtin_amdgcn_mfma_f32_32x32x16_bf16(pa2, (bf16x8){l2[0], l2[1], l2[2], l2[3], h2[0], h2[1], h2[2], h2[3]}, o[d0], 0, 0, 0);   \
        o[d0] = __builtin_amdgcn_mfma_f32_32x32x16_bf16(pa3, (bf16x8){l3[0], l3[1], l3[2], l3[3], h3[0], h3[1], h3[2], h3[3]}, o[d0], 0, 0, 0); } while (0)
    PV_D0(0); PV_D0(1); PV_D0(2); PV_D0(3);
#undef PV_D0
#undef TRRD
}

template <int MODE>
__device__ __forceinline__ void attn_block(const bf16* __restrict__ Qp, int ldq, const bf16* __restrict__ Kp, int ldk, const bf16* __restrict__ Vp, int ldv, bf16* __restrict__ Op, int ldo,
                                           int qb, LAS char* lds, const float* __restrict__ aux0, const float* __restrict__ aux1, const float* __restrict__ aux2) {
    int tid_ = threadIdx.x; asm volatile("" : "+v"(tid_));
    const int tid = tid_, wid = __builtin_amdgcn_readfirstlane(tid >> 6), lane = tid & 63, r32 = lane & 31, hi = lane >> 5;
    const int P0 = qb * 256, qlo = P0 + wid * 32, qpos = qlo + r32;
    const int NT = 4 * qb + 4;
    LAS char* V_lds = lds + OFF_V; LAS char* K_lds = lds + OFF_K;
    LAS float* wsf = (LAS float*)(lds + OFF_WS) + wid * 64; LAS float* li_l = wsf; LAS float* al_l = wsf + 32;
    LAS float* aux = (LAS float*)(lds + OFF_AUX);
    bf16x8 qr[8];
#pragma unroll
    for (int d0 = 0; d0 < 8; ++d0) qr[d0] = *reinterpret_cast<const bf16x8*>(Qp + (size_t)qpos * ldq + d0 * 16 + hi * 8);
    unsigned kso[2], vso[2];
#pragma unroll
    for (int i = 0; i < 2; ++i) { const int pc = 2 * wid + i, krow = pc * 4 + (lane >> 4), kch = (lane & 15) ^ (krow & 7);
        kso[i] = (unsigned)(krow * ldk + kch * 8) * 2u;
        const int kk = wid * 8 + ((lane & 31) >> 2), vk = (kk & ~0xC) | ((kk & 4) << 1) | ((kk & 8) >> 1), vc = (2 * i + (lane >> 5)) * 32 + (lane & 3) * 8;
        vso[i] = (unsigned)(vk * ldv + vc) * 2u; }
    const int vb0 = (int)(unsigned)(size_t)V_lds + v_rd_base(lane);
    float m_reg = -1e30f, l_reg = 0.f, Rsum = 0.f, den = 0.f, M2row = 0.f, nmrow = 1.f; unsigned sel = 0u;
    if constexpr (MODE == MODE_ML) { for (int i = tid; i < P0 + 256; i += 512) aux[i] = aux0[i]; M2row = aux1[qpos]; nmrow = aux2[qpos]; }
    if constexpr (MODE == MODE_MOBA) { for (int i = tid; i < qb * 128; i += 512) aux[i] = aux0[i]; }
#define TJ(i) ((MODE == MODE_SB) ? (NT - 1 - (i)) : (i))
#define SLOAD(kb_, bf) do { const char* kg_ = (const char*)(Kp + (size_t)(kb_) * ldk); const char* vg_ = (const char*)(Vp + (size_t)(kb_) * ldv); \
        _Pragma("unroll") for (int i_ = 0; i_ < 2; ++i_) { \
            __builtin_amdgcn_global_load_lds((const unsigned*)(kg_ + kso[i_]), (LAS unsigned*)(K_lds + (bf) * SHM + (2 * wid + i_) * 1024), 16, 0, 0); \
            __builtin_amdgcn_global_load_lds((const unsigned*)(vg_ + vso[i_]), (LAS unsigned*)(V_lds + (bf) * SHM + (2 * wid + i_) * 1024), 16, 0, 0); } } while (0)
    SLOAD(TJ(0) * 64, 0); VM_WAIT(); LDS_WAIT(); WG_BAR();
    if constexpr (MODE == MODE_MOBA) {
        if (qb <= 3) sel = (1u << qb) - 1u;
        else {
            float g[7];
#pragma unroll
            for (int n = 0; n < 7; ++n) { g[n] = -__builtin_inff();
                if (n < qb) { float s = 0.f;
#pragma unroll
                    for (int d0 = 0; d0 < 8; ++d0) { const LAS f32x4* kp = (const LAS f32x4*)(aux + n * 128 + d0 * 16 + hi * 8); const f32x4 k0 = kp[0], k1 = kp[1];
                        const u32x4 qw = *reinterpret_cast<const u32x4*>(&qr[d0]);
                        s = fmaf(bf_lo(qw.x), k0[0], s); s = fmaf(bf_hi(qw.x), k0[1], s); s = fmaf(bf_lo(qw.y), k0[2], s); s = fmaf(bf_hi(qw.y), k0[3], s);
                        s = fmaf(bf_lo(qw.z), k1[0], s); s = fmaf(bf_hi(qw.z), k1[1], s); s = fmaf(bf_lo(qw.w), k1[2], s); s = fmaf(bf_hi(qw.w), k1[3], s); }
                    g[n] = pair_sum(s); }
                asm volatile("" ::: "memory"); }
#pragma unroll
            for (int k = 0; k < 3; ++k) { float best = -__builtin_inff(); int bi = 0;
#pragma unroll
                for (int n = 0; n < 7; ++n) if (g[n] > best) { best = g[n]; bi = n; }
                sel |= 1u << bi;
#pragma unroll
                for (int n = 0; n < 7; ++n) g[n] = (bi == n) ? -__builtin_inff() : g[n]; }
        }
    }
    f32x16 o[4];
#pragma unroll
    for (int d_ = 0; d_ < 4; ++d_)
#pragma unroll
        for (int r = 0; r < 16; ++r) o[d_][r] = 0.f;
    for (int i = 0; i < NT; ++i) {
        const int tj = TJ(i), kb = tj * 64, buf = i & 1;
        if (i + 1 < NT) SLOAD(TJ(i + 1) * 64, buf ^ 1);
        SBAR();
        bool act = (MODE == MODE_SB) ? (kb <= qlo + 30) : (kb <= qlo + 31);
        if constexpr (MODE == MODE_MOBA) { const int n = tj >> 2; if (n != qb) act = act && __any((int)((sel >> n) & 1u)); }
        if (act) {
            f32x16 p0, p1; bf16x8 pa0, pa1, pa2, pa3;
            qkt(p0, p1, K_lds + buf * SHM, r32, hi, qr);
            const int dq = qpos - kb - 4 * hi;
            if constexpr (MODE == MODE_DIL || MODE == MODE_MOBA) {
                if constexpr (MODE == MODE_DIL) {
#pragma unroll
                    for (int r = 0; r < 16; ++r) { const int c = (r & 3) + 8 * (r >> 2);
                        { const unsigned ud = (unsigned)(dq - c); const int cnt = (int)(ud <= 128u) + (int)(((ud & 3u) == 0u) & (ud <= 512u)) + (int)((ud & 0x8000000Fu) == 0u);
                          p0[r] += __builtin_amdgcn_logf((float)cnt) * (1.0f / C2); }
                        { const unsigned ud = (unsigned)(dq - c - 32); const int cnt = (int)(ud <= 128u) + (int)(((ud & 3u) == 0u) & (ud <= 512u)) + (int)((ud & 0x8000000Fu) == 0u);
                          p1[r] += __builtin_amdgcn_logf((float)cnt) * (1.0f / C2); } }
                } else {
                    const int n = tj >> 2;
                    if (n == qb) { if (kb + 63 > qlo) mask_tile(p0, p1, dq); }
                    else if (!((sel >> n) & 1u)) {
#pragma unroll
                        for (int r = 0; r < 16; ++r) { p0[r] = -__builtin_inff(); p1[r] = -__builtin_inff(); } }
                }
                float mn, alpha;
                partialSM(p0, p1, m_reg, mn, alpha);
                float ps = 0.f;
#pragma unroll
                for (int r = 0; r < 16; ++r) ps += p0[r];
#pragma unroll
                for (int r = 0; r < 16; ++r) ps += p1[r];
                ps = pair_sum(ps);
                l_reg = l_reg * alpha + ps;
                pack_p(p0, p1, pa0, pa1, pa2, pa3);
                if (__any(alpha < 1.f)) { if (hi == 0) al_l[r32] = alpha; LDS_WAIT();
#pragma unroll
                    for (int d_ = 0; d_ < 4; ++d_)
#pragma unroll
                        for (int r = 0; r < 16; ++r) o[d_][r] *= al_l[crow(r, hi)]; }
            } else if constexpr (MODE == MODE_ML) {
                float dsum = 0.f;
#pragma unroll
                for (int r4 = 0; r4 < 4; ++r4) {
                    const f32x4 a0 = *(const LAS f32x4*)(aux + kb + 8 * r4 + 4 * hi), a1 = *(const LAS f32x4*)(aux + kb + 32 + 8 * r4 + 4 * hi);
#pragma unroll
                    for (int j = 0; j < 4; ++j) { const int r = 4 * r4 + j, c = 8 * r4 + j;
                        float s0 = p0[r] * SCALE * __builtin_amdgcn_exp2f(a0[j] - M2row); s0 = (dq - c < 0) ? 0.f : s0;
                        float s1 = p1[r] * SCALE * __builtin_amdgcn_exp2f(a1[j] - M2row); s1 = (dq - c - 32 < 0) ? 0.f : s1;
                        p0[r] = s0; p1[r] = s1; dsum += s0 + s1; } }
                den += dsum;
                pack_p(p0, p1, pa0, pa1, pa2, pa3);
            } else {
                f32x16 z0, z1; float gs[8];
#pragma unroll
                for (int r = 0; r < 16; ++r) { const int c = (r & 3) + 8 * (r >> 2);
                    { const float z2 = p0[r] * C2; const float sp = fmaxf(z2, 0.f) + __builtin_amdgcn_logf(1.0f + __builtin_amdgcn_exp2f(-fabsf(z2)));
                      z0[r] = z2; const float spm = ((dq - 1 - c) >= 0) ? sp : 0.f; p0[r] = spm; if ((r & 3) == 0) gs[r >> 2] = spm; else gs[r >> 2] += spm; }
                    { const float z2 = p1[r] * C2; const float sp = fmaxf(z2, 0.f) + __builtin_amdgcn_logf(1.0f + __builtin_amdgcn_exp2f(-fabsf(z2)));
                      z1[r] = z2; const float spm = ((dq - 1 - c - 32) >= 0) ? sp : 0.f; p1[r] = spm; if ((r & 3) == 0) gs[4 + (r >> 2)] = spm; else gs[4 + (r >> 2)] += spm; } }
                float aft[8]; float run = 0.f;
#pragma unroll
                for (int i2 = 7; i2 >= 0; --i2) { const float pg = __shfl_xor(gs[i2], 32); aft[i2] = run + (hi == 0 ? pg : 0.f); run += gs[i2] + pg; }
#pragma unroll
                for (int i2 = 0; i2 < 8; ++i2) { float suf = Rsum + aft[i2];
#pragma unroll
                    for (int j = 3; j >= 0; --j) { const int r = 4 * (i2 & 3) + j, c = 8 * (i2 & 3) + j + ((i2 >> 2) ? 32 : 0);
                        const bool ok = (dq - 1 - c) >= 0;
                        if (i2 >> 2) { suf += p1[r]; p1[r] = ok ? __builtin_amdgcn_exp2f(z1[r] - suf) : 0.f; }
                        else { suf += p0[r]; p0[r] = ok ? __builtin_amdgcn_exp2f(z0[r] - suf) : 0.f; } } }
                Rsum += run;
                pack_p(p0, p1, pa0, pa1, pa2, pa3);
            }
            SBAR();
            pv_tile(o, vb0 + buf * SHM, pa0, pa1, pa2, pa3);
        }
        SBAR();
        VM_WAIT(); LDS_WAIT(); WG_BAR();
    }
    if constexpr (MODE == MODE_DIL || MODE == MODE_MOBA) { if (hi == 0) li_l[r32] = l_reg; }
    if constexpr (MODE == MODE_ML) { const float dt = pair_sum(den); if (hi == 0) li_l[r32] = fmaxf(fabsf(dt), nmrow); }
    LDS_WAIT();
    bf16* Ow = Op + (size_t)qlo * ldo;
#pragma unroll
    for (int r = 0; r < 16; ++r) { const int orow = crow(r, hi);
        float rl = 1.f; if constexpr (MODE != MODE_SB) rl = __builtin_amdgcn_rcpf(li_l[orow]);
#pragma unroll
        for (int d0 = 0; d0 < 4; ++d0) { const float v = o[d0][r] * rl; const float vn = __shfl_xor(v, 1);
            if ((r32 & 1) == 0) *(unsigned*)(Ow + (size_t)orow * ldo + d0 * 32 + r32) = cvtpk(v, vn); } }
    LDS_WAIT();
#undef TJ
#undef SLOAD
}
}

struct Args { const float* in[16]; float* out; unsigned char* ws; };
static_assert(sizeof(Args) == 18 * 8, "Args has no padding");

struct Frame {
    LAS unsigned char* lds; int tid, lane, wave, vcu, G, gw, NGW;
};

__device__ __forceinline__ void tr_item(const float* __restrict__ W, int K, int N, bf16* __restrict__ WT, int item, int nblk, LAS unsigned* scr, int lane, int rmode) {
    const int kb = item / nblk, nb = item - kb * nblk, k0 = kb * 64, n0 = nb * 64;
    const int nq = lane & 15, kr = lane >> 4;
    const bool inb = (n0 + 4 * nq) < N;
    f32x4 a[8], b[8];
#pragma unroll
    for (int s = 0; s < 8; ++s) { const int kp = 4 * s + kr; const float* p = W + (size_t)(k0 + 2 * kp) * N + n0 + 4 * nq;
        if (inb) { a[s] = *(const f32x4*)p; b[s] = *(const f32x4*)(p + N); } else { a[s] = (f32x4){0.f, 0.f, 0.f, 0.f}; b[s] = (f32x4){0.f, 0.f, 0.f, 0.f}; } }
#pragma unroll
    for (int s = 0; s < 8; ++s) { const int kp = 4 * s + kr;
#pragma unroll
        for (int i = 0; i < 4; ++i) scr[(4 * nq + i) * 33 + kp] = cvtpk(a[s][i], b[s][i]); }
    LDS_WAIT();
#pragma unroll
    for (int jj = 0; jj < 8; ++jj) { const int n = (lane >> 3) + 8 * jj, c = lane & 7; const LAS unsigned* s = scr + n * 33 + 4 * c;
        u32x4 o; o.x = s[0]; o.y = s[1]; o.z = s[2]; o.w = s[3];
        const int nn = n0 + n, drow = rmode ? (((nn >> 7) << 8) + (nn & 127) + (rmode == 2 ? 128 : 0)) : nn;
        *(u32x4*)(WT + (size_t)drow * K + k0 + 8 * c) = o; }
    LDS_WAIT();
}

__device__ __forceinline__ void prologue(const Frame& F_, const Args& a) {
    Frame F = F_; asm volatile("" : "+v"(F.lane), "+v"(F.tid), "+s"(F.gw), "+s"(F.vcu), "+s"(F.wave));
    unsigned char* ws = a.ws;
    LAS unsigned* scr = (LAS unsigned*)(F.lds + F.wave * 8448);
    constexpr int I_INAB = 64 * 192, I_OUT = 64 * 64, I_INCD = 64 * 196, I_UP = 64 * 172, I_DN = 172 * 64;
    constexpr int TOTAL = I_INAB + I_OUT + I_INCD + I_OUT + 4 * I_UP + 2 * I_DN;
    for (int it = F.gw; it < TOTAL; it += F.NGW) {
        int r = it; const float* W; int K, N, nblk; bf16* WT; int rmode = 0;
        if (r < I_INAB) { W = a.in[1]; K = DM; N = N_AB; nblk = 192; WT = (bf16*)(ws + WS_W_INAB); }
        else if ((r -= I_INAB) < I_OUT) { W = a.in[2]; K = DM; N = DM; nblk = 64; WT = (bf16*)(ws + WS_W_OUTAB); }
        else if ((r -= I_OUT) < I_INCD) { W = a.in[3]; K = DM; N = N_CD; nblk = 196; WT = (bf16*)(ws + WS_W_INCD); }
        else if ((r -= I_INCD) < I_OUT) { W = a.in[8]; K = DM; N = DM; nblk = 64; WT = (bf16*)(ws + WS_W_OUTCD); }
        else if ((r -= I_OUT) < I_UP) { W = a.in[9]; K = DM; N = DFF; nblk = 172; WT = (bf16*)(ws + WS_W_UG0); rmode = 1; }
        else if ((r -= I_UP) < I_UP) { W = a.in[10]; K = DM; N = DFF; nblk = 172; WT = (bf16*)(ws + WS_W_UG0); rmode = 2; }
        else if ((r -= I_UP) < I_DN) { W = a.in[13]; K = DFF; N = DM; nblk = 64; WT = (bf16*)(ws + WS_W_DN0); }
        else if ((r -= I_DN) < I_UP) { W = a.in[9] + (size_t)DM * DFF; K = DM; N = DFF; nblk = 172; WT = (bf16*)(ws + WS_W_UG1); rmode = 1; }
        else if ((r -= I_UP) < I_UP) { W = a.in[10] + (size_t)DM * DFF; K = DM; N = DFF; nblk = 172; WT = (bf16*)(ws + WS_W_UG1); rmode = 2; }
        else { r -= I_UP; W = a.in[13] + (size_t)DFF * DM; K = DFF; N = DM; nblk = 64; WT = (bf16*)(ws + WS_W_DN1); }
        tr_item(W, K, N, WT, r, nblk, scr, F.lane, rmode);
    }
    const f32x4* x4 = (const f32x4*)a.in[0]; u32x2* xb = (u32x2*)(ws + WS_XB);
    for (size_t i = (size_t)F.gw * 64 + F.lane; i < (size_t)M * DM / 4; i += (size_t)F.NGW * 64) { const f32x4 v = x4[i]; u32x2 o; o.x = cvtpk(v[0], v[1]); o.y = cvtpk(v[2], v[3]); xb[i] = o; }
}

__device__ __forceinline__ void ln_phase(const Frame& F_, const float* z, float* xo, bf16* xb, const float* g, const float* b, float oscale = 1.f) {
    Frame F = F_; asm volatile("" : "+v"(F.lane), "+v"(F.tid), "+s"(F.gw), "+s"(F.vcu), "+s"(F.wave));
    for (int m = F.gw; m < M; m += F.NGW) {
        const f32x4* zr = (const f32x4*)(z + (size_t)m * DM) + F.lane;
        f32x4 v[16]; float s = 0.f;
#pragma unroll
        for (int j = 0; j < 16; ++j) { v[j] = zr[64 * j]; s += (v[j][0] + v[j][1]) + (v[j][2] + v[j][3]); }
        const float mean = wave_sum(s) * (1.f / DM); float s2 = 0.f;
#pragma unroll
        for (int j = 0; j < 16; ++j) { v[j] = v[j] - mean; s2 += (v[j][0] * v[j][0] + v[j][1] * v[j][1]) + (v[j][2] * v[j][2] + v[j][3] * v[j][3]); }
        const float rstd = 1.f / sqrtf(wave_sum(s2) * (1.f / DM) + LN_EPS);
        f32x4* xr = (f32x4*)(xo + (size_t)m * DM) + F.lane; u32x2* br = (u32x2*)((xb ? xb : (bf16*)xo) + (size_t)m * DM) + F.lane;
        const f32x4* g4 = (const f32x4*)g + F.lane; const f32x4* b4 = (const f32x4*)b + F.lane;
#pragma unroll
        for (int j = 0; j < 16; ++j) { f32x4 o = v[j] * rstd * g4[64 * j] + b4[64 * j]; if (SELFCHECK) o = o * oscale; xr[64 * j] = o;
            if (xb) { u32x2 w; w.x = cvtpk(o[0], o[1]); w.y = cvtpk(o[2], o[3]); br[64 * j] = w; } }
    }
}

__device__ __forceinline__ void ffn_act_phase(const Frame& F_, bf16* U, const bf16* Gb, const float* cw  , const float* cb, bool dummy = false) {
    Frame F = F_; asm volatile("" : "+v"(F.lane), "+v"(F.tid), "+s"(F.gw), "+s"(F.vcu), "+s"(F.wave));
    constexpr int NCH = DFF / 8, NCB = (NCH + 63) / 64, NITEM = (M / 32) * NCB;
    for (int it = F.gw; it < NITEM; it += F.NGW) {
        const int rb = it / NCB, cbk = it - rb * NCB, ch = cbk * 64 + F.lane;
        if (ch >= NCH) continue;
        const int c0 = ch * 8, r0 = rb * 32;
        float w0[8], w1[8], w2[8], bb[8];
#pragma unroll
        for (int q = 0; q < 2; ++q) { const f32x4 t0 = *(const f32x4*)(cw + c0 + 4 * q), t1 = *(const f32x4*)(cw + DFF + c0 + 4 * q), t2 = *(const f32x4*)(cw + 2 * DFF + c0 + 4 * q), t3 = *(const f32x4*)(cb + c0 + 4 * q);
#pragma unroll
            for (int j = 0; j < 4; ++j) { w0[4 * q + j] = t0[j]; w1[4 * q + j] = t1[j]; w2[4 * q + j] = t2[j]; bb[4 * q + j] = t3[j]; } }
        u32x4 gm2 = {0u, 0u, 0u, 0u}, gm1 = {0u, 0u, 0u, 0u};
        if ((r0 & (SEQ - 1)) != 0) { gm2 = *(const u32x4*)(Gb + (size_t)(r0 - 2) * DFF + c0); gm1 = *(const u32x4*)(Gb + (size_t)(r0 - 1) * DFF + c0); }
        for (int t8 = 0; t8 < 32; t8 += 8) {
            u32x4 gv[8], uv[8];
#pragma unroll
            for (int t = 0; t < 8; ++t) { gv[t] = *(const u32x4*)(Gb + (size_t)(r0 + t8 + t) * DFF + c0); uv[t] = *(const u32x4*)(U + (size_t)(r0 + t8 + t) * DFF + c0); }
#pragma unroll
            for (int t = 0; t < 8; ++t) { u32x4 ov;
#pragma unroll
                for (int q = 0; q < 4; ++q) {
                    const float y0 = w0[2 * q] * bf_lo(gm2[q]) + w1[2 * q] * bf_lo(gm1[q]) + w2[2 * q] * bf_lo(gv[t][q]) + bb[2 * q];
                    const float y1 = w0[2 * q + 1] * bf_hi(gm2[q]) + w1[2 * q + 1] * bf_hi(gm1[q]) + w2[2 * q + 1] * bf_hi(gv[t][q]) + bb[2 * q + 1];
                    ov[q] = cvtpk(silu_f(y0) * bf_lo(uv[t][q]), silu_f(y1) * bf_hi(uv[t][q])); }
                if (REP_MASK & 4096) { if (dummy) ov = uv[t]; }
                *(u32x4*)(U + (size_t)(r0 + t8 + t) * DFF + c0) = ov; gm2 = gm1; gm1 = gv[t]; }
        }
    }
}


__device__ __forceinline__ void ffn_fix_phase(const Frame& F_, bf16* H, const float* EG0, const float* EU0, const float* EGL, const float* cw, const float* cb) {
    Frame F = F_; asm volatile("" : "+v"(F.lane), "+v"(F.tid), "+s"(F.gw), "+s"(F.vcu), "+s"(F.wave));
    constexpr int C4 = DFF / 4;
    for (int idx = F.gw * 64 + F.lane; idx < 64 * C4; idx += F.NGW * 64) {
        const int pm = idx / C4, ch = (idx - pm * C4) * 4;
        f32x4 gl0 = {0.f, 0.f, 0.f, 0.f}, gl1 = gl0;
        if ((pm & 7) != 0) { gl0 = *(const f32x4*)(EGL + (size_t)((pm - 1) * 2) * DFF + ch); gl1 = *(const f32x4*)(EGL + (size_t)((pm - 1) * 2 + 1) * DFF + ch); }
        const f32x4 g0 = *(const f32x4*)(EG0 + (size_t)(pm * 2) * DFF + ch), g1 = *(const f32x4*)(EG0 + (size_t)(pm * 2 + 1) * DFF + ch);
        const f32x4 u0 = *(const f32x4*)(EU0 + (size_t)(pm * 2) * DFF + ch), u1 = *(const f32x4*)(EU0 + (size_t)(pm * 2 + 1) * DFF + ch);
        const f32x4 w0 = *(const f32x4*)(cw + ch), w1 = *(const f32x4*)(cw + DFF + ch), w2 = *(const f32x4*)(cw + 2 * DFF + ch), bb = *(const f32x4*)(cb + ch);
        const f32x4 y0 = w0 * gl0 + w1 * gl1 + w2 * g0 + bb, y1 = w0 * gl1 + w1 * g0 + w2 * g1 + bb;
        u32x2 o0, o1;
        o0.x = cvtpk(silu_f(y0[0]) * u0[0], silu_f(y0[1]) * u0[1]); o0.y = cvtpk(silu_f(y0[2]) * u0[2], silu_f(y0[3]) * u0[3]);
        o1.x = cvtpk(silu_f(y1[0]) * u1[0], silu_f(y1[1]) * u1[1]); o1.y = cvtpk(silu_f(y1[2]) * u1[2], silu_f(y1[3]) * u1[3]);
        *(u32x2*)(H + (size_t)(pm * 256) * DFF + ch) = o0; *(u32x2*)(H + (size_t)(pm * 256 + 1) * DFF + ch) = o1;
    }
}

__device__ __forceinline__ void kmean_phase(const Frame& F_, const bf16* QKV, float* kmean) {
    Frame F = F_; asm volatile("" : "+v"(F.lane), "+v"(F.tid), "+s"(F.gw), "+s"(F.vcu), "+s"(F.wave));
    LAS float* red = (LAS float*)F.lds;
    for (int it = F.vcu; it < 256; it += F.G) {
        const int b = it >> 5, n = (it >> 2) & 7, cbk = it & 3;
        const bf16* src = QKV + (size_t)(b * SEQ + n * 256 + F.wave * 32) * N_AB + 8192 + cbk * 512 + F.lane * 8;
        float acc[8];
#pragma unroll
        for (int j = 0; j < 8; ++j) acc[j] = 0.f;
        for (int r8 = 0; r8 < 32; r8 += 8) { u32x4 v[8];
#pragma unroll
            for (int r = 0; r < 8; ++r) v[r] = *(const u32x4*)(src + (size_t)(r8 + r) * N_AB);
#pragma unroll
            for (int r = 0; r < 8; ++r)
#pragma unroll
                for (int q = 0; q < 4; ++q) { acc[2 * q] += bf_lo(v[r][q]); acc[2 * q + 1] += bf_hi(v[r][q]); } }
#pragma unroll
        for (int j = 0; j < 8; ++j) red[F.wave * 512 + F.lane * 8 + j] = acc[j];
        LDS_WAIT(); WG_BAR();
        float s = 0.f;
#pragma unroll
        for (int w = 0; w < 8; ++w) s += red[w * 512 + F.tid];
        const int col = cbk * 512 + F.tid, h = col >> 7, d = col & 127;
        kmean[((size_t)(b * 16 + h) * 8 + n) * 128 + d] = s * (1.f / 256.f);
        LDS_WAIT(); WG_BAR();
    }
}

__device__ __forceinline__ void cd_pre_phase(const Frame& F_, const bf16* QKV, bf16* QKDC, const float* cw  , const float* cb, const float* gates, const float* bif, float* A2, float* M2, float* NM) {
    Frame F = F_; asm volatile("" : "+v"(F.lane), "+v"(F.tid), "+s"(F.gw), "+s"(F.vcu), "+s"(F.wave));
    for (int it = F.gw; it < (M / 32) * 4; it += F.NGW) {
        const int rb = it >> 2, cbk = it & 3, c0 = cbk * 512 + F.lane * 8, r0 = rb * 32;
        float w[4][8], bb[8];
#pragma unroll
        for (int q = 0; q < 2; ++q) { const f32x4 t3 = *(const f32x4*)(cb + c0 + 4 * q);
#pragma unroll
            for (int j = 0; j < 4; ++j) bb[4 * q + j] = t3[j];
#pragma unroll
            for (int k = 0; k < 4; ++k) { const f32x4 t = *(const f32x4*)(cw + k * 2048 + c0 + 4 * q);
#pragma unroll
                for (int j = 0; j < 4; ++j) w[k][4 * q + j] = t[j]; } }
        const bf16* src = QKV + 6144 + c0;
        u32x4 x3 = {0u, 0u, 0u, 0u}, x2 = x3, x1 = x3;
        if ((r0 & (SEQ - 1)) != 0) { x3 = *(const u32x4*)(src + (size_t)(r0 - 3) * N_AB); x2 = *(const u32x4*)(src + (size_t)(r0 - 2) * N_AB); x1 = *(const u32x4*)(src + (size_t)(r0 - 1) * N_AB); }
        for (int t8 = 0; t8 < 32; t8 += 8) {
            u32x4 xv[8];
#pragma unroll
            for (int t = 0; t < 8; ++t) xv[t] = *(const u32x4*)(src + (size_t)(r0 + t8 + t) * N_AB);
#pragma unroll
            for (int t = 0; t < 8; ++t) { u32x4 ov;
#pragma unroll
                for (int q = 0; q < 4; ++q) {
                    const float y0 = w[0][2 * q] * bf_lo(x3[q]) + w[1][2 * q] * bf_lo(x2[q]) + w[2][2 * q] * bf_lo(x1[q]) + w[3][2 * q] * bf_lo(xv[t][q]) + bb[2 * q];
                    const float y1 = w[0][2 * q + 1] * bf_hi(x3[q]) + w[1][2 * q + 1] * bf_hi(x2[q]) + w[2][2 * q + 1] * bf_hi(x1[q]) + w[3][2 * q + 1] * bf_hi(xv[t][q]) + bb[2 * q + 1];
                    ov[q] = cvtpk(silu_f(y0), silu_f(y1)); }
                *(u32x4*)(QKDC + (size_t)(r0 + t8 + t) * 2048 + c0) = ov; x3 = x2; x2 = x1; x1 = xv[t]; }
        }
    }
    for (int sq = F.gw; sq < 64; sq += F.NGW) {
        const int b = sq >> 3, h = sq & 7; const float bi = bif[h], bfv = bif[8 + h];
        const float* gp = gates + (size_t)(b * SEQ + F.lane * 32) * 16;
        float lf[32], ai[32]; float run = 0.f;
#pragma unroll
        for (int t = 0; t < 32; ++t) { const float f = gp[t * 16 + 8 + h] + bfv; ai[t] = gp[t * 16 + h] + bi;
            const float ls = fminf(f, 0.f) - log1pf(expf(-fabsf(f)));
            run += ls; lf[t] = run; }
        float incl = run;
#pragma unroll
        for (int o = 1; o < 64; o <<= 1) { const float t = __shfl_up(incl, o); if (F.lane >= o) incl += t; }
        const float base = incl - run; float mx = -__builtin_inff();
#pragma unroll
        for (int t = 0; t < 32; ++t) { lf[t] += base; ai[t] -= lf[t]; mx = fmaxf(mx, ai[t]); }
        float minc = mx;
#pragma unroll
        for (int o = 1; o < 64; o <<= 1) { const float t = __shfl_up(minc, o); if (F.lane >= o) minc = fmaxf(minc, t); }
        float mprev = __shfl_up(minc, 1); if (F.lane == 0) mprev = -__builtin_inff();
        float cm = fmaxf(mprev, 0.f);
        float* a2o = A2 + (size_t)sq * SEQ + F.lane * 32; float* m2o = M2 + (size_t)sq * SEQ + F.lane * 32; float* nmo = NM + (size_t)sq * SEQ + F.lane * 32;
#pragma unroll
        for (int t = 0; t < 32; ++t) { cm = fmaxf(cm, ai[t]); a2o[t] = ai[t] * 1.4426950408889634f; m2o[t] = cm * 1.4426950408889634f; nmo[t] = expf(-lf[t] - cm); }
    }
}

__device__ __forceinline__ void cd_post_phase(const Frame& F_, const bf16* HD, const bf16* QKV, bf16* Y, const float* ng) {
    Frame F = F_; asm volatile("" : "+v"(F.lane), "+v"(F.tid), "+s"(F.gw), "+s"(F.vcu), "+s"(F.wave));
    for (int it = F.gw; it < M * 8; it += F.NGW) {
        const int m = it >> 3, h = it & 7, c = h * 256 + F.lane * 4;
        const u32x2 hv = *(const u32x2*)(HD + (size_t)m * 2048 + c); const u32x2 ov = *(const u32x2*)(QKV + (size_t)m * N_AB + 10240 + c);
        const f32x4 g = *(const f32x4*)(ng + c);
        float v0 = bf_lo(hv.x), v1 = bf_hi(hv.x), v2 = bf_lo(hv.y), v3 = bf_hi(hv.y);
        const float mean = wave_sum((v0 + v1) + (v2 + v3)) * (1.f / 256.f);
        v0 -= mean; v1 -= mean; v2 -= mean; v3 -= mean;
        const float rstd = 1.f / sqrtf(wave_sum((v0 * v0 + v1 * v1) + (v2 * v2 + v3 * v3)) * (1.f / 256.f) + LN_EPS);
        const float o0 = bf_lo(ov.x), o1 = bf_hi(ov.x), o2 = bf_lo(ov.y), o3 = bf_hi(ov.y);
        const float y0 = v0 * rstd * g[0] * __builtin_amdgcn_rcpf(1.f + __builtin_amdgcn_exp2f(-1.4426950408889634f * o0));
        const float y1 = v1 * rstd * g[1] * __builtin_amdgcn_rcpf(1.f + __builtin_amdgcn_exp2f(-1.4426950408889634f * o1));
        const float y2 = v2 * rstd * g[2] * __builtin_amdgcn_rcpf(1.f + __builtin_amdgcn_exp2f(-1.4426950408889634f * o2));
        const float y3 = v3 * rstd * g[3] * __builtin_amdgcn_rcpf(1.f + __builtin_amdgcn_exp2f(-1.4426950408889634f * o3));
        u32x2 w; w.x = cvtpk(y0, y1); w.y = cvtpk(y2, y3);
        *(u32x2*)(Y + (size_t)m * DM + 2048 + c) = w;
    }
}


#if SELFCHECK
constexpr int CW_ERR = 64;
__device__ __forceinline__ unsigned hash_u(unsigned x) { x ^= x >> 16; x *= 0x7feb352du; x ^= x >> 15; x *= 0x846ca68bu; x ^= x >> 16; return x; }
__device__ __forceinline__ float bfr(float f) { return bf_lo(cvtpk(f, 0.f)); }
__device__ __forceinline__ float bfv(const bf16* p) { return __uint_as_float(((unsigned)*p) << 16); }
__device__ __forceinline__ float blk_red(LAS float* red, float v, int tid, bool domax) {
    red[tid] = v; __syncthreads();
    for (int o = 256; o >= 1; o >>= 1) { if (tid < o) red[tid] = domax ? fmaxf(red[tid], red[tid + o]) : (red[tid] + red[tid + o]); __syncthreads(); }
    const float r = red[0]; __syncthreads(); return r;
}
__device__ __forceinline__ int sample_t(int ci) {
    if (ci < 4) return ci;
    if (ci < 22) { const int g = (ci - 4) / 3, o = (ci - 4) % 3 - 1; return (g == 0 ? 16 : (32 << g)) + o; }
    if (ci < 24) return 2024 + ci;
    return (int)(hash_u(ci * 2654435761u + 12345u) & 2047u); }
__device__ __forceinline__ void gemm_check(const Frame& F_, const bf16* XB, const float* W, int N, const bf16* QKV, const float* GATES, unsigned* err, unsigned bit) {
    Frame F = F_; asm volatile("" : "+v"(F.lane), "+v"(F.tid), "+s"(F.gw), "+s"(F.vcu), "+s"(F.wave));
    for (int e = 0; e < 16; ++e) {
        const unsigned hsh = hash_u((unsigned)(F.gw * 16 + e) * 2246822519u + bit);
        const int row = (int)(hsh & 16383u); int col = (int)((hsh >> 14) % (unsigned)N);
        if (N == N_CD && (e & 3) == 3) col = 12288 + (int)((hsh >> 14) & 15u);
        float s = 0.f;
        for (int k = F.lane; k < DM; k += 64) s += bfv(XB + (size_t)row * DM + k) * bfr(W[(size_t)k * N + col]);
        s = wave_sum(s);
        const float got = (col < 12288) ? bfv(QKV + (size_t)row * N_AB + col) : GATES[(size_t)row * 16 + (col - 12288)];
        if (!(fabsf(got - s) <= 0.02f * fabsf(s) + 0.02f)) { if (F.lane == 0) atomicOr(err, bit); }
    }
}
__device__ __forceinline__ void attn_check(const Frame& F_, int mode, const bf16* Q, const bf16* K, const bf16* V, int ld, const bf16* O, int ldo, int t, unsigned* err, unsigned bit) {
    Frame F = F_; asm volatile("" : "+v"(F.lane), "+v"(F.tid), "+s"(F.gw), "+s"(F.vcu), "+s"(F.wave));
    LAS float* qf = (LAS float*)F.lds; LAS float* sc = qf + 256; LAS float* red = sc + 2048; LAS float* km = red + 512;
    LAS unsigned* selw = (LAS unsigned*)(km + 1024);
    const int tid = F.tid;
    if (tid < 128) qf[tid] = bfv(Q + (size_t)t * ld + tid);
    __syncthreads();
    const int own = t >> 8;
    if (mode == 1) {
        for (int i = tid; i < own * 128; i += 512) { const int n = i >> 7, d = i & 127; float a = 0.f; for (int r = 0; r < 256; ++r) a += bfv(K + (size_t)(n * 256 + r) * ld + d); km[i] = a * (1.f / 256.f); }
        __syncthreads();
        if (tid == 0) { LAS float* g = km + 1024 + 16; for (int n = 0; n < 8; ++n) { g[n] = -__builtin_inff(); if (n < own) { float a = 0.f; for (int d = 0; d < 128; ++d) a += qf[d] * km[n * 128 + d]; g[n] = a; } }
            unsigned sel = 0u; const int topk = own < 3 ? own : 3;
            for (int k = 0; k < topk; ++k) { int bi = 0; float best = -__builtin_inff(); for (int n = 0; n < own; ++n) if (g[n] > best) { best = g[n]; bi = n; } sel |= 1u << bi; g[bi] = -__builtin_inff(); }
            selw[0] = sel; }
        __syncthreads();
    }
    const int nk = (mode == 2) ? t : t + 1;
    float lmax = -__builtin_inff();
    for (int sidx = tid; sidx < nk; sidx += 512) { float a = 0.f; for (int d = 0; d < 128; ++d) a += qf[d] * bfv(K + (size_t)sidx * ld + d);
        a *= 0.08838834764831845f;
        if (mode == 0) { const int dd = t - sidx; const int cnt = (dd <= 128 ? 1 : 0) + (((dd & 3) == 0 && dd <= 512) ? 1 : 0) + ((dd & 15) == 0 ? 1 : 0); a = cnt ? a + logf((float)cnt) : -__builtin_inff(); }
        if (mode == 1) { const int n = sidx >> 8; if (!(n == own || ((selw[0] >> n) & 1u))) a = -__builtin_inff(); }
        sc[sidx] = a; lmax = fmaxf(lmax, a); }
    __syncthreads();
    float den = 1.f;
    if (mode != 2) { const float mx = blk_red(red, lmax, tid, true); float ls = 0.f;
        for (int sidx = tid; sidx < nk; sidx += 512) { const float p = expf(sc[sidx] - mx); sc[sidx] = p; ls += p; }
        __syncthreads(); den = blk_red(red, ls, tid, false); }
    else { if (tid == 0) { float rc = 0.f; for (int sidx = nk - 1; sidx >= 0; --sidx) { const float z = sc[sidx]; const float sp = fmaxf(z, 0.f) + log1pf(expf(-fabsf(z))); rc += sp; sc[sidx] = expf(z - rc); } } __syncthreads(); }
    float ov = 0.f, df = 0.f;
    if (tid < 128) { float a = 0.f; for (int sidx = 0; sidx < nk; ++sidx) a += sc[sidx] * bfv(V + (size_t)sidx * ld + tid); ov = a / den; df = fabsf(bfv(O + (size_t)t * ldo + tid) - ov); }
    const float mo = blk_red(red, fabsf(ov), tid, true), md = blk_red(red, df, tid, true);
    if (tid == 0 && !(md <= 0.03f * mo + 1e-6f)) atomicOr(err, bit);
    __syncthreads();
}
__device__ __forceinline__ void ml_check(const Frame& F_, const bf16* QKV  , const float* GATES  , const float* cw, const float* cb, const float* bif, const float* ng, const bf16* Y  , int h, int t, unsigned* err, unsigned bit) {
    Frame F = F_; asm volatile("" : "+v"(F.lane), "+v"(F.tid), "+s"(F.gw), "+s"(F.vcu), "+s"(F.wave));
    LAS float* qf = (LAS float*)F.lds; LAS float* sc = qf + 256; LAS float* red = sc + 2048; LAS float* av = red + 512; LAS float* misc = av + 2048;
    const int tid = F.tid;
    if (tid == 0) { float B = 0.f, mx = 0.f; for (int sidx = 0; sidx <= t; ++sidx) { const float f = GATES[(size_t)sidx * 16 + 8 + h] + bif[8 + h]; B += fminf(f, 0.f) - log1pf(expf(-fabsf(f)));
            const float a = GATES[(size_t)sidx * 16 + h] + bif[h] - B; av[sidx] = a; mx = fmaxf(mx, a); } misc[0] = mx; misc[1] = B; }
    if (tid >= 64 && tid < 192) { const int d = tid - 64, c = h * 128 + d; float y = cb[c]; for (int k = 0; k < 4; ++k) { const int r = t - 3 + k; if (r >= 0) y += cw[k * 2048 + c] * bfv(QKV + (size_t)r * N_AB + 6144 + c); } qf[d] = bfr(y / (1.f + expf(-y))); }
    __syncthreads();
    const float Mt = misc[0], Bt = misc[1];
    float ls = 0.f;
    for (int sidx = tid; sidx <= t; sidx += 512) { float a = 0.f;
        for (int d = 0; d < 128; ++d) { const int c = 1024 + h * 128 + d; float y = cb[c]; for (int k = 0; k < 4; ++k) { const int r = sidx - 3 + k; if (r >= 0) y += cw[k * 2048 + c] * bfv(QKV + (size_t)r * N_AB + 6144 + c); }
            a += qf[d] * bfr(y / (1.f + expf(-y))); }
        a *= 0.08838834764831845f * expf(av[sidx] - Mt); sc[sidx] = a; ls += a; }
    __syncthreads();
    const float den = blk_red(red, ls, tid, false);
    float hv = 0.f;
    if (tid < 256) { float a = 0.f; for (int sidx = 0; sidx <= t; ++sidx) a += sc[sidx] * bfv(QKV + (size_t)sidx * N_AB + 8192 + h * 256 + tid); hv = a / fmaxf(fabsf(den), expf(-Bt - Mt)); }
    const float mean = blk_red(red, tid < 256 ? hv : 0.f, tid, false) * (1.f / 256.f);
    const float var = blk_red(red, tid < 256 ? (hv - mean) * (hv - mean) : 0.f, tid, false) * (1.f / 256.f);
    float yv = 0.f, df = 0.f;
    if (tid < 256) { const float od = bfv(QKV + (size_t)t * N_AB + 10240 + h * 256 + tid); yv = (hv - mean) / sqrtf(var + LN_EPS) * ng[h * 256 + tid] / (1.f + expf(-od)); df = fabsf(bfv(Y + (size_t)t * DM + 2048 + h * 256 + tid) - yv); }
    const float mo = blk_red(red, fabsf(yv), tid, true), md = blk_red(red, df, tid, true);
    if (tid == 0 && !(md <= 0.03f * mo + 1e-6f)) atomicOr(err, bit);
    __syncthreads();
}
#endif

__global__ void __launch_bounds__(NWAVES * 64, 2) mk_fwd(Args args) {
    extern __shared__ __attribute__((aligned(16))) unsigned char lds_raw[];
    Frame F;
    F.lds = (LAS unsigned char*)lds_raw;
    F.tid = threadIdx.x; F.lane = F.tid & 63; F.wave = __builtin_amdgcn_readfirstlane(F.tid >> 6);
    F.G = gridDim.x; { const int bx = blockIdx.x; F.vcu = (F.G % 8 == 0) ? (bx % 8) * (F.G / 8) + bx / 8 : bx; }
    F.gw = F.vcu * NWAVES + F.wave; F.NGW = F.G * NWAVES;
    unsigned char* ws = args.ws;
    volatile LAS unsigned* MISC = (volatile LAS unsigned*)(F.lds + MISC_OFF);
    for (int u = F.tid; u < (LDS_BYTES - RING_BYTES) / 4; u += NWAVES * 64) ((LAS unsigned*)(F.lds + RING_BYTES))[u] = 0u;
    __syncthreads();
    XcdBarrier bar = xcd_barrier_post((unsigned*)(ws + WS_CTL) + CW_BAR, MISC + 8);
#define GRID_BAR() xcd_barrier(bar)

    bf16* XB = (bf16*)(ws + WS_XB); bf16* QKV = (bf16*)(ws + WS_QKV); bf16* Y = (bf16*)(ws + WS_Y); bf16* QKDC = (bf16*)(ws + WS_QKDC); bf16* HD = (bf16*)(ws + WS_HD);
    bf16* U = (bf16*)(ws + WS_U); float* EG0 = (float*)(ws + WS_G); float* EU0 = (float*)(ws + WS_G + 8 * MiB); float* EGL = (float*)(ws + WS_G + 16 * MiB);
    float* KMEAN = (float*)(ws + WS_KMEAN); float* GATES = (float*)(ws + WS_GATES); float* A2 = (float*)(ws + WS_A2); float* M2 = (float*)(ws + WS_M2); float* NMv = (float*)(ws + WS_NM);
    float* OUT = args.out;

    RP(1) PH(1) prologue(F, args);
    GRID_BAR();

    for (int layer = 0; layer < 2; ++layer) {
        {
            pg8::Gemm g{XB, (const bf16*)(ws + (layer == 0 ? WS_W_INAB : WS_W_INCD)), M, layer == 0 ? N_AB : N_CDP, DM};
            pg8::StaticOrder S; S.init(g.M, g.N, F.G, (int)blockIdx.x);
            pg8::EpiBf16 E{QKV, N_AB, 0, 0, GATES, layer == 0 ? -1 : 48};
            RP(2) PH(2) pg8::gemm_phase<pg8::EpiBf16, pg8::StaticOrder, true, true>(F.lds, g, S, E);
        }
        GRID_BAR();
#if SELFCHECK
        gemm_check(F, XB, layer == 0 ? args.in[1] : args.in[3], layer == 0 ? N_AB : N_CD, QKV, GATES, (unsigned*)(ws + WS_CTL) + CW_ERR, layer == 0 ? 4u : 32u);
#endif
        if (layer == 0) { RP(4) PH(4) kmean_phase(F, QKV, KMEAN); }
        else RP(8) PH(8) cd_pre_phase(F, QKV, QKDC, args.in[5], args.in[6], GATES, args.in[4], A2, M2, NMv);
        GRID_BAR();
#if !SKIP_MIX
        if (layer == 0) {
            for (int it = F.vcu; it < 512; it += F.G) { const int bh = it >> 2, pr = it & 3, b = bh >> 4, h = bh & 15;
                const bf16* base = QKV + (size_t)b * SEQ * N_AB + h * 128; bf16* ob = Y + (size_t)b * SEQ * DM + h * 128;
                RP(16) for (int ps = 0; ps < 2; ++ps) PH(16) att::attn_block<att::MODE_DIL>(base, N_AB, base + 2048, N_AB, base + 4096, N_AB, ob, DM, ps ? 7 - pr : pr, (LAS char*)F.lds, nullptr, nullptr, nullptr); }
            for (int it = F.vcu; it < 512; it += F.G) { const int bh = it >> 2, pr = it & 3, b = bh >> 4, h = bh & 15;
                const bf16* base = QKV + (size_t)b * SEQ * N_AB + 6144 + h * 128; bf16* ob = Y + (size_t)b * SEQ * DM + 2048 + h * 128;
                RP(32) for (int ps = 0; ps < 2; ++ps) PH(32) att::attn_block<att::MODE_MOBA>(base, N_AB, base + 2048, N_AB, base + 4096, N_AB, ob, DM, ps ? 7 - pr : pr, (LAS char*)F.lds, KMEAN + (size_t)bh * 1024, nullptr, nullptr); }
        } else {
            for (int it = F.vcu; it < 512; it += F.G) { const int bh = it >> 2, pr = it & 3, b = bh >> 4, h = bh & 15;
                const bf16* base = QKV + (size_t)b * SEQ * N_AB + h * 128; bf16* ob = Y + (size_t)b * SEQ * DM + h * 128;
                RP(64) for (int ps = 0; ps < 2; ++ps) PH(64) att::attn_block<att::MODE_SB>(base, N_AB, base + 2048, N_AB, base + 4096, N_AB, ob, DM, ps ? 7 - pr : pr, (LAS char*)F.lds, nullptr, nullptr, nullptr); }
            for (int it = F.vcu; it < 512; it += F.G) { const int bv = it >> 2, pr = it & 3, b = bv >> 4, vh = bv & 15, h = vh >> 1, half = vh & 1;
                const bf16* qd = QKDC + (size_t)b * SEQ * 2048 + h * 128; const bf16* vd = QKV + (size_t)b * SEQ * N_AB + 8192 + h * 256 + half * 128;
                bf16* ob = HD + (size_t)b * SEQ * 2048 + h * 256 + half * 128; const size_t so = (size_t)(b * 8 + h) * SEQ;
                RP(128) for (int ps = 0; ps < 2; ++ps) PH(128) att::attn_block<att::MODE_ML>(qd, 2048, qd + 1024, 2048, vd, N_AB, ob, 2048, ps ? 7 - pr : pr, (LAS char*)F.lds, A2 + so, M2 + so, NMv + so); }
            GRID_BAR();
            RP(256) PH(256) cd_post_phase(F, HD, QKV, Y, args.in[7]);
        }
#else
        { u32x4* y4 = (u32x4*)Y; for (size_t i = (size_t)F.gw * 64 + F.lane; i < (size_t)M * DM / 8; i += (size_t)F.NGW * 64) y4[i] = (u32x4){0u, 0u, 0u, 0u}; }
#endif
        GRID_BAR();
#if SELFCHECK
        { unsigned* errw = (unsigned*)(ws + WS_CTL) + CW_ERR;
          for (int ci = F.vcu; ci < 512; ci += F.G) { const int cs = ci >> 1, which = ci & 1, b = cs & 7, t = sample_t(cs);
            if (layer == 0) { const int h = (cs >> 3) & 15; const bf16* base = QKV + (size_t)b * SEQ * N_AB + (which ? 6144 : 0) + h * 128;
                attn_check(F, which, base, base + 2048, base + 4096, N_AB, Y + (size_t)b * SEQ * DM + (which ? 2048 : 0) + h * 128, DM, t, errw, which ? 2u : 1u); }
            else if (which == 0) { const int h = (cs >> 3) & 15; const bf16* base = QKV + (size_t)b * SEQ * N_AB + h * 128;
                attn_check(F, 2, base, base + 2048, base + 4096, N_AB, Y + (size_t)b * SEQ * DM + h * 128, DM, t, errw, 8u); }
            else { const int h = (cs >> 3) & 7; ml_check(F, QKV + (size_t)b * SEQ * N_AB, GATES + (size_t)b * SEQ * 16, args.in[5], args.in[6], args.in[4], args.in[7], Y + (size_t)b * SEQ * DM, h, t, errw, 16u); } }
          __syncthreads(); }
#endif
        {
            pg8::Gemm g{Y, (const bf16*)(ws + (layer == 0 ? WS_W_OUTAB : WS_W_OUTCD)), M, DM, DM};
            pg8::StaticOrder S; S.init(g.M, g.N, F.G, (int)blockIdx.x);
            RP(512) { const bool dm_ = (REP_MASK & 512) && rep_ == 0;
            pg8::EpiResid E{layer == 0 ? args.in[0] : OUT, dm_ ? (float*)(ws + WS_R) : OUT, DM, ALPHA};
            PH(512) pg8::gemm_phase<pg8::EpiResid, pg8::StaticOrder, true, true>(F.lds, g, S, E); }
        }
        GRID_BAR();
        RP(1024) { const bool dm_ = (REP_MASK & 1024) && rep_ == 0;
        PH(1024) ln_phase(F, OUT, dm_ ? (float*)(ws + WS_R) : OUT, dm_ ? (bf16*)(ws + WS_R + 256 * MiB) : XB, args.in[14] + (size_t)(layer * 2) * DM, args.in[15] + (size_t)(layer * 2) * DM); }
        GRID_BAR();
        {
            pg8::Gemm g{XB, (const bf16*)(ws + (layer == 0 ? WS_W_UG0 : WS_W_UG1)), M, 2 * DFF, DM};
            pg8::StaticOrder S; S.init(g.M, g.N, F.G, (int)blockIdx.x);
            pg8::EpiFfnAct E{U, args.in[11] + (size_t)layer * 3 * DFF, args.in[12] + (size_t)layer * DFF, EG0, EU0, EGL, (LAS float*)(F.lds + RING_BYTES + 1024)};
            RP(2048) PH(2048) pg8::gemm_phase<pg8::EpiFfnAct, pg8::StaticOrder, true, true>(F.lds, g, S, E);
        }
        GRID_BAR();
        PH(4096) ffn_fix_phase(F, U, EG0, EU0, EGL, args.in[11] + (size_t)layer * 3 * DFF, args.in[12] + (size_t)layer * DFF);
        GRID_BAR();
        {
            pg8::Gemm g{U, (const bf16*)(ws + (layer == 0 ? WS_W_DN0 : WS_W_DN1)), M, DM, DFF};
            pg8::StaticOrder S; S.init(g.M, g.N, F.G, (int)blockIdx.x);
            RP(8192) { const bool dm_ = (REP_MASK & 8192) && rep_ == 0;
            pg8::EpiResid E{OUT, dm_ ? (float*)(ws + WS_G) : OUT, DM, ALPHA};
            PH(8192) pg8::gemm_phase<pg8::EpiResid, pg8::StaticOrder, true, true>(F.lds, g, S, E); }
        }
        GRID_BAR();
        float oscale = 1.f;
#if SELFCHECK
        if (layer == 1) oscale = 1.f + (float)__hip_atomic_load((GAS unsigned*)((unsigned*)(ws + WS_CTL) + CW_ERR), __ATOMIC_RELAXED, __HIP_MEMORY_SCOPE_AGENT);
#endif
        RP(1024) { const bool dm_ = (REP_MASK & 1024) && rep_ == 0;
        PH(1024) ln_phase(F, OUT, dm_ ? (float*)(ws + WS_R) : OUT, dm_ ? (bf16*)(ws + WS_R + 256 * MiB) : (layer == 0 ? XB : nullptr), args.in[14] + (size_t)(layer * 2 + 1) * DM, args.in[15] + (size_t)(layer * 2 + 1) * DM, oscale); }
        if (layer == 0) GRID_BAR();
    }
}

extern "C" void kernel_launch(void* const* d_in, const int* in_sizes, int n_in, void* d_out, int out_size, void* d_ws, size_t ws_size, hipStream_t stream) {
    static int grid = 0;
    if (grid == 0) {
        if (n_in != 16 || in_sizes[0] != M * DM || out_size != M * DM || ws_size < WS_END) { fprintf(stderr, "kernel_launch: unexpected shapes (n_in %d, in0 %d, out %d, ws %zu < %zu)\n", n_in, n_in > 0 ? in_sizes[0] : -1, out_size, ws_size, (size_t)WS_END); grid = -1; return; }
        int dev = 0, cus = 0;
        if (hipGetDevice(&dev) != hipSuccess || hipDeviceGetAttribute(&cus, hipDeviceAttributeMultiprocessorCount, dev) != hipSuccess) { grid = -1; return; }
        if (hipFuncSetAttribute((const void*)mk_fwd, hipFuncAttributeMaxDynamicSharedMemorySize, LDS_BYTES) != hipSuccess) { fprintf(stderr, "kernel_launch: hipFuncSetAttribute failed\n"); grid = -1; return; }
        int per_cu = 0;
        if (hipOccupancyMaxActiveBlocksPerMultiprocessor(&per_cu, (const void*)mk_fwd, NWAVES * 64, LDS_BYTES) != hipSuccess || per_cu < 1) fprintf(stderr, "kernel_launch: occupancy query says %d\n", per_cu);
        (void)hipGetLastError();
        grid = cus;
    }
    if (grid < 0) return;
    if (hipMemsetAsync((char*)d_ws + WS_CTL, 0, CTL_ZERO_BYTES, stream) != hipSuccess) return;
    Args a{};
    for (int i = 0; i < 16; ++i) a.in[i] = (const float*)d_in[i];
    a.out = (float*)d_out; a.ws = (unsigned char*)d_ws;
    hipLaunchKernelGGL(mk_fwd, dim3(grid), dim3(NWAVES * 64), LDS_BYTES, stream, a);
}
```

```cpp
#include <hip/hip_runtime.h>
#include <cstdio>
#include <cstdint>

#define LAS __attribute__((address_space(3)))
#define GAS __attribute__((address_space(1)))
typedef unsigned short bf16;
typedef short bf16x8 __attribute__((ext_vector_type(8)));
typedef short s16x4 __attribute__((ext_vector_type(4)));
typedef float f32x16 __attribute__((ext_vector_type(16)));
typedef float f32x4 __attribute__((ext_vector_type(4)));
typedef float f32x2 __attribute__((ext_vector_type(2)));
typedef unsigned u32x4 __attribute__((ext_vector_type(4)));
typedef unsigned u32x2 __attribute__((ext_vector_type(2)));

#ifndef SKIP_MIX
#define SKIP_MIX 0
#endif
#ifndef SELFCHECK
#define SELFCHECK 0
#endif
#ifndef PH_MASK
#define PH_MASK 0xFFFF
#endif
#define PH(x) if constexpr ((PH_MASK & (x)) != 0)
#ifndef REP_MASK
#define REP_MASK 0
#endif
#define RP(x) _Pragma("unroll 1") for (int rep_ = 0; rep_ < (((REP_MASK) & (x)) ? 2 : 1); ++rep_)

constexpr int BATCH = 8, SEQ = 2048, DM = 4096, M = BATCH * SEQ;
constexpr int DFF = 11008, N_AB = 12288, N_CD = 12304, N_CDP = 12544;
constexpr float ALPHA = 1.4142135623730951f;
constexpr float LN_EPS = 1e-5f;
constexpr int NWAVES = 8;

constexpr size_t MiB = 1u << 20;
constexpr size_t WS_CTL = 0, CTL_ZERO_BYTES = 1 * MiB;
constexpr size_t WS_KMEAN = 1 * MiB;
constexpr size_t WS_GATES = 2 * MiB;
constexpr size_t WS_A2 = 3 * MiB;
constexpr size_t WS_M2 = 3 * MiB + 512 * 1024;
constexpr size_t WS_NM = 4 * MiB;
constexpr size_t WS_W_INAB = 8 * MiB, WS_W_OUTAB = 104 * MiB, WS_W_UG0 = 136 * MiB, WS_W_DN0 = 308 * MiB;
constexpr size_t WS_W_INCD = 394 * MiB, WS_W_OUTCD = 492 * MiB, WS_W_UG1 = 524 * MiB, WS_W_DN1 = 696 * MiB;
constexpr size_t WS_XB = 782 * MiB;
constexpr size_t WS_R = 910 * MiB;
constexpr size_t WS_QKV = WS_R, WS_Y = WS_R + 384 * MiB, WS_QKDC = WS_R + 512 * MiB, WS_HD = WS_R + 576 * MiB;
constexpr size_t WS_U = WS_R, WS_G = WS_R + 344 * MiB;
constexpr size_t WS_END = WS_R + 688 * MiB;
static_assert((size_t)M * DFF * 2 == 344 * MiB, "u/g size");
constexpr int CW_BAR = 4096;
constexpr size_t CTL_STATS = 65536;
constexpr size_t CTL_CS_UG0 = 524288, CTL_BS_UG0 = CTL_CS_UG0 + 88064, CTL_CS_INCD = CTL_BS_UG0 + 88064, CTL_BS_INCD = CTL_CS_INCD + 50176, CTL_CS_UG1 = CTL_BS_INCD + 50176, CTL_BS_UG1 = CTL_CS_UG1 + 88064;
static_assert(CTL_BS_UG1 + 88064 <= CTL_ZERO_BYTES && CTL_STATS + 3 * (size_t)M * 8 <= CTL_CS_UG0, "CTL map");

constexpr int RING_BYTES = 131072;
constexpr int MISC_OFF = RING_BYTES + 320;
constexpr int LDS_BYTES = 147456;

#define LDS_WAIT() asm volatile("s_waitcnt lgkmcnt(0)" ::: "memory")
#define VM_WAIT() asm volatile("s_waitcnt vmcnt(0)" ::: "memory")
#define SBAR() __builtin_amdgcn_sched_barrier(0)
#define WG_BAR() do { asm volatile("" ::: "memory"); __builtin_amdgcn_s_barrier(); asm volatile("" ::: "memory"); } while (0)

__device__ __forceinline__ unsigned cvtpk(float lo, float hi) { unsigned r; asm volatile("v_cvt_pk_bf16_f32 %0, %1, %2" : "=v"(r) : "v"(lo), "v"(hi)); return r; }
__device__ __forceinline__ float bf_lo(unsigned w) { return __uint_as_float(w << 16); }
__device__ __forceinline__ float bf_hi(unsigned w) { return __uint_as_float(w & 0xffff0000u); }
__device__ __forceinline__ float wave_sum(float v) {
#pragma unroll
    for (int o = 1; o < 64; o <<= 1) v += __shfl_xor(v, o);
    return v;
}
__device__ __forceinline__ float silu_f(float y) { return y * __builtin_amdgcn_rcpf(1.0f + __builtin_amdgcn_exp2f(-1.4426950408889634f * y)); }

namespace pg8 {
typedef unsigned short bf16_t;
constexpr int BM = 256, BK = 64, HALF = 128, HTB = HALF * BK * 2, STAGE_BYTES = 8 * HTB, NXCD = 8, WGM = 8;
__host__ __device__ __forceinline__ int lds_byte(int r, int c) { const int st = (r >> 4) * 2 + (c >> 5), rr = r & 15, cc = c & 31, ob = rr * 64 + cc * 2; return st * 1024 + (ob ^ (((ob >> 9) & 1) << 5)); }
__host__ __device__ __forceinline__ void stage_rc(int b, int& R, int& C) { const int st = b / 1024, sb = b % 1024, swz = sb ^ (((sb >> 9) & 1) << 5); R = (st >> 1) * 16 + swz / 64; C = (st & 1) * 32 + (swz % 64) / 2; }
__host__ __device__ __forceinline__ int perm32(int rho) { const int n = rho >> 4, i = rho & 15; return 8 * (i >> 2) + 4 * n + (i & 3); }
struct Unit { int pm, pn; };
struct Gemm { const bf16_t* A; const bf16_t* Bt; int M, N, K; };
struct StaticOrder {
    int nM, nN, nwg, G, c;
    __host__ __device__ void init(int M_, int N_, int G_, int c_) { nM = M_ / BM; nN = N_ / BM; nwg = nM * nN; G = G_; c = c_; }
    __host__ __device__ bool next(int i, Unit& u) const {
        const long L = (long)i * G + c; if (L >= nwg) return false;
        int wgid = (int)L; { const int q = nwg / NXCD, r = nwg % NXCD, xcd = wgid % NXCD, off = wgid / NXCD; wgid = (xcd < r ? xcd * (q + 1) : r * (q + 1) + (xcd - r) * q) + off; }
        const int nig = WGM * nN, gid = wgid / nig, fm = gid * WGM, gsz = (nM - fm) < WGM ? (nM - fm) : WGM;
        u.pm = fm + ((wgid % nig) % gsz); u.pn = (wgid % nig) / gsz; return true;
    }
    __device__ __forceinline__ void a_ready(const Unit&) const {}
    __device__ __forceinline__ void done(const Unit&) const {}
};
struct EpiBf16 {
    static constexpr bool PERM = true, AFTER_DRAIN = false;
    bf16_t* O; int ldc; int split_cols; size_t split_stride; float* gates; int gate_pn; const float* st; const float* cs; const float* bs;
    __device__ __forceinline__ void operator()(const f32x4 (&acc)[2][2][4][2], const Unit& u, int wr_, int wc_, int fr_, int fq_) const {
        int tid_ = threadIdx.x; asm volatile("" : "+v"(tid_));
        const int wid = __builtin_amdgcn_readfirstlane(tid_ >> 6), wr = wid >> 2, wc = wid & 3, fr = tid_ & 15, fq = (tid_ & 63) >> 4;
        const int row0 = u.pm * BM + wr * 64 + fr;
        const int colg = u.pn * BM + wc * 32 + 8 * fq;
        f32x4 csv[2][2], bsv[2][2];
        if (st) {
#pragma unroll
            for (int bj = 0; bj < 2; ++bj)
#pragma unroll
                for (int n = 0; n < 2; ++n) { csv[bj][n] = *(const f32x4*)(cs + colg + bj * HALF + 4 * n); bsv[bj][n] = *(const f32x4*)(bs + colg + bj * HALF + 4 * n); }
        }
        int colt = u.pn * BM; bf16_t* base = O;
        if (split_cols) { const int t = colt / split_cols; base += (size_t)t * split_stride; colt -= t * split_cols; }
        const int col0 = colt + wc * 32 + 8 * fq;
        const float* stp = st + (size_t)row0 * 2;
#pragma unroll
        for (int ai = 0; ai < 2; ++ai)
#pragma unroll
            for (int m = 0; m < 4; ++m) { const int row = row0 + ai * HALF + m * 16;
                float mu = 0.f, rs = 1.f;
                if (st) { const f32x2 sv = *(const f32x2*)(stp + (ai * HALF + m * 16) * 2); mu = sv[0] * (1.f / DM); rs = __builtin_amdgcn_rsqf(sv[1] * (1.f / DM) - mu * mu + LN_EPS); }
                f32x4 v[2][2];
#pragma unroll
                for (int bj = 0; bj < 2; ++bj)
#pragma unroll
                    for (int n = 0; n < 2; ++n) v[bj][n] = st ? (acc[ai][bj][m][n] - csv[bj][n] * mu) * rs + bsv[bj][n] : acc[ai][bj][m][n];
                if (u.pn == gate_pn) { if (wc == 0 && fq < 2) { float* gp = gates + (size_t)row * 16 + 8 * fq; *(GAS f32x4*)gp = v[0][0]; *(GAS f32x4*)(gp + 4) = v[0][1]; } }
                else { bf16_t* rowp = base + (size_t)row * ldc + col0;
#pragma unroll
                    for (int bj = 0; bj < 2; ++bj) { u32x4 w; w.x = cvtpk(v[bj][0][0], v[bj][0][1]); w.y = cvtpk(v[bj][0][2], v[bj][0][3]); w.z = cvtpk(v[bj][1][0], v[bj][1][1]); w.w = cvtpk(v[bj][1][2], v[bj][1][3]);
                        *(u32x4*)(rowp + bj * HALF) = w; } } }
    }
};
struct EpiResid {
    static constexpr bool PERM = true, AFTER_DRAIN = false;
    const float* base; float* out; float alpha; const float* st_in; const float* lg; const float* lb; bf16_t* zb; float* st_out; LAS float* red;
    __device__ __forceinline__ void operator()(const f32x4 (&acc)[2][2][4][2], const Unit& u, int wr_, int wc_, int fr_, int fq_) const {
        int tid_ = threadIdx.x; asm volatile("" : "+v"(tid_));
        const int wid = __builtin_amdgcn_readfirstlane(tid_ >> 6), wr = wid >> 2, wc = wid & 3, lane = tid_ & 63, fr = tid_ & 15, fq = (tid_ & 63) >> 4;
        constexpr int ldc = DM;
        const int row0 = u.pm * BM + wr * 64 + fr, col0 = u.pn * BM + wc * 32 + 8 * fq;
        f32x4 gv[2][2], bv[2][2];
        if (st_in) {
#pragma unroll
            for (int bj = 0; bj < 2; ++bj)
#pragma unroll
                for (int n = 0; n < 2; ++n) { gv[bj][n] = *(const f32x4*)(lg + col0 + bj * HALF + 4 * n); bv[bj][n] = *(const f32x4*)(lb + col0 + bj * HALF + 4 * n); }
        }
        LAS float* myred = red + wid * 256;
#pragma unroll
        for (int ai = 0; ai < 2; ++ai)
#pragma unroll
            for (int mp = 0; mp < 2; ++mp) {
                f32x4 xs[2][2][2]; f32x2 sv[2] = {(f32x2){0.f, 1.f}, (f32x2){0.f, 1.f}};
#pragma unroll
                for (int q = 0; q < 2; ++q) { const int m = 2 * mp + q; const size_t off = (size_t)(row0 + ai * HALF + m * 16) * ldc + col0;
#pragma unroll
                    for (int bj = 0; bj < 2; ++bj)
#pragma unroll
                        for (int n = 0; n < 2; ++n) xs[q][bj][n] = *(const f32x4*)(base + off + bj * HALF + 4 * n);
                    if (st_in) sv[q] = *(const f32x2*)(st_in + (size_t)row0 * 2 + (ai * HALF + m * 16) * 2); }
#pragma unroll
                for (int q = 0; q < 2; ++q) { const int m = 2 * mp + q; const size_t off = (size_t)(row0 + ai * HALF + m * 16) * ldc + col0;
                    if (st_in) { const float mu = sv[q][0] * (1.f / DM), rs = __builtin_amdgcn_rsqf(sv[q][1] * (1.f / DM) - mu * mu + LN_EPS);
#pragma unroll
                        for (int bj = 0; bj < 2; ++bj)
#pragma unroll
                            for (int n = 0; n < 2; ++n) xs[q][bj][n] = (xs[q][bj][n] - mu) * rs * gv[bj][n] + bv[bj][n]; }
                    float s1 = 0.f, s2 = 0.f;
#pragma unroll
                    for (int bj = 0; bj < 2; ++bj) { const f32x4 z0 = xs[q][bj][0] * alpha + acc[ai][bj][m][0], z1 = xs[q][bj][1] * alpha + acc[ai][bj][m][1];
                        *(f32x4*)(out + off + bj * HALF) = z0; *(f32x4*)(out + off + bj * HALF + 4) = z1;
                        if (zb) { u32x4 w; w.x = cvtpk(z0[0], z0[1]); w.y = cvtpk(z0[2], z0[3]); w.z = cvtpk(z1[0], z1[1]); w.w = cvtpk(z1[2], z1[3]); *(u32x4*)(zb + off + bj * HALF) = w; }
                        s1 += (z0[0] + z0[1]) + (z0[2] + z0[3]) + (z1[0] + z1[1]) + (z1[2] + z1[3]);
                        s2 += (z0[0] * z0[0] + z0[1] * z0[1]) + (z0[2] * z0[2] + z0[3] * z0[3]) + (z1[0] * z1[0] + z1[1] * z1[1]) + (z1[2] * z1[2] + z1[3] * z1[3]); }
                    if (st_out) { s1 += __shfl_xor(s1, 16); s1 += __shfl_xor(s1, 32); s2 += __shfl_xor(s2, 16); s2 += __shfl_xor(s2, 32);
                        if (fq == 0) *(LAS f32x2*)(myred + ((ai * 4 + m) * 16 + fr) * 2) = (f32x2){s1, s2}; } }
                asm volatile("" ::: "memory"); }
        if (st_out) {
            asm volatile("s_waitcnt lgkmcnt(0)" ::: "memory");
            float* sp = st_out + (size_t)(u.pm * BM + wr * 64) * 2;
#pragma unroll
            for (int j = 0; j < 4; ++j) { const int idx = j * 64 + lane, g = idx >> 5, r = (idx & 31) >> 1, c = idx & 1;
                unsafeAtomicAdd(sp + ((g >> 2) * HALF + (g & 3) * 16 + r) * 2 + c, myred[idx]); }
            asm volatile("s_waitcnt lgkmcnt(0)" ::: "memory");
        }
    }
};

__device__ __forceinline__ float dpp_ror1(float x) { return __int_as_float(__builtin_amdgcn_update_dpp(0, __float_as_int(x), 0x121, 0xF, 0xF, false)); }
__device__ __forceinline__ float dpp_ror2(float x) { return __int_as_float(__builtin_amdgcn_update_dpp(0, __float_as_int(x), 0x122, 0xF, 0xF, false)); }
struct EpiFfnAct {
    static constexpr bool PERM = true, AFTER_DRAIN = false;
    bf16_t* H; const float* cw; const float* cb; float* EG0; float* EU0; float* EGL; LAS float* edge; const float* st; const float* cs; const float* bs;
    __device__ __forceinline__ void operator()(f32x4 (&acc)[2][2][4][2], const Unit& u, int wr_, int wc_, int fr_, int fq_) const {
        int tid_ = threadIdx.x; asm volatile("" : "+v"(tid_));
        const int wid = __builtin_amdgcn_readfirstlane(tid_ >> 6), wr = wid >> 2, wc = wid & 3, fr = tid_ & 15, fq = (tid_ & 63) >> 4;
        const int ch0 = u.pn * 128 + wc * 32 + fq * 8, row0 = u.pm * BM + wr * 64 + fr, colg = u.pn * BM + wc * 32 + 8 * fq;
        const float* stp = st + (size_t)row0 * 2;
        f32x2 sv[2][4]; f32x4 csg[2], bsg[2];
#pragma unroll
        for (int ai = 0; ai < 2; ++ai)
#pragma unroll
            for (int m = 0; m < 4; ++m) sv[ai][m] = *(const f32x2*)(stp + (ai * HALF + m * 16) * 2);
#pragma unroll
        for (int n = 0; n < 2; ++n) { csg[n] = *(const f32x4*)(cs + colg + HALF + 4 * n); bsg[n] = *(const f32x4*)(bs + colg + HALF + 4 * n); }
        float mu[2][4], rs[2][4];
#pragma unroll
        for (int ai = 0; ai < 2; ++ai)
#pragma unroll
            for (int m = 0; m < 4; ++m) { mu[ai][m] = sv[ai][m][0] * (1.f / DM); rs[ai][m] = __builtin_amdgcn_rsqf(sv[ai][m][1] * (1.f / DM) - mu[ai][m] * mu[ai][m] + LN_EPS);
#pragma unroll
                for (int n = 0; n < 2; ++n) acc[ai][1][m][n] = (acc[ai][1][m][n] - csg[n] * mu[ai][m]) * rs[ai][m] + bsg[n];
                asm volatile("" : "+v"(acc[ai][1][m][0]), "+v"(acc[ai][1][m][1])); }
        asm volatile("" ::: "memory");
        f32x4 csu[2], bsu[2], wt[4][2];
#pragma unroll
        for (int n = 0; n < 2; ++n) { csu[n] = *(const f32x4*)(cs + colg + 4 * n); bsu[n] = *(const f32x4*)(bs + colg + 4 * n);
            wt[0][n] = *(const f32x4*)(cw + ch0 + 4 * n); wt[1][n] = *(const f32x4*)(cw + DFF + ch0 + 4 * n); wt[2][n] = *(const f32x4*)(cw + 2 * DFF + ch0 + 4 * n); wt[3][n] = *(const f32x4*)(cb + ch0 + 4 * n); }
#define FFN_G(ai, m, n) (acc[ai][1][m][n])
#define FFN_U(ai, m, n) ((acc[ai][0][m][n] - csu[n] * mu[ai][m]) * rs[ai][m] + bsu[n])
        if (fr >= 14) {
#pragma unroll
            for (int ai = 0; ai < 2; ++ai) { LAS float* e = edge + ((((ai * 2 + wr) * 4 + wc) * 4 + fq) * 2 + (fr - 14)) * 8; *(LAS f32x4*)e = FFN_G(ai, 3, 0); *(LAS f32x4*)(e + 4) = FFN_G(ai, 3, 1); }
            if (wr == 1) { float* p = EGL + (size_t)(u.pm * 2 + (fr - 14)) * DFF + ch0; *(GAS f32x4*)p = FFN_G(1, 3, 0); *(GAS f32x4*)(p + 4) = FFN_G(1, 3, 1); }
        }
        if (wr == 0 && fr < 2) { float* pg = EG0 + (size_t)(u.pm * 2 + fr) * DFF + ch0; float* pu = EU0 + (size_t)(u.pm * 2 + fr) * DFF + ch0;
            *(GAS f32x4*)pg = FFN_G(0, 0, 0); *(GAS f32x4*)(pg + 4) = FFN_G(0, 0, 1); *(GAS f32x4*)pu = FFN_U(0, 0, 0); *(GAS f32x4*)(pu + 4) = FFN_U(0, 0, 1); }
        asm volatile("s_waitcnt lgkmcnt(0)" ::: "memory"); __builtin_amdgcn_s_barrier(); asm volatile("" ::: "memory");
#pragma unroll
        for (int ai = 0; ai < 2; ++ai) {
            f32x4 e14[2] = {(f32x4){0.f, 0.f, 0.f, 0.f}, (f32x4){0.f, 0.f, 0.f, 0.f}}, e15[2] = {(f32x4){0.f, 0.f, 0.f, 0.f}, (f32x4){0.f, 0.f, 0.f, 0.f}};
            if (wr == 1 || ai == 1) { const int sa = (wr == 1) ? ai : 0, sw = (wr == 1) ? 0 : 1; const LAS float* e = edge + (((sa * 2 + sw) * 4 + wc) * 4 + fq) * 16;
                e14[0] = *(const LAS f32x4*)e; e14[1] = *(const LAS f32x4*)(e + 4); e15[0] = *(const LAS f32x4*)(e + 8); e15[1] = *(const LAS f32x4*)(e + 12); }
#pragma unroll
            for (int m = 0; m < 4; ++m) {
                float hv[8];
#pragma unroll
                for (int n = 0; n < 2; ++n) { const f32x4 uu = FFN_U(ai, m, n);
#pragma unroll
                    for (int j = 0; j < 4; ++j) { const int c = 4 * n + j; const float gc = acc[ai][1][m][n][j]; const float r1 = dpp_ror1(gc), r2 = dpp_ror2(gc);
                        float q1, q2;
                        if (m == 0) { q1 = e15[n][j]; q2 = (fr == 0) ? e14[n][j] : e15[n][j]; }
                        else { const float gpv = acc[ai][1][m > 0 ? m - 1 : 0][n][j]; q1 = dpp_ror1(gpv); q2 = dpp_ror2(gpv); }
                        const float p1 = (fr == 0) ? q1 : r1, p2 = (fr < 2) ? q2 : r2;
                        const float y = wt[0][n][j] * p2 + wt[1][n][j] * p1 + wt[2][n][j] * gc + wt[3][n][j];
                        hv[c] = silu_f(y) * uu[j]; } }
                if (!(ai == 0 && m == 0 && wr == 0 && fr < 2)) { u32x4 w; w.x = cvtpk(hv[0], hv[1]); w.y = cvtpk(hv[2], hv[3]); w.z = cvtpk(hv[4], hv[5]); w.w = cvtpk(hv[6], hv[7]);
                    *(u32x4*)(H + (size_t)(row0 + ai * HALF + m * 16) * DFF + ch0) = w; }
            }
        }
#undef FFN_G
#undef FFN_U
    }
};

template <class Epi, class Sched, bool ALIGN_EPI = false, bool SP2 = false>
__device__ __forceinline__ void gemm_phase(LAS unsigned char* lds, const Gemm g, const Sched& S, const Epi& E) {
    int tid_ = threadIdx.x; asm volatile("" : "+v"(tid_));
    const int tid = tid_, wid = __builtin_amdgcn_readfirstlane(tid >> 6), lane = tid & 63, wr = wid >> 2, wc = wid & 3, fr = lane & 15, fq = lane >> 4;
    const int K = g.K, nt = K / BK;
    unsigned voffA[2], voffB[2];
#pragma unroll
    for (int i = 0; i < 2; ++i) { int R, C; stage_rc(tid * 16 + i * 8192, R, C); const int Rb = Epi::PERM ? ((R & ~31) + perm32(R & 31)) : R;
        voffA[i] = (unsigned)(R * K + C) * 2u; voffB[i] = (unsigned)(Rb * K + C) * 2u; }
    const size_t kstep = (size_t)(BK * 2);
    const size_t hstep = (size_t)HALF * K * 2;
    const size_t tstep = 2 * hstep;
    const unsigned ldsw = (unsigned)wid * 1024u;
    const int aoff = lds_byte(wr * 64 + fr, fq * 8), boff = lds_byte(wc * 32 + fr, fq * 8);
#define PG8_SA(b, h) (((b) * 2 + (h)) * HTB)
#define PG8_SB(b, h) ((4 + (b) * 2 + (h)) * HTB)
#define PG8_STAGE(bufoff, gbase, voff) do { _Pragma("unroll") for (int _i = 0; _i < 2; ++_i) \
        __builtin_amdgcn_global_load_lds((const unsigned*)((const char*)(gbase) + (voff)[_i]), (LAS unsigned*)(lds + (bufoff) + ldsw + _i * 8192), 16, 0, 0); } while (0)
#define PG8_LDA(dst, b, h) do { _Pragma("unroll") for (int m = 0; m < 4; ++m) _Pragma("unroll") for (int k = 0; k < 2; ++k) dst[m][k] = *(const LAS bf16x8*)(lds + PG8_SA(b, h) + aoff + m * 2048 + k * 1024); } while (0)
#define PG8_LDB(dst, b, h) do { _Pragma("unroll") for (int n = 0; n < 2; ++n) _Pragma("unroll") for (int k = 0; k < 2; ++k) dst[n][k] = *(const LAS bf16x8*)(lds + PG8_SB(b, h) + boff + n * 2048 + k * 1024); } while (0)
#define PG8_MMA(ai, bj, At, Bt) do { __builtin_amdgcn_s_setprio(1); _Pragma("unroll") for (int m = 0; m < 4; ++m) _Pragma("unroll") for (int n = 0; n < 2; ++n) _Pragma("unroll") for (int k = 0; k < 2; ++k) \
        acc[ai][bj][m][n] = __builtin_amdgcn_mfma_f32_16x16x32_bf16(Bt[n][k], At[m][k], acc[ai][bj][m][n], 0, 0, 0); __builtin_amdgcn_s_setprio(0); } while (0)
#define PG8_WAIT_V(n) asm volatile("s_waitcnt vmcnt(" #n ")" ::: "memory")
#define PG8_WAIT_L(n) asm volatile("s_waitcnt lgkmcnt(" #n ")" ::: "memory")
#define PG8_BAR __builtin_amdgcn_s_barrier()
#define PG8_SCHED __builtin_amdgcn_sched_barrier(0)
    Unit cur, nxt; int ui = 0;
    if (!S.next(0, cur)) return;
    f32x4 acc[2][2][4][2];
#pragma unroll
    for (int a = 0; a < 2; ++a)
#pragma unroll
        for (int b = 0; b < 2; ++b)
#pragma unroll
            for (int m = 0; m < 4; ++m)
#pragma unroll
                for (int n = 0; n < 2; ++n) acc[a][b][m][n] = (f32x4){0.f, 0.f, 0.f, 0.f};
    bf16x8 At[4][2], B0[2][2], B1[2][2];
    const char* cA = (const char*)g.A + (size_t)cur.pm * tstep; const char* cB = (const char*)g.Bt + (size_t)cur.pn * tstep;
    S.a_ready(cur);
    if constexpr (SP2) {
        PG8_STAGE(PG8_SB(0, 0), cB, voffB); PG8_STAGE(PG8_SB(0, 1), cB + hstep, voffB); PG8_STAGE(PG8_SA(0, 0), cA, voffA); PG8_STAGE(PG8_SA(0, 1), cA + hstep, voffA);
        if (wr == 1) PG8_BAR;
        PG8_WAIT_V(2); PG8_BAR;
        PG8_STAGE(PG8_SB(1, 0), cB + kstep, voffB); PG8_STAGE(PG8_SA(1, 0), cA + kstep, voffA); PG8_STAGE(PG8_SB(1, 1), cB + hstep + kstep, voffB);
        PG8_WAIT_V(6); PG8_BAR;
    } else {
        PG8_STAGE(PG8_SB(0, 0), cB, voffB); PG8_STAGE(PG8_SA(0, 0), cA, voffA); PG8_STAGE(PG8_SB(0, 1), cB + hstep, voffB); PG8_STAGE(PG8_SA(0, 1), cA + hstep, voffA);
        if (wr == 1) PG8_BAR;
        PG8_WAIT_V(4); PG8_BAR;
        PG8_STAGE(PG8_SB(1, 0), cB + kstep, voffB); PG8_STAGE(PG8_SA(1, 0), cA + kstep, voffA); PG8_STAGE(PG8_SB(1, 1), cB + hstep + kstep, voffB);
        PG8_WAIT_V(6); PG8_BAR;
    }
    for (;;) {
        const bool has_next = S.next(ui + 1, nxt);
        const char* nA = has_next ? (const char*)g.A + (size_t)nxt.pm * tstep : cA; const char* nB = has_next ? (const char*)g.Bt + (size_t)nxt.pn * tstep : cB;
        for (int t = 0; t < nt; t += 2) {
            const bool last = (t == nt - 2);
            const char* a1 = cA + (size_t)(t + 1) * kstep;
            const char* a2 = last ? nA : cA + (size_t)(t + 2) * kstep; const char* b2 = last ? nB : cB + (size_t)(t + 2) * kstep;
            const char* a3 = a2 + kstep; const char* b3 = b2 + kstep;
            if (last && has_next) S.a_ready(nxt);
            if constexpr (SP2) {
            PG8_LDB(B0, 0, 0); PG8_LDB(B1, 0, 1); PG8_SCHED; PG8_LDA(At, 0, 0); PG8_STAGE(PG8_SA(1, 1), a1 + hstep, voffA);
            PG8_WAIT_V(8); PG8_WAIT_L(0); PG8_BAR; PG8_MMA(0, 0, At, B0); PG8_MMA(0, 1, At, B1); PG8_BAR; PG8_SCHED;
            PG8_LDA(At, 0, 1); PG8_STAGE(PG8_SB(0, 0), b2, voffB); PG8_STAGE(PG8_SB(0, 1), b2 + hstep, voffB); PG8_STAGE(PG8_SA(0, 0), a2, voffA);
            PG8_WAIT_V(8); PG8_WAIT_L(0); PG8_BAR; PG8_MMA(1, 0, At, B0); PG8_MMA(1, 1, At, B1); PG8_BAR; PG8_SCHED;
            PG8_LDB(B0, 1, 0); PG8_LDB(B1, 1, 1); PG8_SCHED; PG8_LDA(At, 1, 0); PG8_STAGE(PG8_SA(0, 1), a2 + hstep, voffA);
            PG8_WAIT_V(8); PG8_WAIT_L(0); PG8_BAR; PG8_MMA(0, 0, At, B0); PG8_MMA(0, 1, At, B1); PG8_BAR; PG8_SCHED;
            PG8_LDA(At, 1, 1); PG8_STAGE(PG8_SB(1, 0), b3, voffB); PG8_STAGE(PG8_SB(1, 1), b3 + hstep, voffB); PG8_STAGE(PG8_SA(1, 0), a3, voffA);
            PG8_WAIT_V(8); PG8_WAIT_L(0); PG8_BAR; PG8_MMA(1, 0, At, B0); PG8_MMA(1, 1, At, B1); PG8_BAR; PG8_SCHED;
            } else {
            PG8_LDB(B0, 0, 0); PG8_SCHED; PG8_LDA(At, 0, 0); PG8_STAGE(PG8_SA(1, 1), a1 + hstep, voffA);
            PG8_WAIT_L(8); PG8_BAR; PG8_WAIT_L(0); PG8_MMA(0, 0, At, B0); PG8_BAR; PG8_SCHED;
            PG8_LDB(B1, 0, 1); PG8_STAGE(PG8_SB(0, 0), b2, voffB);
            PG8_BAR; PG8_WAIT_L(0); PG8_MMA(0, 1, At, B1); PG8_BAR;
            PG8_LDA(At, 0, 1); PG8_STAGE(PG8_SA(0, 0), a2, voffA);
            PG8_BAR; PG8_WAIT_L(0); PG8_MMA(1, 0, At, B0); PG8_BAR; PG8_SCHED;
            PG8_STAGE(PG8_SB(0, 1), b2 + hstep, voffB);
            PG8_WAIT_V(6); PG8_BAR; PG8_MMA(1, 1, At, B1); PG8_BAR;
            PG8_LDB(B0, 1, 0); PG8_SCHED; PG8_LDA(At, 1, 0); PG8_STAGE(PG8_SA(0, 1), a2 + hstep, voffA);
            PG8_WAIT_L(8); PG8_BAR; PG8_WAIT_L(0); PG8_MMA(0, 0, At, B0); PG8_BAR; PG8_SCHED;
            PG8_LDB(B1, 1, 1); PG8_STAGE(PG8_SB(1, 0), b3, voffB);
            PG8_BAR; PG8_WAIT_L(0); PG8_MMA(0, 1, At, B1); PG8_BAR;
            PG8_LDA(At, 1, 1); PG8_STAGE(PG8_SA(1, 0), a3, voffA);
            PG8_BAR; PG8_WAIT_L(0); PG8_MMA(1, 0, At, B0); PG8_BAR; PG8_SCHED;
            PG8_STAGE(PG8_SB(1, 1), b3 + hstep, voffB);
            PG8_WAIT_V(6); PG8_BAR; PG8_MMA(1, 1, At, B1); PG8_BAR;
            }
        }
        if constexpr (ALIGN_EPI) { if (wr == 0) PG8_BAR; }
        if constexpr (!Epi::AFTER_DRAIN) { E(acc, cur, wr, wc, fr, fq); S.done(cur); }
        if (!has_next) break;
#pragma unroll
        for (int a = 0; a < 2; ++a)
#pragma unroll
            for (int b = 0; b < 2; ++b)
#pragma unroll
                for (int m = 0; m < 4; ++m)
#pragma unroll
                    for (int n = 0; n < 2; ++n) acc[a][b][m][n] = (f32x4){0.f, 0.f, 0.f, 0.f};
        cur = nxt; cA = nA; cB = nB; ++ui;
        if constexpr (ALIGN_EPI) { if (wr == 1) PG8_BAR; }
    }
    PG8_WAIT_V(0);
    if constexpr (!ALIGN_EPI) { if (wr == 0) PG8_BAR; }
    PG8_BAR;
#undef PG8_SA
#undef PG8_SB
#undef PG8_STAGE
#undef PG8_LDA
#undef PG8_LDB
#undef PG8_MMA
#undef PG8_WAIT_V
#undef PG8_WAIT_L
#undef PG8_BAR
#undef PG8_SCHED
}
}

#define XB_TMO      128
#define XB_XCNT(j)  (256  + 64 * (j))
#define XB_XSUB(j)  (1280 + 64 * (j))
#define XB_XGEN(j)  (2304 + 64 * (j))
#define XB_TOP      3328
#define XB_TOPGEN   3392
#define XCD_BAR_WORDS 3456
#define XB_SPIN_CAP (1u << 18)
__device__ __forceinline__ unsigned xb_ld(unsigned* p)              { return __hip_atomic_load((GAS unsigned*)p, __ATOMIC_RELAXED, __HIP_MEMORY_SCOPE_AGENT); }
__device__ __forceinline__ unsigned xb_add(unsigned* p, unsigned v) { return __hip_atomic_fetch_add((GAS unsigned*)p, v, __ATOMIC_RELAXED, __HIP_MEMORY_SCOPE_AGENT); }
__device__ __forceinline__ unsigned xb_xcc_id() { return (unsigned)__builtin_amdgcn_s_getreg((3 << 11) | 20) & 0xFu; }
#define XB_SPIN(cond, bar) do { unsigned _sp = 0; while (cond) { __builtin_amdgcn_s_sleep(1); \
    if ((++_sp & 255u) == 0u) { if (xb_ld(&(bar)[XB_TMO])) break; if (_sp > XB_SPIN_CAP) { (void)xb_add(&(bar)[XB_TMO], 1u); break; } } } } while (0)
struct XcdBarrier { unsigned* bar; unsigned x; volatile LAS unsigned* st; };
__device__ __forceinline__ XcdBarrier xcd_barrier_post(unsigned* bar, volatile LAS unsigned* st) {
    XcdBarrier b; b.bar = bar; b.x = xb_xcc_id(); b.st = st;
    if (threadIdx.x == 0) (void)xb_add(&bar[XB_XCNT(b.x)], 1u);
    return b;
}
__device__ __forceinline__ void xcd_barrier_complete(unsigned* bar, unsigned x, unsigned& nloc, unsigned& nx) {
    const unsigned G = gridDim.x * gridDim.y * gridDim.z;
    unsigned sum, cnt, mine, sp = 0u;
    for (;;) {
        sum = 0u; cnt = 0u; mine = 0u;
#pragma unroll
        for (unsigned j = 0; j < 16; ++j) { const unsigned c = xb_ld(&bar[XB_XCNT(j)]); sum += c; cnt += (c > 0u) ? 1u : 0u; mine = (j == x) ? c : mine; }
        if (sum == G) break;
        __builtin_amdgcn_s_sleep(1);
        if ((++sp & 255u) == 0u) { if (xb_ld(&bar[XB_TMO])) break; if (sp > XB_SPIN_CAP) { (void)xb_add(&bar[XB_TMO], 1u); break; } }
    }
    nloc = mine > 0u ? mine : 1u; nx = cnt > 0u ? cnt : 1u;
}
__device__ __forceinline__ void xcd_barrier(const XcdBarrier& b) {
    asm volatile("s_waitcnt vmcnt(0)" ::: "memory");
    __syncthreads();
    if (threadIdx.x == 0) {
        unsigned* bar = b.bar; unsigned bx = b.x;
        asm volatile("" : "+s"(bar), "+s"(bx));
        __builtin_amdgcn_s_waitcnt(0);
        unsigned nloc = b.st[0], nx = b.st[1];
        if (nloc == 0u) { xcd_barrier_complete(bar, bx, nloc, nx); b.st[0] = nloc; b.st[1] = nx; }
        const unsigned old = xb_add(&bar[XB_XSUB(bx)], 1u);
        const unsigned gen = old / nloc;
        if (old + 1u == (gen + 1u) * nloc) {
            __builtin_amdgcn_fence(__ATOMIC_RELEASE, "agent");
            asm volatile("s_waitcnt vmcnt(0)" ::: "memory");
            const unsigned og = xb_add(&bar[XB_TOP], 1u);
            const unsigned tg = og / nx;
            if (og + 1u == (tg + 1u) * nx) xb_add(&bar[XB_TOPGEN], 1u);
            else XB_SPIN(xb_ld(&bar[XB_TOPGEN]) == tg, bar);
            __builtin_amdgcn_fence(__ATOMIC_ACQUIRE, "agent");
            xb_add(&bar[XB_XGEN(bx)], 1u);
            asm volatile("s_waitcnt vmcnt(0)" ::: "memory");
        } else {
            XB_SPIN(xb_ld(&bar[XB_XGEN(bx)]) == gen, bar);
            __builtin_amdgcn_fence(__ATOMIC_ACQUIRE, "agent");
            asm volatile("s_waitcnt vmcnt(0)" ::: "memory");
        }
    }
    __syncthreads();
}

namespace att {
constexpr int D = 128, SHM = 16384;
constexpr int OFF_V = 0, OFF_K = 2 * SHM, OFF_WS = 4 * SHM, OFF_AUX = 4 * SHM + 2048, LDS_USED = 4 * SHM + 2048 + 8192;
constexpr float SCALE = 0.08838834764831845f;
constexpr float C2 = 1.4426950408889634f * SCALE;
constexpr float THR = 8.f;
enum { MODE_DIL = 0, MODE_MOBA = 1, MODE_SB = 2, MODE_ML = 3 };
#define KSWZ(row, colB) ((row) * 256 + ((colB) ^ (((row) & 7) << 4)))
__device__ __forceinline__ int v_st(int k, int c) { const int kk = (k & ~0xC) | ((k & 4) << 1) | ((k & 8) >> 1); return ((kk >> 3) * 4 + (c >> 5)) * 512 + ((kk & 7) * 32 + (c & 31)) * 2; }
__device__ __forceinline__ int v_rd_base(int lane) { return ((lane & 3) << 3) | (((lane >> 2) & 3) << 6) | (((lane >> 4) & 1) << 5) | (((lane >> 5) & 1) << 8); }
__device__ __forceinline__ int crow(int r, int hi) { return (r & 3) + 8 * (r >> 2) + 4 * hi; }
__device__ __forceinline__ void mask_tile(f32x16& p0, f32x16& p1, int dq) {
    const float NEG = -__builtin_inff();
#pragma unroll
    for (int r = 0; r < 16; ++r) {
        const int c = (r & 3) + 8 * (r >> 2);
        if (dq - c < 0) p0[r] = NEG;
        if (dq - c - 32 < 0) p1[r] = NEG;
    }
}
__device__ __forceinline__ void partialSM(f32x16& p0, f32x16& p1, float& m_reg, float& mn, float& alpha) {
    float pmax = p0[0];
#pragma unroll
    for (int r = 1; r < 16; ++r) pmax = fmaxf(pmax, p0[r]);
#pragma unroll
    for (int r = 0; r < 16; ++r) pmax = fmaxf(pmax, p1[r]);
    { auto rr = __builtin_amdgcn_permlane32_swap(__float_as_uint(pmax), __float_as_uint(pmax), false, false);
      pmax = fmaxf(__uint_as_float(rr[0]), __uint_as_float(rr[1])); }
    if (__builtin_expect(__all((pmax - m_reg) * SCALE <= THR), 1)) { mn = m_reg; alpha = 1.f; }
    else { mn = fmaxf(m_reg, pmax); alpha = __builtin_amdgcn_exp2f((m_reg - mn) * C2); m_reg = mn; }
    const float mnL = -mn * C2;
#pragma unroll
    for (int r = 0; r < 16; ++r) p0[r] = fmaf(p0[r], C2, mnL);
#pragma unroll
    for (int r = 0; r < 16; ++r) p1[r] = fmaf(p1[r], C2, mnL);
#pragma unroll
    for (int r = 0; r < 16; ++r) p0[r] = __builtin_amdgcn_exp2f(p0[r]);
#pragma unroll
    for (int r = 0; r < 16; ++r) p1[r] = __builtin_amdgcn_exp2f(p1[r]);
}
#define ATT_PK4(P, B_, OUT) do { unsigned a0 = cvtpk(P[B_+0], P[B_+1]), a1 = cvtpk(P[B_+2], P[B_+3]);                          \
        unsigned b0 = cvtpk(P[B_+4], P[B_+5]), b1 = cvtpk(P[B_+6], P[B_+7]);                                             \
        auto r0 = __builtin_amdgcn_permlane32_swap(a0, b0, false, false); auto r1 = __builtin_amdgcn_permlane32_swap(a1, b1, false, false); \
        u32x4 w = {r0[0], r1[0], r0[1], r1[1]}; OUT = *reinterpret_cast<bf16x8*>(&w); } while (0)
__device__ __forceinline__ void pack_p(const f32x16& p0, const f32x16& p1, bf16x8& pa0, bf16x8& pa1, bf16x8& pa2, bf16x8& pa3) {
    ATT_PK4(p0, 0, pa0); ATT_PK4(p0, 8, pa1); ATT_PK4(p1, 0, pa2); ATT_PK4(p1, 8, pa3);
}
__device__ __forceinline__ float pair_sum(float v) {
    auto rr = __builtin_amdgcn_permlane32_swap(__float_as_uint(v), __float_as_uint(v), false, false);
    return __uint_as_float(rr[0]) + __uint_as_float(rr[1]);
}
__device__ __forceinline__ void qkt(f32x16& p0, f32x16& p1, const LAS char* Kb, int r32, int hi, const bf16x8* qr) {
#pragma unroll
    for (int r = 0; r < 16; ++r) { p0[r] = 0.f; p1[r] = 0.f; }
    const LAS char* kb[4];
#pragma unroll
    for (int dd = 0; dd < 4; ++dd) kb[dd] = Kb + KSWZ(r32, (dd * 16 + hi * 8) * 2);
#pragma unroll
    for (int d0 = 0; d0 < 8; ++d0) { const LAS char* a = kb[d0 & 3] + (d0 >> 2) * 128;
        const bf16x8 b0 = *reinterpret_cast<const LAS bf16x8*>(a);
        const bf16x8 b1 = *reinterpret_cast<const LAS bf16x8*>(a + 32 * 256);
        p0 = __builtin_amdgcn_mfma_f32_32x32x16_bf16(b0, qr[d0], p0, 0, 0, 0);
        p1 = __builtin_amdgcn_mfma_f32_32x32x16_bf16(b1, qr[d0], p1, 0, 0, 0); }
}
__device__ __forceinline__ void pv_tile(f32x16* o, int vb0, bf16x8 pa0, bf16x8 pa1, bf16x8 pa2, bf16x8 pa3) {
#define TRRD(dst, off) asm volatile("ds_read_b64_tr_b16 %0, %1 offset:%2" : "=&v"(dst) : "v"(vb0), "i"(off) : "memory")
#define PV_D0(d0) do { s16x4 l0, l1, l2, l3, h0, h1, h2, h3; constexpr int b_ = (d0) * 512; \
        TRRD(l0, b_); TRRD(h0, b_ + 2048); TRRD(l1, b_ + 4096); TRRD(h1, b_ + 6144); TRRD(l2, b_ + 8192); TRRD(h2, b_ + 10240); TRRD(l3, b_ + 12288); TRRD(h3, b_ + 14336); \
        asm volatile("s_waitcnt lgkmcnt(0)" ::: "memory"); SBAR();   \
        o[d0] = __builtin_amdgcn_mfma_f32_32x32x16_bf16(pa0, (bf16x8){l0[0], l0[1], l0[2], l0[3], h0[0], h0[1], h0[2], h0[3]}, o[d0], 0, 0, 0);   \
        o[d0] = __builtin_amdgcn_mfma_f32_32x32x16_bf16(pa1, (bf16x8){l1[0], l1[1], l1[2], l1[3], h1[0], h1[1], h1[2], h1[3]}, o[d0], 0, 0, 0);   \
        o[d0] = __builtin_amdgcn_mfma_f32_32x32x16_bf16(pa2, (bf16x8){l2[0], l2[1], l2[2], l2[3], h2[0], h2[1], h2[2], h2[3]}, o[d0], 0, 0, 0);   \
        o[d0] = __builtin_amdgcn_mfma_f32_32x32x16_bf16(pa3, (bf16x8){l3[0], l3[1], l3[2], l3[3], h3[0], h3[1], h3[2], h3[3]}, o[d0], 0, 0, 0); } while (0)
    PV_D0(0); PV_D0(1); PV_D0(2); PV_D0(3);
#undef PV_D0
#undef TRRD
}

template <int MODE>
__device__ __forceinline__ void attn_block(const bf16* __restrict__ Qp, int ldq, const bf16* __restrict__ Kp, int ldk, const bf16* __restrict__ Vp, int ldv, bf16* __restrict__ Op, int ldo,
                                           int qb, LAS char* lds, const float* __restrict__ aux0, const float* __restrict__ aux1, const float* __restrict__ aux2) {
    int tid_ = threadIdx.x; asm volatile("" : "+v"(tid_));
    const int tid = tid_, wid = __builtin_amdgcn_readfirstlane(tid >> 6), lane = tid & 63, r32 = lane & 31, hi = lane >> 5;
    const int P0 = qb * 256, qlo = P0 + wid * 32, qpos = qlo + r32;
    const int NT = 4 * qb + 4;
    LAS char* V_lds = lds + OFF_V; LAS char* K_lds = lds + OFF_K;
    LAS float* wsf = (LAS float*)(lds + OFF_WS) + wid * 64; LAS float* li_l = wsf; LAS float* al_l = wsf + 32;
    LAS float* aux = (LAS float*)(lds + OFF_AUX);
    bf16x8 qr[8];
#pragma unroll
    for (int d0 = 0; d0 < 8; ++d0) qr[d0] = *reinterpret_cast<const bf16x8*>(Qp + (size_t)qpos * ldq + d0 * 16 + hi * 8);
    unsigned kso[2], vso[2];
#pragma unroll
    for (int i = 0; i < 2; ++i) { const int pc = 2 * wid + i, krow = pc * 4 + (lane >> 4), kch = (lane & 15) ^ (krow & 7);
        kso[i] = (unsigned)(krow * ldk + kch * 8) * 2u;
        const int kk = wid * 8 + ((lane & 31) >> 2), vk = (kk & ~0xC) | ((kk & 4) << 1) | ((kk & 8) >> 1), vc = (2 * i + (lane >> 5)) * 32 + (lane & 3) * 8;
        vso[i] = (unsigned)(vk * ldv + vc) * 2u; }
    const int vb0 = (int)(unsigned)(size_t)V_lds + v_rd_base(lane);
    float m_reg = -1e30f, l_reg = 0.f, Rsum = 0.f, den = 0.f, M2row = 0.f, nmrow = 1.f; unsigned sel = 0u;
    if constexpr (MODE == MODE_ML) { for (int i = tid; i < P0 + 256; i += 512) aux[i] = aux0[i]; M2row = aux1[qpos]; nmrow = aux2[qpos]; }
    if constexpr (MODE == MODE_MOBA) { for (int i = tid; i < qb * 128; i += 512) aux[i] = aux0[i]; }
#define TJ(i) ((MODE == MODE_SB) ? (NT - 1 - (i)) : (i))
#define SLOAD(kb_, bf) do { const char* kg_ = (const char*)(Kp + (size_t)(kb_) * ldk); const char* vg_ = (const char*)(Vp + (size_t)(kb_) * ldv); \
        _Pragma("unroll") for (int i_ = 0; i_ < 2; ++i_) { \
            __builtin_amdgcn_global_load_lds((const unsigned*)(kg_ + kso[i_]), (LAS unsigned*)(K_lds + (bf) * SHM + (2 * wid + i_) * 1024), 16, 0, 0); \
            __builtin_amdgcn_global_load_lds((const unsigned*)(vg_ + vso[i_]), (LAS unsigned*)(V_lds + (bf) * SHM + (2 * wid + i_) * 1024), 16, 0, 0); } } while (0)
    SLOAD(TJ(0) * 64, 0); VM_WAIT(); LDS_WAIT(); WG_BAR();
    if constexpr (MODE == MODE_MOBA) {
        if (qb <= 3) sel = (1u << qb) - 1u;
        else {
            float g[7];
#pragma unroll
            for (int n = 0; n < 7; ++n) { g[n] = -__builtin_inff();
                if (n < qb) { float s = 0.f;
#pragma unroll
                    for (int d0 = 0; d0 < 8; ++d0) { const LAS f32x4* kp = (const LAS f32x4*)(aux + n * 128 + d0 * 16 + hi * 8); const f32x4 k0 = kp[0], k1 = kp[1];
                        const u32x4 qw = *reinterpret_cast<const u32x4*>(&qr[d0]);
                        s = fmaf(bf_lo(qw.x), k0[0], s); s = fmaf(bf_hi(qw.x), k0[1], s); s = fmaf(bf_lo(qw.y), k0[2], s); s = fmaf(bf_hi(qw.y), k0[3], s);
                        s = fmaf(bf_lo(qw.z), k1[0], s); s = fmaf(bf_hi(qw.z), k1[1], s); s = fmaf(bf_lo(qw.w), k1[2], s); s = fmaf(bf_hi(qw.w), k1[3], s); }
                    g[n] = pair_sum(s); }
                asm volatile("" ::: "memory"); }
#pragma unroll
            for (int k = 0; k < 3; ++k) { float best = -__builtin_inff(); int bi = 0;
#pragma unroll
                for (int n = 0; n < 7; ++n) if (g[n] > best) { best = g[n]; bi = n; }
                sel |= 1u << bi;
#pragma unroll
                for (int n = 0; n < 7; ++n) g[n] = (bi == n) ? -__builtin_inff() : g[n]; }
        }
    }
    f32x16 o[4];
#pragma unroll
    for (int d_ = 0; d_ < 4; ++d_)
#pragma unroll
        for (int r = 0; r < 16; ++r) o[d_][r] = 0.f;
    for (int i = 0; i < NT; ++i) {
        const int tj = TJ(i), kb = tj * 64, buf = i & 1;
        if (i + 1 < NT) SLOAD(TJ(i + 1) * 64, buf ^ 1);
        SBAR();
        bool act = (MODE == MODE_SB) ? (kb <= qlo + 30) : (kb <= qlo + 31);
        if constexpr (MODE == MODE_MOBA) { const int n = tj >> 2; if (n != qb) act = act && __any((int)((sel >> n) & 1u)); }
        if (act) {
            f32x16 p0, p1; bf16x8 pa0, pa1, pa2, pa3;
            qkt(p0, p1, K_lds + buf * SHM, r32, hi, qr);
            const int dq = qpos - kb - 4 * hi;
            if constexpr (MODE == MODE_DIL || MODE == MODE_MOBA) {
                if constexpr (MODE == MODE_DIL) {
#pragma unroll
                    for (int r = 0; r < 16; ++r) { const int c = (r & 3) + 8 * (r >> 2);
                        { const unsigned ud = (unsigned)(dq - c); const int cnt = (int)(ud <= 128u) + (int)(((ud & 3u) == 0u) & (ud <= 512u)) + (int)((ud & 0x8000000Fu) == 0u);
                          p0[r] += __builtin_amdgcn_logf((float)cnt) * (1.0f / C2); }
                        { const unsigned ud = (unsigned)(dq - c - 32); const int cnt = (int)(ud <= 128u) + (int)(((ud & 3u) == 0u) & (ud <= 512u)) + (int)((ud & 0x8000000Fu) == 0u);
                          p1[r] += __builtin_amdgcn_logf((float)cnt) * (1.0f / C2); } }
                } else {
                    const int n = tj >> 2;
                    if (n == qb) { if (kb + 63 > qlo) mask_tile(p0, p1, dq); }
                    else if (!((sel >> n) & 1u)) {
#pragma unroll
                        for (int r = 0; r < 16; ++r) { p0[r] = -__builtin_inff(); p1[r] = -__builtin_inff(); } }
                }
                float mn, alpha;
                partialSM(p0, p1, m_reg, mn, alpha);
                float ps = 0.f;
#pragma unroll
                for (int r = 0; r < 16; ++r) ps += p0[r];
#pragma unroll
                for (int r = 0; r < 16; ++r) ps += p1[r];
                ps = pair_sum(ps);
                l_reg = l_reg * alpha + ps;
                pack_p(p0, p1, pa0, pa1, pa2, pa3);
                if (__any(alpha < 1.f)) { if (hi == 0) al_l[r32] = alpha; LDS_WAIT();
#pragma unroll
                    for (int d_ = 0; d_ < 4; ++d_)
#pragma unroll
                        for (int r = 0; r < 16; ++r) o[d_][r] *= al_l[crow(r, hi)]; }
            } else if constexpr (MODE == MODE_ML) {
                float dsum = 0.f;
#pragma unroll
                for (int r4 = 0; r4 < 4; ++r4) {
                    const f32x4 a0 = *(const LAS f32x4*)(aux + kb + 8 * r4 + 4 * hi), a1 = *(const LAS f32x4*)(aux + kb + 32 + 8 * r4 + 4 * hi);
#pragma unroll
                    for (int j = 0; j < 4; ++j) { const int r = 4 * r4 + j, c = 8 * r4 + j;
                        float s0 = p0[r] * SCALE * __builtin_amdgcn_exp2f(a0[j] - M2row); s0 = (dq - c < 0) ? 0.f : s0;
                        float s1 = p1[r] * SCALE * __builtin_amdgcn_exp2f(a1[j] - M2row); s1 = (dq - c - 32 < 0) ? 0.f : s1;
                        p0[r] = s0; p1[r] = s1; dsum += s0 + s1; } }
                den += dsum;
                pack_p(p0, p1, pa0, pa1, pa2, pa3);
            } else {
                f32x16 z0, z1; float gs[8];
#pragma unroll
                for (int r = 0; r < 16; ++r) { const int c = (r & 3) + 8 * (r >> 2);
                    { const float z2 = p0[r] * C2; const float sp = fmaxf(z2, 0.f) + __builtin_amdgcn_logf(1.0f + __builtin_amdgcn_exp2f(-fabsf(z2)));
                      z0[r] = z2; const float spm = ((dq - 1 - c) >= 0) ? sp : 0.f; p0[r] = spm; if ((r & 3) == 0) gs[r >> 2] = spm; else gs[r >> 2] += spm; }
                    { const float z2 = p1[r] * C2; const float sp = fmaxf(z2, 0.f) + __builtin_amdgcn_logf(1.0f + __builtin_amdgcn_exp2f(-fabsf(z2)));
                      z1[r] = z2; const float spm = ((dq - 1 - c - 32) >= 0) ? sp : 0.f; p1[r] = spm; if ((r & 3) == 0) gs[4 + (r >> 2)] = spm; else gs[4 + (r >> 2)] += spm; } }
                float aft[8]; float run = 0.f;
#pragma unroll
                for (int i2 = 7; i2 >= 0; --i2) { const float pg = __shfl_xor(gs[i2], 32); aft[i2] = run + (hi == 0 ? pg : 0.f); run += gs[i2] + pg; }
#pragma unroll
                for (int i2 = 0; i2 < 8; ++i2) { float suf = Rsum + aft[i2];
#pragma unroll
                    for (int j = 3; j >= 0; --j) { const int r = 4 * (i2 & 3) + j, c = 8 * (i2 & 3) + j + ((i2 >> 2) ? 32 : 0);
                        const bool ok = (dq - 1 - c) >= 0;
                        if (i2 >> 2) { suf += p1[r]; p1[r] = ok ? __builtin_amdgcn_exp2f(z1[r] - suf) : 0.f; }
                        else { suf += p0[r]; p0[r] = ok ? __builtin_amdgcn_exp2f(z0[r] - suf) : 0.f; } } }
                Rsum += run;
                pack_p(p0, p1, pa0, pa1, pa2, pa3);
            }
            SBAR();
            pv_tile(o, vb0 + buf * SHM, pa0, pa1, pa2, pa3);
        }
        SBAR();
        VM_WAIT(); LDS_WAIT(); WG_BAR();
    }
    if constexpr (MODE == MODE_DIL || MODE == MODE_MOBA) { if (hi == 0) li_l[r32] = l_reg; }
    if constexpr (MODE == MODE_ML) { const float dt = pair_sum(den); if (hi == 0) li_l[r32] = fmaxf(fabsf(dt), nmrow); }
    LDS_WAIT();
    bf16* Ow = Op + (size_t)qlo * ldo;
#pragma unroll
    for (int r = 0; r < 16; ++r) { const int orow = crow(r, hi);
        float rl = 1.f; if constexpr (MODE != MODE_SB) rl = __builtin_amdgcn_rcpf(li_l[orow]);
#pragma unroll
        for (int d0 = 0; d0 < 4; ++d0) { const float v = o[d0][r] * rl; const float vn = __shfl_xor(v, 1);
            if ((r32 & 1) == 0) *(unsigned*)(Ow + (size_t)orow * ldo + d0 * 32 + r32) = cvtpk(v, vn); } }
    LDS_WAIT();
#undef TJ
#undef SLOAD
}
}

struct Args { const float* in[16]; float* out; unsigned char* ws; };
static_assert(sizeof(Args) == 18 * 8, "Args has no padding");
__device__ __forceinline__ const float* ldin(const Args& a, int i) { asm volatile("" : "+s"(i)); return a.in[i]; }

__device__ __forceinline__ int opq_i(int v) { asm volatile("" : "+s"(v)); return v; }
__device__ __forceinline__ unsigned char* opq_p(unsigned char* p) { asm volatile("" : "+s"(p)); return p; }
struct Frame {
    LAS unsigned char* lds; int tid, lane, wave, vcu, G, gw, NGW;
};

template <bool FOLD>
__device__ __forceinline__ void tr_item(const float* __restrict__ W, int K, int N, bf16* __restrict__ WT, int item, int nblk, LAS unsigned* scr, int lane, int rmode, const float* lg, const float* lb, float* cs, float* bs) {
    const int kb = item / nblk, nb = item - kb * nblk, k0 = kb * 64, n0 = nb * 64;
    const int nq = lane & 15, kr = lane >> 4;
    const bool inb = (n0 + 4 * nq) < N;
    f32x4 a[8], b[8];
#pragma unroll
    for (int s = 0; s < 8; ++s) { const int kp = 4 * s + kr; const float* p = W + (size_t)(k0 + 2 * kp) * N + (inb ? n0 + 4 * nq : 0);
        a[s] = *(const f32x4*)p; b[s] = *(const f32x4*)(p + N); }
    if (!inb) {
#pragma unroll
        for (int s = 0; s < 8; ++s) { a[s] = (f32x4){0.f, 0.f, 0.f, 0.f}; b[s] = (f32x4){0.f, 0.f, 0.f, 0.f}; } }
    f32x4 csum = {0.f, 0.f, 0.f, 0.f}, bsum = {0.f, 0.f, 0.f, 0.f};
    if constexpr (FOLD) {
#pragma unroll
        for (int s = 0; s < 8; ++s) { const int k = k0 + 2 * (4 * s + kr); const f32x2 g2 = *(const f32x2*)(lg + k), b2 = *(const f32x2*)(lb + k);
            bsum += a[s] * b2[0] + b[s] * b2[1]; a[s] = a[s] * g2[0]; b[s] = b[s] * g2[1]; }
    }
#pragma unroll
    for (int s = 0; s < 8; ++s) { const int kp = 4 * s + kr;
#pragma unroll
        for (int i = 0; i < 4; ++i) { const unsigned pk = cvtpk(a[s][i], b[s][i]); scr[(4 * nq + i) * 33 + kp] = pk; if constexpr (FOLD) csum[i] += bf_lo(pk) + bf_hi(pk); } }
    LDS_WAIT();
#pragma unroll
    for (int jj = 0; jj < 8; ++jj) { const int n = (lane >> 3) + 8 * jj, c = lane & 7; const LAS unsigned* s = scr + n * 33 + 4 * c;
        u32x4 o; o.x = s[0]; o.y = s[1]; o.z = s[2]; o.w = s[3];
        const int nn = n0 + n, drow = rmode ? (((nn >> 7) << 8) + (nn & 127) + (rmode == 2 ? 128 : 0)) : nn;
        *(u32x4*)(WT + (size_t)drow * K + k0 + 8 * c) = o; }
    LDS_WAIT();
    if constexpr (FOLD) {
#pragma unroll
        for (int i = 0; i < 4; ++i) { csum[i] += __shfl_xor(csum[i], 16); csum[i] += __shfl_xor(csum[i], 32); bsum[i] += __shfl_xor(bsum[i], 16); bsum[i] += __shfl_xor(bsum[i], 32); }
        LAS float* fs = (LAS float*)scr;
        if (kr == 0) { *(LAS f32x4*)(fs + 4 * nq) = csum; *(LAS f32x4*)(fs + 64 + 4 * nq) = bsum; }
        LDS_WAIT();
        const int nn = n0 + lane, drow = rmode ? (((nn >> 7) << 8) + (nn & 127) + (rmode == 2 ? 128 : 0)) : nn;
        if (nn < N) { unsafeAtomicAdd(cs + drow, fs[lane]); unsafeAtomicAdd(bs + drow, fs[64 + lane]); }
        LDS_WAIT();
    }
}

__device__ __forceinline__ void prologue(const Frame& F_, const Args& a) {
    Frame F = F_; asm volatile("" : "+v"(F.lane), "+v"(F.tid), "+s"(F.gw), "+s"(F.vcu), "+s"(F.wave));
    unsigned char* ws = a.ws;
    LAS unsigned* scr = (LAS unsigned*)(F.lds + F.wave * 8448);
    constexpr int I_INAB = 64 * 192, I_OUT = 64 * 64, I_INCD = 64 * 196, I_UP = 64 * 172, I_DN = 172 * 64;
    constexpr int TOTAL = I_INAB + I_OUT + I_INCD + I_OUT + 4 * I_UP + 2 * I_DN;
    for (int it = F.gw; it < TOTAL; it += F.NGW) {
        int r = it; const float* W; int K, N, nblk; bf16* WT; int rmode = 0; const float* lg = nullptr; const float* lb = nullptr; float* cs = nullptr; float* bs = nullptr;
        unsigned char* ctl = ws + WS_CTL;
        if (r < I_INAB) { W = a.in[1]; K = DM; N = N_AB; nblk = 192; WT = (bf16*)(ws + WS_W_INAB); }
        else if ((r -= I_INAB) < I_OUT) { W = a.in[2]; K = DM; N = DM; nblk = 64; WT = (bf16*)(ws + WS_W_OUTAB); }
        else if ((r -= I_OUT) < I_INCD) { W = a.in[3]; K = DM; N = N_CD; nblk = 196; WT = (bf16*)(ws + WS_W_INCD); lg = a.in[14] + DM; lb = a.in[15] + DM; cs = (float*)(ctl + CTL_CS_INCD); bs = (float*)(ctl + CTL_BS_INCD); }
        else if ((r -= I_INCD) < I_OUT) { W = a.in[8]; K = DM; N = DM; nblk = 64; WT = (bf16*)(ws + WS_W_OUTCD); }
        else if ((r -= I_OUT) < I_UP) { W = a.in[9]; K = DM; N = DFF; nblk = 172; WT = (bf16*)(ws + WS_W_UG0); rmode = 1; lg = a.in[14]; lb = a.in[15]; cs = (float*)(ctl + CTL_CS_UG0); bs = (float*)(ctl + CTL_BS_UG0); }
        else if ((r -= I_UP) < I_UP) { W = a.in[10]; K = DM; N = DFF; nblk = 172; WT = (bf16*)(ws + WS_W_UG0); rmode = 2; lg = a.in[14]; lb = a.in[15]; cs = (float*)(ctl + CTL_CS_UG0); bs = (float*)(ctl + CTL_BS_UG0); }
        else if ((r -= I_UP) < I_DN) { W = a.in[13]; K = DFF; N = DM; nblk = 64; WT = (bf16*)(ws + WS_W_DN0); }
        else if ((r -= I_DN) < I_UP) { W = a.in[9] + (size_t)DM * DFF; K = DM; N = DFF; nblk = 172; WT = (bf16*)(ws + WS_W_UG1); rmode = 1; lg = a.in[14] + 2 * DM; lb = a.in[15] + 2 * DM; cs = (float*)(ctl + CTL_CS_UG1); bs = (float*)(ctl + CTL_BS_UG1); }
        else if ((r -= I_UP) < I_UP) { W = a.in[10] + (size_t)DM * DFF; K = DM; N = DFF; nblk = 172; WT = (bf16*)(ws + WS_W_UG1); rmode = 2; lg = a.in[14] + 2 * DM; lb = a.in[15] + 2 * DM; cs = (float*)(ctl + CTL_CS_UG1); bs = (float*)(ctl + CTL_BS_UG1); }
        else { r -= I_UP; W = a.in[13] + (size_t)DFF * DM; K = DFF; N = DM; nblk = 64; WT = (bf16*)(ws + WS_W_DN1); }
        if (lg) tr_item<true>(W, K, N, WT, r, nblk, scr, F.lane, rmode, lg, lb, cs, bs); else tr_item<false>(W, K, N, WT, r, nblk, scr, F.lane, rmode, lg, lb, cs, bs);
    }
    const f32x4* x4 = (const f32x4*)a.in[0]; u32x2* xb = (u32x2*)(ws + WS_XB);
    for (size_t i = (size_t)F.gw * 64 + F.lane; i < (size_t)M * DM / 4; i += (size_t)F.NGW * 64) { const f32x4 v = x4[i]; u32x2 o; o.x = cvtpk(v[0], v[1]); o.y = cvtpk(v[2], v[3]); xb[i] = o; }
}

__device__ __forceinline__ void ln_phase(const Frame& F_, const float* z, float* xo, bf16* xb, const float* g, const float* b, float oscale = 1.f) {
    Frame F = F_; asm volatile("" : "+v"(F.lane), "+v"(F.tid), "+s"(F.gw), "+s"(F.vcu), "+s"(F.wave));
    for (int m = F.gw; m < M; m += F.NGW) {
        const f32x4* zr = (const f32x4*)(z + (size_t)m * DM) + F.lane;
        f32x4 v[16]; float s = 0.f;
#pragma unroll
        for (int j = 0; j < 16; ++j) { v[j] = zr[64 * j]; s += (v[j][0] + v[j][1]) + (v[j][2] + v[j][3]); }
        const float mean = wave_sum(s) * (1.f / DM); float s2 = 0.f;
#pragma unroll
        for (int j = 0; j < 16; ++j) { v[j] = v[j] - mean; s2 += (v[j][0] * v[j][0] + v[j][1] * v[j][1]) + (v[j][2] * v[j][2] + v[j][3] * v[j][3]); }
        const float rstd = 1.f / sqrtf(wave_sum(s2) * (1.f / DM) + LN_EPS);
        f32x4* xr = (f32x4*)(xo + (size_t)m * DM) + F.lane; u32x2* br = (u32x2*)((xb ? xb : (bf16*)xo) + (size_t)m * DM) + F.lane;
        const f32x4* g4 = (const f32x4*)g + F.lane; const f32x4* b4 = (const f32x4*)b + F.lane;
#pragma unroll
        for (int j = 0; j < 16; ++j) { f32x4 o = v[j] * rstd * g4[64 * j] + b4[64 * j]; if (SELFCHECK) o = o * oscale; xr[64 * j] = o;
            if (xb) { u32x2 w; w.x = cvtpk(o[0], o[1]); w.y = cvtpk(o[2], o[3]); br[64 * j] = w; } }
    }
}

__device__ __forceinline__ void ffn_act_phase(const Frame& F_, bf16* U, const bf16* Gb, const float* cw  , const float* cb, bool dummy = false) {
    Frame F = F_; asm volatile("" : "+v"(F.lane), "+v"(F.tid), "+s"(F.gw), "+s"(F.vcu), "+s"(F.wave));
    constexpr int NCH = DFF / 8, NCB = (NCH + 63) / 64, NITEM = (M / 32) * NCB;
    for (int it = F.gw; it < NITEM; it += F.NGW) {
        const int rb = it / NCB, cbk = it - rb * NCB, ch = cbk * 64 + F.lane;
        if (ch >= NCH) continue;
        const int c0 = ch * 8, r0 = rb * 32;
        float w0[8], w1[8], w2[8], bb[8];
#pragma unroll
        for (int q = 0; q < 2; ++q) { const f32x4 t0 = *(const f32x4*)(cw + c0 + 4 * q), t1 = *(const f32x4*)(cw + DFF + c0 + 4 * q), t2 = *(const f32x4*)(cw + 2 * DFF + c0 + 4 * q), t3 = *(const f32x4*)(cb + c0 + 4 * q);
#pragma unroll
            for (int j = 0; j < 4; ++j) { w0[4 * q + j] = t0[j]; w1[4 * q + j] = t1[j]; w2[4 * q + j] = t2[j]; bb[4 * q + j] = t3[j]; } }
        u32x4 gm2 = {0u, 0u, 0u, 0u}, gm1 = {0u, 0u, 0u, 0u};
        if ((r0 & (SEQ - 1)) != 0) { gm2 = *(const u32x4*)(Gb + (size_t)(r0 - 2) * DFF + c0); gm1 = *(const u32x4*)(Gb + (size_t)(r0 - 1) * DFF + c0); }
        for (int t8 = 0; t8 < 32; t8 += 8) {
            u32x4 gv[8], uv[8];
#pragma unroll
            for (int t = 0; t < 8; ++t) { gv[t] = *(const u32x4*)(Gb + (size_t)(r0 + t8 + t) * DFF + c0); uv[t] = *(const u32x4*)(U + (size_t)(r0 + t8 + t) * DFF + c0); }
#pragma unroll
            for (int t = 0; t < 8; ++t) { u32x4 ov;
#pragma unroll
                for (int q = 0; q < 4; ++q) {
                    const float y0 = w0[2 * q] * bf_lo(gm2[q]) + w1[2 * q] * bf_lo(gm1[q]) + w2[2 * q] * bf_lo(gv[t][q]) + bb[2 * q];
                    const float y1 = w0[2 * q + 1] * bf_hi(gm2[q]) + w1[2 * q + 1] * bf_hi(gm1[q]) + w2[2 * q + 1] * bf_hi(gv[t][q]) + bb[2 * q + 1];
                    ov[q] = cvtpk(silu_f(y0) * bf_lo(uv[t][q]), silu_f(y1) * bf_hi(uv[t][q])); }
                if (REP_MASK & 4096) { if (dummy) ov = uv[t]; }
                *(u32x4*)(U + (size_t)(r0 + t8 + t) * DFF + c0) = ov; gm2 = gm1; gm1 = gv[t]; }
        }
    }
}


__device__ __forceinline__ void ffn_fix_phase(const Frame& F_, bf16* H, const float* EG0, const float* EU0, const float* EGL, const float* cw, const float* cb) {
    Frame F = F_; asm volatile("" : "+v"(F.lane), "+v"(F.tid), "+s"(F.gw), "+s"(F.vcu), "+s"(F.wave));
    constexpr int C4 = DFF / 4;
    for (int idx = F.gw * 64 + F.lane; idx < 64 * C4; idx += F.NGW * 64) {
        const int pm = idx / C4, ch = (idx - pm * C4) * 4;
        f32x4 gl0 = {0.f, 0.f, 0.f, 0.f}, gl1 = gl0;
        if ((pm & 7) != 0) { gl0 = *(const f32x4*)(EGL + (size_t)((pm - 1) * 2) * DFF + ch); gl1 = *(const f32x4*)(EGL + (size_t)((pm - 1) * 2 + 1) * DFF + ch); }
        const f32x4 g0 = *(const f32x4*)(EG0 + (size_t)(pm * 2) * DFF + ch), g1 = *(const f32x4*)(EG0 + (size_t)(pm * 2 + 1) * DFF + ch);
        const f32x4 u0 = *(const f32x4*)(EU0 + (size_t)(pm * 2) * DFF + ch), u1 = *(const f32x4*)(EU0 + (size_t)(pm * 2 + 1) * DFF + ch);
        const f32x4 w0 = *(const f32x4*)(cw + ch), w1 = *(const f32x4*)(cw + DFF + ch), w2 = *(const f32x4*)(cw + 2 * DFF + ch), bb = *(const f32x4*)(cb + ch);
        const f32x4 y0 = w0 * gl0 + w1 * gl1 + w2 * g0 + bb, y1 = w0 * gl1 + w1 * g0 + w2 * g1 + bb;
        u32x2 o0, o1;
        o0.x = cvtpk(silu_f(y0[0]) * u0[0], silu_f(y0[1]) * u0[1]); o0.y = cvtpk(silu_f(y0[2]) * u0[2], silu_f(y0[3]) * u0[3]);
        o1.x = cvtpk(silu_f(y1[0]) * u1[0], silu_f(y1[1]) * u1[1]); o1.y = cvtpk(silu_f(y1[2]) * u1[2], silu_f(y1[3]) * u1[3]);
        *(u32x2*)(H + (size_t)(pm * 256) * DFF + ch) = o0; *(u32x2*)(H + (size_t)(pm * 256 + 1) * DFF + ch) = o1;
    }
}

__device__ __forceinline__ void kmean_phase(const Frame& F_, const bf16* QKV, float* kmean) {
    Frame F = F_; asm volatile("" : "+v"(F.lane), "+v"(F.tid), "+s"(F.gw), "+s"(F.vcu), "+s"(F.wave));
    LAS float* red = (LAS float*)F.lds;
    for (int it = F.vcu; it < 256; it += F.G) {
        const int b = it >> 5, n = (it >> 2) & 7, cbk = it & 3;
        const bf16* src = QKV + (size_t)(b * SEQ + n * 256 + F.wave * 32) * N_AB + 8192 + cbk * 512 + F.lane * 8;
        float acc[8];
#pragma unroll
        for (int j = 0; j < 8; ++j) acc[j] = 0.f;
        for (int r8 = 0; r8 < 32; r8 += 8) { u32x4 v[8];
#pragma unroll
            for (int r = 0; r < 8; ++r) v[r] = *(const u32x4*)(src + (size_t)(r8 + r) * N_AB);
#pragma unroll
            for (int r = 0; r < 8; ++r)
#pragma unroll
                for (int q = 0; q < 4; ++q) { acc[2 * q] += bf_lo(v[r][q]); acc[2 * q + 1] += bf_hi(v[r][q]); } }
#pragma unroll
        for (int j = 0; j < 8; ++j) red[F.wave * 512 + F.lane * 8 + j] = acc[j];
        LDS_WAIT(); WG_BAR();
        float s = 0.f;
#pragma unroll
        for (int w = 0; w < 8; ++w) s += red[w * 512 + F.tid];
        const int col = cbk * 512 + F.tid, h = col >> 7, d = col & 127;
        kmean[((size_t)(b * 16 + h) * 8 + n) * 128 + d] = s * (1.f / 256.f);
        LDS_WAIT(); WG_BAR();
    }
}

__device__ __forceinline__ void cd_pre_phase(const Frame& F_, const bf16* QKV, bf16* QKDC, const float* cw  , const float* cb, const float* gates, const float* bif, float* A2, float* M2, float* NM) {
    Frame F = F_; asm volatile("" : "+v"(F.lane), "+v"(F.tid), "+s"(F.gw), "+s"(F.vcu), "+s"(F.wave));
    for (int it = F.gw; it < (M / 32) * 4; it += F.NGW) {
        const int rb = it >> 2, cbk = it & 3, c0 = cbk * 512 + F.lane * 8, r0 = rb * 32;
        float w[4][8], bb[8];
#pragma unroll
        for (int q = 0; q < 2; ++q) { const f32x4 t3 = *(const f32x4*)(cb + c0 + 4 * q);
#pragma unroll
            for (int j = 0; j < 4; ++j) bb[4 * q + j] = t3[j];
#pragma unroll
            for (int k = 0; k < 4; ++k) { const f32x4 t = *(const f32x4*)(cw + k * 2048 + c0 + 4 * q);
#pragma unroll
                for (int j = 0; j < 4; ++j) w[k][4 * q + j] = t[j]; } }
        const bf16* src = QKV + 6144 + c0;
        u32x4 x3 = {0u, 0u, 0u, 0u}, x2 = x3, x1 = x3;
        if ((r0 & (SEQ - 1)) != 0) { x3 = *(const u32x4*)(src + (size_t)(r0 - 3) * N_AB); x2 = *(const u32x4*)(src + (size_t)(r0 - 2) * N_AB); x1 = *(const u32x4*)(src + (size_t)(r0 - 1) * N_AB); }
        for (int t8 = 0; t8 < 32; t8 += 8) {
            u32x4 xv[8];
#pragma unroll
            for (int t = 0; t < 8; ++t) xv[t] = *(const u32x4*)(src + (size_t)(r0 + t8 + t) * N_AB);
#pragma unroll
            for (int t = 0; t < 8; ++t) { u32x4 ov;
#pragma unroll
                for (int q = 0; q < 4; ++q) {
                    const float y0 = w[0][2 * q] * bf_lo(x3[q]) + w[1][2 * q] * bf_lo(x2[q]) + w[2][2 * q] * bf_lo(x1[q]) + w[3][2 * q] * bf_lo(xv[t][q]) + bb[2 * q];
                    const float y1 = w[0][2 * q + 1] * bf_hi(x3[q]) + w[1][2 * q + 1] * bf_hi(x2[q]) + w[2][2 * q + 1] * bf_hi(x1[q]) + w[3][2 * q + 1] * bf_hi(xv[t][q]) + bb[2 * q + 1];
                    ov[q] = cvtpk(silu_f(y0), silu_f(y1)); }
                *(u32x4*)(QKDC + (size_t)(r0 + t8 + t) * 2048 + c0) = ov; x3 = x2; x2 = x1; x1 = xv[t]; }
        }
    }
    for (int sq = F.gw; sq < 64; sq += F.NGW) {
        const int b = sq >> 3, h = sq & 7; const float bi = bif[h], bfv = bif[8 + h];
        const float* gp = gates + (size_t)(b * SEQ + F.lane * 32) * 16;
        float lf[32], ai[32]; float run = 0.f;
#pragma unroll
        for (int t = 0; t < 32; ++t) { const float f = gp[t * 16 + 8 + h] + bfv; ai[t] = gp[t * 16 + h] + bi;
            const float ls = fminf(f, 0.f) - log1pf(expf(-fabsf(f)));
            run += ls; lf[t] = run; }
        float incl = run;
#pragma unroll
        for (int o = 1; o < 64; o <<= 1) { const float t = __shfl_up(incl, o); if (F.lane >= o) incl += t; }
        const float base = incl - run; float mx = -__builtin_inff();
#pragma unroll
        for (int t = 0; t < 32; ++t) { lf[t] += base; ai[t] -= lf[t]; mx = fmaxf(mx, ai[t]); }
        float minc = mx;
#pragma unroll
        for (int o = 1; o < 64; o <<= 1) { const float t = __shfl_up(minc, o); if (F.lane >= o) minc = fmaxf(minc, t); }
        float mprev = __shfl_up(minc, 1); if (F.lane == 0) mprev = -__builtin_inff();
        float cm = fmaxf(mprev, 0.f);
        float* a2o = A2 + (size_t)sq * SEQ + F.lane * 32; float* m2o = M2 + (size_t)sq * SEQ + F.lane * 32; float* nmo = NM + (size_t)sq * SEQ + F.lane * 32;
#pragma unroll
        for (int t = 0; t < 32; ++t) { cm = fmaxf(cm, ai[t]); a2o[t] = ai[t] * 1.4426950408889634f; m2o[t] = cm * 1.4426950408889634f; nmo[t] = expf(-lf[t] - cm); }
    }
}

__device__ __forceinline__ void cd_post_phase(const Frame& F_, const bf16* HD, const bf16* QKV, bf16* Y, const float* ng) {
    Frame F = F_; asm volatile("" : "+v"(F.lane), "+v"(F.tid), "+s"(F.gw), "+s"(F.vcu), "+s"(F.wave));
    for (int it = F.gw; it < M * 8; it += F.NGW) {
        const int m = it >> 3, h = it & 7, c = h * 256 + F.lane * 4;
        const u32x2 hv = *(const u32x2*)(HD + (size_t)m * 2048 + c); const u32x2 ov = *(const u32x2*)(QKV + (size_t)m * N_AB + 10240 + c);
        const f32x4 g = *(const f32x4*)(ng + c);
        float v0 = bf_lo(hv.x), v1 = bf_hi(hv.x), v2 = bf_lo(hv.y), v3 = bf_hi(hv.y);
        const float mean = wave_sum((v0 + v1) + (v2 + v3)) * (1.f / 256.f);
        v0 -= mean; v1 -= mean; v2 -= mean; v3 -= mean;
        const float rstd = 1.f / sqrtf(wave_sum((v0 * v0 + v1 * v1) + (v2 * v2 + v3 * v3)) * (1.f / 256.f) + LN_EPS);
        const float o0 = bf_lo(ov.x), o1 = bf_hi(ov.x), o2 = bf_lo(ov.y), o3 = bf_hi(ov.y);
        const float y0 = v0 * rstd * g[0] * __builtin_amdgcn_rcpf(1.f + __builtin_amdgcn_exp2f(-1.4426950408889634f * o0));
        const float y1 = v1 * rstd * g[1] * __builtin_amdgcn_rcpf(1.f + __builtin_amdgcn_exp2f(-1.4426950408889634f * o1));
        const float y2 = v2 * rstd * g[2] * __builtin_amdgcn_rcpf(1.f + __builtin_amdgcn_exp2f(-1.4426950408889634f * o2));
        const float y3 = v3 * rstd * g[3] * __builtin_amdgcn_rcpf(1.f + __builtin_amdgcn_exp2f(-1.4426950408889634f * o3));
        u32x2 w; w.x = cvtpk(y0, y1); w.y = cvtpk(y2, y3);
        *(u32x2*)(Y + (size_t)m * DM + 2048 + c) = w;
    }
}


#if SELFCHECK
constexpr int CW_ERR = 64;
__device__ __forceinline__ unsigned hash_u(unsigned x) { x ^= x >> 16; x *= 0x7feb352du; x ^= x >> 15; x *= 0x846ca68bu; x ^= x >> 16; return x; }
__device__ __forceinline__ float bfr(float f) { return bf_lo(cvtpk(f, 0.f)); }
__device__ __forceinline__ float bfv(const bf16* p) { return __uint_as_float(((unsigned)*p) << 16); }
__device__ __forceinline__ float blk_red(LAS float* red, float v, int tid, bool domax) {
    red[tid] = v; __syncthreads();
    for (int o = 256; o >= 1; o >>= 1) { if (tid < o) red[tid] = domax ? fmaxf(red[tid], red[tid + o]) : (red[tid] + red[tid + o]); __syncthreads(); }
    const float r = red[0]; __syncthreads(); return r;
}
__device__ __forceinline__ int sample_t(int ci) {
    if (ci < 4) return ci;
    if (ci < 22) { const int g = (ci - 4) / 3, o = (ci - 4) % 3 - 1; return (g == 0 ? 16 : (32 << g)) + o; }
    if (ci < 24) return 2024 + ci;
    return (int)(hash_u(ci * 2654435761u + 12345u) & 2047u); }
__device__ __forceinline__ void gemm_check(const Frame& F_, const bf16* XB, const float* W, int N, const bf16* QKV, const float* GATES, unsigned* err, unsigned bit) {
    Frame F = F_; asm volatile("" : "+v"(F.lane), "+v"(F.tid), "+s"(F.gw), "+s"(F.vcu), "+s"(F.wave));
    for (int e = 0; e < 16; ++e) {
        const unsigned hsh = hash_u((unsigned)(F.gw * 16 + e) * 2246822519u + bit);
        const int row = (int)(hsh & 16383u); int col = (int)((hsh >> 14) % (unsigned)N);
        if (N == N_CD && (e & 3) == 3) col = 12288 + (int)((hsh >> 14) & 15u);
        float s = 0.f;
        for (int k = F.lane; k < DM; k += 64) s += bfv(XB + (size_t)row * DM + k) * bfr(W[(size_t)k * N + col]);
        s = wave_sum(s);
        const float got = (col < 12288) ? bfv(QKV + (size_t)row * N_AB + col) : GATES[(size_t)row * 16 + (col - 12288)];
        if (!(fabsf(got - s) <= 0.02f * fabsf(s) + 0.02f)) { if (F.lane == 0) atomicOr(err, bit); }
    }
}
__device__ __forceinline__ void attn_check(const Frame& F_, int mode, const bf16* Q, const bf16* K, const bf16* V, int ld, const bf16* O, int ldo, int t, unsigned* err, unsigned bit) {
    Frame F = F_; asm volatile("" : "+v"(F.lane), "+v"(F.tid), "+s"(F.gw), "+s"(F.vcu), "+s"(F.wave));
    LAS float* qf = (LAS float*)F.lds; LAS float* sc = qf + 256; LAS float* red = sc + 2048; LAS float* km = red + 512;
    LAS unsigned* selw = (LAS unsigned*)(km + 1024);
    const int tid = F.tid;
    if (tid < 128) qf[tid] = bfv(Q + (size_t)t * ld + tid);
    __syncthreads();
    const int own = t >> 8;
    if (mode == 1) {
        for (int i = tid; i < own * 128; i += 512) { const int n = i >> 7, d = i & 127; float a = 0.f; for (int r = 0; r < 256; ++r) a += bfv(K + (size_t)(n * 256 + r) * ld + d); km[i] = a * (1.f / 256.f); }
        __syncthreads();
        if (tid == 0) { LAS float* g = km + 1024 + 16; for (int n = 0; n < 8; ++n) { g[n] = -__builtin_inff(); if (n < own) { float a = 0.f; for (int d = 0; d < 128; ++d) a += qf[d] * km[n * 128 + d]; g[n] = a; } }
            unsigned sel = 0u; const int topk = own < 3 ? own : 3;
            for (int k = 0; k < topk; ++k) { int bi = 0; float best = -__builtin_inff(); for (int n = 0; n < own; ++n) if (g[n] > best) { best = g[n]; bi = n; } sel |= 1u << bi; g[bi] = -__builtin_inff(); }
            selw[0] = sel; }
        __syncthreads();
    }
    const int nk = (mode == 2) ? t : t + 1;
    float lmax = -__builtin_inff();
    for (int sidx = tid; sidx < nk; sidx += 512) { float a = 0.f; for (int d = 0; d < 128; ++d) a += qf[d] * bfv(K + (size_t)sidx * ld + d);
        a *= 0.08838834764831845f;
        if (mode == 0) { const int dd = t - sidx; const int cnt = (dd <= 128 ? 1 : 0) + (((dd & 3) == 0 && dd <= 512) ? 1 : 0) + ((dd & 15) == 0 ? 1 : 0); a = cnt ? a + logf((float)cnt) : -__builtin_inff(); }
        if (mode == 1) { const int n = sidx >> 8; if (!(n == own || ((selw[0] >> n) & 1u))) a = -__builtin_inff(); }
        sc[sidx] = a; lmax = fmaxf(lmax, a); }
    __syncthreads();
    float den = 1.f;
    if (mode != 2) { const float mx = blk_red(red, lmax, tid, true); float ls = 0.f;
        for (int sidx = tid; sidx < nk; sidx += 512) { const float p = expf(sc[sidx] - mx); sc[sidx] = p; ls += p; }
        __syncthreads(); den = blk_red(red, ls, tid, false); }
    else { if (tid == 0) { float rc = 0.f; for (int sidx = nk - 1; sidx >= 0; --sidx) { const float z = sc[sidx]; const float sp = fmaxf(z, 0.f) + log1pf(expf(-fabsf(z))); rc += sp; sc[sidx] = expf(z - rc); } } __syncthreads(); }
    float ov = 0.f, df = 0.f;
    if (tid < 128) { float a = 0.f; for (int sidx = 0; sidx < nk; ++sidx) a += sc[sidx] * bfv(V + (size_t)sidx * ld + tid); ov = a / den; df = fabsf(bfv(O + (size_t)t * ldo + tid) - ov); }
    const float mo = blk_red(red, fabsf(ov), tid, true), md = blk_red(red, df, tid, true);
    if (tid == 0 && !(md <= 0.03f * mo + 1e-6f)) atomicOr(err, bit);
    __syncthreads();
}
__device__ __forceinline__ void ml_check(const Frame& F_, const bf16* QKV  , const float* GATES  , const float* cw, const float* cb, const float* bif, const float* ng, const bf16* Y  , int h, int t, unsigned* err, unsigned bit) {
    Frame F = F_; asm volatile("" : "+v"(F.lane), "+v"(F.tid), "+s"(F.gw), "+s"(F.vcu), "+s"(F.wave));
    LAS float* qf = (LAS float*)F.lds; LAS float* sc = qf + 256; LAS float* red = sc + 2048; LAS float* av = red + 512; LAS float* misc = av + 2048;
    const int tid = F.tid;
    if (tid == 0) { float B = 0.f, mx = 0.f; for (int sidx = 0; sidx <= t; ++sidx) { const float f = GATES[(size_t)sidx * 16 + 8 + h] + bif[8 + h]; B += fminf(f, 0.f) - log1pf(expf(-fabsf(f)));
            const float a = GATES[(size_t)sidx * 16 + h] + bif[h] - B; av[sidx] = a; mx = fmaxf(mx, a); } misc[0] = mx; misc[1] = B; }
    if (tid >= 64 && tid < 192) { const int d = tid - 64, c = h * 128 + d; float y = cb[c]; for (int k = 0; k < 4; ++k) { const int r = t - 3 + k; if (r >= 0) y += cw[k * 2048 + c] * bfv(QKV + (size_t)r * N_AB + 6144 + c); } qf[d] = bfr(y / (1.f + expf(-y))); }
    __syncthreads();
    const float Mt = misc[0], Bt = misc[1];
    float ls = 0.f;
    for (int sidx = tid; sidx <= t; sidx += 512) { float a = 0.f;
        for (int d = 0; d < 128; ++d) { const int c = 1024 + h * 128 + d; float y = cb[c]; for (int k = 0; k < 4; ++k) { const int r = sidx - 3 + k; if (r >= 0) y += cw[k * 2048 + c] * bfv(QKV + (size_t)r * N_AB + 6144 + c); }
            a += qf[d] * bfr(y / (1.f + expf(-y))); }
        a *= 0.08838834764831845f * expf(av[sidx] - Mt); sc[sidx] = a; ls += a; }
    __syncthreads();
    const float den = blk_red(red, ls, tid, false);
    float hv = 0.f;
    if (tid < 256) { float a = 0.f; for (int sidx = 0; sidx <= t; ++sidx) a += sc[sidx] * bfv(QKV + (size_t)sidx * N_AB + 8192 + h * 256 + tid); hv = a / fmaxf(fabsf(den), expf(-Bt - Mt)); }
    const float mean = blk_red(red, tid < 256 ? hv : 0.f, tid, false) * (1.f / 256.f);
    const float var = blk_red(red, tid < 256 ? (hv - mean) * (hv - mean) : 0.f, tid, false) * (1.f / 256.f);
    float yv = 0.f, df = 0.f;
    if (tid < 256) { const float od = bfv(QKV + (size_t)t * N_AB + 10240 + h * 256 + tid); yv = (hv - mean) / sqrtf(var + LN_EPS) * ng[h * 256 + tid] / (1.f + expf(-od)); df = fabsf(bfv(Y + (size_t)t * DM + 2048 + h * 256 + tid) - yv); }
    const float mo = blk_red(red, fabsf(yv), tid, true), md = blk_red(red, df, tid, true);
    if (tid == 0 && !(md <= 0.03f * mo + 1e-6f)) atomicOr(err, bit);
    __syncthreads();
}
#endif

__global__ void __launch_bounds__(NWAVES * 64, 2) mk_fwd(Args args) {
    extern __shared__ __attribute__((aligned(16))) unsigned char lds_raw[];
    Frame F;
    F.lds = (LAS unsigned char*)lds_raw;
    F.tid = threadIdx.x; F.lane = F.tid & 63; F.wave = __builtin_amdgcn_readfirstlane(F.tid >> 6);
    F.G = gridDim.x; { const int bx = blockIdx.x; F.vcu = (F.G % 8 == 0) ? (bx % 8) * (F.G / 8) + bx / 8 : bx; }
    F.gw = F.vcu * NWAVES + F.wave; F.NGW = F.G * NWAVES;
    unsigned char* ws = args.ws;
    volatile LAS unsigned* MISC = (volatile LAS unsigned*)(F.lds + MISC_OFF);
    for (int u = F.tid; u < (LDS_BYTES - RING_BYTES) / 4; u += NWAVES * 64) ((LAS unsigned*)(F.lds + RING_BYTES))[u] = 0u;
    __syncthreads();
    XcdBarrier bar = xcd_barrier_post((unsigned*)(ws + WS_CTL) + CW_BAR, MISC + 8);
#define GRID_BAR() xcd_barrier(bar)

    PH(1) prologue(F, args);
    GRID_BAR();

#define PHASE_BEGIN const int L = opq_i(layer); unsigned char* const W = opq_p(ws); (void)L; (void)W;
    for (int layer = 0; layer < 2; ++layer) {
        { PHASE_BEGIN
            pg8::Gemm g{(const bf16*)(W + WS_XB), (const bf16*)(W + (L == 0 ? WS_W_INAB : WS_W_INCD)), M, L == 0 ? N_AB : N_CDP, DM};
            pg8::StaticOrder S; S.init(g.M, g.N, F.G, (int)blockIdx.x);
            pg8::EpiBf16 E{(bf16*)(W + WS_QKV), N_AB, 0, 0, (float*)(W + WS_GATES), L == 0 ? -1 : 48, L == 0 ? nullptr : (const float*)(W + WS_CTL + CTL_STATS) + (size_t)1 * M * 2,
                           (const float*)(W + WS_CTL + CTL_CS_INCD), (const float*)(W + WS_CTL + CTL_BS_INCD)};
            PH(2) pg8::gemm_phase<pg8::EpiBf16, pg8::StaticOrder, true, true>(F.lds, g, S, E);
        }
        GRID_BAR();
        { PHASE_BEGIN
            if (L == 0) { PH(4) kmean_phase(F, (const bf16*)(W + WS_QKV), (float*)(W + WS_KMEAN)); }
            else PH(8) cd_pre_phase(F, (const bf16*)(W + WS_QKV), (bf16*)(W + WS_QKDC), ldin(args, 5), ldin(args, 6), (const float*)(W + WS_GATES), ldin(args, 4), (float*)(W + WS_A2), (float*)(W + WS_M2), (float*)(W + WS_NM));
        }
        GRID_BAR();
        { PHASE_BEGIN
            const bf16* QKV = (const bf16*)(W + WS_QKV); bf16* Y = (bf16*)(W + WS_Y);
            if (L == 0) {
                for (int it = F.vcu; it < 512; it += F.G) { const int bh = it >> 2, pr = it & 3, b = bh >> 4, h = bh & 15;
                    const bf16* base = QKV + (size_t)b * SEQ * N_AB + h * 128; bf16* ob = Y + (size_t)b * SEQ * DM + h * 128;
                    for (int ps = 0; ps < 2; ++ps) PH(16) att::attn_block<att::MODE_DIL>(base, N_AB, base + 2048, N_AB, base + 4096, N_AB, ob, DM, ps ? 7 - pr : pr, (LAS char*)F.lds, nullptr, nullptr, nullptr); }
                const float* KMEAN = (const float*)(W + WS_KMEAN);
                for (int it = F.vcu; it < 512; it += F.G) { const int bh = it >> 2, pr = it & 3, b = bh >> 4, h = bh & 15;
                    const bf16* base = QKV + (size_t)b * SEQ * N_AB + 6144 + h * 128; bf16* ob = Y + (size_t)b * SEQ * DM + 2048 + h * 128;
                    for (int ps = 0; ps < 2; ++ps) PH(32) att::attn_block<att::MODE_MOBA>(base, N_AB, base + 2048, N_AB, base + 4096, N_AB, ob, DM, ps ? 7 - pr : pr, (LAS char*)F.lds, KMEAN + (size_t)bh * 1024, nullptr, nullptr); }
            } else {
                for (int it = F.vcu; it < 512; it += F.G) { const int bh = it >> 2, pr = it & 3, b = bh >> 4, h = bh & 15;
                    const bf16* base = QKV + (size_t)b * SEQ * N_AB + h * 128; bf16* ob = Y + (size_t)b * SEQ * DM + h * 128;
                    for (int ps = 0; ps < 2; ++ps) PH(64) att::attn_block<att::MODE_SB>(base, N_AB, base + 2048, N_AB, base + 4096, N_AB, ob, DM, ps ? 7 - pr : pr, (LAS char*)F.lds, nullptr, nullptr, nullptr); }
                const bf16* QKDC = (const bf16*)(W + WS_QKDC); bf16* HD = (bf16*)(W + WS_HD); const float* A2 = (const float*)(W + WS_A2); const float* M2 = (const float*)(W + WS_M2); const float* NMv = (const float*)(W + WS_NM);
                for (int it = F.vcu; it < 512; it += F.G) { const int bv = it >> 2, pr = it & 3, b = bv >> 4, vh = bv & 15, h = vh >> 1, half = vh & 1;
                    const bf16* qd = QKDC + (size_t)b * SEQ * 2048 + h * 128; const bf16* vd = QKV + (size_t)b * SEQ * N_AB + 8192 + h * 256 + half * 128;
                    bf16* ob = HD + (size_t)b * SEQ * 2048 + h * 256 + half * 128; const size_t so = (size_t)(b * 8 + h) * SEQ;
                    for (int ps = 0; ps < 2; ++ps) PH(128) att::attn_block<att::MODE_ML>(qd, 2048, qd + 1024, 2048, vd, N_AB, ob, 2048, ps ? 7 - pr : pr, (LAS char*)F.lds, A2 + so, M2 + so, NMv + so); }
            }
        }
        if (layer == 1) { GRID_BAR(); PHASE_BEGIN PH(256) cd_post_phase(F, (const bf16*)(W + WS_HD), (const bf16*)(W + WS_QKV), (bf16*)(W + WS_Y), ldin(args, 7)); }
        GRID_BAR();
        { PHASE_BEGIN
            float* const STATS = (float*)(W + WS_CTL + CTL_STATS); float* const OUT = args.out;
            pg8::Gemm g{(const bf16*)(W + WS_Y), (const bf16*)(W + (L == 0 ? WS_W_OUTAB : WS_W_OUTCD)), M, DM, DM};
            pg8::StaticOrder S; S.init(g.M, g.N, F.G, (int)blockIdx.x);
            pg8::EpiResid E{L == 0 ? ldin(args, 0) : OUT, OUT, ALPHA, L == 0 ? nullptr : STATS + (size_t)1 * M * 2, ldin(args, 14) + DM, ldin(args, 15) + DM, (bf16*)(W + WS_XB), STATS + (size_t)(L == 0 ? 0 : 2) * M * 2, (LAS float*)(F.lds + RING_BYTES + 1024)};
            PH(512) pg8::gemm_phase<pg8::EpiResid, pg8::StaticOrder, true, true>(F.lds, g, S, E);
        }
        GRID_BAR();
        { PHASE_BEGIN
            pg8::Gemm g{(const bf16*)(W + WS_XB), (const bf16*)(W + (L == 0 ? WS_W_UG0 : WS_W_UG1)), M, 2 * DFF, DM};
            pg8::StaticOrder S; S.init(g.M, g.N, F.G, (int)blockIdx.x);
            pg8::EpiFfnAct E{(bf16*)(W + WS_U), ldin(args, 11) + (size_t)L * 3 * DFF, ldin(args, 12) + (size_t)L * DFF, (float*)(W + WS_G), (float*)(W + WS_G + 8 * MiB), (float*)(W + WS_G + 16 * MiB), (LAS float*)(F.lds + RING_BYTES + 1024),
                             (const float*)(W + WS_CTL + CTL_STATS) + (size_t)(L == 0 ? 0 : 2) * M * 2, (const float*)(W + WS_CTL + (L == 0 ? CTL_CS_UG0 : CTL_CS_UG1)), (const float*)(W + WS_CTL + (L == 0 ? CTL_BS_UG0 : CTL_BS_UG1))};
            PH(2048) pg8::gemm_phase<pg8::EpiFfnAct, pg8::StaticOrder, true, true>(F.lds, g, S, E);
        }
        GRID_BAR();
        { PHASE_BEGIN PH(4096) ffn_fix_phase(F, (bf16*)(W + WS_U), (const float*)(W + WS_G), (const float*)(W + WS_G + 8 * MiB), (const float*)(W + WS_G + 16 * MiB), ldin(args, 11) + (size_t)L * 3 * DFF, ldin(args, 12) + (size_t)L * DFF); }
        GRID_BAR();
        { PHASE_BEGIN
            float* const STATS = (float*)(W + WS_CTL + CTL_STATS); float* const OUT = args.out;
            pg8::Gemm g{(const bf16*)(W + WS_U), (const bf16*)(W + (L == 0 ? WS_W_DN0 : WS_W_DN1)), M, DM, DFF};
            pg8::StaticOrder S; S.init(g.M, g.N, F.G, (int)blockIdx.x);
            pg8::EpiResid E{OUT, OUT, ALPHA, STATS + (size_t)(L == 0 ? 0 : 2) * M * 2, ldin(args, 14) + (size_t)(L * 2) * DM, ldin(args, 15) + (size_t)(L * 2) * DM,
                            L == 0 ? (bf16*)(W + WS_XB) : nullptr, L == 0 ? STATS + (size_t)1 * M * 2 : nullptr, (LAS float*)(F.lds + RING_BYTES + 1024)};
            PH(8192) pg8::gemm_phase<pg8::EpiResid, pg8::StaticOrder, true, true>(F.lds, g, S, E);
        }
        GRID_BAR();
        if (layer == 1) { PHASE_BEGIN PH(1024) ln_phase(F, args.out, args.out, nullptr, ldin(args, 14) + (size_t)3 * DM, ldin(args, 15) + (size_t)3 * DM); }
    }
#undef PHASE_BEGIN
}

extern "C" void kernel_launch(void* const* d_in, const int* in_sizes, int n_in, void* d_out, int out_size, void* d_ws, size_t ws_size, hipStream_t stream) {
    static int grid = 0;
    if (grid == 0) {
        if (n_in != 16 || in_sizes[0] != M * DM || out_size != M * DM || ws_size < WS_END) { fprintf(stderr, "kernel_launch: unexpected shapes (n_in %d, in0 %d, out %d, ws %zu < %zu)\n", n_in, n_in > 0 ? in_sizes[0] : -1, out_size, ws_size, (size_t)WS_END); grid = -1; return; }
        int dev = 0, cus = 0;
        if (hipGetDevice(&dev) != hipSuccess || hipDeviceGetAttribute(&cus, hipDeviceAttributeMultiprocessorCount, dev) != hipSuccess) { grid = -1; return; }
        if (hipFuncSetAttribute((const void*)mk_fwd, hipFuncAttributeMaxDynamicSharedMemorySize, LDS_BYTES) != hipSuccess) { fprintf(stderr, "kernel_launch: hipFuncSetAttribute failed\n"); grid = -1; return; }
        int per_cu = 0;
        if (hipOccupancyMaxActiveBlocksPerMultiprocessor(&per_cu, (const void*)mk_fwd, NWAVES * 64, LDS_BYTES) != hipSuccess || per_cu < 1) fprintf(stderr, "kernel_launch: occupancy query says %d\n", per_cu);
        (void)hipGetLastError();
        grid = cus;
    }
    if (grid < 0) return;
    if (hipMemsetAsync((char*)d_ws + WS_CTL, 0, CTL_ZERO_BYTES, stream) != hipSuccess) return;
    Args a{};
    for (int i = 0; i < 16; ++i) a.in[i] = (const float*)d_in[i];
    a.out = (float*)d_out; a.ws = (unsigned char*)d_ws;
    hipLaunchKernelGGL(mk_fwd, dim3(grid), dim3(NWAVES * 64), LDS_BYTES, stream, a);
}
```

```cpp
#include <hip/hip_runtime.h>
#include <cstdio>
#include <cstdint>

#define LAS __attribute__((address_space(3)))
#define GAS __attribute__((address_space(1)))
typedef unsigned short bf16;
typedef short bf16x8 __attribute__((ext_vector_type(8)));
typedef short s16x4 __attribute__((ext_vector_type(4)));
typedef float f32x16 __attribute__((ext_vector_type(16)));
typedef float f32x4 __attribute__((ext_vector_type(4)));
typedef float f32x2 __attribute__((ext_vector_type(2)));
typedef unsigned u32x4 __attribute__((ext_vector_type(4)));
typedef unsigned u32x2 __attribute__((ext_vector_type(2)));

#ifndef SKIP_MIX
#define SKIP_MIX 0
#endif
#ifndef SELFCHECK
#define SELFCHECK 0
#endif
#ifndef PH_MASK
#define PH_MASK 0xFFFF
#endif
#define PH(x) if constexpr ((PH_MASK & (x)) != 0)
#ifndef REP_MASK
#define REP_MASK 0
#endif
#define RP(x) _Pragma("unroll 1") for (int rep_ = 0; rep_ < (((REP_MASK) & (x)) ? 2 : 1); ++rep_)

constexpr int BATCH = 8, SEQ = 2048, DM = 4096, M = BATCH * SEQ;
constexpr int DFF = 11008, N_AB = 12288, N_CD = 12304, N_CDP = 12544;
constexpr float ALPHA = 1.4142135623730951f;
constexpr float LN_EPS = 1e-5f;
constexpr int NWAVES = 8;

constexpr size_t MiB = 1u << 20;
constexpr size_t WS_CTL = 0, CTL_ZERO_BYTES = 1 * MiB;
constexpr size_t WS_KMEAN = 1 * MiB;
constexpr size_t WS_GATES = 2 * MiB;
constexpr size_t WS_A2 = 3 * MiB;
constexpr size_t WS_M2 = 3 * MiB + 512 * 1024;
constexpr size_t WS_NM = 4 * MiB;
constexpr size_t WS_W_INAB = 8 * MiB, WS_W_OUTAB = 104 * MiB, WS_W_UG0 = 136 * MiB, WS_W_DN0 = 308 * MiB;
constexpr size_t WS_W_INCD = 394 * MiB, WS_W_OUTCD = 492 * MiB, WS_W_UG1 = 524 * MiB, WS_W_DN1 = 696 * MiB;
constexpr size_t WS_XB = 782 * MiB;
constexpr size_t WS_R = 910 * MiB;
constexpr size_t WS_QKV = WS_R, WS_Y = WS_R + 384 * MiB, WS_QKDC = WS_R + 512 * MiB, WS_HD = WS_R + 576 * MiB;
constexpr size_t WS_U = WS_R, WS_G = WS_R + 344 * MiB;
constexpr size_t WS_END = WS_R + 688 * MiB;
static_assert((size_t)M * DFF * 2 == 344 * MiB, "u/g size");
constexpr int CW_BAR = 4096;
constexpr size_t CTL_STATS = 65536;
constexpr size_t CTL_CS_UG0 = 524288, CTL_BS_UG0 = CTL_CS_UG0 + 88064, CTL_CS_INCD = CTL_BS_UG0 + 88064, CTL_BS_INCD = CTL_CS_INCD + 50176, CTL_CS_UG1 = CTL_BS_INCD + 50176, CTL_BS_UG1 = CTL_CS_UG1 + 88064;
static_assert(CTL_BS_UG1 + 88064 <= CTL_ZERO_BYTES && CTL_STATS + 3 * (size_t)M * 8 <= CTL_CS_UG0, "CTL map");

constexpr int RING_BYTES = 131072;
constexpr int MISC_OFF = RING_BYTES + 320;
constexpr int LDS_BYTES = 147456;

#define LDS_WAIT() asm volatile("s_waitcnt lgkmcnt(0)" ::: "memory")
#define VM_WAIT() asm volatile("s_waitcnt vmcnt(0)" ::: "memory")
#define SBAR() __builtin_amdgcn_sched_barrier(0)
#define WG_BAR() do { asm volatile("" ::: "memory"); __builtin_amdgcn_s_barrier(); asm volatile("" ::: "memory"); } while (0)

__device__ __forceinline__ unsigned cvtpk(float lo, float hi) { unsigned r; asm volatile("v_cvt_pk_bf16_f32 %0, %1, %2" : "=v"(r) : "v"(lo), "v"(hi)); return r; }
__device__ __forceinline__ float bf_lo(unsigned w) { return __uint_as_float(w << 16); }
__device__ __forceinline__ float bf_hi(unsigned w) { return __uint_as_float(w & 0xffff0000u); }
__device__ __forceinline__ float wave_sum(float v) {
#pragma unroll
    for (int o = 1; o < 64; o <<= 1) v += __shfl_xor(v, o);
    return v;
}
__device__ __forceinline__ float silu_f(float y) { return y * __builtin_amdgcn_rcpf(1.0f + __builtin_amdgcn_exp2f(-1.4426950408889634f * y)); }

struct Args { const float* in[16]; float* out; unsigned char* ws; };
static_assert(sizeof(Args) == 18 * 8, "Args has no padding");
__device__ __forceinline__ const GAS float* ldin(const Args& a, int i) { asm volatile("" : "+s"(i)); return (const GAS float*)a.in[i]; }
__device__ __forceinline__ int opq_i(int v) { asm volatile("" : "+s"(v)); return v; }
__device__ __forceinline__ unsigned char* opq_p(unsigned char* p) { asm volatile("" : "+s"(p)); return p; }

namespace pg8 {
typedef unsigned short bf16_t;
constexpr int BM = 256, BK = 64, HALF = 128, HTB = HALF * BK * 2, STAGE_BYTES = 8 * HTB, NXCD = 8, WGM = 8;
__host__ __device__ __forceinline__ int lds_byte(int r, int c) { const int st = (r >> 4) * 2 + (c >> 5), rr = r & 15, cc = c & 31, ob = rr * 64 + cc * 2; return st * 1024 + (ob ^ (((ob >> 9) & 1) << 5)); }
__host__ __device__ __forceinline__ void stage_rc(int b, int& R, int& C) { const int st = b / 1024, sb = b % 1024, swz = sb ^ (((sb >> 9) & 1) << 5); R = (st >> 1) * 16 + swz / 64; C = (st & 1) * 32 + (swz % 64) / 2; }
__host__ __device__ __forceinline__ int perm32(int rho) { const int n = rho >> 4, i = rho & 15; return 8 * (i >> 2) + 4 * n + (i & 3); }
struct Unit { int pm, pn; };
struct Gemm { const bf16_t* A; const bf16_t* Bt; int M, N, K; };
struct StaticOrder {
    int nM, nN, nwg, G, c;
    __host__ __device__ void init(int M_, int N_, int G_, int c_) { nM = M_ / BM; nN = N_ / BM; nwg = nM * nN; G = G_; c = c_; }
    __host__ __device__ bool next(int i, Unit& u) const {
        const long L = (long)i * G + c; if (L >= nwg) return false;
        int wgid = (int)L; { const int q = nwg / NXCD, r = nwg % NXCD, xcd = wgid % NXCD, off = wgid / NXCD; wgid = (xcd < r ? xcd * (q + 1) : r * (q + 1) + (xcd - r) * q) + off; }
        const int nig = WGM * nN, gid = wgid / nig, fm = gid * WGM, gsz = (nM - fm) < WGM ? (nM - fm) : WGM;
        u.pm = fm + ((wgid % nig) % gsz); u.pn = (wgid % nig) / gsz; return true;
    }
    __device__ __forceinline__ void a_ready(const Unit&) const {}
    __device__ __forceinline__ void done(const Unit&) const {}
};
struct EpiBf16 {
    static constexpr bool PERM = true, AFTER_DRAIN = false;
    unsigned char* W; int L;
    __device__ __forceinline__ void operator()(const f32x4 (&acc)[2][2][4][2], const Unit& u, int wr_, int wc_, int fr_, int fq_) const {
        int tid_ = threadIdx.x; asm volatile("" : "+v"(tid_));
        GAS unsigned char* const Wg = (GAS unsigned char*)W;
        GAS bf16_t* const O = (GAS bf16_t*)(Wg + WS_QKV); constexpr int ldc = N_AB, split_cols = 0; constexpr size_t split_stride = 0; GAS float* const gates = (GAS float*)(Wg + WS_GATES); const int gate_pn = L == 0 ? -1 : 48;
        const GAS float* const st = L == 0 ? nullptr : (const GAS float*)(Wg + WS_CTL + CTL_STATS) + (size_t)1 * M * 2;
        const GAS float* const cs = (const GAS float*)(Wg + WS_CTL + CTL_CS_INCD); const GAS float* const bs = (const GAS float*)(Wg + WS_CTL + CTL_BS_INCD);
        const int wid = __builtin_amdgcn_readfirstlane(tid_ >> 6), wr = wid >> 2, wc = wid & 3, fr = tid_ & 15, fq = (tid_ & 63) >> 4;
        const int row0 = u.pm * BM + wr * 64 + fr;
        const int colg = u.pn * BM + wc * 32 + 8 * fq;
        f32x4 csv[2][2], bsv[2][2];
        if (st) {
#pragma unroll
            for (int bj = 0; bj < 2; ++bj)
#pragma unroll
                for (int n = 0; n < 2; ++n) { csv[bj][n] = *(const f32x4*)(cs + colg + bj * HALF + 4 * n); bsv[bj][n] = *(const f32x4*)(bs + colg + bj * HALF + 4 * n); }
        }
        int colt = u.pn * BM; GAS bf16_t* base = O;
        if (split_cols) { const int t = colt / split_cols; base += (size_t)t * split_stride; colt -= t * split_cols; }
        const int col0 = colt + wc * 32 + 8 * fq;
        const GAS float* stp = st + (size_t)row0 * 2;
#pragma unroll
        for (int ai = 0; ai < 2; ++ai)
#pragma unroll
            for (int m = 0; m < 4; ++m) { const int row = row0 + ai * HALF + m * 16;
                float mu = 0.f, rs = 1.f;
                if (st) { const f32x2 sv = *(const f32x2*)(stp + (ai * HALF + m * 16) * 2); mu = sv[0] * (1.f / DM); rs = __builtin_amdgcn_rsqf(sv[1] * (1.f / DM) - mu * mu + LN_EPS); }
                f32x4 v[2][2];
#pragma unroll
                for (int bj = 0; bj < 2; ++bj)
#pragma unroll
                    for (int n = 0; n < 2; ++n) v[bj][n] = st ? (acc[ai][bj][m][n] - csv[bj][n] * mu) * rs + bsv[bj][n] : acc[ai][bj][m][n];
                if (u.pn == gate_pn) { if (wc == 0 && fq < 2) { GAS float* gp = gates + (size_t)row * 16 + 8 * fq; *(GAS f32x4*)gp = v[0][0]; *(GAS f32x4*)(gp + 4) = v[0][1]; } }
                else { GAS bf16_t* rowp = base + (size_t)row * ldc + col0;
#pragma unroll
                    for (int bj = 0; bj < 2; ++bj) { u32x4 w; w.x = cvtpk(v[bj][0][0], v[bj][0][1]); w.y = cvtpk(v[bj][0][2], v[bj][0][3]); w.z = cvtpk(v[bj][1][0], v[bj][1][1]); w.w = cvtpk(v[bj][1][2], v[bj][1][3]);
                        *(u32x4*)(rowp + bj * HALF) = w; } } }
    }
};
struct EpiResid {
    static constexpr bool PERM = true, AFTER_DRAIN = false;
    const Args* ap; unsigned char* W; int L, which; LAS unsigned char* lds;
    __device__ __forceinline__ void operator()(const f32x4 (&acc)[2][2][4][2], const Unit& u, int wr_, int wc_, int fr_, int fq_) const {
        int tid_ = threadIdx.x; asm volatile("" : "+v"(tid_));
        const int wid = __builtin_amdgcn_readfirstlane(tid_ >> 6), wr = wid >> 2, wc = wid & 3, lane = tid_ & 63, fr = tid_ & 15, fq = (tid_ & 63) >> 4;
        GAS unsigned char* const Wg = (GAS unsigned char*)W; GAS float* const STATS = (GAS float*)(Wg + WS_CTL + CTL_STATS);
        const bool lastsub = (which == 1 && L == 1);
        const GAS bf16_t* const zbin = (const GAS bf16_t*)(Wg + WS_XB); GAS bf16_t* const zb = lastsub ? nullptr : (GAS bf16_t*)(Wg + WS_XB); GAS float* const out32 = lastsub ? (GAS float*)ap->out : nullptr;
        const GAS float* const st_in = which == 0 ? (L == 0 ? nullptr : STATS + (size_t)1 * M * 2) : STATS + (size_t)(L == 0 ? 0 : 2) * M * 2;
        GAS float* const st_out = which == 0 ? STATS + (size_t)(L == 0 ? 0 : 2) * M * 2 : (L == 0 ? STATS + (size_t)1 * M * 2 : nullptr);
        const int lnoff = which == 0 ? DM : 2 * L * DM;
        const GAS float* const lg = ldin(*ap, 14) + lnoff; const GAS float* const lb = ldin(*ap, 15) + lnoff;
        constexpr float alpha = ALPHA; LAS float* const red = (LAS float*)(lds + RING_BYTES + 1024);
        constexpr int ldc = DM;
        const int row0 = u.pm * BM + wr * 64 + fr, col0 = u.pn * BM + wc * 32 + 8 * fq;
        LAS float* myred = red + wid * 256;
#pragma unroll
        for (int ai = 0; ai < 2; ++ai) { u32x4 xr[4][2]; f32x2 sv[4]; f32x4 s1 = {0.f, 0.f, 0.f, 0.f}, s2 = {0.f, 0.f, 0.f, 0.f};
#pragma unroll
            for (int m = 0; m < 4; ++m) { const size_t off = (size_t)(row0 + ai * HALF + m * 16) * ldc + col0;
                xr[m][0] = *(const GAS u32x4*)(zbin + off); xr[m][1] = *(const GAS u32x4*)(zbin + off + HALF); sv[m] = st_in ? *(const GAS f32x2*)(st_in + (size_t)row0 * 2 + (ai * HALF + m * 16) * 2) : (f32x2){0.f, 0.f}; }
#pragma unroll
            for (int bj = 0; bj < 2; ++bj) {
                f32x4 gv[2], bv[2];
#pragma unroll
                for (int n = 0; n < 2; ++n) { gv[n] = st_in ? *(const GAS f32x4*)(lg + col0 + bj * HALF + 4 * n) : (f32x4){1.f, 1.f, 1.f, 1.f}; bv[n] = st_in ? *(const GAS f32x4*)(lb + col0 + bj * HALF + 4 * n) : (f32x4){0.f, 0.f, 0.f, 0.f}; }
#pragma unroll
                for (int m = 0; m < 4; ++m) { const float mu = sv[m][0] * (1.f / DM), rs = st_in ? __builtin_amdgcn_rsqf(sv[m][1] * (1.f / DM) - mu * mu + LN_EPS) : 1.f;
                    const u32x4 r = xr[m][bj]; const size_t off = (size_t)(row0 + ai * HALF + m * 16) * ldc + col0 + bj * HALF;
                    const f32x4 z0 = (((f32x4){bf_lo(r.x), bf_hi(r.x), bf_lo(r.y), bf_hi(r.y)} - mu) * rs * gv[0] + bv[0]) * alpha + acc[ai][bj][m][0];
                    const f32x4 z1 = (((f32x4){bf_lo(r.z), bf_hi(r.z), bf_lo(r.w), bf_hi(r.w)} - mu) * rs * gv[1] + bv[1]) * alpha + acc[ai][bj][m][1];
                    if (out32) { *(GAS f32x4*)(out32 + off) = z0; *(GAS f32x4*)(out32 + off + 4) = z1; }
                    if (zb) { u32x4 w; w.x = cvtpk(z0[0], z0[1]); w.y = cvtpk(z0[2], z0[3]); w.z = cvtpk(z1[0], z1[1]); w.w = cvtpk(z1[2], z1[3]); *(GAS u32x4*)(zb + off) = w; }
                    s1[m] += (z0[0] + z0[1]) + (z0[2] + z0[3]) + (z1[0] + z1[1]) + (z1[2] + z1[3]);
                    s2[m] += (z0[0] * z0[0] + z0[1] * z0[1]) + (z0[2] * z0[2] + z0[3] * z0[3]) + (z1[0] * z1[0] + z1[1] * z1[1]) + (z1[2] * z1[2] + z1[3] * z1[3]); }
            }
            if (st_out) {
#pragma unroll
                for (int m = 0; m < 4; ++m) { float a1 = s1[m], a2 = s2[m]; a1 += __shfl_xor(a1, 16); a1 += __shfl_xor(a1, 32); a2 += __shfl_xor(a2, 16); a2 += __shfl_xor(a2, 32);
                    if (fq == 0) *(LAS f32x2*)(myred + ((ai * 4 + m) * 16 + fr) * 2) = (f32x2){a1, a2}; } }
            asm volatile("" ::: "memory"); }
        if (st_out) {
            asm volatile("s_waitcnt lgkmcnt(0)" ::: "memory");
            GAS float* sp = st_out + (size_t)(u.pm * BM + wr * 64) * 2;
#pragma unroll
            for (int j = 0; j < 4; ++j) { const int idx = j * 64 + lane, g = idx >> 5, r = (idx & 31) >> 1, c = idx & 1;
                unsafeAtomicAdd((float*)(sp + ((g >> 2) * HALF + (g & 3) * 16 + r) * 2 + c), myred[idx]); }
            asm volatile("s_waitcnt lgkmcnt(0)" ::: "memory");
        }
    }
};

__device__ __forceinline__ float dpp_ror1(float x) { return __int_as_float(__builtin_amdgcn_update_dpp(0, __float_as_int(x), 0x121, 0xF, 0xF, false)); }
__device__ __forceinline__ float dpp_ror2(float x) { return __int_as_float(__builtin_amdgcn_update_dpp(0, __float_as_int(x), 0x122, 0xF, 0xF, false)); }
struct EpiFfnAct {
    static constexpr bool PERM = true, AFTER_DRAIN = false;
    const Args* ap; unsigned char* W; int L; LAS unsigned char* lds;
    __device__ __forceinline__ void operator()(f32x4 (&acc)[2][2][4][2], const Unit& u, int wr_, int wc_, int fr_, int fq_) const {
        int tid_ = threadIdx.x; asm volatile("" : "+v"(tid_));
        GAS unsigned char* const Wg = (GAS unsigned char*)W;
        GAS bf16_t* const H = (GAS bf16_t*)(Wg + WS_U); const GAS float* const cw = ldin(*ap, 11) + (size_t)L * 3 * DFF; const GAS float* const cb = ldin(*ap, 12) + (size_t)L * DFF;
        GAS float* const EG0 = (GAS float*)(Wg + WS_G); GAS float* const EU0 = (GAS float*)(Wg + WS_G + 8 * MiB); GAS float* const EGL = (GAS float*)(Wg + WS_G + 16 * MiB); LAS float* const edge = (LAS float*)(lds + RING_BYTES + 1024);
        const GAS float* const st = (const GAS float*)(Wg + WS_CTL + CTL_STATS) + (size_t)(L == 0 ? 0 : 2) * M * 2;
        const GAS float* const cs = (const GAS float*)(Wg + WS_CTL + (L == 0 ? CTL_CS_UG0 : CTL_CS_UG1)); const GAS float* const bs = (const GAS float*)(Wg + WS_CTL + (L == 0 ? CTL_BS_UG0 : CTL_BS_UG1));
        const int wid = __builtin_amdgcn_readfirstlane(tid_ >> 6), wr = wid >> 2, wc = wid & 3, fr = tid_ & 15, fq = (tid_ & 63) >> 4;
        const int ch0 = u.pn * 128 + wc * 32 + fq * 8, row0 = u.pm * BM + wr * 64 + fr, colg = u.pn * BM + wc * 32 + 8 * fq;
        const GAS float* stp = st + (size_t)row0 * 2;
        f32x2 sv[2][4]; f32x4 csg[2], bsg[2];
#pragma unroll
        for (int ai = 0; ai < 2; ++ai)
#pragma unroll
            for (int m = 0; m < 4; ++m) sv[ai][m] = *(const f32x2*)(stp + (ai * HALF + m * 16) * 2);
#pragma unroll
        for (int n = 0; n < 2; ++n) { csg[n] = *(const f32x4*)(cs + colg + HALF + 4 * n); bsg[n] = *(const f32x4*)(bs + colg + HALF + 4 * n); }
        float mu[2][4], rs[2][4];
#pragma unroll
        for (int ai = 0; ai < 2; ++ai)
#pragma unroll
            for (int m = 0; m < 4; ++m) { mu[ai][m] = sv[ai][m][0] * (1.f / DM); rs[ai][m] = __builtin_amdgcn_rsqf(sv[ai][m][1] * (1.f / DM) - mu[ai][m] * mu[ai][m] + LN_EPS);
#pragma unroll
                for (int n = 0; n < 2; ++n) acc[ai][1][m][n] = (acc[ai][1][m][n] - csg[n] * mu[ai][m]) * rs[ai][m] + bsg[n];
                asm volatile("" : "+v"(acc[ai][1][m][0]), "+v"(acc[ai][1][m][1])); }
        asm volatile("" ::: "memory");
        f32x4 csu[2], bsu[2], wt[4][2];
#pragma unroll
        for (int n = 0; n < 2; ++n) { csu[n] = *(const f32x4*)(cs + colg + 4 * n); bsu[n] = *(const f32x4*)(bs + colg + 4 * n);
            wt[0][n] = *(const f32x4*)(cw + ch0 + 4 * n); wt[1][n] = *(const f32x4*)(cw + DFF + ch0 + 4 * n); wt[2][n] = *(const f32x4*)(cw + 2 * DFF + ch0 + 4 * n); wt[3][n] = *(const f32x4*)(cb + ch0 + 4 * n); }
#define FFN_G(ai, m, n) (acc[ai][1][m][n])
#define FFN_U(ai, m, n) ((acc[ai][0][m][n] - csu[n] * mu[ai][m]) * rs[ai][m] + bsu[n])
        if (fr >= 14) {
#pragma unroll
            for (int ai = 0; ai < 2; ++ai) { LAS float* e = edge + ((((ai * 2 + wr) * 4 + wc) * 4 + fq) * 2 + (fr - 14)) * 8; *(LAS f32x4*)e = FFN_G(ai, 3, 0); *(LAS f32x4*)(e + 4) = FFN_G(ai, 3, 1); }
            if (wr == 1) { GAS float* p = EGL + (size_t)(u.pm * 2 + (fr - 14)) * DFF + ch0; *(GAS f32x4*)p = FFN_G(1, 3, 0); *(GAS f32x4*)(p + 4) = FFN_G(1, 3, 1); }
        }
        if (wr == 0 && fr < 2) { GAS float* pg = EG0 + (size_t)(u.pm * 2 + fr) * DFF + ch0; GAS float* pu = EU0 + (size_t)(u.pm * 2 + fr) * DFF + ch0;
            *(GAS f32x4*)pg = FFN_G(0, 0, 0); *(GAS f32x4*)(pg + 4) = FFN_G(0, 0, 1); *(GAS f32x4*)pu = FFN_U(0, 0, 0); *(GAS f32x4*)(pu + 4) = FFN_U(0, 0, 1); }
        asm volatile("s_waitcnt lgkmcnt(0)" ::: "memory"); __builtin_amdgcn_s_barrier(); asm volatile("" ::: "memory");
#pragma unroll
        for (int ai = 0; ai < 2; ++ai) {
            f32x4 e14[2] = {(f32x4){0.f, 0.f, 0.f, 0.f}, (f32x4){0.f, 0.f, 0.f, 0.f}}, e15[2] = {(f32x4){0.f, 0.f, 0.f, 0.f}, (f32x4){0.f, 0.f, 0.f, 0.f}};
            if (wr == 1 || ai == 1) { const int sa = (wr == 1) ? ai : 0, sw = (wr == 1) ? 0 : 1; const LAS float* e = edge + (((sa * 2 + sw) * 4 + wc) * 4 + fq) * 16;
                e14[0] = *(const LAS f32x4*)e; e14[1] = *(const LAS f32x4*)(e + 4); e15[0] = *(const LAS f32x4*)(e + 8); e15[1] = *(const LAS f32x4*)(e + 12); }
#pragma unroll
            for (int m = 0; m < 4; ++m) {
                float hv[8];
#pragma unroll
                for (int n = 0; n < 2; ++n) { const f32x4 uu = FFN_U(ai, m, n);
#pragma unroll
                    for (int j = 0; j < 4; ++j) { const int c = 4 * n + j; const float gc = acc[ai][1][m][n][j]; const float r1 = dpp_ror1(gc), r2 = dpp_ror2(gc);
                        float q1, q2;
                        if (m == 0) { q1 = e15[n][j]; q2 = (fr == 0) ? e14[n][j] : e15[n][j]; }
                        else { const float gpv = acc[ai][1][m > 0 ? m - 1 : 0][n][j]; q1 = dpp_ror1(gpv); q2 = dpp_ror2(gpv); }
                        const float p1 = (fr == 0) ? q1 : r1, p2 = (fr < 2) ? q2 : r2;
                        const float y = wt[0][n][j] * p2 + wt[1][n][j] * p1 + wt[2][n][j] * gc + wt[3][n][j];
                        hv[c] = silu_f(y) * uu[j]; } }
                if (!(ai == 0 && m == 0 && wr == 0 && fr < 2)) { u32x4 w; w.x = cvtpk(hv[0], hv[1]); w.y = cvtpk(hv[2], hv[3]); w.z = cvtpk(hv[4], hv[5]); w.w = cvtpk(hv[6], hv[7]);
                    *(u32x4*)(H + (size_t)(row0 + ai * HALF + m * 16) * DFF + ch0) = w; }
            }
        }
#undef FFN_G
#undef FFN_U
    }
};

template <class Epi, class Sched, bool ALIGN_EPI = false, bool SP2 = false>
__device__ __forceinline__ void gemm_phase(LAS unsigned char* lds, const Gemm g, const Sched& S, const Epi& E) {
    int tid_ = threadIdx.x; asm volatile("" : "+v"(tid_));
    const int tid = tid_, wid = __builtin_amdgcn_readfirstlane(tid >> 6), lane = tid & 63, wr = wid >> 2, wc = wid & 3, fr = lane & 15, fq = lane >> 4;
    const int K = g.K, nt = K / BK;
    unsigned voffA[2], voffB[2];
#pragma unroll
    for (int i = 0; i < 2; ++i) { int R, C; stage_rc(tid * 16 + i * 8192, R, C); const int Rb = Epi::PERM ? ((R & ~31) + perm32(R & 31)) : R;
        voffA[i] = (unsigned)(R * K + C) * 2u; voffB[i] = (unsigned)(Rb * K + C) * 2u; }
    const size_t kstep = (size_t)(BK * 2);
    const size_t hstep = (size_t)HALF * K * 2;
    const size_t tstep = 2 * hstep;
    const unsigned ldsw = (unsigned)wid * 1024u;
    const int aoff = lds_byte(wr * 64 + fr, fq * 8), boff = lds_byte(wc * 32 + fr, fq * 8);
#define PG8_SA(b, h) (((b) * 2 + (h)) * HTB)
#define PG8_SB(b, h) ((4 + (b) * 2 + (h)) * HTB)
#define PG8_STAGE(bufoff, gbase, voff) do { _Pragma("unroll") for (int _i = 0; _i < 2; ++_i) \
        __builtin_amdgcn_global_load_lds((const unsigned*)((const char*)(gbase) + (voff)[_i]), (LAS unsigned*)(lds + (bufoff) + ldsw + _i * 8192), 16, 0, 0); } while (0)
#define PG8_LDA(dst, b, h) do { _Pragma("unroll") for (int m = 0; m < 4; ++m) _Pragma("unroll") for (int k = 0; k < 2; ++k) dst[m][k] = *(const LAS bf16x8*)(lds + PG8_SA(b, h) + aoff + m * 2048 + k * 1024); } while (0)
#define PG8_LDB(dst, b, h) do { _Pragma("unroll") for (int n = 0; n < 2; ++n) _Pragma("unroll") for (int k = 0; k < 2; ++k) dst[n][k] = *(const LAS bf16x8*)(lds + PG8_SB(b, h) + boff + n * 2048 + k * 1024); } while (0)
#define PG8_MMA(ai, bj, At, Bt) do { __builtin_amdgcn_s_setprio(1); _Pragma("unroll") for (int m = 0; m < 4; ++m) _Pragma("unroll") for (int n = 0; n < 2; ++n) _Pragma("unroll") for (int k = 0; k < 2; ++k) \
        acc[ai][bj][m][n] = __builtin_amdgcn_mfma_f32_16x16x32_bf16(Bt[n][k], At[m][k], acc[ai][bj][m][n], 0, 0, 0); __builtin_amdgcn_s_setprio(0); } while (0)
#define PG8_WAIT_V(n) asm volatile("s_waitcnt vmcnt(" #n ")" ::: "memory")
#define PG8_WAIT_L(n) asm volatile("s_waitcnt lgkmcnt(" #n ")" ::: "memory")
#define PG8_BAR __builtin_amdgcn_s_barrier()
#define PG8_SCHED __builtin_amdgcn_sched_barrier(0)
    Unit cur, nxt; int ui = 0;
    if (!S.next(0, cur)) return;
    f32x4 acc[2][2][4][2];
#pragma unroll
    for (int a = 0; a < 2; ++a)
#pragma unroll
        for (int b = 0; b < 2; ++b)
#pragma unroll
            for (int m = 0; m < 4; ++m)
#pragma unroll
                for (int n = 0; n < 2; ++n) acc[a][b][m][n] = (f32x4){0.f, 0.f, 0.f, 0.f};
    bf16x8 At[4][2], B0[2][2], B1[2][2];
    const char* cA = (const char*)g.A + (size_t)cur.pm * tstep; const char* cB = (const char*)g.Bt + (size_t)cur.pn * tstep;
    S.a_ready(cur);
    if constexpr (SP2) {
        PG8_STAGE(PG8_SB(0, 0), cB, voffB); PG8_STAGE(PG8_SB(0, 1), cB + hstep, voffB); PG8_STAGE(PG8_SA(0, 0), cA, voffA); PG8_STAGE(PG8_SA(0, 1), cA + hstep, voffA);
        if (wr == 1) PG8_BAR;
        PG8_WAIT_V(2); PG8_BAR;
        PG8_STAGE(PG8_SB(1, 0), cB + kstep, voffB); PG8_STAGE(PG8_SA(1, 0), cA + kstep, voffA); PG8_STAGE(PG8_SB(1, 1), cB + hstep + kstep, voffB);
        PG8_WAIT_V(6); PG8_BAR;
    } else {
        PG8_STAGE(PG8_SB(0, 0), cB, voffB); PG8_STAGE(PG8_SA(0, 0), cA, voffA); PG8_STAGE(PG8_SB(0, 1), cB + hstep, voffB); PG8_STAGE(PG8_SA(0, 1), cA + hstep, voffA);
        if (wr == 1) PG8_BAR;
        PG8_WAIT_V(4); PG8_BAR;
        PG8_STAGE(PG8_SB(1, 0), cB + kstep, voffB); PG8_STAGE(PG8_SA(1, 0), cA + kstep, voffA); PG8_STAGE(PG8_SB(1, 1), cB + hstep + kstep, voffB);
        PG8_WAIT_V(6); PG8_BAR;
    }
    for (;;) {
        const bool has_next = S.next(ui + 1, nxt);
        const char* nA = has_next ? (const char*)g.A + (size_t)nxt.pm * tstep : cA; const char* nB = has_next ? (const char*)g.Bt + (size_t)nxt.pn * tstep : cB;
        for (int t = 0; t < nt; t += 2) {
            const bool last = (t == nt - 2);
            const char* a1 = cA + (size_t)(t + 1) * kstep;
            const char* a2 = last ? nA : cA + (size_t)(t + 2) * kstep; const char* b2 = last ? nB : cB + (size_t)(t + 2) * kstep;
            const char* a3 = a2 + kstep; const char* b3 = b2 + kstep;
            if (last && has_next) S.a_ready(nxt);
            if constexpr (SP2) {
            PG8_LDB(B0, 0, 0); PG8_LDB(B1, 0, 1); PG8_SCHED; PG8_LDA(At, 0, 0); PG8_STAGE(PG8_SA(1, 1), a1 + hstep, voffA);
            PG8_WAIT_V(8); PG8_WAIT_L(0); PG8_BAR; PG8_MMA(0, 0, At, B0); PG8_MMA(0, 1, At, B1); PG8_BAR; PG8_SCHED;
            PG8_LDA(At, 0, 1); PG8_STAGE(PG8_SB(0, 0), b2, voffB); PG8_STAGE(PG8_SB(0, 1), b2 + hstep, voffB); PG8_STAGE(PG8_SA(0, 0), a2, voffA);
            PG8_WAIT_V(8); PG8_WAIT_L(0); PG8_BAR; PG8_MMA(1, 0, At, B0); PG8_MMA(1, 1, At, B1); PG8_BAR; PG8_SCHED;
            PG8_LDB(B0, 1, 0); PG8_LDB(B1, 1, 1); PG8_SCHED; PG8_LDA(At, 1, 0); PG8_STAGE(PG8_SA(0, 1), a2 + hstep, voffA);
            PG8_WAIT_V(8); PG8_WAIT_L(0); PG8_BAR; PG8_MMA(0, 0, At, B0); PG8_MMA(0, 1, At, B1); PG8_BAR; PG8_SCHED;
            PG8_LDA(At, 1, 1); PG8_STAGE(PG8_SB(1, 0), b3, voffB); PG8_STAGE(PG8_SB(1, 1), b3 + hstep, voffB); PG8_STAGE(PG8_SA(1, 0), a3, voffA);
            PG8_WAIT_V(8); PG8_WAIT_L(0); PG8_BAR; PG8_MMA(1, 0, At, B0); PG8_MMA(1, 1, At, B1); PG8_BAR; PG8_SCHED;
            } else {
            PG8_LDB(B0, 0, 0); PG8_SCHED; PG8_LDA(At, 0, 0); PG8_STAGE(PG8_SA(1, 1), a1 + hstep, voffA);
            PG8_WAIT_L(8); PG8_BAR; PG8_WAIT_L(0); PG8_MMA(0, 0, At, B0); PG8_BAR; PG8_SCHED;
            PG8_LDB(B1, 0, 1); PG8_STAGE(PG8_SB(0, 0), b2, voffB);
            PG8_BAR; PG8_WAIT_L(0); PG8_MMA(0, 1, At, B1); PG8_BAR;
            PG8_LDA(At, 0, 1); PG8_STAGE(PG8_SA(0, 0), a2, voffA);
            PG8_BAR; PG8_WAIT_L(0); PG8_MMA(1, 0, At, B0); PG8_BAR; PG8_SCHED;
            PG8_STAGE(PG8_SB(0, 1), b2 + hstep, voffB);
            PG8_WAIT_V(6); PG8_BAR; PG8_MMA(1, 1, At, B1); PG8_BAR;
            PG8_LDB(B0, 1, 0); PG8_SCHED; PG8_LDA(At, 1, 0); PG8_STAGE(PG8_SA(0, 1), a2 + hstep, voffA);
            PG8_WAIT_L(8); PG8_BAR; PG8_WAIT_L(0); PG8_MMA(0, 0, At, B0); PG8_BAR; PG8_SCHED;
            PG8_LDB(B1, 1, 1); PG8_STAGE(PG8_SB(1, 0), b3, voffB);
            PG8_BAR; PG8_WAIT_L(0); PG8_MMA(0, 1, At, B1); PG8_BAR;
            PG8_LDA(At, 1, 1); PG8_STAGE(PG8_SA(1, 0), a3, voffA);
            PG8_BAR; PG8_WAIT_L(0); PG8_MMA(1, 0, At, B0); PG8_BAR; PG8_SCHED;
            PG8_STAGE(PG8_SB(1, 1), b3 + hstep, voffB);
            PG8_WAIT_V(6); PG8_BAR; PG8_MMA(1, 1, At, B1); PG8_BAR;
            }
        }
        if constexpr (ALIGN_EPI) { if (wr == 0) PG8_BAR; }
        if constexpr (!Epi::AFTER_DRAIN) { E(acc, cur, wr, wc, fr, fq); S.done(cur); }
        if (!has_next) break;
#pragma unroll
        for (int a = 0; a < 2; ++a)
#pragma unroll
            for (int b = 0; b < 2; ++b)
#pragma unroll
                for (int m = 0; m < 4; ++m)
#pragma unroll
                    for (int n = 0; n < 2; ++n) acc[a][b][m][n] = (f32x4){0.f, 0.f, 0.f, 0.f};
        cur = nxt; cA = nA; cB = nB; ++ui;
        if constexpr (ALIGN_EPI) { if (wr == 1) PG8_BAR; }
    }
    PG8_WAIT_V(0);
    if constexpr (!ALIGN_EPI) { if (wr == 0) PG8_BAR; }
    PG8_BAR;
#undef PG8_SA
#undef PG8_SB
#undef PG8_STAGE
#undef PG8_LDA
#undef PG8_LDB
#undef PG8_MMA
#undef PG8_WAIT_V
#undef PG8_WAIT_L
#undef PG8_BAR
#undef PG8_SCHED
}
}

#define XB_TMO      128
#define XB_XCNT(j)  (256  + 64 * (j))
#define XB_XSUB(j)  (1280 + 64 * (j))
#define XB_XGEN(j)  (2304 + 64 * (j))
#define XB_TOP      3328
#define XB_TOPGEN   3392
#define XCD_BAR_WORDS 3456
#define XB_SPIN_CAP (1u << 18)
__device__ __forceinline__ unsigned xb_ld(unsigned* p)              { return __hip_atomic_load((GAS unsigned*)p, __ATOMIC_RELAXED, __HIP_MEMORY_SCOPE_AGENT); }
__device__ __forceinline__ unsigned xb_add(unsigned* p, unsigned v) { return __hip_atomic_fetch_add((GAS unsigned*)p, v, __ATOMIC_RELAXED, __HIP_MEMORY_SCOPE_AGENT); }
__device__ __forceinline__ unsigned xb_xcc_id() { return (unsigned)__builtin_amdgcn_s_getreg((3 << 11) | 20) & 0xFu; }
#define XB_SPIN(cond, bar) do { unsigned _sp = 0; while (cond) { __builtin_amdgcn_s_sleep(1); \
    if ((++_sp & 255u) == 0u) { if (xb_ld(&(bar)[XB_TMO])) break; if (_sp > XB_SPIN_CAP) { (void)xb_add(&(bar)[XB_TMO], 1u); break; } } } } while (0)
struct XcdBarrier { unsigned* bar; unsigned x; volatile LAS unsigned* st; };
__device__ __forceinline__ XcdBarrier xcd_barrier_post(unsigned* bar, volatile LAS unsigned* st) {
    XcdBarrier b; b.bar = bar; b.x = xb_xcc_id(); b.st = st;
    if (threadIdx.x == 0) (void)xb_add(&bar[XB_XCNT(b.x)], 1u);
    return b;
}
__device__ __forceinline__ void xcd_barrier_complete(unsigned* bar, unsigned x, unsigned& nloc, unsigned& nx) {
    const unsigned G = gridDim.x * gridDim.y * gridDim.z;
    unsigned sum, cnt, mine, sp = 0u;
    for (;;) {
        sum = 0u; cnt = 0u; mine = 0u;
#pragma unroll
        for (unsigned j = 0; j < 16; ++j) { const unsigned c = xb_ld(&bar[XB_XCNT(j)]); sum += c; cnt += (c > 0u) ? 1u : 0u; mine = (j == x) ? c : mine; }
        if (sum == G) break;
        __builtin_amdgcn_s_sleep(1);
        if ((++sp & 255u) == 0u) { if (xb_ld(&bar[XB_TMO])) break; if (sp > XB_SPIN_CAP) { (void)xb_add(&bar[XB_TMO], 1u); break; } }
    }
    nloc = mine > 0u ? mine : 1u; nx = cnt > 0u ? cnt : 1u;
}
__device__ __forceinline__ void xcd_barrier(const XcdBarrier& b) {
    asm volatile("s_waitcnt vmcnt(0)" ::: "memory");
    __syncthreads();
    if (threadIdx.x == 0) {
        unsigned* bar = b.bar; unsigned bx = b.x;
        asm volatile("" : "+s"(bar), "+s"(bx));
        __builtin_amdgcn_s_waitcnt(0);
        unsigned nloc = b.st[0], nx = b.st[1];
        if (nloc == 0u) { xcd_barrier_complete(bar, bx, nloc, nx); b.st[0] = nloc; b.st[1] = nx; }
        const unsigned old = xb_add(&bar[XB_XSUB(bx)], 1u);
        const unsigned gen = old / nloc;
        if (old + 1u == (gen + 1u) * nloc) {
            __builtin_amdgcn_fence(__ATOMIC_RELEASE, "agent");
            asm volatile("s_waitcnt vmcnt(0)" ::: "memory");
            const unsigned og = xb_add(&bar[XB_TOP], 1u);
            const unsigned tg = og / nx;
            if (og + 1u == (tg + 1u) * nx) xb_add(&bar[XB_TOPGEN], 1u);
            else XB_SPIN(xb_ld(&bar[XB_TOPGEN]) == tg, bar);
            __builtin_amdgcn_fence(__ATOMIC_ACQUIRE, "agent");
            xb_add(&bar[XB_XGEN(bx)], 1u);
            asm volatile("s_waitcnt vmcnt(0)" ::: "memory");
        } else {
            XB_SPIN(xb_ld(&bar[XB_XGEN(bx)]) == gen, bar);
            __builtin_amdgcn_fence(__ATOMIC_ACQUIRE, "agent");
            asm volatile("s_waitcnt vmcnt(0)" ::: "memory");
        }
    }
    __syncthreads();
}

namespace att {
constexpr int D = 128, SHM = 16384;
constexpr int OFF_V = 0, OFF_K = 2 * SHM, OFF_WS = 4 * SHM, OFF_AUX = 4 * SHM + 2048, LDS_USED = 4 * SHM + 2048 + 8192;
constexpr float SCALE = 0.08838834764831845f;
constexpr float C2 = 1.4426950408889634f * SCALE;
constexpr float THR = 8.f;
enum { MODE_DIL = 0, MODE_MOBA = 1, MODE_SB = 2, MODE_ML = 3 };
#define KSWZ(row, colB) ((row) * 256 + ((colB) ^ (((row) & 7) << 4)))
__device__ __forceinline__ int v_st(int k, int c) { const int kk = (k & ~0xC) | ((k & 4) << 1) | ((k & 8) >> 1); return ((kk >> 3) * 4 + (c >> 5)) * 512 + ((kk & 7) * 32 + (c & 31)) * 2; }
__device__ __forceinline__ int v_rd_base(int lane) { return ((lane & 3) << 3) | (((lane >> 2) & 3) << 6) | (((lane >> 4) & 1) << 5) | (((lane >> 5) & 1) << 8); }
__device__ __forceinline__ int crow(int r, int hi) { return (r & 3) + 8 * (r >> 2) + 4 * hi; }
__device__ __forceinline__ void mask_tile(f32x16& p0, f32x16& p1, int dq) {
    const float NEG = -__builtin_inff();
#pragma unroll
    for (int r = 0; r < 16; ++r) {
        const int c = (r & 3) + 8 * (r >> 2);
        if (dq - c < 0) p0[r] = NEG;
        if (dq - c - 32 < 0) p1[r] = NEG;
    }
}
__device__ __forceinline__ void partialSM(f32x16& p0, f32x16& p1, float& m_reg, float& mn, float& alpha) {
    float pmax = p0[0];
#pragma unroll
    for (int r = 1; r < 16; ++r) pmax = fmaxf(pmax, p0[r]);
#pragma unroll
    for (int r = 0; r < 16; ++r) pmax = fmaxf(pmax, p1[r]);
    { auto rr = __builtin_amdgcn_permlane32_swap(__float_as_uint(pmax), __float_as_uint(pmax), false, false);
      pmax = fmaxf(__uint_as_float(rr[0]), __uint_as_float(rr[1])); }
    if (__builtin_expect(__all((pmax - m_reg) * SCALE <= THR), 1)) { mn = m_reg; alpha = 1.f; }
    else { mn = fmaxf(m_reg, pmax); alpha = __builtin_amdgcn_exp2f((m_reg - mn) * C2); m_reg = mn; }
    const float mnL = -mn * C2;
#pragma unroll
    for (int r = 0; r < 16; ++r) p0[r] = fmaf(p0[r], C2, mnL);
#pragma unroll
    for (int r = 0; r < 16; ++r) p1[r] = fmaf(p1[r], C2, mnL);
#pragma unroll
    for (int r = 0; r < 16; ++r) p0[r] = __builtin_amdgcn_exp2f(p0[r]);
#pragma unroll
    for (int r = 0; r < 16; ++r) p1[r] = __builtin_amdgcn_exp2f(p1[r]);
}
#define ATT_PK4(P, B_, OUT) do { unsigned a0 = cvtpk(P[B_+0], P[B_+1]), a1 = cvtpk(P[B_+2], P[B_+3]);                          \
        unsigned b0 = cvtpk(P[B_+4], P[B_+5]), b1 = cvtpk(P[B_+6], P[B_+7]);                                             \
        auto r0 = __builtin_amdgcn_permlane32_swap(a0, b0, false, false); auto r1 = __builtin_amdgcn_permlane32_swap(a1, b1, false, false); \
        u32x4 w = {r0[0], r1[0], r0[1], r1[1]}; OUT = *reinterpret_cast<bf16x8*>(&w); } while (0)
__device__ __forceinline__ void pack_p(const f32x16& p0, const f32x16& p1, bf16x8& pa0, bf16x8& pa1, bf16x8& pa2, bf16x8& pa3) {
    ATT_PK4(p0, 0, pa0); ATT_PK4(p0, 8, pa1); ATT_PK4(p1, 0, pa2); ATT_PK4(p1, 8, pa3);
}
__device__ __forceinline__ float pair_sum(float v) {
    auto rr = __builtin_amdgcn_permlane32_swap(__float_as_uint(v), __float_as_uint(v), false, false);
    return __uint_as_float(rr[0]) + __uint_as_float(rr[1]);
}
__device__ __forceinline__ void qkt(f32x16& p0, f32x16& p1, const LAS char* Kb, int r32, int hi, const bf16x8* qr) {
#pragma unroll
    for (int r = 0; r < 16; ++r) { p0[r] = 0.f; p1[r] = 0.f; }
    const LAS char* kb[4];
#pragma unroll
    for (int dd = 0; dd < 4; ++dd) kb[dd] = Kb + KSWZ(r32, (dd * 16 + hi * 8) * 2);
#pragma unroll
    for (int d0 = 0; d0 < 8; ++d0) { const LAS char* a = kb[d0 & 3] + (d0 >> 2) * 128;
        const bf16x8 b0 = *reinterpret_cast<const LAS bf16x8*>(a);
        const bf16x8 b1 = *reinterpret_cast<const LAS bf16x8*>(a + 32 * 256);
        p0 = __builtin_amdgcn_mfma_f32_32x32x16_bf16(b0, qr[d0], p0, 0, 0, 0);
        p1 = __builtin_amdgcn_mfma_f32_32x32x16_bf16(b1, qr[d0], p1, 0, 0, 0); }
}
__device__ __forceinline__ void pv_tile(f32x16* o, int vb0, bf16x8 pa0, bf16x8 pa1, bf16x8 pa2, bf16x8 pa3) {
#define TRRD(dst, off) asm volatile("ds_read_b64_tr_b16 %0, %1 offset:%2" : "=&v"(dst) : "v"(vb0), "i"(off) : "memory")
#define PV_D0(d0) do { s16x4 l0, l1, l2, l3, h0, h1, h2, h3; constexpr int b_ = (d0) * 512; \
        TRRD(l0, b_); TRRD(h0, b_ + 2048); TRRD(l1, b_ + 4096); TRRD(h1, b_ + 6144); TRRD(l2, b_ + 8192); TRRD(h2, b_ + 10240); TRRD(l3, b_ + 12288); TRRD(h3, b_ + 14336); \
        asm volatile("s_waitcnt lgkmcnt(0)" ::: "memory"); SBAR();   \
        o[d0] = __builtin_amdgcn_mfma_f32_32x32x16_bf16(pa0, (bf16x8){l0[0], l0[1], l0[2], l0[3], h0[0], h0[1], h0[2], h0[3]}, o[d0], 0, 0, 0);   \
        o[d0] = __builtin_amdgcn_mfma_f32_32x32x16_bf16(pa1, (bf16x8){l1[0], l1[1], l1[2], l1[3], h1[0], h1[1], h1[2], h1[3]}, o[d0], 0, 0, 0);   \
        o[d0] = __builtin_amdgcn_mfma_f32_32x32x16_bf16(pa2, (bf16x8){l2[0], l2[1], l2[2], l2[3], h2[0], h2[1], h2[2], h2[3]}, o[d0], 0, 0, 0);   \
        o[d0] = __builtin_amdgcn_mfma_f32_32x32x16_bf16(pa3, (bf16x8){l3[0], l3[1], l3[2], l3[3], h3[0], h3[1], h3[2], h3[3]}, o[d0], 0, 0, 0); } while (0)
    PV_D0(0); PV_D0(1); PV_D0(2); PV_D0(3);
#undef PV_D0
#undef TRRD
}

template <int MODE>
__device__ __forceinline__ void attn_block(const bf16* __restrict__ Qp, int ldq, const bf16* __restrict__ Kp, int ldk, const bf16* __restrict__ Vp, int ldv, bf16* __restrict__ Op, int ldo,
                                           int qb, LAS char* lds, const float* __restrict__ aux0, const float* __restrict__ aux1, const float* __restrict__ aux2) {
    int tid_ = threadIdx.x; asm volatile("" : "+v"(tid_));
    const int tid = tid_, wid = __builtin_amdgcn_readfirstlane(tid >> 6), lane = tid & 63, r32 = lane & 31, hi = lane >> 5;
    const int P0 = qb * 256, qlo = P0 + wid * 32, qpos = qlo + r32;
    const int NT = 4 * qb + 4;
    LAS char* V_lds = lds + OFF_V; LAS char* K_lds = lds + OFF_K;
    LAS float* wsf = (LAS float*)(lds + OFF_WS) + wid * 64; LAS float* li_l = wsf; LAS float* al_l = wsf + 32;
    LAS float* aux = (LAS float*)(lds + OFF_AUX);
    bf16x8 qr[8];
#pragma unroll
    for (int d0 = 0; d0 < 8; ++d0) qr[d0] = *reinterpret_cast<const bf16x8*>(Qp + (size_t)qpos * ldq + d0 * 16 + hi * 8);
    unsigned kso[2], vso[2];
#pragma unroll
    for (int i = 0; i < 2; ++i) { const int pc = 2 * wid + i, krow = pc * 4 + (lane >> 4), kch = (lane & 15) ^ (krow & 7);
        kso[i] = (unsigned)(krow * ldk + kch * 8) * 2u;
        const int kk = wid * 8 + ((lane & 31) >> 2), vk = (kk & ~0xC) | ((kk & 4) << 1) | ((kk & 8) >> 1), vc = (2 * i + (lane >> 5)) * 32 + (lane & 3) * 8;
        vso[i] = (unsigned)(vk * ldv + vc) * 2u; }
    const int vb0 = (int)(unsigned)(size_t)V_lds + v_rd_base(lane);
    float m_reg = -1e30f, l_reg = 0.f, Rsum = 0.f, den = 0.f, M2row = 0.f, nmrow = 1.f; unsigned sel = 0u;
    if constexpr (MODE == MODE_ML) { for (int i = tid; i < P0 + 256; i += 512) aux[i] = aux0[i]; M2row = aux1[qpos]; nmrow = aux2[qpos]; }
    if constexpr (MODE == MODE_MOBA) { for (int i = tid; i < qb * 128; i += 512) aux[i] = aux0[i]; }
#define TJ(i) ((MODE == MODE_SB) ? (NT - 1 - (i)) : (i))
#define SLOAD(kb_, bf) do { const char* kg_ = (const char*)(Kp + (size_t)(kb_) * ldk); const char* vg_ = (const char*)(Vp + (size_t)(kb_) * ldv); \
        _Pragma("unroll") for (int i_ = 0; i_ < 2; ++i_) { \
            __builtin_amdgcn_global_load_lds((const unsigned*)(kg_ + kso[i_]), (LAS unsigned*)(K_lds + (bf) * SHM + (2 * wid + i_) * 1024), 16, 0, 0); \
            __builtin_amdgcn_global_load_lds((const unsigned*)(vg_ + vso[i_]), (LAS unsigned*)(V_lds + (bf) * SHM + (2 * wid + i_) * 1024), 16, 0, 0); } } while (0)
    SLOAD(TJ(0) * 64, 0); VM_WAIT(); LDS_WAIT(); WG_BAR();
    if constexpr (MODE == MODE_MOBA) {
        if (qb <= 3) sel = (1u << qb) - 1u;
        else {
            float g[7];
#pragma unroll
            for (int n = 0; n < 7; ++n) { g[n] = -__builtin_inff();
                if (n < qb) { float s = 0.f;
#pragma unroll
                    for (int d0 = 0; d0 < 8; ++d0) { const LAS f32x4* kp = (const LAS f32x4*)(aux + n * 128 + d0 * 16 + hi * 8); const f32x4 k0 = kp[0], k1 = kp[1];
                        const u32x4 qw = *reinterpret_cast<const u32x4*>(&qr[d0]);
                        s = fmaf(bf_lo(qw.x), k0[0], s); s = fmaf(bf_hi(qw.x), k0[1], s); s = fmaf(bf_lo(qw.y), k0[2], s); s = fmaf(bf_hi(qw.y), k0[3], s);
                        s = fmaf(bf_lo(qw.z), k1[0], s); s = fmaf(bf_hi(qw.z), k1[1], s); s = fmaf(bf_lo(qw.w), k1[2], s); s = fmaf(bf_hi(qw.w), k1[3], s); }
                    g[n] = pair_sum(s); }
                asm volatile("" ::: "memory"); }
#pragma unroll
            for (int k = 0; k < 3; ++k) { float best = -__builtin_inff(); int bi = 0;
#pragma unroll
                for (int n = 0; n < 7; ++n) if (g[n] > best) { best = g[n]; bi = n; }
                sel |= 1u << bi;
#pragma unroll
                for (int n = 0; n < 7; ++n) g[n] = (bi == n) ? -__builtin_inff() : g[n]; }
        }
    }
    f32x16 o[4];
#pragma unroll
    for (int d_ = 0; d_ < 4; ++d_)
#pragma unroll
        for (int r = 0; r < 16; ++r) o[d_][r] = 0.f;
    for (int i = 0; i < NT; ++i) {
        const int tj = TJ(i), kb = tj * 64, buf = i & 1;
        if (i + 1 < NT) SLOAD(TJ(i + 1) * 64, buf ^ 1);
        SBAR();
        bool act = (MODE == MODE_SB) ? (kb <= qlo + 30) : (kb <= qlo + 31);
        if constexpr (MODE == MODE_MOBA) { const int n = tj >> 2; if (n != qb) act = act && __any((int)((sel >> n) & 1u)); }
        if (act) {
            f32x16 p0, p1; bf16x8 pa0, pa1, pa2, pa3;
            qkt(p0, p1, K_lds + buf * SHM, r32, hi, qr);
            const int dq = qpos - kb - 4 * hi;
            if constexpr (MODE == MODE_DIL || MODE == MODE_MOBA) {
                if constexpr (MODE == MODE_DIL) {
#pragma unroll
                    for (int r = 0; r < 16; ++r) { const int c = (r & 3) + 8 * (r >> 2);
                        { const unsigned ud = (unsigned)(dq - c); const int cnt = (int)(ud <= 128u) + (int)(((ud & 3u) == 0u) & (ud <= 512u)) + (int)((ud & 0x8000000Fu) == 0u);
                          p0[r] += __builtin_amdgcn_logf((float)cnt) * (1.0f / C2); }
                        { const unsigned ud = (unsigned)(dq - c - 32); const int cnt = (int)(ud <= 128u) + (int)(((ud & 3u) == 0u) & (ud <= 512u)) + (int)((ud & 0x8000000Fu) == 0u);
                          p1[r] += __builtin_amdgcn_logf((float)cnt) * (1.0f / C2); } }
                } else {
                    const int n = tj >> 2;
                    if (n == qb) { if (kb + 63 > qlo) mask_tile(p0, p1, dq); }
                    else if (!((sel >> n) & 1u)) {
#pragma unroll
                        for (int r = 0; r < 16; ++r) { p0[r] = -__builtin_inff(); p1[r] = -__builtin_inff(); } }
                }
                float mn, alpha;
                partialSM(p0, p1, m_reg, mn, alpha);
                float ps = 0.f;
#pragma unroll
                for (int r = 0; r < 16; ++r) ps += p0[r];
#pragma unroll
                for (int r = 0; r < 16; ++r) ps += p1[r];
                ps = pair_sum(ps);
                l_reg = l_reg * alpha + ps;
                pack_p(p0, p1, pa0, pa1, pa2, pa3);
                if (__any(alpha < 1.f)) { if (hi == 0) al_l[r32] = alpha; LDS_WAIT();
#pragma unroll
                    for (int d_ = 0; d_ < 4; ++d_)
#pragma unroll
                        for (int r = 0; r < 16; ++r) o[d_][r] *= al_l[crow(r, hi)]; }
            } else if constexpr (MODE == MODE_ML) {
                float dsum = 0.f;
#pragma unroll
                for (int r4 = 0; r4 < 4; ++r4) {
                    const f32x4 a0 = *(const LAS f32x4*)(aux + kb + 8 * r4 + 4 * hi), a1 = *(const LAS f32x4*)(aux + kb + 32 + 8 * r4 + 4 * hi);
#pragma unroll
                    for (int j = 0; j < 4; ++j) { const int r = 4 * r4 + j, c = 8 * r4 + j;
                        float s0 = p0[r] * SCALE * __builtin_amdgcn_exp2f(a0[j] - M2row); s0 = (dq - c < 0) ? 0.f : s0;
                        float s1 = p1[r] * SCALE * __builtin_amdgcn_exp2f(a1[j] - M2row); s1 = (dq - c - 32 < 0) ? 0.f : s1;
                        p0[r] = s0; p1[r] = s1; dsum += s0 + s1; } }
                den += dsum;
                pack_p(p0, p1, pa0, pa1, pa2, pa3);
            } else {
                f32x16 z0, z1; float gs[8];
#pragma unroll
                for (int r = 0; r < 16; ++r) { const int c = (r & 3) + 8 * (r >> 2);
                    { const float z2 = p0[r] * C2; const float sp = fmaxf(z2, 0.f) + __builtin_amdgcn_logf(1.0f + __builtin_amdgcn_exp2f(-fabsf(z2)));
                      z0[r] = z2; const float spm = ((dq - 1 - c) >= 0) ? sp : 0.f; p0[r] = spm; if ((r & 3) == 0) gs[r >> 2] = spm; else gs[r >> 2] += spm; }
                    { const float z2 = p1[r] * C2; const float sp = fmaxf(z2, 0.f) + __builtin_amdgcn_logf(1.0f + __builtin_amdgcn_exp2f(-fabsf(z2)));
                      z1[r] = z2; const float spm = ((dq - 1 - c - 32) >= 0) ? sp : 0.f; p1[r] = spm; if ((r & 3) == 0) gs[4 + (r >> 2)] = spm; else gs[4 + (r >> 2)] += spm; } }
                float aft[8]; float run = 0.f;
#pragma unroll
                for (int i2 = 7; i2 >= 0; --i2) { const float pg = __shfl_xor(gs[i2], 32); aft[i2] = run + (hi == 0 ? pg : 0.f); run += gs[i2] + pg; }
#pragma unroll
                for (int i2 = 0; i2 < 8; ++i2) { float suf = Rsum + aft[i2];
#pragma unroll
                    for (int j = 3; j >= 0; --j) { const int r = 4 * (i2 & 3) + j, c = 8 * (i2 & 3) + j + ((i2 >> 2) ? 32 : 0);
                        const bool ok = (dq - 1 - c) >= 0;
                        if (i2 >> 2) { suf += p1[r]; p1[r] = ok ? __builtin_amdgcn_exp2f(z1[r] - suf) : 0.f; }
                        else { suf += p0[r]; p0[r] = ok ? __builtin_amdgcn_exp2f(z0[r] - suf) : 0.f; } } }
                Rsum += run;
                pack_p(p0, p1, pa0, pa1, pa2, pa3);
            }
            SBAR();
            pv_tile(o, vb0 + buf * SHM, pa0, pa1, pa2, pa3);
        }
        SBAR();
        VM_WAIT(); LDS_WAIT(); WG_BAR();
    }
    if constexpr (MODE == MODE_DIL || MODE == MODE_MOBA) { if (hi == 0) li_l[r32] = l_reg; }
    if constexpr (MODE == MODE_ML) { const float dt = pair_sum(den); if (hi == 0) li_l[r32] = fmaxf(fabsf(dt), nmrow); }
    LDS_WAIT();
    bf16* Ow = Op + (size_t)qlo * ldo;
#pragma unroll
    for (int r = 0; r < 16; ++r) { const int orow = crow(r, hi);
        float rl = 1.f; if constexpr (MODE != MODE_SB) rl = __builtin_amdgcn_rcpf(li_l[orow]);
#pragma unroll
        for (int d0 = 0; d0 < 4; ++d0) { const float v = o[d0][r] * rl; const float vn = __shfl_xor(v, 1);
            if ((r32 & 1) == 0) *(unsigned*)(Ow + (size_t)orow * ldo + d0 * 32 + r32) = cvtpk(v, vn); } }
    LDS_WAIT();
#undef TJ
#undef SLOAD
}
}


struct Frame {
    LAS unsigned char* lds; int tid, lane, wave, vcu, G, gw, NGW;
};

template <bool FOLD>
__device__ __forceinline__ void tr_item(const float* __restrict__ W, int K, int N, bf16* __restrict__ WT, int item, int nblk, LAS unsigned* scr, int lane, int rmode, const float* lg, const float* lb, float* cs, float* bs) {
    const int kb = item / nblk, nb = item - kb * nblk, k0 = kb * 64, n0 = nb * 64;
    const int nq = lane & 15, kr = lane >> 4;
    const bool inb = (n0 + 4 * nq) < N;
    f32x4 a[8], b[8];
#pragma unroll
    for (int s = 0; s < 8; ++s) { const int kp = 4 * s + kr; const float* p = W + (size_t)(k0 + 2 * kp) * N + (inb ? n0 + 4 * nq : 0);
        a[s] = *(const f32x4*)p; b[s] = *(const f32x4*)(p + N); }
    if (!inb) {
#pragma unroll
        for (int s = 0; s < 8; ++s) { a[s] = (f32x4){0.f, 0.f, 0.f, 0.f}; b[s] = (f32x4){0.f, 0.f, 0.f, 0.f}; } }
    f32x4 csum = {0.f, 0.f, 0.f, 0.f}, bsum = {0.f, 0.f, 0.f, 0.f};
    if constexpr (FOLD) {
#pragma unroll
        for (int s = 0; s < 8; ++s) { const int k = k0 + 2 * (4 * s + kr); const f32x2 g2 = *(const f32x2*)(lg + k), b2 = *(const f32x2*)(lb + k);
            bsum += a[s] * b2[0] + b[s] * b2[1]; a[s] = a[s] * g2[0]; b[s] = b[s] * g2[1]; }
    }
#pragma unroll
    for (int s = 0; s < 8; ++s) { const int kp = 4 * s + kr;
#pragma unroll
        for (int i = 0; i < 4; ++i) { const unsigned pk = cvtpk(a[s][i], b[s][i]); scr[(4 * nq + i) * 33 + kp] = pk; if constexpr (FOLD) csum[i] += bf_lo(pk) + bf_hi(pk); } }
    LDS_WAIT();
#pragma unroll
    for (int jj = 0; jj < 8; ++jj) { const int n = (lane >> 3) + 8 * jj, c = lane & 7; const LAS unsigned* s = scr + n * 33 + 4 * c;
        u32x4 o; o.x = s[0]; o.y = s[1]; o.z = s[2]; o.w = s[3];
        const int nn = n0 + n, drow = rmode ? (((nn >> 7) << 8) + (nn & 127) + (rmode == 2 ? 128 : 0)) : nn;
        *(u32x4*)(WT + (size_t)drow * K + k0 + 8 * c) = o; }
    LDS_WAIT();
    if constexpr (FOLD) {
#pragma unroll
        for (int i = 0; i < 4; ++i) { csum[i] += __shfl_xor(csum[i], 16); csum[i] += __shfl_xor(csum[i], 32); bsum[i] += __shfl_xor(bsum[i], 16); bsum[i] += __shfl_xor(bsum[i], 32); }
        LAS float* fs = (LAS float*)scr;
        if (kr == 0) { *(LAS f32x4*)(fs + 4 * nq) = csum; *(LAS f32x4*)(fs + 64 + 4 * nq) = bsum; }
        LDS_WAIT();
        const int nn = n0 + lane, drow = rmode ? (((nn >> 7) << 8) + (nn & 127) + (rmode == 2 ? 128 : 0)) : nn;
        if (nn < N) { unsafeAtomicAdd(cs + drow, fs[lane]); unsafeAtomicAdd(bs + drow, fs[64 + lane]); }
        LDS_WAIT();
    }
}

__device__ __forceinline__ void prologue(const Frame& F_, const Args& a) {
    Frame F = F_; asm volatile("" : "+v"(F.lane), "+v"(F.tid), "+s"(F.gw), "+s"(F.vcu), "+s"(F.wave));
    unsigned char* ws = a.ws;
    LAS unsigned* scr = (LAS unsigned*)(F.lds + F.wave * 8448);
    constexpr int I_INAB = 64 * 192, I_OUT = 64 * 64, I_INCD = 64 * 196, I_UP = 64 * 172, I_DN = 172 * 64;
    constexpr int TOTAL = I_INAB + I_OUT + I_INCD + I_OUT + 4 * I_UP + 2 * I_DN;
    for (int it = F.gw; it < TOTAL; it += F.NGW) {
        int r = it; const float* W; int K, N, nblk; bf16* WT; int rmode = 0; const float* lg = nullptr; const float* lb = nullptr; float* cs = nullptr; float* bs = nullptr;
        unsigned char* ctl = ws + WS_CTL;
        if (r < I_INAB) { W = a.in[1]; K = DM; N = N_AB; nblk = 192; WT = (bf16*)(ws + WS_W_INAB); }
        else if ((r -= I_INAB) < I_OUT) { W = a.in[2]; K = DM; N = DM; nblk = 64; WT = (bf16*)(ws + WS_W_OUTAB); }
        else if ((r -= I_OUT) < I_INCD) { W = a.in[3]; K = DM; N = N_CD; nblk = 196; WT = (bf16*)(ws + WS_W_INCD); lg = a.in[14] + DM; lb = a.in[15] + DM; cs = (float*)(ctl + CTL_CS_INCD); bs = (float*)(ctl + CTL_BS_INCD); }
        else if ((r -= I_INCD) < I_OUT) { W = a.in[8]; K = DM; N = DM; nblk = 64; WT = (bf16*)(ws + WS_W_OUTCD); }
        else if ((r -= I_OUT) < I_UP) { W = a.in[9]; K = DM; N = DFF; nblk = 172; WT = (bf16*)(ws + WS_W_UG0); rmode = 1; lg = a.in[14]; lb = a.in[15]; cs = (float*)(ctl + CTL_CS_UG0); bs = (float*)(ctl + CTL_BS_UG0); }
        else if ((r -= I_UP) < I_UP) { W = a.in[10]; K = DM; N = DFF; nblk = 172; WT = (bf16*)(ws + WS_W_UG0); rmode = 2; lg = a.in[14]; lb = a.in[15]; cs = (float*)(ctl + CTL_CS_UG0); bs = (float*)(ctl + CTL_BS_UG0); }
        else if ((r -= I_UP) < I_DN) { W = a.in[13]; K = DFF; N = DM; nblk = 64; WT = (bf16*)(ws + WS_W_DN0); }
        else if ((r -= I_DN) < I_UP) { W = a.in[9] + (size_t)DM * DFF; K = DM; N = DFF; nblk = 172; WT = (bf16*)(ws + WS_W_UG1); rmode = 1; lg = a.in[14] + 2 * DM; lb = a.in[15] + 2 * DM; cs = (float*)(ctl + CTL_CS_UG1); bs = (float*)(ctl + CTL_BS_UG1); }
        else if ((r -= I_UP) < I_UP) { W = a.in[10] + (size_t)DM * DFF; K = DM; N = DFF; nblk = 172; WT = (bf16*)(ws + WS_W_UG1); rmode = 2; lg = a.in[14] + 2 * DM; lb = a.in[15] + 2 * DM; cs = (float*)(ctl + CTL_CS_UG1); bs = (float*)(ctl + CTL_BS_UG1); }
        else { r -= I_UP; W = a.in[13] + (size_t)DFF * DM; K = DFF; N = DM; nblk = 64; WT = (bf16*)(ws + WS_W_DN1); }
        if (lg) tr_item<true>(W, K, N, WT, r, nblk, scr, F.lane, rmode, lg, lb, cs, bs); else tr_item<false>(W, K, N, WT, r, nblk, scr, F.lane, rmode, lg, lb, cs, bs);
    }
    const f32x4* x4 = (const f32x4*)a.in[0]; u32x2* xb = (u32x2*)(ws + WS_XB);
    for (size_t i = (size_t)F.gw * 64 + F.lane; i < (size_t)M * DM / 4; i += (size_t)F.NGW * 64) { const f32x4 v = x4[i]; u32x2 o; o.x = cvtpk(v[0], v[1]); o.y = cvtpk(v[2], v[3]); xb[i] = o; }
}

__device__ __forceinline__ void ln_phase(const Frame& F_, const float* z, float* xo, bf16* xb, const float* g, const float* b, float oscale = 1.f) {
    Frame F = F_; asm volatile("" : "+v"(F.lane), "+v"(F.tid), "+s"(F.gw), "+s"(F.vcu), "+s"(F.wave));
    for (int m = F.gw; m < M; m += F.NGW) {
        const f32x4* zr = (const f32x4*)(z + (size_t)m * DM) + F.lane;
        f32x4 v[16]; float s = 0.f;
#pragma unroll
        for (int j = 0; j < 16; ++j) { v[j] = zr[64 * j]; s += (v[j][0] + v[j][1]) + (v[j][2] + v[j][3]); }
        const float mean = wave_sum(s) * (1.f / DM); float s2 = 0.f;
#pragma unroll
        for (int j = 0; j < 16; ++j) { v[j] = v[j] - mean; s2 += (v[j][0] * v[j][0] + v[j][1] * v[j][1]) + (v[j][2] * v[j][2] + v[j][3] * v[j][3]); }
        const float rstd = 1.f / sqrtf(wave_sum(s2) * (1.f / DM) + LN_EPS);
        f32x4* xr = (f32x4*)(xo + (size_t)m * DM) + F.lane; u32x2* br = (u32x2*)((xb ? xb : (bf16*)xo) + (size_t)m * DM) + F.lane;
        const f32x4* g4 = (const f32x4*)g + F.lane; const f32x4* b4 = (const f32x4*)b + F.lane;
#pragma unroll
        for (int j = 0; j < 16; ++j) { f32x4 o = v[j] * rstd * g4[64 * j] + b4[64 * j]; if (SELFCHECK) o = o * oscale; xr[64 * j] = o;
            if (xb) { u32x2 w; w.x = cvtpk(o[0], o[1]); w.y = cvtpk(o[2], o[3]); br[64 * j] = w; } }
    }
}

__device__ __forceinline__ void ffn_act_phase(const Frame& F_, bf16* U, const bf16* Gb, const float* cw  , const float* cb, bool dummy = false) {
    Frame F = F_; asm volatile("" : "+v"(F.lane), "+v"(F.tid), "+s"(F.gw), "+s"(F.vcu), "+s"(F.wave));
    constexpr int NCH = DFF / 8, NCB = (NCH + 63) / 64, NITEM = (M / 32) * NCB;
    for (int it = F.gw; it < NITEM; it += F.NGW) {
        const int rb = it / NCB, cbk = it - rb * NCB, ch = cbk * 64 + F.lane;
        if (ch >= NCH) continue;
        const int c0 = ch * 8, r0 = rb * 32;
        float w0[8], w1[8], w2[8], bb[8];
#pragma unroll
        for (int q = 0; q < 2; ++q) { const f32x4 t0 = *(const f32x4*)(cw + c0 + 4 * q), t1 = *(const f32x4*)(cw + DFF + c0 + 4 * q), t2 = *(const f32x4*)(cw + 2 * DFF + c0 + 4 * q), t3 = *(const f32x4*)(cb + c0 + 4 * q);
#pragma unroll
            for (int j = 0; j < 4; ++j) { w0[4 * q + j] = t0[j]; w1[4 * q + j] = t1[j]; w2[4 * q + j] = t2[j]; bb[4 * q + j] = t3[j]; } }
        u32x4 gm2 = {0u, 0u, 0u, 0u}, gm1 = {0u, 0u, 0u, 0u};
        if ((r0 & (SEQ - 1)) != 0) { gm2 = *(const u32x4*)(Gb + (size_t)(r0 - 2) * DFF + c0); gm1 = *(const u32x4*)(Gb + (size_t)(r0 - 1) * DFF + c0); }
        for (int t8 = 0; t8 < 32; t8 += 8) {
            u32x4 gv[8], uv[8];
#pragma unroll
            for (int t = 0; t < 8; ++t) { gv[t] = *(const u32x4*)(Gb + (size_t)(r0 + t8 + t) * DFF + c0); uv[t] = *(const u32x4*)(U + (size_t)(r0 + t8 + t) * DFF + c0); }
#pragma unroll
            for (int t = 0; t < 8; ++t) { u32x4 ov;
#pragma unroll
                for (int q = 0; q < 4; ++q) {
                    const float y0 = w0[2 * q] * bf_lo(gm2[q]) + w1[2 * q] * bf_lo(gm1[q]) + w2[2 * q] * bf_lo(gv[t][q]) + bb[2 * q];
                    const float y1 = w0[2 * q + 1] * bf_hi(gm2[q]) + w1[2 * q + 1] * bf_hi(gm1[q]) + w2[2 * q + 1] * bf_hi(gv[t][q]) + bb[2 * q + 1];
                    ov[q] = cvtpk(silu_f(y0) * bf_lo(uv[t][q]), silu_f(y1) * bf_hi(uv[t][q])); }
                if (REP_MASK & 4096) { if (dummy) ov = uv[t]; }
                *(u32x4*)(U + (size_t)(r0 + t8 + t) * DFF + c0) = ov; gm2 = gm1; gm1 = gv[t]; }
        }
    }
}


__device__ __forceinline__ void ffn_fix_phase(const Frame& F_, bf16* H, const float* EG0, const float* EU0, const float* EGL, const float* cw, const float* cb) {
    Frame F = F_; asm volatile("" : "+v"(F.lane), "+v"(F.tid), "+s"(F.gw), "+s"(F.vcu), "+s"(F.wave));
    constexpr int C4 = DFF / 4;
    for (int idx = F.gw * 64 + F.lane; idx < 64 * C4; idx += F.NGW * 64) {
        const int pm = idx / C4, ch = (idx - pm * C4) * 4;
        f32x4 gl0 = {0.f, 0.f, 0.f, 0.f}, gl1 = gl0;
        if ((pm & 7) != 0) { gl0 = *(const f32x4*)(EGL + (size_t)((pm - 1) * 2) * DFF + ch); gl1 = *(const f32x4*)(EGL + (size_t)((pm - 1) * 2 + 1) * DFF + ch); }
        const f32x4 g0 = *(const f32x4*)(EG0 + (size_t)(pm * 2) * DFF + ch), g1 = *(const f32x4*)(EG0 + (size_t)(pm * 2 + 1) * DFF + ch);
        const f32x4 u0 = *(const f32x4*)(EU0 + (size_t)(pm * 2) * DFF + ch), u1 = *(const f32x4*)(EU0 + (size_t)(pm * 2 + 1) * DFF + ch);
        const f32x4 w0 = *(const f32x4*)(cw + ch), w1 = *(const f32x4*)(cw + DFF + ch), w2 = *(const f32x4*)(cw + 2 * DFF + ch), bb = *(const f32x4*)(cb + ch);
        const f32x4 y0 = w0 * gl0 + w1 * gl1 + w2 * g0 + bb, y1 = w0 * gl1 + w1 * g0 + w2 * g1 + bb;
        u32x2 o0, o1;
        o0.x = cvtpk(silu_f(y0[0]) * u0[0], silu_f(y0[1]) * u0[1]); o0.y = cvtpk(silu_f(y0[2]) * u0[2], silu_f(y0[3]) * u0[3]);
        o1.x = cvtpk(silu_f(y1[0]) * u1[0], silu_f(y1[1]) * u1[1]); o1.y = cvtpk(silu_f(y1[2]) * u1[2], silu_f(y1[3]) * u1[3]);
        *(u32x2*)(H + (size_t)(pm * 256) * DFF + ch) = o0; *(u32x2*)(H + (size_t)(pm * 256 + 1) * DFF + ch) = o1;
    }
}

__device__ __forceinline__ void kmean_phase(const Frame& F_, const bf16* QKV, float* kmean) {
    Frame F = F_; asm volatile("" : "+v"(F.lane), "+v"(F.tid), "+s"(F.gw), "+s"(F.vcu), "+s"(F.wave));
    LAS float* red = (LAS float*)F.lds;
    for (int it = F.vcu; it < 256; it += F.G) {
        const int b = it >> 5, n = (it >> 2) & 7, cbk = it & 3;
        const bf16* src = QKV + (size_t)(b * SEQ + n * 256 + F.wave * 32) * N_AB + 8192 + cbk * 512 + F.lane * 8;
        float acc[8];
#pragma unroll
        for (int j = 0; j < 8; ++j) acc[j] = 0.f;
        for (int r8 = 0; r8 < 32; r8 += 8) { u32x4 v[8];
#pragma unroll
            for (int r = 0; r < 8; ++r) v[r] = *(const u32x4*)(src + (size_t)(r8 + r) * N_AB);
#pragma unroll
            for (int r = 0; r < 8; ++r)
#pragma unroll
                for (int q = 0; q < 4; ++q) { acc[2 * q] += bf_lo(v[r][q]); acc[2 * q + 1] += bf_hi(v[r][q]); } }
#pragma unroll
        for (int j = 0; j < 8; ++j) red[F.wave * 512 + F.lane * 8 + j] = acc[j];
        LDS_WAIT(); WG_BAR();
        float s = 0.f;
#pragma unroll
        for (int w = 0; w < 8; ++w) s += red[w * 512 + F.tid];
        const int col = cbk * 512 + F.tid, h = col >> 7, d = col & 127;
        kmean[((size_t)(b * 16 + h) * 8 + n) * 128 + d] = s * (1.f / 256.f);
        LDS_WAIT(); WG_BAR();
    }
}

__device__ __forceinline__ void cd_pre_phase(const Frame& F_, const bf16* QKV, bf16* QKDC, const float* cw  , const float* cb, const float* gates, const float* bif, float* A2, float* M2, float* NM) {
    Frame F = F_; asm volatile("" : "+v"(F.lane), "+v"(F.tid), "+s"(F.gw), "+s"(F.vcu), "+s"(F.wave));
    for (int it = F.gw; it < (M / 32) * 4; it += F.NGW) {
        const int rb = it >> 2, cbk = it & 3, c0 = cbk * 512 + F.lane * 8, r0 = rb * 32;
        float w[4][8], bb[8];
#pragma unroll
        for (int q = 0; q < 2; ++q) { const f32x4 t3 = *(const f32x4*)(cb + c0 + 4 * q);
#pragma unroll
            for (int j = 0; j < 4; ++j) bb[4 * q + j] = t3[j];
#pragma unroll
            for (int k = 0; k < 4; ++k) { const f32x4 t = *(const f32x4*)(cw + k * 2048 + c0 + 4 * q);
#pragma unroll
                for (int j = 0; j < 4; ++j) w[k][4 * q + j] = t[j]; } }
        const bf16* src = QKV + 6144 + c0;
        u32x4 x3 = {0u, 0u, 0u, 0u}, x2 = x3, x1 = x3;
        if ((r0 & (SEQ - 1)) != 0) { x3 = *(const u32x4*)(src + (size_t)(r0 - 3) * N_AB); x2 = *(const u32x4*)(src + (size_t)(r0 - 2) * N_AB); x1 = *(const u32x4*)(src + (size_t)(r0 - 1) * N_AB); }
        for (int t8 = 0; t8 < 32; t8 += 8) {
            u32x4 xv[8];
#pragma unroll
            for (int t = 0; t < 8; ++t) xv[t] = *(const u32x4*)(src + (size_t)(r0 + t8 + t) * N_AB);
#pragma unroll
            for (int t = 0; t < 8; ++t) { u32x4 ov;
#pragma unroll
                for (int q = 0; q < 4; ++q) {
                    const float y0 = w[0][2 * q] * bf_lo(x3[q]) + w[1][2 * q] * bf_lo(x2[q]) + w[2][2 * q] * bf_lo(x1[q]) + w[3][2 * q] * bf_lo(xv[t][q]) + bb[2 * q];
                    const float y1 = w[0][2 * q + 1] * bf_hi(x3[q]) + w[1][2 * q + 1] * bf_hi(x2[q]) + w[2][2 * q + 1] * bf_hi(x1[q]) + w[3][2 * q + 1] * bf_hi(xv[t][q]) + bb[2 * q + 1];
                    ov[q] = cvtpk(silu_f(y0), silu_f(y1)); }
                *(u32x4*)(QKDC + (size_t)(r0 + t8 + t) * 2048 + c0) = ov; x3 = x2; x2 = x1; x1 = xv[t]; }
        }
    }
    for (int sq = F.gw; sq < 64; sq += F.NGW) {
        const int b = sq >> 3, h = sq & 7; const float bi = bif[h], bfv = bif[8 + h];
        const float* gp = gates + (size_t)(b * SEQ + F.lane * 32) * 16;
        float lf[32], ai[32]; float run = 0.f;
#pragma unroll
        for (int t = 0; t < 32; ++t) { const float f = gp[t * 16 + 8 + h] + bfv; ai[t] = gp[t * 16 + h] + bi;
            const float ls = fminf(f, 0.f) - log1pf(expf(-fabsf(f)));
            run += ls; lf[t] = run; }
        float incl = run;
#pragma unroll
        for (int o = 1; o < 64; o <<= 1) { const float t = __shfl_up(incl, o); if (F.lane >= o) incl += t; }
        const float base = incl - run; float mx = -__builtin_inff();
#pragma unroll
        for (int t = 0; t < 32; ++t) { lf[t] += base; ai[t] -= lf[t]; mx = fmaxf(mx, ai[t]); }
        float minc = mx;
#pragma unroll
        for (int o = 1; o < 64; o <<= 1) { const float t = __shfl_up(minc, o); if (F.lane >= o) minc = fmaxf(minc, t); }
        float mprev = __shfl_up(minc, 1); if (F.lane == 0) mprev = -__builtin_inff();
        float cm = fmaxf(mprev, 0.f);
        float* a2o = A2 + (size_t)sq * SEQ + F.lane * 32; float* m2o = M2 + (size_t)sq * SEQ + F.lane * 32; float* nmo = NM + (size_t)sq * SEQ + F.lane * 32;
#pragma unroll
        for (int t = 0; t < 32; ++t) { cm = fmaxf(cm, ai[t]); a2o[t] = ai[t] * 1.4426950408889634f; m2o[t] = cm * 1.4426950408889634f; nmo[t] = expf(-lf[t] - cm); }
    }
}

__device__ __forceinline__ void cd_post_phase(const Frame& F_, const bf16* HD, const bf16* QKV, bf16* Y, const float* ng) {
    Frame F = F_; asm volatile("" : "+v"(F.lane), "+v"(F.tid), "+s"(F.gw), "+s"(F.vcu), "+s"(F.wave));
    for (int it = F.gw; it < M * 8; it += F.NGW) {
        const int m = it >> 3, h = it & 7, c = h * 256 + F.lane * 4;
        const u32x2 hv = *(const u32x2*)(HD + (size_t)m * 2048 + c); const u32x2 ov = *(const u32x2*)(QKV + (size_t)m * N_AB + 10240 + c);
        const f32x4 g = *(const f32x4*)(ng + c);
        float v0 = bf_lo(hv.x), v1 = bf_hi(hv.x), v2 = bf_lo(hv.y), v3 = bf_hi(hv.y);
        const float mean = wave_sum((v0 + v1) + (v2 + v3)) * (1.f / 256.f);
        v0 -= mean; v1 -= mean; v2 -= mean; v3 -= mean;
        const float rstd = 1.f / sqrtf(wave_sum((v0 * v0 + v1 * v1) + (v2 * v2 + v3 * v3)) * (1.f / 256.f) + LN_EPS);
        const float o0 = bf_lo(ov.x), o1 = bf_hi(ov.x), o2 = bf_lo(ov.y), o3 = bf_hi(ov.y);
        const float y0 = v0 * rstd * g[0] * __builtin_amdgcn_rcpf(1.f + __builtin_amdgcn_exp2f(-1.4426950408889634f * o0));
        const float y1 = v1 * rstd * g[1] * __builtin_amdgcn_rcpf(1.f + __builtin_amdgcn_exp2f(-1.4426950408889634f * o1));
        const float y2 = v2 * rstd * g[2] * __builtin_amdgcn_rcpf(1.f + __builtin_amdgcn_exp2f(-1.4426950408889634f * o2));
        const float y3 = v3 * rstd * g[3] * __builtin_amdgcn_rcpf(1.f + __builtin_amdgcn_exp2f(-1.4426950408889634f * o3));
        u32x2 w; w.x = cvtpk(y0, y1); w.y = cvtpk(y2, y3);
        *(u32x2*)(Y + (size_t)m * DM + 2048 + c) = w;
    }
}


#if SELFCHECK
constexpr int CW_ERR = 64;
__device__ __forceinline__ unsigned hash_u(unsigned x) { x ^= x >> 16; x *= 0x7feb352du; x ^= x >> 15; x *= 0x846ca68bu; x ^= x >> 16; return x; }
__device__ __forceinline__ float bfr(float f) { return bf_lo(cvtpk(f, 0.f)); }
__device__ __forceinline__ float bfv(const bf16* p) { return __uint_as_float(((unsigned)*p) << 16); }
__device__ __forceinline__ float blk_red(LAS float* red, float v, int tid, bool domax) {
    red[tid] = v; __syncthreads();
    for (int o = 256; o >= 1; o >>= 1) { if (tid < o) red[tid] = domax ? fmaxf(red[tid], red[tid + o]) : (red[tid] + red[tid + o]); __syncthreads(); }
    const float r = red[0]; __syncthreads(); return r;
}
__device__ __forceinline__ int sample_t(int ci) {
    if (ci < 4) return ci;
    if (ci < 22) { const int g = (ci - 4) / 3, o = (ci - 4) % 3 - 1; return (g == 0 ? 16 : (32 << g)) + o; }
    if (ci < 24) return 2024 + ci;
    return (int)(hash_u(ci * 2654435761u + 12345u) & 2047u); }
__device__ __forceinline__ void gemm_check(const Frame& F_, const bf16* XB, const float* W, int N, const bf16* QKV, const float* GATES, unsigned* err, unsigned bit) {
    Frame F = F_; asm volatile("" : "+v"(F.lane), "+v"(F.tid), "+s"(F.gw), "+s"(F.vcu), "+s"(F.wave));
    for (int e = 0; e < 16; ++e) {
        const unsigned hsh = hash_u((unsigned)(F.gw * 16 + e) * 2246822519u + bit);
        const int row = (int)(hsh & 16383u); int col = (int)((hsh >> 14) % (unsigned)N);
        if (N == N_CD && (e & 3) == 3) col = 12288 + (int)((hsh >> 14) & 15u);
        float s = 0.f;
        for (int k = F.lane; k < DM; k += 64) s += bfv(XB + (size_t)row * DM + k) * bfr(W[(size_t)k * N + col]);
        s = wave_sum(s);
        const float got = (col < 12288) ? bfv(QKV + (size_t)row * N_AB + col) : GATES[(size_t)row * 16 + (col - 12288)];
        if (!(fabsf(got - s) <= 0.02f * fabsf(s) + 0.02f)) { if (F.lane == 0) atomicOr(err, bit); }
    }
}
__device__ __forceinline__ void attn_check(const Frame& F_, int mode, const bf16* Q, const bf16* K, const bf16* V, int ld, const bf16* O, int ldo, int t, unsigned* err, unsigned bit) {
    Frame F = F_; asm volatile("" : "+v"(F.lane), "+v"(F.tid), "+s"(F.gw), "+s"(F.vcu), "+s"(F.wave));
    LAS float* qf = (LAS float*)F.lds; LAS float* sc = qf + 256; LAS float* red = sc + 2048; LAS float* km = red + 512;
    LAS unsigned* selw = (LAS unsigned*)(km + 1024);
    const int tid = F.tid;
    if (tid < 128) qf[tid] = bfv(Q + (size_t)t * ld + tid);
    __syncthreads();
    const int own = t >> 8;
    if (mode == 1) {
        for (int i = tid; i < own * 128; i += 512) { const int n = i >> 7, d = i & 127; float a = 0.f; for (int r = 0; r < 256; ++r) a += bfv(K + (size_t)(n * 256 + r) * ld + d); km[i] = a * (1.f / 256.f); }
        __syncthreads();
        if (tid == 0) { LAS float* g = km + 1024 + 16; for (int n = 0; n < 8; ++n) { g[n] = -__builtin_inff(); if (n < own) { float a = 0.f; for (int d = 0; d < 128; ++d) a += qf[d] * km[n * 128 + d]; g[n] = a; } }
            unsigned sel = 0u; const int topk = own < 3 ? own : 3;
            for (int k = 0; k < topk; ++k) { int bi = 0; float best = -__builtin_inff(); for (int n = 0; n < own; ++n) if (g[n] > best) { best = g[n]; bi = n; } sel |= 1u << bi; g[bi] = -__builtin_inff(); }
            selw[0] = sel; }
        __syncthreads();
    }
    const int nk = (mode == 2) ? t : t + 1;
    float lmax = -__builtin_inff();
    for (int sidx = tid; sidx < nk; sidx += 512) { float a = 0.f; for (int d = 0; d < 128; ++d) a += qf[d] * bfv(K + (size_t)sidx * ld + d);
        a *= 0.08838834764831845f;
        if (mode == 0) { const int dd = t - sidx; const int cnt = (dd <= 128 ? 1 : 0) + (((dd & 3) == 0 && dd <= 512) ? 1 : 0) + ((dd & 15) == 0 ? 1 : 0); a = cnt ? a + logf((float)cnt) : -__builtin_inff(); }
        if (mode == 1) { const int n = sidx >> 8; if (!(n == own || ((selw[0] >> n) & 1u))) a = -__builtin_inff(); }
        sc[sidx] = a; lmax = fmaxf(lmax, a); }
    __syncthreads();
    float den = 1.f;
    if (mode != 2) { const float mx = blk_red(red, lmax, tid, true); float ls = 0.f;
        for (int sidx = tid; sidx < nk; sidx += 512) { const float p = expf(sc[sidx] - mx); sc[sidx] = p; ls += p; }
        __syncthreads(); den = blk_red(red, ls, tid, false); }
    else { if (tid == 0) { float rc = 0.f; for (int sidx = nk - 1; sidx >= 0; --sidx) { const float z = sc[sidx]; const float sp = fmaxf(z, 0.f) + log1pf(expf(-fabsf(z))); rc += sp; sc[sidx] = expf(z - rc); } } __syncthreads(); }
    float ov = 0.f, df = 0.f;
    if (tid < 128) { float a = 0.f; for (int sidx = 0; sidx < nk; ++sidx) a += sc[sidx] * bfv(V + (size_t)sidx * ld + tid); ov = a / den; df = fabsf(bfv(O + (size_t)t * ldo + tid) - ov); }
    const float mo = blk_red(red, fabsf(ov), tid, true), md = blk_red(red, df, tid, true);
    if (tid == 0 && !(md <= 0.03f * mo + 1e-6f)) atomicOr(err, bit);
    __syncthreads();
}
__device__ __forceinline__ void ml_check(const Frame& F_, const bf16* QKV  , const float* GATES  , const float* cw, const float* cb, const float* bif, const float* ng, const bf16* Y  , int h, int t, unsigned* err, unsigned bit) {
    Frame F = F_; asm volatile("" : "+v"(F.lane), "+v"(F.tid), "+s"(F.gw), "+s"(F.vcu), "+s"(F.wave));
    LAS float* qf = (LAS float*)F.lds; LAS float* sc = qf + 256; LAS float* red = sc + 2048; LAS float* av = red + 512; LAS float* misc = av + 2048;
    const int tid = F.tid;
    if (tid == 0) { float B = 0.f, mx = 0.f; for (int sidx = 0; sidx <= t; ++sidx) { const float f = GATES[(size_t)sidx * 16 + 8 + h] + bif[8 + h]; B += fminf(f, 0.f) - log1pf(expf(-fabsf(f)));
            const float a = GATES[(size_t)sidx * 16 + h] + bif[h] - B; av[sidx] = a; mx = fmaxf(mx, a); } misc[0] = mx; misc[1] = B; }
    if (tid >= 64 && tid < 192) { const int d = tid - 64, c = h * 128 + d; float y = cb[c]; for (int k = 0; k < 4; ++k) { const int r = t - 3 + k; if (r >= 0) y += cw[k * 2048 + c] * bfv(QKV + (size_t)r * N_AB + 6144 + c); } qf[d] = bfr(y / (1.f + expf(-y))); }
    __syncthreads();
    const float Mt = misc[0], Bt = misc[1];
    float ls = 0.f;
    for (int sidx = tid; sidx <= t; sidx += 512) { float a = 0.f;
        for (int d = 0; d < 128; ++d) { const int c = 1024 + h * 128 + d; float y = cb[c]; for (int k = 0; k < 4; ++k) { const int r = sidx - 3 + k; if (r >= 0) y += cw[k * 2048 + c] * bfv(QKV + (size_t)r * N_AB + 6144 + c); }
            a += qf[d] * bfr(y / (1.f + expf(-y))); }
        a *= 0.08838834764831845f * expf(av[sidx] - Mt); sc[sidx] = a; ls += a; }
    __syncthreads();
    const float den = blk_red(red, ls, tid, false);
    float hv = 0.f;
    if (tid < 256) { float a = 0.f; for (int sidx = 0; sidx <= t; ++sidx) a += sc[sidx] * bfv(QKV + (size_t)sidx * N_AB + 8192 + h * 256 + tid); hv = a / fmaxf(fabsf(den), expf(-Bt - Mt)); }
    const float mean = blk_red(red, tid < 256 ? hv : 0.f, tid, false) * (1.f / 256.f);
    const float var = blk_red(red, tid < 256 ? (hv - mean) * (hv - mean) : 0.f, tid, false) * (1.f / 256.f);
    float yv = 0.f, df = 0.f;
    if (tid < 256) { const float od = bfv(QKV + (size_t)t * N_AB + 10240 + h * 256 + tid); yv = (hv - mean) / sqrtf(var + LN_EPS) * ng[h * 256 + tid] / (1.f + expf(-od)); df = fabsf(bfv(Y + (size_t)t * DM + 2048 + h * 256 + tid) - yv); }
    const float mo = blk_red(red, fabsf(yv), tid, true), md = blk_red(red, df, tid, true);
    if (tid == 0 && !(md <= 0.03f * mo + 1e-6f)) atomicOr(err, bit);
    __syncthreads();
}
#endif

__global__ void __launch_bounds__(NWAVES * 64, 2) mk_fwd(Args args) {
    extern __shared__ __attribute__((aligned(16))) unsigned char lds_raw[];
    Frame F;
    F.lds = (LAS unsigned char*)lds_raw;
    F.tid = threadIdx.x; F.lane = F.tid & 63; F.wave = __builtin_amdgcn_readfirstlane(F.tid >> 6);
    F.G = gridDim.x; { const int bx = blockIdx.x; F.vcu = (F.G % 8 == 0) ? (bx % 8) * (F.G / 8) + bx / 8 : bx; }
    F.gw = F.vcu * NWAVES + F.wave; F.NGW = F.G * NWAVES;
    unsigned char* ws = args.ws;
    volatile LAS unsigned* MISC = (volatile LAS unsigned*)(F.lds + MISC_OFF);
    for (int u = F.tid; u < (LDS_BYTES - RING_BYTES) / 4; u += NWAVES * 64) ((LAS unsigned*)(F.lds + RING_BYTES))[u] = 0u;
    __syncthreads();
    XcdBarrier bar = xcd_barrier_post((unsigned*)(ws + WS_CTL) + CW_BAR, MISC + 8);
#define GRID_BAR() xcd_barrier(bar)

    PH(1) prologue(F, args);
    GRID_BAR();

#define PHASE_BEGIN const int L = opq_i(layer); GAS unsigned char* const W = (GAS unsigned char*)opq_p(ws); (void)L; (void)W;
    for (int layer = 0; layer < 2; ++layer) {
        { PHASE_BEGIN
            pg8::Gemm g{(const bf16*)(W + WS_XB), (const bf16*)(W + (L == 0 ? WS_W_INAB : WS_W_INCD)), M, L == 0 ? N_AB : N_CDP, DM};
            pg8::StaticOrder S; S.init(g.M, g.N, F.G, (int)blockIdx.x);
            pg8::EpiBf16 E{(unsigned char*)W, L};
            PH(2) pg8::gemm_phase<pg8::EpiBf16, pg8::StaticOrder, true, true>(F.lds, g, S, E);
        }
        GRID_BAR();
        { PHASE_BEGIN
            if (L == 0) { PH(4) kmean_phase(F, (const bf16*)(W + WS_QKV), (float*)(W + WS_KMEAN)); }
            else PH(8) cd_pre_phase(F, (const bf16*)(W + WS_QKV), (bf16*)(W + WS_QKDC), (const float*)ldin(args, 5), (const float*)ldin(args, 6), (const float*)(W + WS_GATES), (const float*)ldin(args, 4), (float*)(W + WS_A2), (float*)(W + WS_M2), (float*)(W + WS_NM));
        }
        GRID_BAR();
        { PHASE_BEGIN
            const bf16* QKV = (const bf16*)(W + WS_QKV); bf16* Y = (bf16*)(W + WS_Y);
            if (L == 0) {
                for (int it = F.vcu; it < 512; it += F.G) { const int bh = it >> 2, pr = it & 3, b = bh >> 4, h = bh & 15;
                    const bf16* base = QKV + (size_t)b * SEQ * N_AB + h * 128; bf16* ob = Y + (size_t)b * SEQ * DM + h * 128;
                    for (int ps = 0; ps < 2; ++ps) PH(16) att::attn_block<att::MODE_DIL>(base, N_AB, base + 2048, N_AB, base + 4096, N_AB, ob, DM, ps ? 7 - pr : pr, (LAS char*)F.lds, nullptr, nullptr, nullptr); }
                const float* KMEAN = (const float*)(W + WS_KMEAN);
                for (int it = F.vcu; it < 512; it += F.G) { const int bh = it >> 2, pr = it & 3, b = bh >> 4, h = bh & 15;
                    const bf16* base = QKV + (size_t)b * SEQ * N_AB + 6144 + h * 128; bf16* ob = Y + (size_t)b * SEQ * DM + 2048 + h * 128;
                    for (int ps = 0; ps < 2; ++ps) PH(32) att::attn_block<att::MODE_MOBA>(base, N_AB, base + 2048, N_AB, base + 4096, N_AB, ob, DM, ps ? 7 - pr : pr, (LAS char*)F.lds, KMEAN + (size_t)bh * 1024, nullptr, nullptr); }
            } else {
                for (int it = F.vcu; it < 512; it += F.G) { const int bh = it >> 2, pr = it & 3, b = bh >> 4, h = bh & 15;
                    const bf16* base = QKV + (size_t)b * SEQ * N_AB + h * 128; bf16* ob = Y + (size_t)b * SEQ * DM + h * 128;
                    for (int ps = 0; ps < 2; ++ps) PH(64) att::attn_block<att::MODE_SB>(base, N_AB, base + 2048, N_AB, base + 4096, N_AB, ob, DM, ps ? 7 - pr : pr, (LAS char*)F.lds, nullptr, nullptr, nullptr); }
                const bf16* QKDC = (const bf16*)(W + WS_QKDC); bf16* HD = (bf16*)(W + WS_HD); const float* A2 = (const float*)(W + WS_A2); const float* M2 = (const float*)(W + WS_M2); const float* NMv = (const float*)(W + WS_NM);
                for (int it = F.vcu; it < 512; it += F.G) { const int bv = it >> 2, pr = it & 3, b = bv >> 4, vh = bv & 15, h = vh >> 1, half = vh & 1;
                    const bf16* qd = QKDC + (size_t)b * SEQ * 2048 + h * 128; const bf16* vd = QKV + (size_t)b * SEQ * N_AB + 8192 + h * 256 + half * 128;
                    bf16* ob = HD + (size_t)b * SEQ * 2048 + h * 256 + half * 128; const size_t so = (size_t)(b * 8 + h) * SEQ;
                    for (int ps = 0; ps < 2; ++ps) PH(128) att::attn_block<att::MODE_ML>(qd, 2048, qd + 1024, 2048, vd, N_AB, ob, 2048, ps ? 7 - pr : pr, (LAS char*)F.lds, A2 + so, M2 + so, NMv + so); }
            }
        }
        if (layer == 1) { GRID_BAR(); PHASE_BEGIN PH(256) cd_post_phase(F, (const bf16*)(W + WS_HD), (const bf16*)(W + WS_QKV), (bf16*)(W + WS_Y), (const float*)ldin(args, 7)); }
        GRID_BAR();
        { PHASE_BEGIN
            pg8::Gemm g{(const bf16*)(W + WS_Y), (const bf16*)(W + (L == 0 ? WS_W_OUTAB : WS_W_OUTCD)), M, DM, DM};
            pg8::StaticOrder S; S.init(g.M, g.N, F.G, (int)blockIdx.x);
            pg8::EpiResid E{&args, (unsigned char*)W, L, 0, F.lds};
            PH(512) pg8::gemm_phase<pg8::EpiResid, pg8::StaticOrder, true, true>(F.lds, g, S, E);
        }
        GRID_BAR();
        { PHASE_BEGIN
            pg8::Gemm g{(const bf16*)(W + WS_XB), (const bf16*)(W + (L == 0 ? WS_W_UG0 : WS_W_UG1)), M, 2 * DFF, DM};
            pg8::StaticOrder S; S.init(g.M, g.N, F.G, (int)blockIdx.x);
            pg8::EpiFfnAct E{&args, (unsigned char*)W, L, F.lds};
            PH(2048) pg8::gemm_phase<pg8::EpiFfnAct, pg8::StaticOrder, true, true>(F.lds, g, S, E);
        }
        GRID_BAR();
        { PHASE_BEGIN PH(4096) ffn_fix_phase(F, (bf16*)(W + WS_U), (const float*)(W + WS_G), (const float*)(W + WS_G + 8 * MiB), (const float*)(W + WS_G + 16 * MiB), (const float*)ldin(args, 11) + (size_t)L * 3 * DFF, (const float*)ldin(args, 12) + (size_t)L * DFF); }
        GRID_BAR();
        { PHASE_BEGIN
            pg8::Gemm g{(const bf16*)(W + WS_U), (const bf16*)(W + (L == 0 ? WS_W_DN0 : WS_W_DN1)), M, DM, DFF};
            pg8::StaticOrder S; S.init(g.M, g.N, F.G, (int)blockIdx.x);
            pg8::EpiResid E{&args, (unsigned char*)W, L, 1, F.lds};
            PH(8192) pg8::gemm_phase<pg8::EpiResid, pg8::StaticOrder, true, true>(F.lds, g, S, E);
        }
        GRID_BAR();
        if (layer == 1) { PHASE_BEGIN PH(1024) ln_phase(F, args.out, args.out, nullptr, (const float*)ldin(args, 14) + (size_t)3 * DM, (const float*)ldin(args, 15) + (size_t)3 * DM); }
    }
#undef PHASE_BEGIN
}

extern "C" void kernel_launch(void* const* d_in, const int* in_sizes, int n_in, void* d_out, int out_size, void* d_ws, size_t ws_size, hipStream_t stream) {
    static int grid = 0;
    if (grid == 0) {
        if (n_in != 16 || in_sizes[0] != M * DM || out_size != M * DM || ws_size < WS_END) { fprintf(stderr, "kernel_launch: unexpected shapes (n_in %d, in0 %d, out %d, ws %zu < %zu)\n", n_in, n_in > 0 ? in_sizes[0] : -1, out_size, ws_size, (size_t)WS_END); grid = -1; return; }
        int dev = 0, cus = 0;
        if (hipGetDevice(&dev) != hipSuccess || hipDeviceGetAttribute(&cus, hipDeviceAttributeMultiprocessorCount, dev) != hipSuccess) { grid = -1; return; }
        if (hipFuncSetAttribute((const void*)mk_fwd, hipFuncAttributeMaxDynamicSharedMemorySize, LDS_BYTES) != hipSuccess) { fprintf(stderr, "kernel_launch: hipFuncSetAttribute failed\n"); grid = -1; return; }
        int per_cu = 0;
        if (hipOccupancyMaxActiveBlocksPerMultiprocessor(&per_cu, (const void*)mk_fwd, NWAVES * 64, LDS_BYTES) != hipSuccess || per_cu < 1) fprintf(stderr, "kernel_launch: occupancy query says %d\n", per_cu);
        (void)hipGetLastError();
        grid = cus;
    }
    if (grid < 0) return;
    if (hipMemsetAsync((char*)d_ws + WS_CTL, 0, CTL_ZERO_BYTES, stream) != hipSuccess) return;
    Args a{};
    for (int i = 0; i < 16; ++i) a.in[i] = (const float*)d_in[i];
    a.out = (float*)d_out; a.ws = (unsigned char*)d_ws;
    hipLaunchKernelGGL(mk_fwd, dim3(grid), dim3(NWAVES * 64), LDS_BYTES, stream, a);
}
```

```cpp
#include <hip/hip_runtime.h>
#include <cstdio>
#include <cstdint>

#define LAS __attribute__((address_space(3)))
#define GAS __attribute__((address_space(1)))
typedef unsigned short bf16;
typedef short bf16x8 __attribute__((ext_vector_type(8)));
typedef short s16x4 __attribute__((ext_vector_type(4)));
typedef float f32x16 __attribute__((ext_vector_type(16)));
typedef float f32x4 __attribute__((ext_vector_type(4)));
typedef float f32x2 __attribute__((ext_vector_type(2)));
typedef unsigned u32x4 __attribute__((ext_vector_type(4)));
typedef unsigned u32x2 __attribute__((ext_vector_type(2)));

#ifndef SKIP_MIX
#define SKIP_MIX 0
#endif
#ifndef SELFCHECK
#define SELFCHECK 0
#endif
#ifndef PH_MASK
#define PH_MASK 0xFFFF
#endif
#define PH(x) if constexpr ((PH_MASK & (x)) != 0)
#ifndef REP_MASK
#define REP_MASK 0
#endif
#define RP(x) _Pragma("unroll 1") for (int rep_ = 0; rep_ < (((REP_MASK) & (x)) ? 2 : 1); ++rep_)

constexpr int BATCH = 8, SEQ = 2048, DM = 4096, M = BATCH * SEQ;
constexpr int DFF = 11008, N_AB = 12288, N_CD = 12304, N_CDP = 12544;
constexpr float ALPHA = 1.4142135623730951f;
constexpr float LN_EPS = 1e-5f;
constexpr int NWAVES = 8;

constexpr size_t MiB = 1u << 20;
constexpr size_t WS_CTL = 0, CTL_ZERO_BYTES = 1 * MiB;
constexpr size_t WS_KMEAN = 1 * MiB;
constexpr size_t WS_GATES = 2 * MiB;
constexpr size_t WS_A2 = 3 * MiB;
constexpr size_t WS_M2 = 3 * MiB + 512 * 1024;
constexpr size_t WS_NM = 4 * MiB;
constexpr size_t WS_W_INAB = 8 * MiB, WS_W_OUTAB = 104 * MiB, WS_W_UG0 = 136 * MiB, WS_W_DN0 = 308 * MiB;
constexpr size_t WS_W_INCD = 394 * MiB, WS_W_OUTCD = 492 * MiB, WS_W_UG1 = 524 * MiB, WS_W_DN1 = 696 * MiB;
constexpr size_t WS_XB = 782 * MiB;
constexpr size_t WS_R = 910 * MiB;
constexpr size_t WS_QKV = WS_R, WS_Y = WS_R + 384 * MiB, WS_QKDC = WS_R + 512 * MiB, WS_HD = WS_R + 576 * MiB;
constexpr size_t WS_U = WS_R, WS_G = WS_R + 344 * MiB;
constexpr size_t WS_END = WS_R + 688 * MiB;
static_assert((size_t)M * DFF * 2 == 344 * MiB, "u/g size");
constexpr int CW_BAR = 4096;
constexpr size_t CTL_KN2 = 32768;
constexpr size_t CTL_STATS = 65536;
constexpr size_t CTL_CS_UG0 = 524288, CTL_BS_UG0 = CTL_CS_UG0 + 88064, CTL_CS_INCD = CTL_BS_UG0 + 88064, CTL_BS_INCD = CTL_CS_INCD + 50176, CTL_CS_UG1 = CTL_BS_INCD + 50176, CTL_BS_UG1 = CTL_CS_UG1 + 88064;
static_assert(CTL_BS_UG1 + 88064 <= CTL_ZERO_BYTES && CTL_STATS + 3 * (size_t)M * 8 <= CTL_CS_UG0, "CTL map");

constexpr int RING_BYTES = 131072;
constexpr int MISC_OFF = RING_BYTES + 320;
constexpr int LDS_BYTES = 147456;

#define LDS_WAIT() asm volatile("s_waitcnt lgkmcnt(0)" ::: "memory")
#define VM_WAIT() asm volatile("s_waitcnt vmcnt(0)" ::: "memory")
#define SBAR() __builtin_amdgcn_sched_barrier(0)
#define WG_BAR() do { asm volatile("" ::: "memory"); __builtin_amdgcn_s_barrier(); asm volatile("" ::: "memory"); } while (0)

__device__ __forceinline__ unsigned cvtpk(float lo, float hi) { unsigned r; asm volatile("v_cvt_pk_bf16_f32 %0, %1, %2" : "=v"(r) : "v"(lo), "v"(hi)); return r; }
__device__ __forceinline__ float bf_lo(unsigned w) { return __uint_as_float(w << 16); }
__device__ __forceinline__ float bf_hi(unsigned w) { return __uint_as_float(w & 0xffff0000u); }
__device__ __forceinline__ float wave_sum(float v) {
#pragma unroll
    for (int o = 1; o < 64; o <<= 1) v += __shfl_xor(v, o);
    return v;
}
__device__ __forceinline__ float silu_f(float y) { return y * __builtin_amdgcn_rcpf(1.0f + __builtin_amdgcn_exp2f(-1.4426950408889634f * y)); }

struct Args { const float* in[16]; float* out; unsigned char* ws; };
static_assert(sizeof(Args) == 18 * 8, "Args has no padding");
__device__ __forceinline__ const GAS float* ldin(const Args& a, int i) { asm volatile("" : "+s"(i)); return (const GAS float*)a.in[i]; }
__device__ __forceinline__ int opq_i(int v) { asm volatile("" : "+s"(v)); return v; }
__device__ __forceinline__ unsigned char* opq_p(unsigned char* p) { asm volatile("" : "+s"(p)); return p; }

namespace pg8 {
typedef unsigned short bf16_t;
constexpr int BM = 256, BK = 64, HALF = 128, HTB = HALF * BK * 2, STAGE_BYTES = 8 * HTB, NXCD = 8, WGM = 8;
__host__ __device__ __forceinline__ int lds_byte(int r, int c) { const int st = (r >> 4) * 2 + (c >> 5), rr = r & 15, cc = c & 31, ob = rr * 64 + cc * 2; return st * 1024 + (ob ^ (((ob >> 9) & 1) << 5)); }
__host__ __device__ __forceinline__ void stage_rc(int b, int& R, int& C) { const int st = b / 1024, sb = b % 1024, swz = sb ^ (((sb >> 9) & 1) << 5); R = (st >> 1) * 16 + swz / 64; C = (st & 1) * 32 + (swz % 64) / 2; }
__host__ __device__ __forceinline__ int perm32(int rho) { const int n = rho >> 4, i = rho & 15; return 8 * (i >> 2) + 4 * n + (i & 3); }
struct Unit { int pm, pn; };
struct Gemm { const bf16_t* A; const bf16_t* Bt; int M, N, K; };
struct StaticOrder {
    int nM, nN, nwg, G, c;
    __host__ __device__ void init(int M_, int N_, int G_, int c_) { nM = M_ / BM; nN = N_ / BM; nwg = nM * nN; G = G_; c = c_; }
    __host__ __device__ bool next(int i, Unit& u) const {
        const long L = (long)i * G + c; if (L >= nwg) return false;
        int wgid = (int)L; { const int q = nwg / NXCD, r = nwg % NXCD, xcd = wgid % NXCD, off = wgid / NXCD; wgid = (xcd < r ? xcd * (q + 1) : r * (q + 1) + (xcd - r) * q) + off; }
        const int nig = WGM * nN, gid = wgid / nig, fm = gid * WGM, gsz = (nM - fm) < WGM ? (nM - fm) : WGM;
        u.pm = fm + ((wgid % nig) % gsz); u.pn = (wgid % nig) / gsz; return true;
    }
    __device__ __forceinline__ void a_ready(const Unit&) const {}
    __device__ __forceinline__ void done(const Unit&) const {}
};
struct EpiBf16 {
    static constexpr bool PERM = true, AFTER_DRAIN = false;
    unsigned char* W; int L;
    __device__ __forceinline__ void operator()(const f32x4 (&acc)[2][2][4][2], const Unit& u, int wr_, int wc_, int fr_, int fq_) const {
        int tid_ = threadIdx.x; asm volatile("" : "+v"(tid_));
        GAS unsigned char* const Wg = (GAS unsigned char*)W;
        GAS bf16_t* const O = (GAS bf16_t*)(Wg + WS_QKV); constexpr int ldc = N_AB, split_cols = 0; constexpr size_t split_stride = 0; GAS float* const gates = (GAS float*)(Wg + WS_GATES); const int gate_pn = L == 0 ? -1 : 48;
        const GAS float* const st = L == 0 ? nullptr : (const GAS float*)(Wg + WS_CTL + CTL_STATS) + (size_t)1 * M * 2;
        const GAS float* const cs = (const GAS float*)(Wg + WS_CTL + CTL_CS_INCD); const GAS float* const bs = (const GAS float*)(Wg + WS_CTL + CTL_BS_INCD);
        const int wid = __builtin_amdgcn_readfirstlane(tid_ >> 6), wr = wid >> 2, wc = wid & 3, fr = tid_ & 15, fq = (tid_ & 63) >> 4;
        const int row0 = u.pm * BM + wr * 64 + fr;
        const int colg = u.pn * BM + wc * 32 + 8 * fq;
        f32x4 csv[2][2], bsv[2][2];
        if (st) {
#pragma unroll
            for (int bj = 0; bj < 2; ++bj)
#pragma unroll
                for (int n = 0; n < 2; ++n) { csv[bj][n] = *(const f32x4*)(cs + colg + bj * HALF + 4 * n); bsv[bj][n] = *(const f32x4*)(bs + colg + bj * HALF + 4 * n); }
        }
        int colt = u.pn * BM; GAS bf16_t* base = O;
        if (split_cols) { const int t = colt / split_cols; base += (size_t)t * split_stride; colt -= t * split_cols; }
        const int col0 = colt + wc * 32 + 8 * fq;
        const GAS float* stp = st + (size_t)row0 * 2;
#pragma unroll
        for (int ai = 0; ai < 2; ++ai)
#pragma unroll
            for (int m = 0; m < 4; ++m) { const int row = row0 + ai * HALF + m * 16;
                float mu = 0.f, rs = 1.f;
                if (st) { const f32x2 sv = *(const f32x2*)(stp + (ai * HALF + m * 16) * 2); mu = sv[0] * (1.f / DM); rs = __builtin_amdgcn_rsqf(sv[1] * (1.f / DM) - mu * mu + LN_EPS); }
                f32x4 v[2][2];
#pragma unroll
                for (int bj = 0; bj < 2; ++bj)
#pragma unroll
                    for (int n = 0; n < 2; ++n) v[bj][n] = st ? (acc[ai][bj][m][n] - csv[bj][n] * mu) * rs + bsv[bj][n] : acc[ai][bj][m][n];
                if (u.pn == gate_pn) { if (wc == 0 && fq < 2) { GAS float* gp = gates + (size_t)row * 16 + 8 * fq; *(GAS f32x4*)gp = v[0][0]; *(GAS f32x4*)(gp + 4) = v[0][1]; } }
                else { GAS bf16_t* rowp = base + (size_t)row * ldc + col0;
#pragma unroll
                    for (int bj = 0; bj < 2; ++bj) { u32x4 w; w.x = cvtpk(v[bj][0][0], v[bj][0][1]); w.y = cvtpk(v[bj][0][2], v[bj][0][3]); w.z = cvtpk(v[bj][1][0], v[bj][1][1]); w.w = cvtpk(v[bj][1][2], v[bj][1][3]);
                        *(u32x4*)(rowp + bj * HALF) = w; } } }
    }
};
struct EpiResid {
    static constexpr bool PERM = true, AFTER_DRAIN = false;
    const Args* ap; unsigned char* W; int L, which; LAS unsigned char* lds;
    __device__ __forceinline__ void operator()(const f32x4 (&acc)[2][2][4][2], const Unit& u, int wr_, int wc_, int fr_, int fq_) const {
        int tid_ = threadIdx.x; asm volatile("" : "+v"(tid_));
        const int wid = __builtin_amdgcn_readfirstlane(tid_ >> 6), wr = wid >> 2, wc = wid & 3, lane = tid_ & 63, fr = tid_ & 15, fq = (tid_ & 63) >> 4;
        GAS unsigned char* const Wg = (GAS unsigned char*)W; GAS float* const STATS = (GAS float*)(Wg + WS_CTL + CTL_STATS);
        const bool lastsub = (which == 1 && L == 1);
        const GAS bf16_t* const zbin = (const GAS bf16_t*)(Wg + WS_XB); GAS bf16_t* const zb = lastsub ? nullptr : (GAS bf16_t*)(Wg + WS_XB); GAS float* const out32 = lastsub ? (GAS float*)ap->out : nullptr;
        const GAS float* const st_in = which == 0 ? (L == 0 ? nullptr : STATS + (size_t)1 * M * 2) : STATS + (size_t)(L == 0 ? 0 : 2) * M * 2;
        GAS float* const st_out = which == 0 ? STATS + (size_t)(L == 0 ? 0 : 2) * M * 2 : (L == 0 ? STATS + (size_t)1 * M * 2 : nullptr);
        const int lnoff = which == 0 ? DM : 2 * L * DM;
        const GAS float* const lg = ldin(*ap, 14) + lnoff; const GAS float* const lb = ldin(*ap, 15) + lnoff;
        constexpr float alpha = ALPHA; LAS float* const red = (LAS float*)(lds + RING_BYTES + 1024);
        constexpr int ldc = DM;
        const int row0 = u.pm * BM + wr * 64 + fr, col0 = u.pn * BM + wc * 32 + 8 * fq;
        LAS float* myred = red + wid * 256;
#pragma unroll
        for (int ai = 0; ai < 2; ++ai) { u32x4 xr[4][2]; f32x2 sv[4]; f32x4 s1 = {0.f, 0.f, 0.f, 0.f}, s2 = {0.f, 0.f, 0.f, 0.f};
#pragma unroll
            for (int m = 0; m < 4; ++m) { const size_t off = (size_t)(row0 + ai * HALF + m * 16) * ldc + col0;
                xr[m][0] = *(const GAS u32x4*)(zbin + off); xr[m][1] = *(const GAS u32x4*)(zbin + off + HALF); sv[m] = st_in ? *(const GAS f32x2*)(st_in + (size_t)row0 * 2 + (ai * HALF + m * 16) * 2) : (f32x2){0.f, 0.f}; }
#pragma unroll
            for (int bj = 0; bj < 2; ++bj) {
                f32x4 gv[2], bv[2];
#pragma unroll
                for (int n = 0; n < 2; ++n) { gv[n] = st_in ? *(const GAS f32x4*)(lg + col0 + bj * HALF + 4 * n) : (f32x4){1.f, 1.f, 1.f, 1.f}; bv[n] = st_in ? *(const GAS f32x4*)(lb + col0 + bj * HALF + 4 * n) : (f32x4){0.f, 0.f, 0.f, 0.f}; }
#pragma unroll
                for (int m = 0; m < 4; ++m) { const float mu = sv[m][0] * (1.f / DM), rs = st_in ? __builtin_amdgcn_rsqf(sv[m][1] * (1.f / DM) - mu * mu + LN_EPS) : 1.f;
                    const u32x4 r = xr[m][bj]; const size_t off = (size_t)(row0 + ai * HALF + m * 16) * ldc + col0 + bj * HALF;
                    const f32x4 z0 = (((f32x4){bf_lo(r.x), bf_hi(r.x), bf_lo(r.y), bf_hi(r.y)} - mu) * rs * gv[0] + bv[0]) * alpha + acc[ai][bj][m][0];
                    const f32x4 z1 = (((f32x4){bf_lo(r.z), bf_hi(r.z), bf_lo(r.w), bf_hi(r.w)} - mu) * rs * gv[1] + bv[1]) * alpha + acc[ai][bj][m][1];
                    if (out32) { *(GAS f32x4*)(out32 + off) = z0; *(GAS f32x4*)(out32 + off + 4) = z1; }
                    if (zb) { u32x4 w; w.x = cvtpk(z0[0], z0[1]); w.y = cvtpk(z0[2], z0[3]); w.z = cvtpk(z1[0], z1[1]); w.w = cvtpk(z1[2], z1[3]); *(GAS u32x4*)(zb + off) = w; }
                    s1[m] += (z0[0] + z0[1]) + (z0[2] + z0[3]) + (z1[0] + z1[1]) + (z1[2] + z1[3]);
                    s2[m] += (z0[0] * z0[0] + z0[1] * z0[1]) + (z0[2] * z0[2] + z0[3] * z0[3]) + (z1[0] * z1[0] + z1[1] * z1[1]) + (z1[2] * z1[2] + z1[3] * z1[3]); }
            }
            if (st_out) {
#pragma unroll
                for (int m = 0; m < 4; ++m) { float a1 = s1[m], a2 = s2[m]; a1 += __shfl_xor(a1, 16); a1 += __shfl_xor(a1, 32); a2 += __shfl_xor(a2, 16); a2 += __shfl_xor(a2, 32);
                    if (fq == 0) *(LAS f32x2*)(myred + ((ai * 4 + m) * 16 + fr) * 2) = (f32x2){a1, a2}; } }
            asm volatile("" ::: "memory"); }
        if (st_out) {
            asm volatile("s_waitcnt lgkmcnt(0)" ::: "memory");
            GAS float* sp = st_out + (size_t)(u.pm * BM + wr * 64) * 2;
#pragma unroll
            for (int j = 0; j < 4; ++j) { const int idx = j * 64 + lane, g = idx >> 5, r = (idx & 31) >> 1, c = idx & 1;
                unsafeAtomicAdd((float*)(sp + ((g >> 2) * HALF + (g & 3) * 16 + r) * 2 + c), myred[idx]); }
            asm volatile("s_waitcnt lgkmcnt(0)" ::: "memory");
        }
    }
};

__device__ __forceinline__ float dpp_ror1(float x) { return __int_as_float(__builtin_amdgcn_update_dpp(0, __float_as_int(x), 0x121, 0xF, 0xF, false)); }
__device__ __forceinline__ float dpp_ror2(float x) { return __int_as_float(__builtin_amdgcn_update_dpp(0, __float_as_int(x), 0x122, 0xF, 0xF, false)); }
struct EpiFfnAct {
    static constexpr bool PERM = true, AFTER_DRAIN = false;
    const Args* ap; unsigned char* W; int L; LAS unsigned char* lds;
    __device__ __forceinline__ void operator()(f32x4 (&acc)[2][2][4][2], const Unit& u, int wr_, int wc_, int fr_, int fq_) const {
        int tid_ = threadIdx.x; asm volatile("" : "+v"(tid_));
        GAS unsigned char* const Wg = (GAS unsigned char*)W;
        GAS bf16_t* const H = (GAS bf16_t*)(Wg + WS_U); const GAS float* const cw = ldin(*ap, 11) + (size_t)L * 3 * DFF; const GAS float* const cb = ldin(*ap, 12) + (size_t)L * DFF;
        GAS float* const EG0 = (GAS float*)(Wg + WS_G); GAS float* const EU0 = (GAS float*)(Wg + WS_G + 8 * MiB); GAS float* const EGL = (GAS float*)(Wg + WS_G + 16 * MiB); LAS float* const edge = (LAS float*)(lds + RING_BYTES + 1024);
        const GAS float* const st = (const GAS float*)(Wg + WS_CTL + CTL_STATS) + (size_t)(L == 0 ? 0 : 2) * M * 2;
        const GAS float* const cs = (const GAS float*)(Wg + WS_CTL + (L == 0 ? CTL_CS_UG0 : CTL_CS_UG1)); const GAS float* const bs = (const GAS float*)(Wg + WS_CTL + (L == 0 ? CTL_BS_UG0 : CTL_BS_UG1));
        const int wid = __builtin_amdgcn_readfirstlane(tid_ >> 6), wr = wid >> 2, wc = wid & 3, fr = tid_ & 15, fq = (tid_ & 63) >> 4;
        const int ch0 = u.pn * 128 + wc * 32 + fq * 8, row0 = u.pm * BM + wr * 64 + fr, colg = u.pn * BM + wc * 32 + 8 * fq;
        const GAS float* stp = st + (size_t)row0 * 2;
        f32x2 sv[2][4]; f32x4 csg[2], bsg[2];
#pragma unroll
        for (int ai = 0; ai < 2; ++ai)
#pragma unroll
            for (int m = 0; m < 4; ++m) sv[ai][m] = *(const f32x2*)(stp + (ai * HALF + m * 16) * 2);
#pragma unroll
        for (int n = 0; n < 2; ++n) { csg[n] = *(const f32x4*)(cs + colg + HALF + 4 * n); bsg[n] = *(const f32x4*)(bs + colg + HALF + 4 * n); }
        float mu[2][4], rs[2][4];
#pragma unroll
        for (int ai = 0; ai < 2; ++ai)
#pragma unroll
            for (int m = 0; m < 4; ++m) { mu[ai][m] = sv[ai][m][0] * (1.f / DM); rs[ai][m] = __builtin_amdgcn_rsqf(sv[ai][m][1] * (1.f / DM) - mu[ai][m] * mu[ai][m] + LN_EPS);
#pragma unroll
                for (int n = 0; n < 2; ++n) acc[ai][1][m][n] = (acc[ai][1][m][n] - csg[n] * mu[ai][m]) * rs[ai][m] + bsg[n];
                asm volatile("" : "+v"(acc[ai][1][m][0]), "+v"(acc[ai][1][m][1])); }
        asm volatile("" ::: "memory");
        f32x4 csu[2], bsu[2], wt[4][2];
#pragma unroll
        for (int n = 0; n < 2; ++n) { csu[n] = *(const f32x4*)(cs + colg + 4 * n); bsu[n] = *(const f32x4*)(bs + colg + 4 * n);
            wt[0][n] = *(const f32x4*)(cw + ch0 + 4 * n); wt[1][n] = *(const f32x4*)(cw + DFF + ch0 + 4 * n); wt[2][n] = *(const f32x4*)(cw + 2 * DFF + ch0 + 4 * n); wt[3][n] = *(const f32x4*)(cb + ch0 + 4 * n); }
#define FFN_G(ai, m, n) (acc[ai][1][m][n])
#define FFN_U(ai, m, n) ((acc[ai][0][m][n] - csu[n] * mu[ai][m]) * rs[ai][m] + bsu[n])
        if (fr >= 14) {
#pragma unroll
            for (int ai = 0; ai < 2; ++ai) { LAS float* e = edge + ((((ai * 2 + wr) * 4 + wc) * 4 + fq) * 2 + (fr - 14)) * 8; *(LAS f32x4*)e = FFN_G(ai, 3, 0); *(LAS f32x4*)(e + 4) = FFN_G(ai, 3, 1); }
            if (wr == 1) { GAS float* p = EGL + (size_t)(u.pm * 2 + (fr - 14)) * DFF + ch0; *(GAS f32x4*)p = FFN_G(1, 3, 0); *(GAS f32x4*)(p + 4) = FFN_G(1, 3, 1); }
        }
        if (wr == 0 && fr < 2) { GAS float* pg = EG0 + (size_t)(u.pm * 2 + fr) * DFF + ch0; GAS float* pu = EU0 + (size_t)(u.pm * 2 + fr) * DFF + ch0;
            *(GAS f32x4*)pg = FFN_G(0, 0, 0); *(GAS f32x4*)(pg + 4) = FFN_G(0, 0, 1); *(GAS f32x4*)pu = FFN_U(0, 0, 0); *(GAS f32x4*)(pu + 4) = FFN_U(0, 0, 1); }
        asm volatile("s_waitcnt lgkmcnt(0)" ::: "memory"); __builtin_amdgcn_s_barrier(); asm volatile("" ::: "memory");
#pragma unroll
        for (int ai = 0; ai < 2; ++ai) {
            f32x4 e14[2] = {(f32x4){0.f, 0.f, 0.f, 0.f}, (f32x4){0.f, 0.f, 0.f, 0.f}}, e15[2] = {(f32x4){0.f, 0.f, 0.f, 0.f}, (f32x4){0.f, 0.f, 0.f, 0.f}};
            if (wr == 1 || ai == 1) { const int sa = (wr == 1) ? ai : 0, sw = (wr == 1) ? 0 : 1; const LAS float* e = edge + (((sa * 2 + sw) * 4 + wc) * 4 + fq) * 16;
                e14[0] = *(const LAS f32x4*)e; e14[1] = *(const LAS f32x4*)(e + 4); e15[0] = *(const LAS f32x4*)(e + 8); e15[1] = *(const LAS f32x4*)(e + 12); }
#pragma unroll
            for (int m = 0; m < 4; ++m) {
                float hv[8];
#pragma unroll
                for (int n = 0; n < 2; ++n) { const f32x4 uu = FFN_U(ai, m, n);
#pragma unroll
                    for (int j = 0; j < 4; ++j) { const int c = 4 * n + j; const float gc = acc[ai][1][m][n][j]; const float r1 = dpp_ror1(gc), r2 = dpp_ror2(gc);
                        float q1, q2;
                        if (m == 0) { q1 = e15[n][j]; q2 = (fr == 0) ? e14[n][j] : e15[n][j]; }
                        else { const float gpv = acc[ai][1][m > 0 ? m - 1 : 0][n][j]; q1 = dpp_ror1(gpv); q2 = dpp_ror2(gpv); }
                        const float p1 = (fr == 0) ? q1 : r1, p2 = (fr < 2) ? q2 : r2;
                        const float y = wt[0][n][j] * p2 + wt[1][n][j] * p1 + wt[2][n][j] * gc + wt[3][n][j];
                        hv[c] = silu_f(y) * uu[j]; } }
                if (!(ai == 0 && m == 0 && wr == 0 && fr < 2)) { u32x4 w; w.x = cvtpk(hv[0], hv[1]); w.y = cvtpk(hv[2], hv[3]); w.z = cvtpk(hv[4], hv[5]); w.w = cvtpk(hv[6], hv[7]);
                    *(u32x4*)(H + (size_t)(row0 + ai * HALF + m * 16) * DFF + ch0) = w; }
            }
        }
#undef FFN_G
#undef FFN_U
    }
};

template <class Epi, class Sched, bool ALIGN_EPI = false, bool SP2 = false>
__device__ __forceinline__ void gemm_phase(LAS unsigned char* lds, const Gemm g, const Sched& S, const Epi& E) {
    int tid_ = threadIdx.x; asm volatile("" : "+v"(tid_));
    const int tid = tid_, wid = __builtin_amdgcn_readfirstlane(tid >> 6), lane = tid & 63, wr = wid >> 2, wc = wid & 3, fr = lane & 15, fq = lane >> 4;
    const int K = g.K, nt = K / BK;
    unsigned voffA[2], voffB[2];
#pragma unroll
    for (int i = 0; i < 2; ++i) { int R, C; stage_rc(tid * 16 + i * 8192, R, C); const int Rb = Epi::PERM ? ((R & ~31) + perm32(R & 31)) : R;
        voffA[i] = (unsigned)(R * K + C) * 2u; voffB[i] = (unsigned)(Rb * K + C) * 2u; }
    const size_t kstep = (size_t)(BK * 2);
    const size_t hstep = (size_t)HALF * K * 2;
    const size_t tstep = 2 * hstep;
    const unsigned ldsw = (unsigned)wid * 1024u;
    const int aoff = lds_byte(wr * 64 + fr, fq * 8), boff = lds_byte(wc * 32 + fr, fq * 8);
#define PG8_SA(b, h) (((b) * 2 + (h)) * HTB)
#define PG8_SB(b, h) ((4 + (b) * 2 + (h)) * HTB)
#define PG8_STAGE(bufoff, gbase, voff) do { _Pragma("unroll") for (int _i = 0; _i < 2; ++_i) \
        __builtin_amdgcn_global_load_lds((const unsigned*)((const char*)(gbase) + (voff)[_i]), (LAS unsigned*)(lds + (bufoff) + ldsw + _i * 8192), 16, 0, 0); } while (0)
#define PG8_LDA(dst, b, h) do { _Pragma("unroll") for (int m = 0; m < 4; ++m) _Pragma("unroll") for (int k = 0; k < 2; ++k) dst[m][k] = *(const LAS bf16x8*)(lds + PG8_SA(b, h) + aoff + m * 2048 + k * 1024); } while (0)
#define PG8_LDB(dst, b, h) do { _Pragma("unroll") for (int n = 0; n < 2; ++n) _Pragma("unroll") for (int k = 0; k < 2; ++k) dst[n][k] = *(const LAS bf16x8*)(lds + PG8_SB(b, h) + boff + n * 2048 + k * 1024); } while (0)
#define PG8_MMA(ai, bj, At, Bt) do { __builtin_amdgcn_s_setprio(1); _Pragma("unroll") for (int m = 0; m < 4; ++m) _Pragma("unroll") for (int n = 0; n < 2; ++n) _Pragma("unroll") for (int k = 0; k < 2; ++k) \
        acc[ai][bj][m][n] = __builtin_amdgcn_mfma_f32_16x16x32_bf16(Bt[n][k], At[m][k], acc[ai][bj][m][n], 0, 0, 0); __builtin_amdgcn_s_setprio(0); } while (0)
#define PG8_WAIT_V(n) asm volatile("s_waitcnt vmcnt(" #n ")" ::: "memory")
#define PG8_WAIT_L(n) asm volatile("s_waitcnt lgkmcnt(" #n ")" ::: "memory")
#define PG8_BAR __builtin_amdgcn_s_barrier()
#define PG8_SCHED __builtin_amdgcn_sched_barrier(0)
    Unit cur, nxt; int ui = 0;
    if (!S.next(0, cur)) return;
    f32x4 acc[2][2][4][2];
#pragma unroll
    for (int a = 0; a < 2; ++a)
#pragma unroll
        for (int b = 0; b < 2; ++b)
#pragma unroll
            for (int m = 0; m < 4; ++m)
#pragma unroll
                for (int n = 0; n < 2; ++n) acc[a][b][m][n] = (f32x4){0.f, 0.f, 0.f, 0.f};
    bf16x8 At[4][2], B0[2][2], B1[2][2];
    const char* cA = (const char*)g.A + (size_t)cur.pm * tstep; const char* cB = (const char*)g.Bt + (size_t)cur.pn * tstep;
    S.a_ready(cur);
    if constexpr (SP2) {
        PG8_STAGE(PG8_SB(0, 0), cB, voffB); PG8_STAGE(PG8_SB(0, 1), cB + hstep, voffB); PG8_STAGE(PG8_SA(0, 0), cA, voffA); PG8_STAGE(PG8_SA(0, 1), cA + hstep, voffA);
        if (wr == 1) PG8_BAR;
        PG8_WAIT_V(2); PG8_BAR;
        PG8_STAGE(PG8_SB(1, 0), cB + kstep, voffB); PG8_STAGE(PG8_SA(1, 0), cA + kstep, voffA); PG8_STAGE(PG8_SB(1, 1), cB + hstep + kstep, voffB);
        PG8_WAIT_V(6); PG8_BAR;
    } else {
        PG8_STAGE(PG8_SB(0, 0), cB, voffB); PG8_STAGE(PG8_SA(0, 0), cA, voffA); PG8_STAGE(PG8_SB(0, 1), cB + hstep, voffB); PG8_STAGE(PG8_SA(0, 1), cA + hstep, voffA);
        if (wr == 1) PG8_BAR;
        PG8_WAIT_V(4); PG8_BAR;
        PG8_STAGE(PG8_SB(1, 0), cB + kstep, voffB); PG8_STAGE(PG8_SA(1, 0), cA + kstep, voffA); PG8_STAGE(PG8_SB(1, 1), cB + hstep + kstep, voffB);
        PG8_WAIT_V(6); PG8_BAR;
    }
    for (;;) {
        const bool has_next = S.next(ui + 1, nxt);
        const char* nA = has_next ? (const char*)g.A + (size_t)nxt.pm * tstep : cA; const char* nB = has_next ? (const char*)g.Bt + (size_t)nxt.pn * tstep : cB;
        for (int t = 0; t < nt; t += 2) {
            const bool last = (t == nt - 2);
            const char* a1 = cA + (size_t)(t + 1) * kstep;
            const char* a2 = last ? nA : cA + (size_t)(t + 2) * kstep; const char* b2 = last ? nB : cB + (size_t)(t + 2) * kstep;
            const char* a3 = a2 + kstep; const char* b3 = b2 + kstep;
            if (last && has_next) S.a_ready(nxt);
            if constexpr (SP2) {
            PG8_LDB(B0, 0, 0); PG8_LDB(B1, 0, 1); PG8_SCHED; PG8_LDA(At, 0, 0); PG8_STAGE(PG8_SA(1, 1), a1 + hstep, voffA);
            PG8_WAIT_V(8); PG8_WAIT_L(0); PG8_BAR; PG8_MMA(0, 0, At, B0); PG8_MMA(0, 1, At, B1); PG8_BAR; PG8_SCHED;
            PG8_LDA(At, 0, 1); PG8_STAGE(PG8_SB(0, 0), b2, voffB); PG8_STAGE(PG8_SB(0, 1), b2 + hstep, voffB); PG8_STAGE(PG8_SA(0, 0), a2, voffA);
            PG8_WAIT_V(8); PG8_WAIT_L(0); PG8_BAR; PG8_MMA(1, 0, At, B0); PG8_MMA(1, 1, At, B1); PG8_BAR; PG8_SCHED;
            PG8_LDB(B0, 1, 0); PG8_LDB(B1, 1, 1); PG8_SCHED; PG8_LDA(At, 1, 0); PG8_STAGE(PG8_SA(0, 1), a2 + hstep, voffA);
            PG8_WAIT_V(8); PG8_WAIT_L(0); PG8_BAR; PG8_MMA(0, 0, At, B0); PG8_MMA(0, 1, At, B1); PG8_BAR; PG8_SCHED;
            PG8_LDA(At, 1, 1); PG8_STAGE(PG8_SB(1, 0), b3, voffB); PG8_STAGE(PG8_SB(1, 1), b3 + hstep, voffB); PG8_STAGE(PG8_SA(1, 0), a3, voffA);
            PG8_WAIT_V(8); PG8_WAIT_L(0); PG8_BAR; PG8_MMA(1, 0, At, B0); PG8_MMA(1, 1, At, B1); PG8_BAR; PG8_SCHED;
            } else {
            PG8_LDB(B0, 0, 0); PG8_SCHED; PG8_LDA(At, 0, 0); PG8_STAGE(PG8_SA(1, 1), a1 + hstep, voffA);
            PG8_WAIT_L(8); PG8_BAR; PG8_WAIT_L(0); PG8_MMA(0, 0, At, B0); PG8_BAR; PG8_SCHED;
            PG8_LDB(B1, 0, 1); PG8_STAGE(PG8_SB(0, 0), b2, voffB);
            PG8_BAR; PG8_WAIT_L(0); PG8_MMA(0, 1, At, B1); PG8_BAR;
            PG8_LDA(At, 0, 1); PG8_STAGE(PG8_SA(0, 0), a2, voffA);
            PG8_BAR; PG8_WAIT_L(0); PG8_MMA(1, 0, At, B0); PG8_BAR; PG8_SCHED;
            PG8_STAGE(PG8_SB(0, 1), b2 + hstep, voffB);
            PG8_WAIT_V(6); PG8_BAR; PG8_MMA(1, 1, At, B1); PG8_BAR;
            PG8_LDB(B0, 1, 0); PG8_SCHED; PG8_LDA(At, 1, 0); PG8_STAGE(PG8_SA(0, 1), a2 + hstep, voffA);
            PG8_WAIT_L(8); PG8_BAR; PG8_WAIT_L(0); PG8_MMA(0, 0, At, B0); PG8_BAR; PG8_SCHED;
            PG8_LDB(B1, 1, 1); PG8_STAGE(PG8_SB(1, 0), b3, voffB);
            PG8_BAR; PG8_WAIT_L(0); PG8_MMA(0, 1, At, B1); PG8_BAR;
            PG8_LDA(At, 1, 1); PG8_STAGE(PG8_SA(1, 0), a3, voffA);
            PG8_BAR; PG8_WAIT_L(0); PG8_MMA(1, 0, At, B0); PG8_BAR; PG8_SCHED;
            PG8_STAGE(PG8_SB(1, 1), b3 + hstep, voffB);
            PG8_WAIT_V(6); PG8_BAR; PG8_MMA(1, 1, At, B1); PG8_BAR;
            }
        }
        if constexpr (ALIGN_EPI) { if (wr == 0) PG8_BAR; }
        if constexpr (!Epi::AFTER_DRAIN) { E(acc, cur, wr, wc, fr, fq); S.done(cur); }
        if (!has_next) break;
#pragma unroll
        for (int a = 0; a < 2; ++a)
#pragma unroll
            for (int b = 0; b < 2; ++b)
#pragma unroll
                for (int m = 0; m < 4; ++m)
#pragma unroll
                    for (int n = 0; n < 2; ++n) acc[a][b][m][n] = (f32x4){0.f, 0.f, 0.f, 0.f};
        cur = nxt; cA = nA; cB = nB; ++ui;
        if constexpr (ALIGN_EPI) { if (wr == 1) PG8_BAR; }
    }
    PG8_WAIT_V(0);
    if constexpr (!ALIGN_EPI) { if (wr == 0) PG8_BAR; }
    PG8_BAR;
#undef PG8_SA
#undef PG8_SB
#undef PG8_STAGE
#undef PG8_LDA
#undef PG8_LDB
#undef PG8_MMA
#undef PG8_WAIT_V
#undef PG8_WAIT_L
#undef PG8_BAR
#undef PG8_SCHED
}
}

#define XB_TMO      128
#define XB_XCNT(j)  (256  + 64 * (j))
#define XB_XSUB(j)  (1280 + 64 * (j))
#define XB_XGEN(j)  (2304 + 64 * (j))
#define XB_TOP      3328
#define XB_TOPGEN   3392
#define XCD_BAR_WORDS 3456
#define XB_SPIN_CAP (1u << 18)
__device__ __forceinline__ unsigned xb_ld(unsigned* p)              { return __hip_atomic_load((GAS unsigned*)p, __ATOMIC_RELAXED, __HIP_MEMORY_SCOPE_AGENT); }
__device__ __forceinline__ unsigned xb_add(unsigned* p, unsigned v) { return __hip_atomic_fetch_add((GAS unsigned*)p, v, __ATOMIC_RELAXED, __HIP_MEMORY_SCOPE_AGENT); }
__device__ __forceinline__ unsigned xb_xcc_id() { return (unsigned)__builtin_amdgcn_s_getreg((3 << 11) | 20) & 0xFu; }
#define XB_SPIN(cond, bar) do { unsigned _sp = 0; while (cond) { __builtin_amdgcn_s_sleep(1); \
    if ((++_sp & 255u) == 0u) { if (xb_ld(&(bar)[XB_TMO])) break; if (_sp > XB_SPIN_CAP) { (void)xb_add(&(bar)[XB_TMO], 1u); break; } } } } while (0)
struct XcdBarrier { unsigned* bar; unsigned x; volatile LAS unsigned* st; };
__device__ __forceinline__ XcdBarrier xcd_barrier_post(unsigned* bar, volatile LAS unsigned* st) {
    XcdBarrier b; b.bar = bar; b.x = xb_xcc_id(); b.st = st;
    if (threadIdx.x == 0) (void)xb_add(&bar[XB_XCNT(b.x)], 1u);
    return b;
}
__device__ __forceinline__ void xcd_barrier_complete(unsigned* bar, unsigned x, unsigned& nloc, unsigned& nx) {
    const unsigned G = gridDim.x * gridDim.y * gridDim.z;
    unsigned sum, cnt, mine, sp = 0u;
    for (;;) {
        sum = 0u; cnt = 0u; mine = 0u;
#pragma unroll
        for (unsigned j = 0; j < 16; ++j) { const unsigned c = xb_ld(&bar[XB_XCNT(j)]); sum += c; cnt += (c > 0u) ? 1u : 0u; mine = (j == x) ? c : mine; }
        if (sum == G) break;
        __builtin_amdgcn_s_sleep(1);
        if ((++sp & 255u) == 0u) { if (xb_ld(&bar[XB_TMO])) break; if (sp > XB_SPIN_CAP) { (void)xb_add(&bar[XB_TMO], 1u); break; } }
    }
    nloc = mine > 0u ? mine : 1u; nx = cnt > 0u ? cnt : 1u;
}
__device__ __forceinline__ void xcd_barrier(const XcdBarrier& b) {
    asm volatile("s_waitcnt vmcnt(0)" ::: "memory");
    __syncthreads();
    if (threadIdx.x == 0) {
        unsigned* bar = b.bar; unsigned bx = b.x;
        asm volatile("" : "+s"(bar), "+s"(bx));
        __builtin_amdgcn_s_waitcnt(0);
        unsigned nloc = b.st[0], nx = b.st[1];
        if (nloc == 0u) { xcd_barrier_complete(bar, bx, nloc, nx); b.st[0] = nloc; b.st[1] = nx; }
        const unsigned old = xb_add(&bar[XB_XSUB(bx)], 1u);
        const unsigned gen = old / nloc;
        if (old + 1u == (gen + 1u) * nloc) {
            __builtin_amdgcn_fence(__ATOMIC_RELEASE, "agent");
            asm volatile("s_waitcnt vmcnt(0)" ::: "memory");
            const unsigned og = xb_add(&bar[XB_TOP], 1u);
            const unsigned tg = og / nx;
            if (og + 1u == (tg + 1u) * nx) xb_add(&bar[XB_TOPGEN], 1u);
            else XB_SPIN(xb_ld(&bar[XB_TOPGEN]) == tg, bar);
            __builtin_amdgcn_fence(__ATOMIC_ACQUIRE, "agent");
            xb_add(&bar[XB_XGEN(bx)], 1u);
            asm volatile("s_waitcnt vmcnt(0)" ::: "memory");
        } else {
            XB_SPIN(xb_ld(&bar[XB_XGEN(bx)]) == gen, bar);
            __builtin_amdgcn_fence(__ATOMIC_ACQUIRE, "agent");
            asm volatile("s_waitcnt vmcnt(0)" ::: "memory");
        }
    }
    __syncthreads();
}

namespace att {
constexpr int D = 128, SHM = 16384;
constexpr int OFF_V = 0, OFF_K = 2 * SHM, OFF_WS = 4 * SHM, OFF_AUX = 4 * SHM + 2048, LDS_USED = 4 * SHM + 2048 + 8192;
constexpr float SCALE = 0.08838834764831845f;
constexpr float C2 = 1.4426950408889634f * SCALE;
constexpr float THR = 8.f;
enum { MODE_DIL = 0, MODE_MOBA = 1, MODE_SB = 2, MODE_ML = 3 };
#define KSWZ(row, colB) ((row) * 256 + ((colB) ^ (((row) & 7) << 4)))
__device__ __forceinline__ int v_st(int k, int c) { const int kk = (k & ~0xC) | ((k & 4) << 1) | ((k & 8) >> 1); return ((kk >> 3) * 4 + (c >> 5)) * 512 + ((kk & 7) * 32 + (c & 31)) * 2; }
__device__ __forceinline__ int v_rd_base(int lane) { return ((lane & 3) << 3) | (((lane >> 2) & 3) << 6) | (((lane >> 4) & 1) << 5) | (((lane >> 5) & 1) << 8); }
__device__ __forceinline__ int crow(int r, int hi) { return (r & 3) + 8 * (r >> 2) + 4 * hi; }
__device__ __forceinline__ void mask_tile(f32x16& p0, f32x16& p1, int dq) {
    const float NEG = -__builtin_inff();
#pragma unroll
    for (int r = 0; r < 16; ++r) {
        const int c = (r & 3) + 8 * (r >> 2);
        if (dq - c < 0) p0[r] = NEG;
        if (dq - c - 32 < 0) p1[r] = NEG;
    }
}
__device__ __forceinline__ void partialSM(f32x16& p0, f32x16& p1, float& m_reg, float& mn, float& alpha) {
    float pmax = p0[0];
#pragma unroll
    for (int r = 1; r < 16; ++r) pmax = fmaxf(pmax, p0[r]);
#pragma unroll
    for (int r = 0; r < 16; ++r) pmax = fmaxf(pmax, p1[r]);
    { auto rr = __builtin_amdgcn_permlane32_swap(__float_as_uint(pmax), __float_as_uint(pmax), false, false);
      pmax = fmaxf(__uint_as_float(rr[0]), __uint_as_float(rr[1])); }
    if (__builtin_expect(__all((pmax - m_reg) * SCALE <= THR), 1)) { mn = m_reg; alpha = 1.f; }
    else { mn = fmaxf(m_reg, pmax); alpha = __builtin_amdgcn_exp2f((m_reg - mn) * C2); m_reg = mn; }
    const float mnL = -mn * C2;
#pragma unroll
    for (int r = 0; r < 16; ++r) p0[r] = fmaf(p0[r], C2, mnL);
#pragma unroll
    for (int r = 0; r < 16; ++r) p1[r] = fmaf(p1[r], C2, mnL);
#pragma unroll
    for (int r = 0; r < 16; ++r) p0[r] = __builtin_amdgcn_exp2f(p0[r]);
#pragma unroll
    for (int r = 0; r < 16; ++r) p1[r] = __builtin_amdgcn_exp2f(p1[r]);
}
#define ATT_PK4(P, B_, OUT) do { unsigned a0 = cvtpk(P[B_+0], P[B_+1]), a1 = cvtpk(P[B_+2], P[B_+3]);                          \
        unsigned b0 = cvtpk(P[B_+4], P[B_+5]), b1 = cvtpk(P[B_+6], P[B_+7]);                                             \
        auto r0 = __builtin_amdgcn_permlane32_swap(a0, b0, false, false); auto r1 = __builtin_amdgcn_permlane32_swap(a1, b1, false, false); \
        u32x4 w = {r0[0], r1[0], r0[1], r1[1]}; OUT = *reinterpret_cast<bf16x8*>(&w); } while (0)
__device__ __forceinline__ void pack_p(const f32x16& p0, const f32x16& p1, bf16x8& pa0, bf16x8& pa1, bf16x8& pa2, bf16x8& pa3) {
    ATT_PK4(p0, 0, pa0); ATT_PK4(p0, 8, pa1); ATT_PK4(p1, 0, pa2); ATT_PK4(p1, 8, pa3);
}
__device__ __forceinline__ float pair_sum(float v) {
    auto rr = __builtin_amdgcn_permlane32_swap(__float_as_uint(v), __float_as_uint(v), false, false);
    return __uint_as_float(rr[0]) + __uint_as_float(rr[1]);
}
__device__ __forceinline__ void qkt(f32x16& p0, f32x16& p1, const LAS char* Kb, int r32, int hi, const bf16x8* qr) {
#pragma unroll
    for (int r = 0; r < 16; ++r) { p0[r] = 0.f; p1[r] = 0.f; }
    const LAS char* kb[4];
#pragma unroll
    for (int dd = 0; dd < 4; ++dd) kb[dd] = Kb + KSWZ(r32, (dd * 16 + hi * 8) * 2);
#pragma unroll
    for (int d0 = 0; d0 < 8; ++d0) { const LAS char* a = kb[d0 & 3] + (d0 >> 2) * 128;
        const bf16x8 b0 = *reinterpret_cast<const LAS bf16x8*>(a);
        const bf16x8 b1 = *reinterpret_cast<const LAS bf16x8*>(a + 32 * 256);
        p0 = __builtin_amdgcn_mfma_f32_32x32x16_bf16(b0, qr[d0], p0, 0, 0, 0);
        p1 = __builtin_amdgcn_mfma_f32_32x32x16_bf16(b1, qr[d0], p1, 0, 0, 0); }
}
__device__ __forceinline__ void pv_tile(f32x16* o, int vb0, bf16x8 pa0, bf16x8 pa1, bf16x8 pa2, bf16x8 pa3) {
#define TRRD(dst, off) asm volatile("ds_read_b64_tr_b16 %0, %1 offset:%2" : "=&v"(dst) : "v"(vb0), "i"(off) : "memory")
#define PV_D0(d0) do { s16x4 l0, l1, l2, l3, h0, h1, h2, h3; constexpr int b_ = (d0) * 512; \
        TRRD(l0, b_); TRRD(h0, b_ + 2048); TRRD(l1, b_ + 4096); TRRD(h1, b_ + 6144); TRRD(l2, b_ + 8192); TRRD(h2, b_ + 10240); TRRD(l3, b_ + 12288); TRRD(h3, b_ + 14336); \
        asm volatile("s_waitcnt lgkmcnt(0)" ::: "memory"); SBAR();   \
        o[d0] = __builtin_amdgcn_mfma_f32_32x32x16_bf16(pa0, (bf16x8){l0[0], l0[1], l0[2], l0[3], h0[0], h0[1], h0[2], h0[3]}, o[d0], 0, 0, 0);   \
        o[d0] = __builtin_amdgcn_mfma_f32_32x32x16_bf16(pa1, (bf16x8){l1[0], l1[1], l1[2], l1[3], h1[0], h1[1], h1[2], h1[3]}, o[d0], 0, 0, 0);   \
        o[d0] = __builtin_amdgcn_mfma_f32_32x32x16_bf16(pa2, (bf16x8){l2[0], l2[1], l2[2], l2[3], h2[0], h2[1], h2[2], h2[3]}, o[d0], 0, 0, 0);   \
        o[d0] = __builtin_amdgcn_mfma_f32_32x32x16_bf16(pa3, (bf16x8){l3[0], l3[1], l3[2], l3[3], h3[0], h3[1], h3[2], h3[3]}, o[d0], 0, 0, 0); } while (0)
    PV_D0(0); PV_D0(1); PV_D0(2); PV_D0(3);
#undef PV_D0
#undef TRRD
}

template <int MODE>
__device__ __forceinline__ void attn_block(const bf16* __restrict__ Qp, int ldq, const bf16* __restrict__ Kp, int ldk, const bf16* __restrict__ Vp, int ldv, bf16* __restrict__ Op, int ldo,
                                           int qb, LAS char* lds, const float* __restrict__ aux0, const float* __restrict__ aux1, const float* __restrict__ aux2) {
    int tid_ = threadIdx.x; asm volatile("" : "+v"(tid_));
    const int tid = tid_, wid = __builtin_amdgcn_readfirstlane(tid >> 6), lane = tid & 63, r32 = lane & 31, hi = lane >> 5;
    const int P0 = qb * 256, qlo = P0 + wid * 32, qpos = qlo + r32;
    const int NT = 4 * qb + 4;
    LAS char* V_lds = lds + OFF_V; LAS char* K_lds = lds + OFF_K;
    LAS float* wsf = (LAS float*)(lds + OFF_WS) + wid * 64; LAS float* li_l = wsf; LAS float* al_l = wsf + 32;
    LAS float* aux = (LAS float*)(lds + OFF_AUX);
    bf16x8 qr[8];
#pragma unroll
    for (int d0 = 0; d0 < 8; ++d0) qr[d0] = *reinterpret_cast<const bf16x8*>(Qp + (size_t)qpos * ldq + d0 * 16 + hi * 8);
    unsigned kso[2], vso[2];
#pragma unroll
    for (int i = 0; i < 2; ++i) { const int pc = 2 * wid + i, krow = pc * 4 + (lane >> 4), kch = (lane & 15) ^ (krow & 7);
        kso[i] = (unsigned)(krow * ldk + kch * 8) * 2u;
        const int kk = wid * 8 + ((lane & 31) >> 2), vk = (kk & ~0xC) | ((kk & 4) << 1) | ((kk & 8) >> 1), vc = (2 * i + (lane >> 5)) * 32 + (lane & 3) * 8;
        vso[i] = (unsigned)(vk * ldv + vc) * 2u; }
    const int vb0 = (int)(unsigned)(size_t)V_lds + v_rd_base(lane);
    float m_reg = -1e30f, l_reg = 0.f, Rsum = 0.f, den = 0.f, M2row = 0.f, nmrow = 1.f; unsigned sel = 0u;
    if constexpr (MODE == MODE_ML) { for (int i = tid; i < P0 + 256; i += 512) aux[i] = aux0[i]; M2row = aux1[qpos]; nmrow = aux2[qpos]; }
    if constexpr (MODE == MODE_MOBA) { for (int i = tid; i < qb * 128; i += 512) aux[i] = aux0[i]; }
#define TJ(i) ((MODE == MODE_SB) ? (NT - 1 - (i)) : (i))
#define SLOAD(kb_, bf) do { const char* kg_ = (const char*)(Kp + (size_t)(kb_) * ldk); const char* vg_ = (const char*)(Vp + (size_t)(kb_) * ldv); \
        _Pragma("unroll") for (int i_ = 0; i_ < 2; ++i_) { \
            __builtin_amdgcn_global_load_lds((const unsigned*)(kg_ + kso[i_]), (LAS unsigned*)(K_lds + (bf) * SHM + (2 * wid + i_) * 1024), 16, 0, 0); \
            __builtin_amdgcn_global_load_lds((const unsigned*)(vg_ + vso[i_]), (LAS unsigned*)(V_lds + (bf) * SHM + (2 * wid + i_) * 1024), 16, 0, 0); } } while (0)
    float zbnd = 0.f; bool wdone = false; LAS int* dflag = (LAS int*)(lds + OFF_WS);
    if constexpr (MODE == MODE_SB) { float s = 0.f;
#pragma unroll
        for (int d0 = 0; d0 < 8; ++d0) { const u32x4 qw = *reinterpret_cast<const u32x4*>(&qr[d0]);
            s = fmaf(bf_lo(qw.x), bf_lo(qw.x), s); s = fmaf(bf_hi(qw.x), bf_hi(qw.x), s); s = fmaf(bf_lo(qw.y), bf_lo(qw.y), s); s = fmaf(bf_hi(qw.y), bf_hi(qw.y), s);
            s = fmaf(bf_lo(qw.z), bf_lo(qw.z), s); s = fmaf(bf_hi(qw.z), bf_hi(qw.z), s); s = fmaf(bf_lo(qw.w), bf_lo(qw.w), s); s = fmaf(bf_hi(qw.w), bf_hi(qw.w), s); }
        s = pair_sum(s); zbnd = sqrtf(s * aux0[0]) * (C2 * 1.001f) + 0.01f; }
    f32x16 lgm;
    if constexpr (MODE == MODE_DIL) {
#pragma unroll
        for (int r = 0; r < 16; ++r) { const unsigned d0 = (unsigned)(qpos - 4 * hi - ((r & 3) + 8 * (r >> 2))); lgm[r] = ((d0 & 15u) == 0u) ? (1.0f / C2) : (((d0 & 3u) == 0u) ? 0.f : -__builtin_inff()); } }
    SLOAD(TJ(0) * 64, 0); VM_WAIT(); LDS_WAIT(); WG_BAR();
    if constexpr (MODE == MODE_MOBA) {
        if (qb <= 3) sel = (1u << qb) - 1u;
        else {
            float g[7];
#pragma unroll
            for (int n = 0; n < 7; ++n) { g[n] = -__builtin_inff();
                if (n < qb) { float s = 0.f;
#pragma unroll
                    for (int d0 = 0; d0 < 8; ++d0) { const LAS f32x4* kp = (const LAS f32x4*)(aux + n * 128 + d0 * 16 + hi * 8); const f32x4 k0 = kp[0], k1 = kp[1];
                        const u32x4 qw = *reinterpret_cast<const u32x4*>(&qr[d0]);
                        s = fmaf(bf_lo(qw.x), k0[0], s); s = fmaf(bf_hi(qw.x), k0[1], s); s = fmaf(bf_lo(qw.y), k0[2], s); s = fmaf(bf_hi(qw.y), k0[3], s);
                        s = fmaf(bf_lo(qw.z), k1[0], s); s = fmaf(bf_hi(qw.z), k1[1], s); s = fmaf(bf_lo(qw.w), k1[2], s); s = fmaf(bf_hi(qw.w), k1[3], s); }
                    g[n] = pair_sum(s); }
                asm volatile("" ::: "memory"); }
#pragma unroll
            for (int k = 0; k < 3; ++k) { float best = -__builtin_inff(); int bi = 0;
#pragma unroll
                for (int n = 0; n < 7; ++n) if (g[n] > best) { best = g[n]; bi = n; }
                sel |= 1u << bi;
#pragma unroll
                for (int n = 0; n < 7; ++n) g[n] = (bi == n) ? -__builtin_inff() : g[n]; }
        }
    }
    f32x16 o[4];
#pragma unroll
    for (int d_ = 0; d_ < 4; ++d_)
#pragma unroll
        for (int r = 0; r < 16; ++r) o[d_][r] = 0.f;
    for (int i = 0; i < NT; ++i) {
        const int tj = TJ(i), kb = tj * 64, buf = i & 1;
        if constexpr (MODE == MODE_SB) { if (i > 0) { const int f = dflag[(lane & 7) * 64 + ((i - 1) & 1)]; if (__all(f != 0)) break; } }
        if (i + 1 < NT) SLOAD(TJ(i + 1) * 64, buf ^ 1);
        SBAR();
        bool act = (MODE == MODE_SB) ? (kb <= qlo + 30 && !wdone) : (kb <= qlo + 31);
        if constexpr (MODE == MODE_MOBA) { const int n = tj >> 2; if (n != qb) act = act && __any((int)((sel >> n) & 1u)); }
        if (act) {
            f32x16 p0, p1; bf16x8 pa0, pa1, pa2, pa3;
            qkt(p0, p1, K_lds + buf * SHM, r32, hi, qr);
            const int dq = qpos - kb - 4 * hi;
            if constexpr (MODE == MODE_DIL || MODE == MODE_MOBA) {
                if constexpr (MODE == MODE_DIL) {
                  const int dlo = qlo - kb - 63, dhi2 = qlo + 31 - kb;
                  if (dlo > 512) {
#pragma unroll
                    for (int r = 0; r < 16; ++r) { const float t = (lgm[r] > 0.f) ? 0.f : -__builtin_inff(); p0[r] += t; p1[r] += t; }
                  } else if (dlo > 128 && dhi2 <= 512) {
#pragma unroll
                    for (int r = 0; r < 16; ++r) { p0[r] += lgm[r]; p1[r] += lgm[r]; }
                  } else {
#pragma unroll
                    for (int r = 0; r < 16; ++r) { const int c = (r & 3) + 8 * (r >> 2);
                        { const unsigned ud = (unsigned)(dq - c); const int cnt = (int)(ud <= 128u) + (int)(((ud & 3u) == 0u) & (ud <= 512u)) + (int)((ud & 0x8000000Fu) == 0u);
                          p0[r] += __builtin_amdgcn_logf((float)cnt) * (1.0f / C2); }
                        { const unsigned ud = (unsigned)(dq - c - 32); const int cnt = (int)(ud <= 128u) + (int)(((ud & 3u) == 0u) & (ud <= 512u)) + (int)((ud & 0x8000000Fu) == 0u);
                          p1[r] += __builtin_amdgcn_logf((float)cnt) * (1.0f / C2); } }
                  }
                } else {
                    const int n = tj >> 2;
                    if (n == qb) { if (kb + 63 > qlo) mask_tile(p0, p1, dq); }
                    else if (!((sel >> n) & 1u)) {
#pragma unroll
                        for (int r = 0; r < 16; ++r) { p0[r] = -__builtin_inff(); p1[r] = -__builtin_inff(); } }
                }
                float mn, alpha;
                partialSM(p0, p1, m_reg, mn, alpha);
                float ps = 0.f;
#pragma unroll
                for (int r = 0; r < 16; ++r) ps += p0[r];
#pragma unroll
                for (int r = 0; r < 16; ++r) ps += p1[r];
                ps = pair_sum(ps);
                l_reg = l_reg * alpha + ps;
                pack_p(p0, p1, pa0, pa1, pa2, pa3);
                if (__any(alpha < 1.f)) { if (hi == 0) al_l[r32] = alpha; LDS_WAIT();
#pragma unroll
                    for (int d_ = 0; d_ < 4; ++d_)
#pragma unroll
                        for (int r = 0; r < 16; ++r) o[d_][r] *= al_l[crow(r, hi)]; }
            } else if constexpr (MODE == MODE_ML) {
                float dsum = 0.f;
#pragma unroll
                for (int r4 = 0; r4 < 4; ++r4) {
                    const f32x4 a0 = *(const LAS f32x4*)(aux + kb + 8 * r4 + 4 * hi), a1 = *(const LAS f32x4*)(aux + kb + 32 + 8 * r4 + 4 * hi);
#pragma unroll
                    for (int j = 0; j < 4; ++j) { const int r = 4 * r4 + j, c = 8 * r4 + j;
                        float s0 = p0[r] * SCALE * __builtin_amdgcn_exp2f(a0[j] - M2row); s0 = (dq - c < 0) ? 0.f : s0;
                        float s1 = p1[r] * SCALE * __builtin_amdgcn_exp2f(a1[j] - M2row); s1 = (dq - c - 32 < 0) ? 0.f : s1;
                        p0[r] = s0; p1[r] = s1; dsum += s0 + s1; } }
                den += dsum;
                pack_p(p0, p1, pa0, pa1, pa2, pa3);
            } else {
                f32x16 z0, z1; float gs[8];
#pragma unroll
                for (int r = 0; r < 16; ++r) { const int c = (r & 3) + 8 * (r >> 2);
                    { const float z2 = p0[r] * C2; const float sp = fmaxf(z2, 0.f) + __builtin_amdgcn_logf(1.0f + __builtin_amdgcn_exp2f(-fabsf(z2)));
                      z0[r] = z2; const float spm = ((dq - 1 - c) >= 0) ? sp : 0.f; p0[r] = spm; if ((r & 3) == 0) gs[r >> 2] = spm; else gs[r >> 2] += spm; }
                    { const float z2 = p1[r] * C2; const float sp = fmaxf(z2, 0.f) + __builtin_amdgcn_logf(1.0f + __builtin_amdgcn_exp2f(-fabsf(z2)));
                      z1[r] = z2; const float spm = ((dq - 1 - c - 32) >= 0) ? sp : 0.f; p1[r] = spm; if ((r & 3) == 0) gs[4 + (r >> 2)] = spm; else gs[4 + (r >> 2)] += spm; } }
                float aft[8]; float run = 0.f;
#pragma unroll
                for (int i2 = 7; i2 >= 0; --i2) { const float pg = __shfl_xor(gs[i2], 32); aft[i2] = run + (hi == 0 ? pg : 0.f); run += gs[i2] + pg; }
#pragma unroll
                for (int i2 = 0; i2 < 8; ++i2) { float suf = Rsum + aft[i2];
#pragma unroll
                    for (int j = 3; j >= 0; --j) { const int r = 4 * (i2 & 3) + j, c = 8 * (i2 & 3) + j + ((i2 >> 2) ? 32 : 0);
                        const bool ok = (dq - 1 - c) >= 0;
                        if (i2 >> 2) { suf += p1[r]; p1[r] = ok ? __builtin_amdgcn_exp2f(z1[r] - suf) : 0.f; }
                        else { suf += p0[r]; p0[r] = ok ? __builtin_amdgcn_exp2f(z0[r] - suf) : 0.f; } } }
                Rsum += run;
                pack_p(p0, p1, pa0, pa1, pa2, pa3);
            }
            SBAR();
            pv_tile(o, vb0 + buf * SHM, pa0, pa1, pa2, pa3);
        }
        SBAR();
        if constexpr (MODE == MODE_SB) { if (!wdone) wdone = __all(Rsum - zbnd > 64.f) != 0; if (lane == 0) dflag[wid * 64 + (i & 1)] = wdone ? 1 : 0; }
        VM_WAIT(); LDS_WAIT(); WG_BAR();
    }
    if constexpr (MODE == MODE_DIL || MODE == MODE_MOBA) { if (hi == 0) li_l[r32] = l_reg; }
    if constexpr (MODE == MODE_ML) { const float dt = pair_sum(den); if (hi == 0) li_l[r32] = fmaxf(fabsf(dt), nmrow); }
    LDS_WAIT();
    bf16* Ow = Op + (size_t)qlo * ldo;
#pragma unroll
    for (int r = 0; r < 16; ++r) { const int orow = crow(r, hi);
        float rl = 1.f; if constexpr (MODE != MODE_SB) rl = __builtin_amdgcn_rcpf(li_l[orow]);
#pragma unroll
        for (int d0 = 0; d0 < 4; ++d0) { const float v = o[d0][r] * rl; const float vn = __shfl_xor(v, 1);
            if ((r32 & 1) == 0) *(unsigned*)(Ow + (size_t)orow * ldo + d0 * 32 + r32) = cvtpk(v, vn); } }
    LDS_WAIT();
#undef TJ
#undef SLOAD
}
}


struct Frame {
    LAS unsigned char* lds; int tid, lane, wave, vcu, G, gw, NGW;
};

template <bool FOLD>
__device__ __forceinline__ void tr_item(const float* __restrict__ W, int K, int N, bf16* __restrict__ WT, int item, int nblk, LAS unsigned* scr, int lane, int rmode, const float* lg, const float* lb, float* cs, float* bs) {
    const int kb = item / nblk, nb = item - kb * nblk, k0 = kb * 64, n0 = nb * 64;
    const int nq = lane & 15, kr = lane >> 4;
    const bool inb = (n0 + 4 * nq) < N;
    f32x4 a[8], b[8];
#pragma unroll
    for (int s = 0; s < 8; ++s) { const int kp = 4 * s + kr; const float* p = W + (size_t)(k0 + 2 * kp) * N + (inb ? n0 + 4 * nq : 0);
        a[s] = *(const f32x4*)p; b[s] = *(const f32x4*)(p + N); }
    if (!inb) {
#pragma unroll
        for (int s = 0; s < 8; ++s) { a[s] = (f32x4){0.f, 0.f, 0.f, 0.f}; b[s] = (f32x4){0.f, 0.f, 0.f, 0.f}; } }
    f32x4 csum = {0.f, 0.f, 0.f, 0.f}, bsum = {0.f, 0.f, 0.f, 0.f};
    if constexpr (FOLD) {
#pragma unroll
        for (int s = 0; s < 8; ++s) { const int k = k0 + 2 * (4 * s + kr); const f32x2 g2 = *(const f32x2*)(lg + k), b2 = *(const f32x2*)(lb + k);
            bsum += a[s] * b2[0] + b[s] * b2[1]; a[s] = a[s] * g2[0]; b[s] = b[s] * g2[1]; }
    }
#pragma unroll
    for (int s = 0; s < 8; ++s) { const int kp = 4 * s + kr;
#pragma unroll
        for (int i = 0; i < 4; ++i) { const unsigned pk = cvtpk(a[s][i], b[s][i]); scr[(4 * nq + i) * 33 + kp] = pk; if constexpr (FOLD) csum[i] += bf_lo(pk) + bf_hi(pk); } }
    LDS_WAIT();
#pragma unroll
    for (int jj = 0; jj < 8; ++jj) { const int n = (lane >> 3) + 8 * jj, c = lane & 7; const LAS unsigned* s = scr + n * 33 + 4 * c;
        u32x4 o; o.x = s[0]; o.y = s[1]; o.z = s[2]; o.w = s[3];
        const int nn = n0 + n, drow = rmode ? (((nn >> 7) << 8) + (nn & 127) + (rmode == 2 ? 128 : 0)) : nn;
        *(u32x4*)(WT + (size_t)drow * K + k0 + 8 * c) = o; }
    LDS_WAIT();
    if constexpr (FOLD) {
#pragma unroll
        for (int i = 0; i < 4; ++i) { csum[i] += __shfl_xor(csum[i], 16); csum[i] += __shfl_xor(csum[i], 32); bsum[i] += __shfl_xor(bsum[i], 16); bsum[i] += __shfl_xor(bsum[i], 32); }
        LAS float* fs = (LAS float*)scr;
        if (kr == 0) { *(LAS f32x4*)(fs + 4 * nq) = csum; *(LAS f32x4*)(fs + 64 + 4 * nq) = bsum; }
        LDS_WAIT();
        const int nn = n0 + lane, drow = rmode ? (((nn >> 7) << 8) + (nn & 127) + (rmode == 2 ? 128 : 0)) : nn;
        if (nn < N) { unsafeAtomicAdd(cs + drow, fs[lane]); unsafeAtomicAdd(bs + drow, fs[64 + lane]); }
        LDS_WAIT();
    }
}

__device__ __forceinline__ void prologue(const Frame& F_, const Args& a) {
    Frame F = F_; asm volatile("" : "+v"(F.lane), "+v"(F.tid), "+s"(F.gw), "+s"(F.vcu), "+s"(F.wave));
    unsigned char* ws = a.ws;
    LAS unsigned* scr = (LAS unsigned*)(F.lds + F.wave * 8448);
    constexpr int I_INAB = 64 * 192, I_OUT = 64 * 64, I_INCD = 64 * 196, I_UP = 64 * 172, I_DN = 172 * 64;
    constexpr int TOTAL = I_INAB + I_OUT + I_INCD + I_OUT + 4 * I_UP + 2 * I_DN;
    for (int it = F.gw; it < TOTAL; it += F.NGW) {
        int r = it; const float* W; int K, N, nblk; bf16* WT; int rmode = 0; const float* lg = nullptr; const float* lb = nullptr; float* cs = nullptr; float* bs = nullptr;
        unsigned char* ctl = ws + WS_CTL;
        if (r < I_INAB) { W = a.in[1]; K = DM; N = N_AB; nblk = 192; WT = (bf16*)(ws + WS_W_INAB); }
        else if ((r -= I_INAB) < I_OUT) { W = a.in[2]; K = DM; N = DM; nblk = 64; WT = (bf16*)(ws + WS_W_OUTAB); }
        else if ((r -= I_OUT) < I_INCD) { W = a.in[3]; K = DM; N = N_CD; nblk = 196; WT = (bf16*)(ws + WS_W_INCD); lg = a.in[14] + DM; lb = a.in[15] + DM; cs = (float*)(ctl + CTL_CS_INCD); bs = (float*)(ctl + CTL_BS_INCD); }
        else if ((r -= I_INCD) < I_OUT) { W = a.in[8]; K = DM; N = DM; nblk = 64; WT = (bf16*)(ws + WS_W_OUTCD); }
        else if ((r -= I_OUT) < I_UP) { W = a.in[9]; K = DM; N = DFF; nblk = 172; WT = (bf16*)(ws + WS_W_UG0); rmode = 1; lg = a.in[14]; lb = a.in[15]; cs = (float*)(ctl + CTL_CS_UG0); bs = (float*)(ctl + CTL_BS_UG0); }
        else if ((r -= I_UP) < I_UP) { W = a.in[10]; K = DM; N = DFF; nblk = 172; WT = (bf16*)(ws + WS_W_UG0); rmode = 2; lg = a.in[14]; lb = a.in[15]; cs = (float*)(ctl + CTL_CS_UG0); bs = (float*)(ctl + CTL_BS_UG0); }
        else if ((r -= I_UP) < I_DN) { W = a.in[13]; K = DFF; N = DM; nblk = 64; WT = (bf16*)(ws + WS_W_DN0); }
        else if ((r -= I_DN) < I_UP) { W = a.in[9] + (size_t)DM * DFF; K = DM; N = DFF; nblk = 172; WT = (bf16*)(ws + WS_W_UG1); rmode = 1; lg = a.in[14] + 2 * DM; lb = a.in[15] + 2 * DM; cs = (float*)(ctl + CTL_CS_UG1); bs = (float*)(ctl + CTL_BS_UG1); }
        else if ((r -= I_UP) < I_UP) { W = a.in[10] + (size_t)DM * DFF; K = DM; N = DFF; nblk = 172; WT = (bf16*)(ws + WS_W_UG1); rmode = 2; lg = a.in[14] + 2 * DM; lb = a.in[15] + 2 * DM; cs = (float*)(ctl + CTL_CS_UG1); bs = (float*)(ctl + CTL_BS_UG1); }
        else { r -= I_UP; W = a.in[13] + (size_t)DFF * DM; K = DFF; N = DM; nblk = 64; WT = (bf16*)(ws + WS_W_DN1); }
        if (lg) tr_item<true>(W, K, N, WT, r, nblk, scr, F.lane, rmode, lg, lb, cs, bs); else tr_item<false>(W, K, N, WT, r, nblk, scr, F.lane, rmode, lg, lb, cs, bs);
    }
    const f32x4* x4 = (const f32x4*)a.in[0]; u32x2* xb = (u32x2*)(ws + WS_XB);
    for (size_t i = (size_t)F.gw * 64 + F.lane; i < (size_t)M * DM / 4; i += (size_t)F.NGW * 64) { const f32x4 v = x4[i]; u32x2 o; o.x = cvtpk(v[0], v[1]); o.y = cvtpk(v[2], v[3]); xb[i] = o; }
}

__device__ __forceinline__ void ln_phase(const Frame& F_, const float* z, float* xo, bf16* xb, const float* g, const float* b, float oscale = 1.f) {
    Frame F = F_; asm volatile("" : "+v"(F.lane), "+v"(F.tid), "+s"(F.gw), "+s"(F.vcu), "+s"(F.wave));
    for (int m = F.gw; m < M; m += F.NGW) {
        const f32x4* zr = (const f32x4*)(z + (size_t)m * DM) + F.lane;
        f32x4 v[16]; float s = 0.f;
#pragma unroll
        for (int j = 0; j < 16; ++j) { v[j] = zr[64 * j]; s += (v[j][0] + v[j][1]) + (v[j][2] + v[j][3]); }
        const float mean = wave_sum(s) * (1.f / DM); float s2 = 0.f;
#pragma unroll
        for (int j = 0; j < 16; ++j) { v[j] = v[j] - mean; s2 += (v[j][0] * v[j][0] + v[j][1] * v[j][1]) + (v[j][2] * v[j][2] + v[j][3] * v[j][3]); }
        const float rstd = 1.f / sqrtf(wave_sum(s2) * (1.f / DM) + LN_EPS);
        f32x4* xr = (f32x4*)(xo + (size_t)m * DM) + F.lane; u32x2* br = (u32x2*)((xb ? xb : (bf16*)xo) + (size_t)m * DM) + F.lane;
        const f32x4* g4 = (const f32x4*)g + F.lane; const f32x4* b4 = (const f32x4*)b + F.lane;
#pragma unroll
        for (int j = 0; j < 16; ++j) { f32x4 o = v[j] * rstd * g4[64 * j] + b4[64 * j]; if (SELFCHECK) o = o * oscale; xr[64 * j] = o;
            if (xb) { u32x2 w; w.x = cvtpk(o[0], o[1]); w.y = cvtpk(o[2], o[3]); br[64 * j] = w; } }
    }
}

__device__ __forceinline__ void ffn_act_phase(const Frame& F_, bf16* U, const bf16* Gb, const float* cw  , const float* cb, bool dummy = false) {
    Frame F = F_; asm volatile("" : "+v"(F.lane), "+v"(F.tid), "+s"(F.gw), "+s"(F.vcu), "+s"(F.wave));
    constexpr int NCH = DFF / 8, NCB = (NCH + 63) / 64, NITEM = (M / 32) * NCB;
    for (int it = F.gw; it < NITEM; it += F.NGW) {
        const int rb = it / NCB, cbk = it - rb * NCB, ch = cbk * 64 + F.lane;
        if (ch >= NCH) continue;
        const int c0 = ch * 8, r0 = rb * 32;
        float w0[8], w1[8], w2[8], bb[8];
#pragma unroll
        for (int q = 0; q < 2; ++q) { const f32x4 t0 = *(const f32x4*)(cw + c0 + 4 * q), t1 = *(const f32x4*)(cw + DFF + c0 + 4 * q), t2 = *(const f32x4*)(cw + 2 * DFF + c0 + 4 * q), t3 = *(const f32x4*)(cb + c0 + 4 * q);
#pragma unroll
            for (int j = 0; j < 4; ++j) { w0[4 * q + j] = t0[j]; w1[4 * q + j] = t1[j]; w2[4 * q + j] = t2[j]; bb[4 * q + j] = t3[j]; } }
        u32x4 gm2 = {0u, 0u, 0u, 0u}, gm1 = {0u, 0u, 0u, 0u};
        if ((r0 & (SEQ - 1)) != 0) { gm2 = *(const u32x4*)(Gb + (size_t)(r0 - 2) * DFF + c0); gm1 = *(const u32x4*)(Gb + (size_t)(r0 - 1) * DFF + c0); }
        for (int t8 = 0; t8 < 32; t8 += 8) {
            u32x4 gv[8], uv[8];
#pragma unroll
            for (int t = 0; t < 8; ++t) { gv[t] = *(const u32x4*)(Gb + (size_t)(r0 + t8 + t) * DFF + c0); uv[t] = *(const u32x4*)(U + (size_t)(r0 + t8 + t) * DFF + c0); }
#pragma unroll
            for (int t = 0; t < 8; ++t) { u32x4 ov;
#pragma unroll
                for (int q = 0; q < 4; ++q) {
                    const float y0 = w0[2 * q] * bf_lo(gm2[q]) + w1[2 * q] * bf_lo(gm1[q]) + w2[2 * q] * bf_lo(gv[t][q]) + bb[2 * q];
                    const float y1 = w0[2 * q + 1] * bf_hi(gm2[q]) + w1[2 * q + 1] * bf_hi(gm1[q]) + w2[2 * q + 1] * bf_hi(gv[t][q]) + bb[2 * q + 1];
                    ov[q] = cvtpk(silu_f(y0) * bf_lo(uv[t][q]), silu_f(y1) * bf_hi(uv[t][q])); }
                if (REP_MASK & 4096) { if (dummy) ov = uv[t]; }
                *(u32x4*)(U + (size_t)(r0 + t8 + t) * DFF + c0) = ov; gm2 = gm1; gm1 = gv[t]; }
        }
    }
}


__device__ __forceinline__ void ffn_fix_phase(const Frame& F_, bf16* H, const float* EG0, const float* EU0, const float* EGL, const float* cw, const float* cb) {
    Frame F = F_; asm volatile("" : "+v"(F.lane), "+v"(F.tid), "+s"(F.gw), "+s"(F.vcu), "+s"(F.wave));
    constexpr int C4 = DFF / 4;
    for (int idx = F.gw * 64 + F.lane; idx < 64 * C4; idx += F.NGW * 64) {
        const int pm = idx / C4, ch = (idx - pm * C4) * 4;
        f32x4 gl0 = {0.f, 0.f, 0.f, 0.f}, gl1 = gl0;
        if ((pm & 7) != 0) { gl0 = *(const f32x4*)(EGL + (size_t)((pm - 1) * 2) * DFF + ch); gl1 = *(const f32x4*)(EGL + (size_t)((pm - 1) * 2 + 1) * DFF + ch); }
        const f32x4 g0 = *(const f32x4*)(EG0 + (size_t)(pm * 2) * DFF + ch), g1 = *(const f32x4*)(EG0 + (size_t)(pm * 2 + 1) * DFF + ch);
        const f32x4 u0 = *(const f32x4*)(EU0 + (size_t)(pm * 2) * DFF + ch), u1 = *(const f32x4*)(EU0 + (size_t)(pm * 2 + 1) * DFF + ch);
        const f32x4 w0 = *(const f32x4*)(cw + ch), w1 = *(const f32x4*)(cw + DFF + ch), w2 = *(const f32x4*)(cw + 2 * DFF + ch), bb = *(const f32x4*)(cb + ch);
        const f32x4 y0 = w0 * gl0 + w1 * gl1 + w2 * g0 + bb, y1 = w0 * gl1 + w1 * g0 + w2 * g1 + bb;
        u32x2 o0, o1;
        o0.x = cvtpk(silu_f(y0[0]) * u0[0], silu_f(y0[1]) * u0[1]); o0.y = cvtpk(silu_f(y0[2]) * u0[2], silu_f(y0[3]) * u0[3]);
        o1.x = cvtpk(silu_f(y1[0]) * u1[0], silu_f(y1[1]) * u1[1]); o1.y = cvtpk(silu_f(y1[2]) * u1[2], silu_f(y1[3]) * u1[3]);
        *(u32x2*)(H + (size_t)(pm * 256) * DFF + ch) = o0; *(u32x2*)(H + (size_t)(pm * 256 + 1) * DFF + ch) = o1;
    }
}

__device__ __forceinline__ void kmean_phase(const Frame& F_, const bf16* QKV, float* kmean) {
    Frame F = F_; asm volatile("" : "+v"(F.lane), "+v"(F.tid), "+s"(F.gw), "+s"(F.vcu), "+s"(F.wave));
    LAS float* red = (LAS float*)F.lds;
    for (int it = F.vcu; it < 256; it += F.G) {
        const int b = it >> 5, n = (it >> 2) & 7, cbk = it & 3;
        const bf16* src = QKV + (size_t)(b * SEQ + n * 256 + F.wave * 32) * N_AB + 8192 + cbk * 512 + F.lane * 8;
        float acc[8];
#pragma unroll
        for (int j = 0; j < 8; ++j) acc[j] = 0.f;
        for (int r8 = 0; r8 < 32; r8 += 8) { u32x4 v[8];
#pragma unroll
            for (int r = 0; r < 8; ++r) v[r] = *(const u32x4*)(src + (size_t)(r8 + r) * N_AB);
#pragma unroll
            for (int r = 0; r < 8; ++r)
#pragma unroll
                for (int q = 0; q < 4; ++q) { acc[2 * q] += bf_lo(v[r][q]); acc[2 * q + 1] += bf_hi(v[r][q]); } }
#pragma unroll
        for (int j = 0; j < 8; ++j) red[F.wave * 512 + F.lane * 8 + j] = acc[j];
        LDS_WAIT(); WG_BAR();
        float s = 0.f;
#pragma unroll
        for (int w = 0; w < 8; ++w) s += red[w * 512 + F.tid];
        const int col = cbk * 512 + F.tid, h = col >> 7, d = col & 127;
        kmean[((size_t)(b * 16 + h) * 8 + n) * 128 + d] = s * (1.f / 256.f);
        LDS_WAIT(); WG_BAR();
    }
}

__device__ __forceinline__ void cd_pre_phase(const Frame& F_, const bf16* QKV, bf16* QKDC, const float* cw  , const float* cb, const float* gates, const float* bif, float* A2, float* M2, float* NM, unsigned* kn2) {
    Frame F = F_; asm volatile("" : "+v"(F.lane), "+v"(F.tid), "+s"(F.gw), "+s"(F.vcu), "+s"(F.wave));
    for (int it = F.gw; it < (M / 32) * 4; it += F.NGW) {
        const int rb = it >> 2, cbk = it & 3, c0 = cbk * 512 + F.lane * 8, r0 = rb * 32;
        float w[4][8], bb[8];
#pragma unroll
        for (int q = 0; q < 2; ++q) { const f32x4 t3 = *(const f32x4*)(cb + c0 + 4 * q);
#pragma unroll
            for (int j = 0; j < 4; ++j) bb[4 * q + j] = t3[j];
#pragma unroll
            for (int k = 0; k < 4; ++k) { const f32x4 t = *(const f32x4*)(cw + k * 2048 + c0 + 4 * q);
#pragma unroll
                for (int j = 0; j < 4; ++j) w[k][4 * q + j] = t[j]; } }
        const bf16* src = QKV + 6144 + c0;
        u32x4 x3 = {0u, 0u, 0u, 0u}, x2 = x3, x1 = x3;
        if ((r0 & (SEQ - 1)) != 0) { x3 = *(const u32x4*)(src + (size_t)(r0 - 3) * N_AB); x2 = *(const u32x4*)(src + (size_t)(r0 - 2) * N_AB); x1 = *(const u32x4*)(src + (size_t)(r0 - 1) * N_AB); }
        for (int t8 = 0; t8 < 32; t8 += 8) {
            u32x4 xv[8];
#pragma unroll
            for (int t = 0; t < 8; ++t) xv[t] = *(const u32x4*)(src + (size_t)(r0 + t8 + t) * N_AB);
#pragma unroll
            for (int t = 0; t < 8; ++t) { u32x4 ov;
#pragma unroll
                for (int q = 0; q < 4; ++q) {
                    const float y0 = w[0][2 * q] * bf_lo(x3[q]) + w[1][2 * q] * bf_lo(x2[q]) + w[2][2 * q] * bf_lo(x1[q]) + w[3][2 * q] * bf_lo(xv[t][q]) + bb[2 * q];
                    const float y1 = w[0][2 * q + 1] * bf_hi(x3[q]) + w[1][2 * q + 1] * bf_hi(x2[q]) + w[2][2 * q + 1] * bf_hi(x1[q]) + w[3][2 * q + 1] * bf_hi(xv[t][q]) + bb[2 * q + 1];
                    ov[q] = cvtpk(silu_f(y0), silu_f(y1)); }
                *(u32x4*)(QKDC + (size_t)(r0 + t8 + t) * 2048 + c0) = ov; x3 = x2; x2 = x1; x1 = xv[t]; }
        }
    }
    for (int it = F.gw; it < (M / 64) * 16; it += F.NGW) {
        const int rb = it >> 4, h = it & 15, row = rb * 64 + F.lane;
        const u32x4* kp = (const u32x4*)(QKV + (size_t)row * N_AB + 2048 + h * 128); float s = 0.f;
#pragma unroll
        for (int j = 0; j < 16; ++j) { const u32x4 v = kp[j];
            s = fmaf(bf_lo(v.x), bf_lo(v.x), s); s = fmaf(bf_hi(v.x), bf_hi(v.x), s); s = fmaf(bf_lo(v.y), bf_lo(v.y), s); s = fmaf(bf_hi(v.y), bf_hi(v.y), s);
            s = fmaf(bf_lo(v.z), bf_lo(v.z), s); s = fmaf(bf_hi(v.z), bf_hi(v.z), s); s = fmaf(bf_lo(v.w), bf_lo(v.w), s); s = fmaf(bf_hi(v.w), bf_hi(v.w), s); }
#pragma unroll
        for (int o = 1; o < 64; o <<= 1) s = fmaxf(s, __shfl_xor(s, o));
        if (F.lane == 0) atomicMax(kn2 + (row >> 11) * 16 + h, __float_as_uint(s));
    }
    for (int sq = F.gw; sq < 64; sq += F.NGW) {
        const int b = sq >> 3, h = sq & 7; const float bi = bif[h], bfv = bif[8 + h];
        const float* gp = gates + (size_t)(b * SEQ + F.lane * 32) * 16;
        float lf[32], ai[32]; float run = 0.f;
#pragma unroll
        for (int t = 0; t < 32; ++t) { const float f = gp[t * 16 + 8 + h] + bfv; ai[t] = gp[t * 16 + h] + bi;
            const float ls = fminf(f, 0.f) - log1pf(expf(-fabsf(f)));
            run += ls; lf[t] = run; }
        float incl = run;
#pragma unroll
        for (int o = 1; o < 64; o <<= 1) { const float t = __shfl_up(incl, o); if (F.lane >= o) incl += t; }
        const float base = incl - run; float mx = -__builtin_inff();
#pragma unroll
        for (int t = 0; t < 32; ++t) { lf[t] += base; ai[t] -= lf[t]; mx = fmaxf(mx, ai[t]); }
        float minc = mx;
#pragma unroll
        for (int o = 1; o < 64; o <<= 1) { const float t = __shfl_up(minc, o); if (F.lane >= o) minc = fmaxf(minc, t); }
        float mprev = __shfl_up(minc, 1); if (F.lane == 0) mprev = -__builtin_inff();
        float cm = fmaxf(mprev, 0.f);
        float* a2o = A2 + (size_t)sq * SEQ + F.lane * 32; float* m2o = M2 + (size_t)sq * SEQ + F.lane * 32; float* nmo = NM + (size_t)sq * SEQ + F.lane * 32;
#pragma unroll
        for (int t = 0; t < 32; ++t) { cm = fmaxf(cm, ai[t]); a2o[t] = ai[t] * 1.4426950408889634f; m2o[t] = cm * 1.4426950408889634f; nmo[t] = expf(-lf[t] - cm); }
    }
}

__device__ __forceinline__ void cd_post_phase(const Frame& F_, const bf16* HD, const bf16* QKV, bf16* Y, const float* ng) {
    Frame F = F_; asm volatile("" : "+v"(F.lane), "+v"(F.tid), "+s"(F.gw), "+s"(F.vcu), "+s"(F.wave));
    for (int it = F.gw; it < M * 8; it += F.NGW) {
        const int m = it >> 3, h = it & 7, c = h * 256 + F.lane * 4;
        const u32x2 hv = *(const u32x2*)(HD + (size_t)m * 2048 + c); const u32x2 ov = *(const u32x2*)(QKV + (size_t)m * N_AB + 10240 + c);
        const f32x4 g = *(const f32x4*)(ng + c);
        float v0 = bf_lo(hv.x), v1 = bf_hi(hv.x), v2 = bf_lo(hv.y), v3 = bf_hi(hv.y);
        const float mean = wave_sum((v0 + v1) + (v2 + v3)) * (1.f / 256.f);
        v0 -= mean; v1 -= mean; v2 -= mean; v3 -= mean;
        const float rstd = 1.f / sqrtf(wave_sum((v0 * v0 + v1 * v1) + (v2 * v2 + v3 * v3)) * (1.f / 256.f) + LN_EPS);
        const float o0 = bf_lo(ov.x), o1 = bf_hi(ov.x), o2 = bf_lo(ov.y), o3 = bf_hi(ov.y);
        const float y0 = v0 * rstd * g[0] * __builtin_amdgcn_rcpf(1.f + __builtin_amdgcn_exp2f(-1.4426950408889634f * o0));
        const float y1 = v1 * rstd * g[1] * __builtin_amdgcn_rcpf(1.f + __builtin_amdgcn_exp2f(-1.4426950408889634f * o1));
        const float y2 = v2 * rstd * g[2] * __builtin_amdgcn_rcpf(1.f + __builtin_amdgcn_exp2f(-1.4426950408889634f * o2));
        const float y3 = v3 * rstd * g[3] * __builtin_amdgcn_rcpf(1.f + __builtin_amdgcn_exp2f(-1.4426950408889634f * o3));
        u32x2 w; w.x = cvtpk(y0, y1); w.y = cvtpk(y2, y3);
        *(u32x2*)(Y + (size_t)m * DM + 2048 + c) = w;
    }
}


#if SELFCHECK
constexpr int CW_ERR = 64;
__device__ __forceinline__ unsigned hash_u(unsigned x) { x ^= x >> 16; x *= 0x7feb352du; x ^= x >> 15; x *= 0x846ca68bu; x ^= x >> 16; return x; }
__device__ __forceinline__ float bfr(float f) { return bf_lo(cvtpk(f, 0.f)); }
__device__ __forceinline__ float bfv(const bf16* p) { return __uint_as_float(((unsigned)*p) << 16); }
__device__ __forceinline__ float blk_red(LAS float* red, float v, int tid, bool domax) {
    red[tid] = v; __syncthreads();
    for (int o = 256; o >= 1; o >>= 1) { if (tid < o) red[tid] = domax ? fmaxf(red[tid], red[tid + o]) : (red[tid] + red[tid + o]); __syncthreads(); }
    const float r = red[0]; __syncthreads(); return r;
}
__device__ __forceinline__ int sample_t(int ci) {
    if (ci < 4) return ci;
    if (ci < 22) { const int g = (ci - 4) / 3, o = (ci - 4) % 3 - 1; return (g == 0 ? 16 : (32 << g)) + o; }
    if (ci < 24) return 2024 + ci;
    return (int)(hash_u(ci * 2654435761u + 12345u) & 2047u); }
__device__ __forceinline__ void gemm_check(const Frame& F_, const bf16* XB, const float* W, int N, const bf16* QKV, const float* GATES, unsigned* err, unsigned bit) {
    Frame F = F_; asm volatile("" : "+v"(F.lane), "+v"(F.tid), "+s"(F.gw), "+s"(F.vcu), "+s"(F.wave));
    for (int e = 0; e < 16; ++e) {
        const unsigned hsh = hash_u((unsigned)(F.gw * 16 + e) * 2246822519u + bit);
        const int row = (int)(hsh & 16383u); int col = (int)((hsh >> 14) % (unsigned)N);
        if (N == N_CD && (e & 3) == 3) col = 12288 + (int)((hsh >> 14) & 15u);
        float s = 0.f;
        for (int k = F.lane; k < DM; k += 64) s += bfv(XB + (size_t)row * DM + k) * bfr(W[(size_t)k * N + col]);
        s = wave_sum(s);
        const float got = (col < 12288) ? bfv(QKV + (size_t)row * N_AB + col) : GATES[(size_t)row * 16 + (col - 12288)];
        if (!(fabsf(got - s) <= 0.02f * fabsf(s) + 0.02f)) { if (F.lane == 0) atomicOr(err, bit); }
    }
}
__device__ __forceinline__ void attn_check(const Frame& F_, int mode, const bf16* Q, const bf16* K, const bf16* V, int ld, const bf16* O, int ldo, int t, unsigned* err, unsigned bit) {
    Frame F = F_; asm volatile("" : "+v"(F.lane), "+v"(F.tid), "+s"(F.gw), "+s"(F.vcu), "+s"(F.wave));
    LAS float* qf = (LAS float*)F.lds; LAS float* sc = qf + 256; LAS float* red = sc + 2048; LAS float* km = red + 512;
    LAS unsigned* selw = (LAS unsigned*)(km + 1024);
    const int tid = F.tid;
    if (tid < 128) qf[tid] = bfv(Q + (size_t)t * ld + tid);
    __syncthreads();
    const int own = t >> 8;
    if (mode == 1) {
        for (int i = tid; i < own * 128; i += 512) { const int n = i >> 7, d = i & 127; float a = 0.f; for (int r = 0; r < 256; ++r) a += bfv(K + (size_t)(n * 256 + r) * ld + d); km[i] = a * (1.f / 256.f); }
        __syncthreads();
        if (tid == 0) { LAS float* g = km + 1024 + 16; for (int n = 0; n < 8; ++n) { g[n] = -__builtin_inff(); if (n < own) { float a = 0.f; for (int d = 0; d < 128; ++d) a += qf[d] * km[n * 128 + d]; g[n] = a; } }
            unsigned sel = 0u; const int topk = own < 3 ? own : 3;
            for (int k = 0; k < topk; ++k) { int bi = 0; float best = -__builtin_inff(); for (int n = 0; n < own; ++n) if (g[n] > best) { best = g[n]; bi = n; } sel |= 1u << bi; g[bi] = -__builtin_inff(); }
            selw[0] = sel; }
        __syncthreads();
    }
    const int nk = (mode == 2) ? t : t + 1;
    float lmax = -__builtin_inff();
    for (int sidx = tid; sidx < nk; sidx += 512) { float a = 0.f; for (int d = 0; d < 128; ++d) a += qf[d] * bfv(K + (size_t)sidx * ld + d);
        a *= 0.08838834764831845f;
        if (mode == 0) { const int dd = t - sidx; const int cnt = (dd <= 128 ? 1 : 0) + (((dd & 3) == 0 && dd <= 512) ? 1 : 0) + ((dd & 15) == 0 ? 1 : 0); a = cnt ? a + logf((float)cnt) : -__builtin_inff(); }
        if (mode == 1) { const int n = sidx >> 8; if (!(n == own || ((selw[0] >> n) & 1u))) a = -__builtin_inff(); }
        sc[sidx] = a; lmax = fmaxf(lmax, a); }
    __syncthreads();
    float den = 1.f;
    if (mode != 2) { const float mx = blk_red(red, lmax, tid, true); float ls = 0.f;
        for (int sidx = tid; sidx < nk; sidx += 512) { const float p = expf(sc[sidx] - mx); sc[sidx] = p; ls += p; }
        __syncthreads(); den = blk_red(red, ls, tid, false); }
    else { if (tid == 0) { float rc = 0.f; for (int sidx = nk - 1; sidx >= 0; --sidx) { const float z = sc[sidx]; const float sp = fmaxf(z, 0.f) + log1pf(expf(-fabsf(z))); rc += sp; sc[sidx] = expf(z - rc); } } __syncthreads(); }
    float ov = 0.f, df = 0.f;
    if (tid < 128) { float a = 0.f; for (int sidx = 0; sidx < nk; ++sidx) a += sc[sidx] * bfv(V + (size_t)sidx * ld + tid); ov = a / den; df = fabsf(bfv(O + (size_t)t * ldo + tid) - ov); }
    const float mo = blk_red(red, fabsf(ov), tid, true), md = blk_red(red, df, tid, true);
    if (tid == 0 && !(md <= 0.03f * mo + 1e-6f)) atomicOr(err, bit);
    __syncthreads();
}
__device__ __forceinline__ void ml_check(const Frame& F_, const bf16* QKV  , const float* GATES  , const float* cw, const float* cb, const float* bif, const float* ng, const bf16* Y  , int h, int t, unsigned* err, unsigned bit) {
    Frame F = F_; asm volatile("" : "+v"(F.lane), "+v"(F.tid), "+s"(F.gw), "+s"(F.vcu), "+s"(F.wave));
    LAS float* qf = (LAS float*)F.lds; LAS float* sc = qf + 256; LAS float* red = sc + 2048; LAS float* av = red + 512; LAS float* misc = av + 2048;
    const int tid = F.tid;
    if (tid == 0) { float B = 0.f, mx = 0.f; for (int sidx = 0; sidx <= t; ++sidx) { const float f = GATES[(size_t)sidx * 16 + 8 + h] + bif[8 + h]; B += fminf(f, 0.f) - log1pf(expf(-fabsf(f)));
            const float a = GATES[(size_t)sidx * 16 + h] + bif[h] - B; av[sidx] = a; mx = fmaxf(mx, a); } misc[0] = mx; misc[1] = B; }
    if (tid >= 64 && tid < 192) { const int d = tid - 64, c = h * 128 + d; float y = cb[c]; for (int k = 0; k < 4; ++k) { const int r = t - 3 + k; if (r >= 0) y += cw[k * 2048 + c] * bfv(QKV + (size_t)r * N_AB + 6144 + c); } qf[d] = bfr(y / (1.f + expf(-y))); }
    __syncthreads();
    const float Mt = misc[0], Bt = misc[1];
    float ls = 0.f;
    for (int sidx = tid; sidx <= t; sidx += 512) { float a = 0.f;
        for (int d = 0; d < 128; ++d) { const int c = 1024 + h * 128 + d; float y = cb[c]; for (int k = 0; k < 4; ++k) { const int r = sidx - 3 + k; if (r >= 0) y += cw[k * 2048 + c] * bfv(QKV + (size_t)r * N_AB + 6144 + c); }
            a += qf[d] * bfr(y / (1.f + expf(-y))); }
        a *= 0.08838834764831845f * expf(av[sidx] - Mt); sc[sidx] = a; ls += a; }
    __syncthreads();
    const float den = blk_red(red, ls, tid, false);
    float hv = 0.f;
    if (tid < 256) { float a = 0.f; for (int sidx = 0; sidx <= t; ++sidx) a += sc[sidx] * bfv(QKV + (size_t)sidx * N_AB + 8192 + h * 256 + tid); hv = a / fmaxf(fabsf(den), expf(-Bt - Mt)); }
    const float mean = blk_red(red, tid < 256 ? hv : 0.f, tid, false) * (1.f / 256.f);
    const float var = blk_red(red, tid < 256 ? (hv - mean) * (hv - mean) : 0.f, tid, false) * (1.f / 256.f);
    float yv = 0.f, df = 0.f;
    if (tid < 256) { const float od = bfv(QKV + (size_t)t * N_AB + 10240 + h * 256 + tid); yv = (hv - mean) / sqrtf(var + LN_EPS) * ng[h * 256 + tid] / (1.f + expf(-od)); df = fabsf(bfv(Y + (size_t)t * DM + 2048 + h * 256 + tid) - yv); }
    const float mo = blk_red(red, fabsf(yv), tid, true), md = blk_red(red, df, tid, true);
    if (tid == 0 && !(md <= 0.03f * mo + 1e-6f)) atomicOr(err, bit);
    __syncthreads();
}
#endif

__global__ void __launch_bounds__(NWAVES * 64, 2) mk_fwd(Args args) {
    extern __shared__ __attribute__((aligned(16))) unsigned char lds_raw[];
    Frame F;
    F.lds = (LAS unsigned char*)lds_raw;
    F.tid = threadIdx.x; F.lane = F.tid & 63; F.wave = __builtin_amdgcn_readfirstlane(F.tid >> 6);
    F.G = gridDim.x; { const int bx = blockIdx.x; F.vcu = (F.G % 8 == 0) ? (bx % 8) * (F.G / 8) + bx / 8 : bx; }
    F.gw = F.vcu * NWAVES + F.wave; F.NGW = F.G * NWAVES;
    unsigned char* ws = args.ws;
    volatile LAS unsigned* MISC = (volatile LAS unsigned*)(F.lds + MISC_OFF);
    for (int u = F.tid; u < (LDS_BYTES - RING_BYTES) / 4; u += NWAVES * 64) ((LAS unsigned*)(F.lds + RING_BYTES))[u] = 0u;
    __syncthreads();
    XcdBarrier bar = xcd_barrier_post((unsigned*)(ws + WS_CTL) + CW_BAR, MISC + 8);
#define GRID_BAR() xcd_barrier(bar)

    PH(1) prologue(F, args);
    GRID_BAR();

#define PHASE_BEGIN const int L = opq_i(layer); GAS unsigned char* const W = (GAS unsigned char*)opq_p(ws); (void)L; (void)W;
    for (int layer = 0; layer < 2; ++layer) {
        { PHASE_BEGIN
            pg8::Gemm g{(const bf16*)(W + WS_XB), (const bf16*)(W + (L == 0 ? WS_W_INAB : WS_W_INCD)), M, L == 0 ? N_AB : N_CDP, DM};
            pg8::StaticOrder S; S.init(g.M, g.N, F.G, (int)blockIdx.x);
            pg8::EpiBf16 E{(unsigned char*)W, L};
            PH(2) pg8::gemm_phase<pg8::EpiBf16, pg8::StaticOrder, true, true>(F.lds, g, S, E);
        }
        GRID_BAR();
        { PHASE_BEGIN
            if (L == 0) { PH(4) kmean_phase(F, (const bf16*)(W + WS_QKV), (float*)(W + WS_KMEAN)); }
            else PH(8) cd_pre_phase(F, (const bf16*)(W + WS_QKV), (bf16*)(W + WS_QKDC), (const float*)ldin(args, 5), (const float*)ldin(args, 6), (const float*)(W + WS_GATES), (const float*)ldin(args, 4), (float*)(W + WS_A2), (float*)(W + WS_M2), (float*)(W + WS_NM), (unsigned*)(W + WS_CTL + CTL_KN2));
        }
        GRID_BAR();
        { PHASE_BEGIN
            const bf16* QKV = (const bf16*)(W + WS_QKV); bf16* Y = (bf16*)(W + WS_Y);
            if (L == 0) {
                for (int it = F.vcu; it < 512; it += F.G) { const int bh = it >> 2, pr = it & 3, b = bh >> 4, h = bh & 15;
                    const bf16* base = QKV + (size_t)b * SEQ * N_AB + h * 128; bf16* ob = Y + (size_t)b * SEQ * DM + h * 128;
                    for (int ps = 0; ps < 2; ++ps) PH(16) att::attn_block<att::MODE_DIL>(base, N_AB, base + 2048, N_AB, base + 4096, N_AB, ob, DM, ps ? 7 - pr : pr, (LAS char*)F.lds, nullptr, nullptr, nullptr); }
                const float* KMEAN = (const float*)(W + WS_KMEAN);
                for (int it = F.vcu; it < 512; it += F.G) { const int bh = it >> 2, pr = it & 3, b = bh >> 4, h = bh & 15;
                    const bf16* base = QKV + (size_t)b * SEQ * N_AB + 6144 + h * 128; bf16* ob = Y + (size_t)b * SEQ * DM + 2048 + h * 128;
                    for (int ps = 0; ps < 2; ++ps) PH(32) att::attn_block<att::MODE_MOBA>(base, N_AB, base + 2048, N_AB, base + 4096, N_AB, ob, DM, ps ? 7 - pr : pr, (LAS char*)F.lds, KMEAN + (size_t)bh * 1024, nullptr, nullptr); }
            } else {
                for (int it = F.vcu; it < 512; it += F.G) { const int bh = it >> 2, pr = it & 3, b = bh >> 4, h = bh & 15;
                    const bf16* base = QKV + (size_t)b * SEQ * N_AB + h * 128; bf16* ob = Y + (size_t)b * SEQ * DM + h * 128;
                    for (int ps = 0; ps < 2; ++ps) PH(64) att::attn_block<att::MODE_SB>(base, N_AB, base + 2048, N_AB, base + 4096, N_AB, ob, DM, ps ? 7 - pr : pr, (LAS char*)F.lds, (const float*)(W + WS_CTL + CTL_KN2) + bh, nullptr, nullptr); }
                const bf16* QKDC = (const bf16*)(W + WS_QKDC); bf16* HD = (bf16*)(W + WS_HD); const float* A2 = (const float*)(W + WS_A2); const float* M2 = (const float*)(W + WS_M2); const float* NMv = (const float*)(W + WS_NM);
                for (int it = F.vcu; it < 512; it += F.G) { const int bv = it >> 2, pr = it & 3, b = bv >> 4, vh = bv & 15, h = vh >> 1, half = vh & 1;
                    const bf16* qd = QKDC + (size_t)b * SEQ * 2048 + h * 128; const bf16* vd = QKV + (size_t)b * SEQ * N_AB + 8192 + h * 256 + half * 128;
                    bf16* ob = HD + (size_t)b * SEQ * 2048 + h * 256 + half * 128; const size_t so = (size_t)(b * 8 + h) * SEQ;
                    for (int ps = 0; ps < 2; ++ps) PH(128) att::attn_block<att::MODE_ML>(qd, 2048, qd + 1024, 2048, vd, N_AB, ob, 2048, ps ? 7 - pr : pr, (LAS char*)F.lds, A2 + so, M2 + so, NMv + so); }
            }
        }
        if (layer == 1) { GRID_BAR(); PHASE_BEGIN PH(256) cd_post_phase(F, (const bf16*)(W + WS_HD), (const bf16*)(W + WS_QKV), (bf16*)(W + WS_Y), (const float*)ldin(args, 7)); }
        GRID_BAR();
        { PHASE_BEGIN
            pg8::Gemm g{(const bf16*)(W + WS_Y), (const bf16*)(W + (L == 0 ? WS_W_OUTAB : WS_W_OUTCD)), M, DM, DM};
            pg8::StaticOrder S; S.init(g.M, g.N, F.G, (int)blockIdx.x);
            pg8::EpiResid E{&args, (unsigned char*)W, L, 0, F.lds};
            PH(512) pg8::gemm_phase<pg8::EpiResid, pg8::StaticOrder, true, true>(F.lds, g, S, E);
        }
        GRID_BAR();
        { PHASE_BEGIN
            pg8::Gemm g{(const bf16*)(W + WS_XB), (const bf16*)(W + (L == 0 ? WS_W_UG0 : WS_W_UG1)), M, 2 * DFF, DM};
            pg8::StaticOrder S; S.init(g.M, g.N, F.G, (int)blockIdx.x);
            pg8::EpiFfnAct E{&args, (unsigned char*)W, L, F.lds};
            PH(2048) pg8::gemm_phase<pg8::EpiFfnAct, pg8::StaticOrder, true, true>(F.lds, g, S, E);
        }
        GRID_BAR();
        { PHASE_BEGIN PH(4096) ffn_fix_phase(F, (bf16*)(W + WS_U), (const float*)(W + WS_G), (const float*)(W + WS_G + 8 * MiB), (const float*)(W + WS_G + 16 * MiB), (const float*)ldin(args, 11) + (size_t)L * 3 * DFF, (const float*)ldin(args, 12) + (size_t)L * DFF); }
        GRID_BAR();
        { PHASE_BEGIN
            pg8::Gemm g{(const bf16*)(W + WS_U), (const bf16*)(W + (L == 0 ? WS_W_DN0 : WS_W_DN1)), M, DM, DFF};
            pg8::StaticOrder S; S.init(g.M, g.N, F.G, (int)blockIdx.x);
            pg8::EpiResid E{&args, (unsigned char*)W, L, 1, F.lds};
            PH(8192) pg8::gemm_phase<pg8::EpiResid, pg8::StaticOrder, true, true>(F.lds, g, S, E);
        }
        GRID_BAR();
        if (layer == 1) { PHASE_BEGIN PH(1024) ln_phase(F, args.out, args.out, nullptr, (const float*)ldin(args, 14) + (size_t)3 * DM, (const float*)ldin(args, 15) + (size_t)3 * DM); }
    }
#undef PHASE_BEGIN
}

extern "C" void kernel_launch(void* const* d_in, const int* in_sizes, int n_in, void* d_out, int out_size, void* d_ws, size_t ws_size, hipStream_t stream) {
    static int grid = 0;
    if (grid == 0) {
        if (n_in != 16 || in_sizes[0] != M * DM || out_size != M * DM || ws_size < WS_END) { fprintf(stderr, "kernel_launch: unexpected shapes (n_in %d, in0 %d, out %d, ws %zu < %zu)\n", n_in, n_in > 0 ? in_sizes[0] : -1, out_size, ws_size, (size_t)WS_END); grid = -1; return; }
        int dev = 0, cus = 0;
        if (hipGetDevice(&dev) != hipSuccess || hipDeviceGetAttribute(&cus, hipDeviceAttributeMultiprocessorCount, dev) != hipSuccess) { grid = -1; return; }
        if (hipFuncSetAttribute((const void*)mk_fwd, hipFuncAttributeMaxDynamicSharedMemorySize, LDS_BYTES) != hipSuccess) { fprintf(stderr, "kernel_launch: hipFuncSetAttribute failed\n"); grid = -1; return; }
        int per_cu = 0;
        if (hipOccupancyMaxActiveBlocksPerMultiprocessor(&per_cu, (const void*)mk_fwd, NWAVES * 64, LDS_BYTES) != hipSuccess || per_cu < 1) fprintf(stderr, "kernel_launch: occupancy query says %d\n", per_cu);
        (void)hipGetLastError();
        grid = cus;
    }
    if (grid < 0) return;
    if (hipMemsetAsync((char*)d_ws + WS_CTL, 0, CTL_ZERO_BYTES, stream) != hipSuccess) return;
    Args a{};
    for (int i = 0; i < 16; ++i) a.in[i] = (const float*)d_in[i];
    a.out = (float*)d_out; a.ws = (unsigned char*)d_ws;
    hipLaunchKernelGGL(mk_fwd, dim3(grid), dim3(NWAVES * 64), LDS_BYTES, stream, a);
}
```

```cpp
#include <hip/hip_runtime.h>
#include <cstdio>
#include <cstdint>

#define LAS __attribute__((address_space(3)))
#define GAS __attribute__((address_space(1)))
typedef unsigned short bf16;
typedef short bf16x8 __attribute__((ext_vector_type(8)));
typedef short s16x4 __attribute__((ext_vector_type(4)));
typedef float f32x16 __attribute__((ext_vector_type(16)));
typedef float f32x4 __attribute__((ext_vector_type(4)));
typedef float f32x2 __attribute__((ext_vector_type(2)));
typedef unsigned u32x4 __attribute__((ext_vector_type(4)));
typedef unsigned u32x2 __attribute__((ext_vector_type(2)));

#ifndef PH_MASK
#define PH_MASK 0xFFFF
#endif
#define PH(x) if constexpr ((PH_MASK & (x)) != 0)

constexpr int BATCH = 8, SEQ = 2048, DM = 4096, M = BATCH * SEQ;
constexpr int DFF = 11008, N_AB = 12288, N_CD = 12304, N_CDP = 12544;
constexpr float ALPHA = 1.4142135623730951f;
constexpr float LN_EPS = 1e-5f;
constexpr int NWAVES = 8;

constexpr size_t MiB = 1u << 20;
constexpr size_t WS_CTL = 0, CTL_ZERO_BYTES = 1 * MiB;
constexpr size_t WS_KMEAN = 1 * MiB;
constexpr size_t WS_GATES = 2 * MiB;
constexpr size_t WS_A2 = 3 * MiB;
constexpr size_t WS_M2 = 3 * MiB + 512 * 1024;
constexpr size_t WS_NM = 4 * MiB;
constexpr size_t WS_W_INAB = 8 * MiB, WS_W_OUTAB = 104 * MiB, WS_W_UG0 = 136 * MiB, WS_W_DN0 = 308 * MiB;
constexpr size_t WS_W_INCD = 394 * MiB, WS_W_OUTCD = 492 * MiB, WS_W_UG1 = 524 * MiB, WS_W_DN1 = 696 * MiB;
constexpr size_t WS_XB = 782 * MiB;
constexpr size_t WS_R = 910 * MiB;
constexpr size_t WS_QKV = WS_R, WS_Y = WS_R + 384 * MiB, WS_QKDC = WS_R + 512 * MiB, WS_HD = WS_R + 576 * MiB;
constexpr size_t WS_U = WS_R, WS_G = WS_R + 344 * MiB;
constexpr size_t WS_END = WS_R + 688 * MiB;
static_assert((size_t)M * DFF * 2 == 344 * MiB, "u/g size");
constexpr int CW_BAR = 4096;
constexpr size_t CTL_KN2 = 32768;
constexpr size_t CTL_STATS = 65536;
constexpr size_t CTL_CS_UG0 = 524288, CTL_BS_UG0 = CTL_CS_UG0 + 88064, CTL_CS_INCD = CTL_BS_UG0 + 88064, CTL_BS_INCD = CTL_CS_INCD + 50176, CTL_CS_UG1 = CTL_BS_INCD + 50176, CTL_BS_UG1 = CTL_CS_UG1 + 88064;
static_assert(CTL_BS_UG1 + 88064 <= CTL_ZERO_BYTES && CTL_STATS + 3 * (size_t)M * 8 <= CTL_CS_UG0, "CTL map");

constexpr int RING_BYTES = 131072;
constexpr int MISC_OFF = RING_BYTES + 320;
constexpr int LDS_BYTES = 147456;

#define LDS_WAIT() asm volatile("s_waitcnt lgkmcnt(0)" ::: "memory")
#define VM_WAIT() asm volatile("s_waitcnt vmcnt(0)" ::: "memory")
#define SBAR() __builtin_amdgcn_sched_barrier(0)
#define WG_BAR() do { asm volatile("" ::: "memory"); __builtin_amdgcn_s_barrier(); asm volatile("" ::: "memory"); } while (0)

__device__ __forceinline__ unsigned cvtpk(float lo, float hi) { unsigned r; asm volatile("v_cvt_pk_bf16_f32 %0, %1, %2" : "=v"(r) : "v"(lo), "v"(hi)); return r; }
__device__ __forceinline__ float bf_lo(unsigned w) { return __uint_as_float(w << 16); }
__device__ __forceinline__ float bf_hi(unsigned w) { return __uint_as_float(w & 0xffff0000u); }
__device__ __forceinline__ float wave_sum(float v) {
#pragma unroll
    for (int o = 1; o < 64; o <<= 1) v += __shfl_xor(v, o);
    return v;
}
__device__ __forceinline__ float silu_f(float y) { return y * __builtin_amdgcn_rcpf(1.0f + __builtin_amdgcn_exp2f(-1.4426950408889634f * y)); }

struct Args { const float* in[16]; float* out; unsigned char* ws; };
static_assert(sizeof(Args) == 18 * 8, "Args has no padding");
__device__ __forceinline__ const GAS float* ldin(const Args& a, int i) { asm volatile("" : "+s"(i)); return (const GAS float*)a.in[i]; }
__device__ __forceinline__ int opq_i(int v) { asm volatile("" : "+s"(v)); return v; }
__device__ __forceinline__ unsigned char* opq_p(unsigned char* p) { asm volatile("" : "+s"(p)); return p; }

namespace pg8 {
typedef unsigned short bf16_t;
constexpr int BM = 256, BK = 64, HALF = 128, HTB = HALF * BK * 2, STAGE_BYTES = 8 * HTB, NXCD = 8, WGM = 8;
__host__ __device__ __forceinline__ int lds_byte(int r, int c) { const int st = (r >> 4) * 2 + (c >> 5), rr = r & 15, cc = c & 31, ob = rr * 64 + cc * 2; return st * 1024 + (ob ^ (((ob >> 9) & 1) << 5)); }
__host__ __device__ __forceinline__ void stage_rc(int b, int& R, int& C) { const int st = b / 1024, sb = b % 1024, swz = sb ^ (((sb >> 9) & 1) << 5); R = (st >> 1) * 16 + swz / 64; C = (st & 1) * 32 + (swz % 64) / 2; }
__host__ __device__ __forceinline__ int perm32(int rho) { const int n = rho >> 4, i = rho & 15; return 8 * (i >> 2) + 4 * n + (i & 3); }
struct Unit { int pm, pn; };
struct Gemm { const bf16_t* A; const bf16_t* Bt; int M, N, K; };
struct StaticOrder {
    int nM, nN, nwg, G, c;
    __host__ __device__ void init(int M_, int N_, int G_, int c_) { nM = M_ / BM; nN = N_ / BM; nwg = nM * nN; G = G_; c = c_; }
    __host__ __device__ bool next(int i, Unit& u) const {
        const long L = (long)i * G + c; if (L >= nwg) return false;
        int wgid = (int)L; { const int q = nwg / NXCD, r = nwg % NXCD, xcd = wgid % NXCD, off = wgid / NXCD; wgid = (xcd < r ? xcd * (q + 1) : r * (q + 1) + (xcd - r) * q) + off; }
        const int nig = WGM * nN, gid = wgid / nig, fm = gid * WGM, gsz = (nM - fm) < WGM ? (nM - fm) : WGM;
        u.pm = fm + ((wgid % nig) % gsz); u.pn = (wgid % nig) / gsz; return true;
    }
    __device__ __forceinline__ void a_ready(const Unit&) const {}
    __device__ __forceinline__ void done(const Unit&) const {}
};
struct EpiBf16 {
    static constexpr bool PERM = true, AFTER_DRAIN = false;
    unsigned char* W; int L;
    __device__ __forceinline__ void operator()(const f32x4 (&acc)[2][2][4][2], const Unit& u, int wr_, int wc_, int fr_, int fq_) const {
        int tid_ = threadIdx.x; asm volatile("" : "+v"(tid_));
        GAS unsigned char* const Wg = (GAS unsigned char*)W;
        GAS bf16_t* const O = (GAS bf16_t*)(Wg + WS_QKV); constexpr int ldc = N_AB, split_cols = 0; constexpr size_t split_stride = 0; GAS float* const gates = (GAS float*)(Wg + WS_GATES); const int gate_pn = L == 0 ? -1 : 48;
        const GAS float* const st = L == 0 ? nullptr : (const GAS float*)(Wg + WS_CTL + CTL_STATS) + (size_t)1 * M * 2;
        const GAS float* const cs = (const GAS float*)(Wg + WS_CTL + CTL_CS_INCD); const GAS float* const bs = (const GAS float*)(Wg + WS_CTL + CTL_BS_INCD);
        const int wid = __builtin_amdgcn_readfirstlane(tid_ >> 6), wr = wid >> 2, wc = wid & 3, fr = tid_ & 15, fq = (tid_ & 63) >> 4;
        const int row0 = u.pm * BM + wr * 64 + fr;
        const int colg = u.pn * BM + wc * 32 + 8 * fq;
        f32x4 csv[2][2], bsv[2][2];
        if (st) {
#pragma unroll
            for (int bj = 0; bj < 2; ++bj)
#pragma unroll
                for (int n = 0; n < 2; ++n) { csv[bj][n] = *(const f32x4*)(cs + colg + bj * HALF + 4 * n); bsv[bj][n] = *(const f32x4*)(bs + colg + bj * HALF + 4 * n); }
        }
        int colt = u.pn * BM; GAS bf16_t* base = O;
        if (split_cols) { const int t = colt / split_cols; base += (size_t)t * split_stride; colt -= t * split_cols; }
        const int col0 = colt + wc * 32 + 8 * fq;
        const GAS float* stp = st + (size_t)row0 * 2;
#pragma unroll
        for (int ai = 0; ai < 2; ++ai)
#pragma unroll
            for (int m = 0; m < 4; ++m) { const int row = row0 + ai * HALF + m * 16;
                float mu = 0.f, rs = 1.f;
                if (st) { const f32x2 sv = *(const f32x2*)(stp + (ai * HALF + m * 16) * 2); mu = sv[0] * (1.f / DM); rs = __builtin_amdgcn_rsqf(sv[1] * (1.f / DM) - mu * mu + LN_EPS); }
                f32x4 v[2][2];
#pragma unroll
                for (int bj = 0; bj < 2; ++bj)
#pragma unroll
                    for (int n = 0; n < 2; ++n) v[bj][n] = st ? (acc[ai][bj][m][n] - csv[bj][n] * mu) * rs + bsv[bj][n] : acc[ai][bj][m][n];
                if (u.pn == gate_pn) { if (wc == 0 && fq < 2) { GAS float* gp = gates + (size_t)row * 16 + 8 * fq; *(GAS f32x4*)gp = v[0][0]; *(GAS f32x4*)(gp + 4) = v[0][1]; } }
                else { GAS bf16_t* rowp = base + (size_t)row * ldc + col0;
#pragma unroll
                    for (int bj = 0; bj < 2; ++bj) { u32x4 w; w.x = cvtpk(v[bj][0][0], v[bj][0][1]); w.y = cvtpk(v[bj][0][2], v[bj][0][3]); w.z = cvtpk(v[bj][1][0], v[bj][1][1]); w.w = cvtpk(v[bj][1][2], v[bj][1][3]);
                        *(u32x4*)(rowp + bj * HALF) = w; } } }
    }
};
struct EpiResid {
    static constexpr bool PERM = true, AFTER_DRAIN = false;
    const Args* ap; unsigned char* W; int L, which; LAS unsigned char* lds;
    __device__ __forceinline__ void operator()(const f32x4 (&acc)[2][2][4][2], const Unit& u, int wr_, int wc_, int fr_, int fq_) const {
        int tid_ = threadIdx.x; asm volatile("" : "+v"(tid_));
        const int wid = __builtin_amdgcn_readfirstlane(tid_ >> 6), wr = wid >> 2, wc = wid & 3, lane = tid_ & 63, fr = tid_ & 15, fq = (tid_ & 63) >> 4;
        GAS unsigned char* const Wg = (GAS unsigned char*)W; GAS float* const STATS = (GAS float*)(Wg + WS_CTL + CTL_STATS);
        const bool lastsub = (which == 1 && L == 1);
        const GAS bf16_t* const zbin = (const GAS bf16_t*)(Wg + WS_XB); GAS bf16_t* const zb = lastsub ? nullptr : (GAS bf16_t*)(Wg + WS_XB); GAS float* const out32 = lastsub ? (GAS float*)ap->out : nullptr;
        const GAS float* const st_in = which == 0 ? (L == 0 ? nullptr : STATS + (size_t)1 * M * 2) : STATS + (size_t)(L == 0 ? 0 : 2) * M * 2;
        GAS float* const st_out = which == 0 ? STATS + (size_t)(L == 0 ? 0 : 2) * M * 2 : (L == 0 ? STATS + (size_t)1 * M * 2 : nullptr);
        const int lnoff = which == 0 ? DM : 2 * L * DM;
        const GAS float* const lg = ldin(*ap, 14) + lnoff; const GAS float* const lb = ldin(*ap, 15) + lnoff;
        constexpr float alpha = ALPHA; LAS float* const red = (LAS float*)(lds + RING_BYTES + 1024);
        constexpr int ldc = DM;
        const int row0 = u.pm * BM + wr * 64 + fr, col0 = u.pn * BM + wc * 32 + 8 * fq;
        LAS float* myred = red + wid * 256;
#pragma unroll
        for (int ai = 0; ai < 2; ++ai) { u32x4 xr[4][2]; f32x2 sv[4]; f32x4 s1 = {0.f, 0.f, 0.f, 0.f}, s2 = {0.f, 0.f, 0.f, 0.f};
#pragma unroll
            for (int m = 0; m < 4; ++m) { const size_t off = (size_t)(row0 + ai * HALF + m * 16) * ldc + col0;
                xr[m][0] = *(const GAS u32x4*)(zbin + off); xr[m][1] = *(const GAS u32x4*)(zbin + off + HALF); sv[m] = st_in ? *(const GAS f32x2*)(st_in + (size_t)row0 * 2 + (ai * HALF + m * 16) * 2) : (f32x2){0.f, 0.f}; }
#pragma unroll
            for (int bj = 0; bj < 2; ++bj) {
                f32x4 gv[2], bv[2];
#pragma unroll
                for (int n = 0; n < 2; ++n) { gv[n] = st_in ? *(const GAS f32x4*)(lg + col0 + bj * HALF + 4 * n) : (f32x4){1.f, 1.f, 1.f, 1.f}; bv[n] = st_in ? *(const GAS f32x4*)(lb + col0 + bj * HALF + 4 * n) : (f32x4){0.f, 0.f, 0.f, 0.f}; }
#pragma unroll
                for (int m = 0; m < 4; ++m) { const float mu = sv[m][0] * (1.f / DM), rs = st_in ? __builtin_amdgcn_rsqf(sv[m][1] * (1.f / DM) - mu * mu + LN_EPS) : 1.f;
                    const u32x4 r = xr[m][bj]; const size_t off = (size_t)(row0 + ai * HALF + m * 16) * ldc + col0 + bj * HALF;
                    const f32x4 z0 = (((f32x4){bf_lo(r.x), bf_hi(r.x), bf_lo(r.y), bf_hi(r.y)} - mu) * rs * gv[0] + bv[0]) * alpha + acc[ai][bj][m][0];
                    const f32x4 z1 = (((f32x4){bf_lo(r.z), bf_hi(r.z), bf_lo(r.w), bf_hi(r.w)} - mu) * rs * gv[1] + bv[1]) * alpha + acc[ai][bj][m][1];
                    if (out32) { *(GAS f32x4*)(out32 + off) = z0; *(GAS f32x4*)(out32 + off + 4) = z1; }
                    if (zb) { u32x4 w; w.x = cvtpk(z0[0], z0[1]); w.y = cvtpk(z0[2], z0[3]); w.z = cvtpk(z1[0], z1[1]); w.w = cvtpk(z1[2], z1[3]); *(GAS u32x4*)(zb + off) = w; }
                    s1[m] += (z0[0] + z0[1]) + (z0[2] + z0[3]) + (z1[0] + z1[1]) + (z1[2] + z1[3]);
                    s2[m] += (z0[0] * z0[0] + z0[1] * z0[1]) + (z0[2] * z0[2] + z0[3] * z0[3]) + (z1[0] * z1[0] + z1[1] * z1[1]) + (z1[2] * z1[2] + z1[3] * z1[3]); }
            }
            if (st_out) {
#pragma unroll
                for (int m = 0; m < 4; ++m) { float a1 = s1[m], a2 = s2[m]; a1 += __shfl_xor(a1, 16); a1 += __shfl_xor(a1, 32); a2 += __shfl_xor(a2, 16); a2 += __shfl_xor(a2, 32);
                    if (fq == 0) *(LAS f32x2*)(myred + ((ai * 4 + m) * 16 + fr) * 2) = (f32x2){a1, a2}; } }
            asm volatile("" ::: "memory"); }
        if (st_out) {
            asm volatile("s_waitcnt lgkmcnt(0)" ::: "memory");
            GAS float* sp = st_out + (size_t)(u.pm * BM + wr * 64) * 2;
#pragma unroll
            for (int j = 0; j < 4; ++j) { const int idx = j * 64 + lane, g = idx >> 5, r = (idx & 31) >> 1, c = idx & 1;
                unsafeAtomicAdd((float*)(sp + ((g >> 2) * HALF + (g & 3) * 16 + r) * 2 + c), myred[idx]); }
            asm volatile("s_waitcnt lgkmcnt(0)" ::: "memory");
        }
    }
};

__device__ __forceinline__ float dpp_ror1(float x) { return __int_as_float(__builtin_amdgcn_update_dpp(0, __float_as_int(x), 0x121, 0xF, 0xF, false)); }
__device__ __forceinline__ float dpp_ror2(float x) { return __int_as_float(__builtin_amdgcn_update_dpp(0, __float_as_int(x), 0x122, 0xF, 0xF, false)); }
struct EpiFfnAct {
    static constexpr bool PERM = true, AFTER_DRAIN = false;
    const Args* ap; unsigned char* W; int L; LAS unsigned char* lds;
    __device__ __forceinline__ void operator()(f32x4 (&acc)[2][2][4][2], const Unit& u, int wr_, int wc_, int fr_, int fq_) const {
        int tid_ = threadIdx.x; asm volatile("" : "+v"(tid_));
        GAS unsigned char* const Wg = (GAS unsigned char*)W;
        GAS bf16_t* const H = (GAS bf16_t*)(Wg + WS_U); const GAS float* const cw = ldin(*ap, 11) + (size_t)L * 3 * DFF; const GAS float* const cb = ldin(*ap, 12) + (size_t)L * DFF;
        GAS float* const EG0 = (GAS float*)(Wg + WS_G); GAS float* const EU0 = (GAS float*)(Wg + WS_G + 8 * MiB); GAS float* const EGL = (GAS float*)(Wg + WS_G + 16 * MiB); LAS float* const edge = (LAS float*)(lds + RING_BYTES + 1024);
        const GAS float* const st = (const GAS float*)(Wg + WS_CTL + CTL_STATS) + (size_t)(L == 0 ? 0 : 2) * M * 2;
        const GAS float* const cs = (const GAS float*)(Wg + WS_CTL + (L == 0 ? CTL_CS_UG0 : CTL_CS_UG1)); const GAS float* const bs = (const GAS float*)(Wg + WS_CTL + (L == 0 ? CTL_BS_UG0 : CTL_BS_UG1));
        const int wid = __builtin_amdgcn_readfirstlane(tid_ >> 6), wr = wid >> 2, wc = wid & 3, fr = tid_ & 15, fq = (tid_ & 63) >> 4;
        const int ch0 = u.pn * 128 + wc * 32 + fq * 8, row0 = u.pm * BM + wr * 64 + fr, colg = u.pn * BM + wc * 32 + 8 * fq;
        const GAS float* stp = st + (size_t)row0 * 2;
        f32x2 sv[2][4]; f32x4 csg[2], bsg[2];
#pragma unroll
        for (int ai = 0; ai < 2; ++ai)
#pragma unroll
            for (int m = 0; m < 4; ++m) sv[ai][m] = *(const f32x2*)(stp + (ai * HALF + m * 16) * 2);
#pragma unroll
        for (int n = 0; n < 2; ++n) { csg[n] = *(const f32x4*)(cs + colg + HALF + 4 * n); bsg[n] = *(const f32x4*)(bs + colg + HALF + 4 * n); }
        float mu[2][4], rs[2][4];
#pragma unroll
        for (int ai = 0; ai < 2; ++ai)
#pragma unroll
            for (int m = 0; m < 4; ++m) { mu[ai][m] = sv[ai][m][0] * (1.f / DM); rs[ai][m] = __builtin_amdgcn_rsqf(sv[ai][m][1] * (1.f / DM) - mu[ai][m] * mu[ai][m] + LN_EPS);
#pragma unroll
                for (int n = 0; n < 2; ++n) acc[ai][1][m][n] = (acc[ai][1][m][n] - csg[n] * mu[ai][m]) * rs[ai][m] + bsg[n];
                asm volatile("" : "+v"(acc[ai][1][m][0]), "+v"(acc[ai][1][m][1])); }
        asm volatile("" ::: "memory");
        f32x4 csu[2], bsu[2], wt[4][2];
#pragma unroll
        for (int n = 0; n < 2; ++n) { csu[n] = *(const f32x4*)(cs + colg + 4 * n); bsu[n] = *(const f32x4*)(bs + colg + 4 * n);
            wt[0][n] = *(const f32x4*)(cw + ch0 + 4 * n); wt[1][n] = *(const f32x4*)(cw + DFF + ch0 + 4 * n); wt[2][n] = *(const f32x4*)(cw + 2 * DFF + ch0 + 4 * n); wt[3][n] = *(const f32x4*)(cb + ch0 + 4 * n); }
#define FFN_G(ai, m, n) (acc[ai][1][m][n])
#define FFN_U(ai, m, n) ((acc[ai][0][m][n] - csu[n] * mu[ai][m]) * rs[ai][m] + bsu[n])
        if (fr >= 14) {
#pragma unroll
            for (int ai = 0; ai < 2; ++ai) { LAS float* e = edge + ((((ai * 2 + wr) * 4 + wc) * 4 + fq) * 2 + (fr - 14)) * 8; *(LAS f32x4*)e = FFN_G(ai, 3, 0); *(LAS f32x4*)(e + 4) = FFN_G(ai, 3, 1); }
            if (wr == 1) { GAS float* p = EGL + (size_t)(u.pm * 2 + (fr - 14)) * DFF + ch0; *(GAS f32x4*)p = FFN_G(1, 3, 0); *(GAS f32x4*)(p + 4) = FFN_G(1, 3, 1); }
        }
        if (wr == 0 && fr < 2) { GAS float* pg = EG0 + (size_t)(u.pm * 2 + fr) * DFF + ch0; GAS float* pu = EU0 + (size_t)(u.pm * 2 + fr) * DFF + ch0;
            *(GAS f32x4*)pg = FFN_G(0, 0, 0); *(GAS f32x4*)(pg + 4) = FFN_G(0, 0, 1); *(GAS f32x4*)pu = FFN_U(0, 0, 0); *(GAS f32x4*)(pu + 4) = FFN_U(0, 0, 1); }
        asm volatile("s_waitcnt lgkmcnt(0)" ::: "memory"); __builtin_amdgcn_s_barrier(); asm volatile("" ::: "memory");
#pragma unroll
        for (int ai = 0; ai < 2; ++ai) {
            f32x4 e14[2] = {(f32x4){0.f, 0.f, 0.f, 0.f}, (f32x4){0.f, 0.f, 0.f, 0.f}}, e15[2] = {(f32x4){0.f, 0.f, 0.f, 0.f}, (f32x4){0.f, 0.f, 0.f, 0.f}};
            if (wr == 1 || ai == 1) { const int sa = (wr == 1) ? ai : 0, sw = (wr == 1) ? 0 : 1; const LAS float* e = edge + (((sa * 2 + sw) * 4 + wc) * 4 + fq) * 16;
                e14[0] = *(const LAS f32x4*)e; e14[1] = *(const LAS f32x4*)(e + 4); e15[0] = *(const LAS f32x4*)(e + 8); e15[1] = *(const LAS f32x4*)(e + 12); }
#pragma unroll
            for (int m = 0; m < 4; ++m) {
                float hv[8];
#pragma unroll
                for (int n = 0; n < 2; ++n) { const f32x4 uu = FFN_U(ai, m, n);
#pragma unroll
                    for (int j = 0; j < 4; ++j) { const int c = 4 * n + j; const float gc = acc[ai][1][m][n][j]; const float r1 = dpp_ror1(gc), r2 = dpp_ror2(gc);
                        float q1, q2;
                        if (m == 0) { q1 = e15[n][j]; q2 = (fr == 0) ? e14[n][j] : e15[n][j]; }
                        else { const float gpv = acc[ai][1][m > 0 ? m - 1 : 0][n][j]; q1 = dpp_ror1(gpv); q2 = dpp_ror2(gpv); }
                        const float p1 = (fr == 0) ? q1 : r1, p2 = (fr < 2) ? q2 : r2;
                        const float y = wt[0][n][j] * p2 + wt[1][n][j] * p1 + wt[2][n][j] * gc + wt[3][n][j];
                        hv[c] = silu_f(y) * uu[j]; } }
                if (!(ai == 0 && m == 0 && wr == 0 && fr < 2)) { u32x4 w; w.x = cvtpk(hv[0], hv[1]); w.y = cvtpk(hv[2], hv[3]); w.z = cvtpk(hv[4], hv[5]); w.w = cvtpk(hv[6], hv[7]);
                    *(u32x4*)(H + (size_t)(row0 + ai * HALF + m * 16) * DFF + ch0) = w; }
            }
        }
#undef FFN_G
#undef FFN_U
    }
};

template <class Epi, class Sched, bool ALIGN_EPI = false, bool SP2 = false>
__device__ __forceinline__ void gemm_phase(LAS unsigned char* lds, const Gemm g, const Sched& S, const Epi& E) {
    int tid_ = threadIdx.x; asm volatile("" : "+v"(tid_));
    const int tid = tid_, wid = __builtin_amdgcn_readfirstlane(tid >> 6), lane = tid & 63, wr = wid >> 2, wc = wid & 3, fr = lane & 15, fq = lane >> 4;
    const int K = g.K, nt = K / BK;
    unsigned voffA[2], voffB[2];
#pragma unroll
    for (int i = 0; i < 2; ++i) { int R, C; stage_rc(tid * 16 + i * 8192, R, C); const int Rb = Epi::PERM ? ((R & ~31) + perm32(R & 31)) : R;
        voffA[i] = (unsigned)(R * K + C) * 2u; voffB[i] = (unsigned)(Rb * K + C) * 2u; }
    const size_t kstep = (size_t)(BK * 2);
    const size_t hstep = (size_t)HALF * K * 2;
    const size_t tstep = 2 * hstep;
    const unsigned ldsw = (unsigned)wid * 1024u;
    const int aoff = lds_byte(wr * 64 + fr, fq * 8), boff = lds_byte(wc * 32 + fr, fq * 8);
#define PG8_SA(b, h) (((b) * 2 + (h)) * HTB)
#define PG8_SB(b, h) ((4 + (b) * 2 + (h)) * HTB)
#define PG8_STAGE(bufoff, gbase, voff) do { _Pragma("unroll") for (int _i = 0; _i < 2; ++_i) \
        __builtin_amdgcn_global_load_lds((const unsigned*)((const char*)(gbase) + (voff)[_i]), (LAS unsigned*)(lds + (bufoff) + ldsw + _i * 8192), 16, 0, 0); } while (0)
#define PG8_LDA(dst, b, h) do { _Pragma("unroll") for (int m = 0; m < 4; ++m) _Pragma("unroll") for (int k = 0; k < 2; ++k) dst[m][k] = *(const LAS bf16x8*)(lds + PG8_SA(b, h) + aoff + m * 2048 + k * 1024); } while (0)
#define PG8_LDB(dst, b, h) do { _Pragma("unroll") for (int n = 0; n < 2; ++n) _Pragma("unroll") for (int k = 0; k < 2; ++k) dst[n][k] = *(const LAS bf16x8*)(lds + PG8_SB(b, h) + boff + n * 2048 + k * 1024); } while (0)
#define PG8_MMA(ai, bj, At, Bt) do { __builtin_amdgcn_s_setprio(1); _Pragma("unroll") for (int m = 0; m < 4; ++m) _Pragma("unroll") for (int n = 0; n < 2; ++n) _Pragma("unroll") for (int k = 0; k < 2; ++k) \
        acc[ai][bj][m][n] = __builtin_amdgcn_mfma_f32_16x16x32_bf16(Bt[n][k], At[m][k], acc[ai][bj][m][n], 0, 0, 0); __builtin_amdgcn_s_setprio(0); } while (0)
#define PG8_WAIT_V(n) asm volatile("s_waitcnt vmcnt(" #n ")" ::: "memory")
#define PG8_WAIT_L(n) asm volatile("s_waitcnt lgkmcnt(" #n ")" ::: "memory")
#define PG8_BAR __builtin_amdgcn_s_barrier()
#define PG8_SCHED __builtin_amdgcn_sched_barrier(0)
    Unit cur, nxt; int ui = 0;
    if (!S.next(0, cur)) return;
    f32x4 acc[2][2][4][2];
#pragma unroll
    for (int a = 0; a < 2; ++a)
#pragma unroll
        for (int b = 0; b < 2; ++b)
#pragma unroll
            for (int m = 0; m < 4; ++m)
#pragma unroll
                for (int n = 0; n < 2; ++n) acc[a][b][m][n] = (f32x4){0.f, 0.f, 0.f, 0.f};
    bf16x8 At[4][2], B0[2][2], B1[2][2];
    const char* cA = (const char*)g.A + (size_t)cur.pm * tstep; const char* cB = (const char*)g.Bt + (size_t)cur.pn * tstep;
    S.a_ready(cur);
    if constexpr (SP2) {
        PG8_STAGE(PG8_SB(0, 0), cB, voffB); PG8_STAGE(PG8_SB(0, 1), cB + hstep, voffB); PG8_STAGE(PG8_SA(0, 0), cA, voffA); PG8_STAGE(PG8_SA(0, 1), cA + hstep, voffA);
        if (wr == 1) PG8_BAR;
        PG8_WAIT_V(2); PG8_BAR;
        PG8_STAGE(PG8_SB(1, 0), cB + kstep, voffB); PG8_STAGE(PG8_SA(1, 0), cA + kstep, voffA); PG8_STAGE(PG8_SB(1, 1), cB + hstep + kstep, voffB);
        PG8_WAIT_V(6); PG8_BAR;
    } else {
        PG8_STAGE(PG8_SB(0, 0), cB, voffB); PG8_STAGE(PG8_SA(0, 0), cA, voffA); PG8_STAGE(PG8_SB(0, 1), cB + hstep, voffB); PG8_STAGE(PG8_SA(0, 1), cA + hstep, voffA);
        if (wr == 1) PG8_BAR;
        PG8_WAIT_V(4); PG8_BAR;
        PG8_STAGE(PG8_SB(1, 0), cB + kstep, voffB); PG8_STAGE(PG8_SA(1, 0), cA + kstep, voffA); PG8_STAGE(PG8_SB(1, 1), cB + hstep + kstep, voffB);
        PG8_WAIT_V(6); PG8_BAR;
    }
    for (;;) {
        const bool has_next = S.next(ui + 1, nxt);
        const char* nA = has_next ? (const char*)g.A + (size_t)nxt.pm * tstep : cA; const char* nB = has_next ? (const char*)g.Bt + (size_t)nxt.pn * tstep : cB;
        for (int t = 0; t < nt; t += 2) {
            const bool last = (t == nt - 2);
            const char* a1 = cA + (size_t)(t + 1) * kstep;
            const char* a2 = last ? nA : cA + (size_t)(t + 2) * kstep; const char* b2 = last ? nB : cB + (size_t)(t + 2) * kstep;
            const char* a3 = a2 + kstep; const char* b3 = b2 + kstep;
            if (last && has_next) S.a_ready(nxt);
            if constexpr (SP2) {
            PG8_LDB(B0, 0, 0); PG8_LDB(B1, 0, 1); PG8_SCHED; PG8_LDA(At, 0, 0); PG8_STAGE(PG8_SA(1, 1), a1 + hstep, voffA);
            PG8_WAIT_V(8); PG8_WAIT_L(0); PG8_BAR; PG8_MMA(0, 0, At, B0); PG8_MMA(0, 1, At, B1); PG8_BAR; PG8_SCHED;
            PG8_LDA(At, 0, 1); PG8_STAGE(PG8_SB(0, 0), b2, voffB); PG8_STAGE(PG8_SB(0, 1), b2 + hstep, voffB); PG8_STAGE(PG8_SA(0, 0), a2, voffA);
            PG8_WAIT_V(8); PG8_WAIT_L(0); PG8_BAR; PG8_MMA(1, 0, At, B0); PG8_MMA(1, 1, At, B1); PG8_BAR; PG8_SCHED;
            PG8_LDB(B0, 1, 0); PG8_LDB(B1, 1, 1); PG8_SCHED; PG8_LDA(At, 1, 0); PG8_STAGE(PG8_SA(0, 1), a2 + hstep, voffA);
            PG8_WAIT_V(8); PG8_WAIT_L(0); PG8_BAR; PG8_MMA(0, 0, At, B0); PG8_MMA(0, 1, At, B1); PG8_BAR; PG8_SCHED;
            PG8_LDA(At, 1, 1); PG8_STAGE(PG8_SB(1, 0), b3, voffB); PG8_STAGE(PG8_SB(1, 1), b3 + hstep, voffB); PG8_STAGE(PG8_SA(1, 0), a3, voffA);
            PG8_WAIT_V(8); PG8_WAIT_L(0); PG8_BAR; PG8_MMA(1, 0, At, B0); PG8_MMA(1, 1, At, B1); PG8_BAR; PG8_SCHED;
            } else {
            PG8_LDB(B0, 0, 0); PG8_SCHED; PG8_LDA(At, 0, 0); PG8_STAGE(PG8_SA(1, 1), a1 + hstep, voffA);
            PG8_WAIT_L(8); PG8_BAR; PG8_WAIT_L(0); PG8_MMA(0, 0, At, B0); PG8_BAR; PG8_SCHED;
            PG8_LDB(B1, 0, 1); PG8_STAGE(PG8_SB(0, 0), b2, voffB);
            PG8_BAR; PG8_WAIT_L(0); PG8_MMA(0, 1, At, B1); PG8_BAR;
            PG8_LDA(At, 0, 1); PG8_STAGE(PG8_SA(0, 0), a2, voffA);
            PG8_BAR; PG8_WAIT_L(0); PG8_MMA(1, 0, At, B0); PG8_BAR; PG8_SCHED;
            PG8_STAGE(PG8_SB(0, 1), b2 + hstep, voffB);
            PG8_WAIT_V(6); PG8_BAR; PG8_MMA(1, 1, At, B1); PG8_BAR;
            PG8_LDB(B0, 1, 0); PG8_SCHED; PG8_LDA(At, 1, 0); PG8_STAGE(PG8_SA(0, 1), a2 + hstep, voffA);
            PG8_WAIT_L(8); PG8_BAR; PG8_WAIT_L(0); PG8_MMA(0, 0, At, B0); PG8_BAR; PG8_SCHED;
            PG8_LDB(B1, 1, 1); PG8_STAGE(PG8_SB(1, 0), b3, voffB);
            PG8_BAR; PG8_WAIT_L(0); PG8_MMA(0, 1, At, B1); PG8_BAR;
            PG8_LDA(At, 1, 1); PG8_STAGE(PG8_SA(1, 0), a3, voffA);
            PG8_BAR; PG8_WAIT_L(0); PG8_MMA(1, 0, At, B0); PG8_BAR; PG8_SCHED;
            PG8_STAGE(PG8_SB(1, 1), b3 + hstep, voffB);
            PG8_WAIT_V(6); PG8_BAR; PG8_MMA(1, 1, At, B1); PG8_BAR;
            }
        }
        if constexpr (ALIGN_EPI) { if (wr == 0) PG8_BAR; }
        if constexpr (!Epi::AFTER_DRAIN) { E(acc, cur, wr, wc, fr, fq); S.done(cur); }
        if (!has_next) break;
#pragma unroll
        for (int a = 0; a < 2; ++a)
#pragma unroll
            for (int b = 0; b < 2; ++b)
#pragma unroll
                for (int m = 0; m < 4; ++m)
#pragma unroll
                    for (int n = 0; n < 2; ++n) acc[a][b][m][n] = (f32x4){0.f, 0.f, 0.f, 0.f};
        cur = nxt; cA = nA; cB = nB; ++ui;
        if constexpr (ALIGN_EPI) { if (wr == 1) PG8_BAR; }
    }
    PG8_WAIT_V(0);
    if constexpr (!ALIGN_EPI) { if (wr == 0) PG8_BAR; }
    PG8_BAR;
#undef PG8_SA
#undef PG8_SB
#undef PG8_STAGE
#undef PG8_LDA
#undef PG8_LDB
#undef PG8_MMA
#undef PG8_WAIT_V
#undef PG8_WAIT_L
#undef PG8_BAR
#undef PG8_SCHED
}
}

#define XB_TMO      128
#define XB_XCNT(j)  (256  + 64 * (j))
#define XB_XSUB(j)  (1280 + 64 * (j))
#define XB_XGEN(j)  (2304 + 64 * (j))
#define XB_TOP      3328
#define XB_TOPGEN   3392
#define XCD_BAR_WORDS 3456
#define XB_SPIN_CAP (1u << 18)
__device__ __forceinline__ unsigned xb_ld(unsigned* p)              { return __hip_atomic_load((GAS unsigned*)p, __ATOMIC_RELAXED, __HIP_MEMORY_SCOPE_AGENT); }
__device__ __forceinline__ unsigned xb_add(unsigned* p, unsigned v) { return __hip_atomic_fetch_add((GAS unsigned*)p, v, __ATOMIC_RELAXED, __HIP_MEMORY_SCOPE_AGENT); }
__device__ __forceinline__ unsigned xb_xcc_id() { return (unsigned)__builtin_amdgcn_s_getreg((3 << 11) | 20) & 0xFu; }
#define XB_SPIN(cond, bar) do { unsigned _sp = 0; while (cond) { __builtin_amdgcn_s_sleep(1); \
    if ((++_sp & 255u) == 0u) { if (xb_ld(&(bar)[XB_TMO])) break; if (_sp > XB_SPIN_CAP) { (void)xb_add(&(bar)[XB_TMO], 1u); break; } } } } while (0)
struct XcdBarrier { unsigned* bar; unsigned x; volatile LAS unsigned* st; };
__device__ __forceinline__ XcdBarrier xcd_barrier_post(unsigned* bar, volatile LAS unsigned* st) {
    XcdBarrier b; b.bar = bar; b.x = xb_xcc_id(); b.st = st;
    if (threadIdx.x == 0) (void)xb_add(&bar[XB_XCNT(b.x)], 1u);
    return b;
}
__device__ __forceinline__ void xcd_barrier_complete(unsigned* bar, unsigned x, unsigned& nloc, unsigned& nx) {
    const unsigned G = gridDim.x * gridDim.y * gridDim.z;
    unsigned sum, cnt, mine, sp = 0u;
    for (;;) {
        sum = 0u; cnt = 0u; mine = 0u;
#pragma unroll
        for (unsigned j = 0; j < 16; ++j) { const unsigned c = xb_ld(&bar[XB_XCNT(j)]); sum += c; cnt += (c > 0u) ? 1u : 0u; mine = (j == x) ? c : mine; }
        if (sum == G) break;
        __builtin_amdgcn_s_sleep(1);
        if ((++sp & 255u) == 0u) { if (xb_ld(&bar[XB_TMO])) break; if (sp > XB_SPIN_CAP) { (void)xb_add(&bar[XB_TMO], 1u); break; } }
    }
    nloc = mine > 0u ? mine : 1u; nx = cnt > 0u ? cnt : 1u;
}
__device__ __forceinline__ void xcd_barrier(const XcdBarrier& b) {
    asm volatile("s_waitcnt vmcnt(0)" ::: "memory");
    __syncthreads();
    if (threadIdx.x == 0) {
        unsigned* bar = b.bar; unsigned bx = b.x;
        asm volatile("" : "+s"(bar), "+s"(bx));
        __builtin_amdgcn_s_waitcnt(0);
        unsigned nloc = b.st[0], nx = b.st[1];
        if (nloc == 0u) { xcd_barrier_complete(bar, bx, nloc, nx); b.st[0] = nloc; b.st[1] = nx; }
        const unsigned old = xb_add(&bar[XB_XSUB(bx)], 1u);
        const unsigned gen = old / nloc;
        if (old + 1u == (gen + 1u) * nloc) {
            __builtin_amdgcn_fence(__ATOMIC_RELEASE, "agent");
            asm volatile("s_waitcnt vmcnt(0)" ::: "memory");
            const unsigned og = xb_add(&bar[XB_TOP], 1u);
            const unsigned tg = og / nx;
            if (og + 1u == (tg + 1u) * nx) xb_add(&bar[XB_TOPGEN], 1u);
            else XB_SPIN(xb_ld(&bar[XB_TOPGEN]) == tg, bar);
            __builtin_amdgcn_fence(__ATOMIC_ACQUIRE, "agent");
            xb_add(&bar[XB_XGEN(bx)], 1u);
            asm volatile("s_waitcnt vmcnt(0)" ::: "memory");
        } else {
            XB_SPIN(xb_ld(&bar[XB_XGEN(bx)]) == gen, bar);
            __builtin_amdgcn_fence(__ATOMIC_ACQUIRE, "agent");
            asm volatile("s_waitcnt vmcnt(0)" ::: "memory");
        }
    }
    __syncthreads();
}

namespace att {
constexpr int D = 128, SHM = 16384;
constexpr int OFF_V = 0, OFF_K = 2 * SHM, OFF_WS = 4 * SHM, OFF_AUX = 4 * SHM + 2048, LDS_USED = 4 * SHM + 2048 + 8192;
constexpr float SCALE = 0.08838834764831845f;
constexpr float C2 = 1.4426950408889634f * SCALE;
constexpr float THR = 8.f;
enum { MODE_DIL = 0, MODE_MOBA = 1, MODE_SB = 2, MODE_ML = 3 };
#define KSWZ(row, colB) ((row) * 256 + ((colB) ^ (((row) & 7) << 4)))
__device__ __forceinline__ int v_st(int k, int c) { const int kk = (k & ~0xC) | ((k & 4) << 1) | ((k & 8) >> 1); return ((kk >> 3) * 4 + (c >> 5)) * 512 + ((kk & 7) * 32 + (c & 31)) * 2; }
__device__ __forceinline__ int v_rd_base(int lane) { return ((lane & 3) << 3) | (((lane >> 2) & 3) << 6) | (((lane >> 4) & 1) << 5) | (((lane >> 5) & 1) << 8); }
__device__ __forceinline__ int crow(int r, int hi) { return (r & 3) + 8 * (r >> 2) + 4 * hi; }
__device__ __forceinline__ void mask_tile(f32x16& p0, f32x16& p1, int dq) {
    const float NEG = -__builtin_inff();
#pragma unroll
    for (int r = 0; r < 16; ++r) {
        const int c = (r & 3) + 8 * (r >> 2);
        if (dq - c < 0) p0[r] = NEG;
        if (dq - c - 32 < 0) p1[r] = NEG;
    }
}
__device__ __forceinline__ void partialSM(f32x16& p0, f32x16& p1, float& m_reg, float& mn, float& alpha) {
    float pmax = p0[0];
#pragma unroll
    for (int r = 1; r < 16; ++r) pmax = fmaxf(pmax, p0[r]);
#pragma unroll
    for (int r = 0; r < 16; ++r) pmax = fmaxf(pmax, p1[r]);
    { auto rr = __builtin_amdgcn_permlane32_swap(__float_as_uint(pmax), __float_as_uint(pmax), false, false);
      pmax = fmaxf(__uint_as_float(rr[0]), __uint_as_float(rr[1])); }
    if (__builtin_expect(__all((pmax - m_reg) * SCALE <= THR), 1)) { mn = m_reg; alpha = 1.f; }
    else { mn = fmaxf(m_reg, pmax); alpha = __builtin_amdgcn_exp2f((m_reg - mn) * C2); m_reg = mn; }
    const float mnL = -mn * C2;
#pragma unroll
    for (int r = 0; r < 16; ++r) p0[r] = fmaf(p0[r], C2, mnL);
#pragma unroll
    for (int r = 0; r < 16; ++r) p1[r] = fmaf(p1[r], C2, mnL);
#pragma unroll
    for (int r = 0; r < 16; ++r) p0[r] = __builtin_amdgcn_exp2f(p0[r]);
#pragma unroll
    for (int r = 0; r < 16; ++r) p1[r] = __builtin_amdgcn_exp2f(p1[r]);
}
#define ATT_PK4(P, B_, OUT) do { unsigned a0 = cvtpk(P[B_+0], P[B_+1]), a1 = cvtpk(P[B_+2], P[B_+3]);                          \
        unsigned b0 = cvtpk(P[B_+4], P[B_+5]), b1 = cvtpk(P[B_+6], P[B_+7]);                                             \
        auto r0 = __builtin_amdgcn_permlane32_swap(a0, b0, false, false); auto r1 = __builtin_amdgcn_permlane32_swap(a1, b1, false, false); \
        u32x4 w = {r0[0], r1[0], r0[1], r1[1]}; OUT = *reinterpret_cast<bf16x8*>(&w); } while (0)
__device__ __forceinline__ void pack_p(const f32x16& p0, const f32x16& p1, bf16x8& pa0, bf16x8& pa1, bf16x8& pa2, bf16x8& pa3) {
    ATT_PK4(p0, 0, pa0); ATT_PK4(p0, 8, pa1); ATT_PK4(p1, 0, pa2); ATT_PK4(p1, 8, pa3);
}
__device__ __forceinline__ float pair_sum(float v) {
    auto rr = __builtin_amdgcn_permlane32_swap(__float_as_uint(v), __float_as_uint(v), false, false);
    return __uint_as_float(rr[0]) + __uint_as_float(rr[1]);
}
__device__ __forceinline__ void qkt(f32x16& p0, f32x16& p1, const LAS char* Kb, int r32, int hi, const bf16x8* qr) {
#pragma unroll
    for (int r = 0; r < 16; ++r) { p0[r] = 0.f; p1[r] = 0.f; }
    const LAS char* kb[4];
#pragma unroll
    for (int dd = 0; dd < 4; ++dd) kb[dd] = Kb + KSWZ(r32, (dd * 16 + hi * 8) * 2);
#pragma unroll
    for (int d0 = 0; d0 < 8; ++d0) { const LAS char* a = kb[d0 & 3] + (d0 >> 2) * 128;
        const bf16x8 b0 = *reinterpret_cast<const LAS bf16x8*>(a);
        const bf16x8 b1 = *reinterpret_cast<const LAS bf16x8*>(a + 32 * 256);
        p0 = __builtin_amdgcn_mfma_f32_32x32x16_bf16(b0, qr[d0], p0, 0, 0, 0);
        p1 = __builtin_amdgcn_mfma_f32_32x32x16_bf16(b1, qr[d0], p1, 0, 0, 0); }
}
__device__ __forceinline__ void pv_tile(f32x16* o, int vb0, bf16x8 pa0, bf16x8 pa1, bf16x8 pa2, bf16x8 pa3) {
#define TRRD(dst, off) asm volatile("ds_read_b64_tr_b16 %0, %1 offset:%2" : "=&v"(dst) : "v"(vb0), "i"(off) : "memory")
#define PV_D0(d0) do { s16x4 l0, l1, l2, l3, h0, h1, h2, h3; constexpr int b_ = (d0) * 512; \
        TRRD(l0, b_); TRRD(h0, b_ + 2048); TRRD(l1, b_ + 4096); TRRD(h1, b_ + 6144); TRRD(l2, b_ + 8192); TRRD(h2, b_ + 10240); TRRD(l3, b_ + 12288); TRRD(h3, b_ + 14336); \
        asm volatile("s_waitcnt lgkmcnt(0)" ::: "memory"); SBAR();   \
        o[d0] = __builtin_amdgcn_mfma_f32_32x32x16_bf16(pa0, (bf16x8){l0[0], l0[1], l0[2], l0[3], h0[0], h0[1], h0[2], h0[3]}, o[d0], 0, 0, 0);   \
        o[d0] = __builtin_amdgcn_mfma_f32_32x32x16_bf16(pa1, (bf16x8){l1[0], l1[1], l1[2], l1[3], h1[0], h1[1], h1[2], h1[3]}, o[d0], 0, 0, 0);   \
        o[d0] = __builtin_amdgcn_mfma_f32_32x32x16_bf16(pa2, (bf16x8){l2[0], l2[1], l2[2], l2[3], h2[0], h2[1], h2[2], h2[3]}, o[d0], 0, 0, 0);   \
        o[d0] = __builtin_amdgcn_mfma_f32_32x32x16_bf16(pa3, (bf16x8){l3[0], l3[1], l3[2], l3[3], h3[0], h3[1], h3[2], h3[3]}, o[d0], 0, 0, 0); } while (0)
    PV_D0(0); PV_D0(1); PV_D0(2); PV_D0(3);
#undef PV_D0
#undef TRRD
}

template <int MODE>
__device__ __forceinline__ void attn_block(const bf16* __restrict__ Qp, int ldq, const bf16* __restrict__ Kp, int ldk, const bf16* __restrict__ Vp, int ldv, bf16* __restrict__ Op, int ldo,
                                           int qb, LAS char* lds, const float* __restrict__ aux0, const float* __restrict__ aux1, const float* __restrict__ aux2) {
    int tid_ = threadIdx.x; asm volatile("" : "+v"(tid_));
    const int tid = tid_, wid = __builtin_amdgcn_readfirstlane(tid >> 6), lane = tid & 63, r32 = lane & 31, hi = lane >> 5;
    const int P0 = qb * 256, qlo = P0 + wid * 32, qpos = qlo + r32;
    const int NT = 4 * qb + 4;
    LAS char* V_lds = lds + OFF_V; LAS char* K_lds = lds + OFF_K;
    LAS float* wsf = (LAS float*)(lds + OFF_WS) + wid * 64; LAS float* li_l = wsf; LAS float* al_l = wsf + 32;
    LAS float* aux = (LAS float*)(lds + OFF_AUX);
    bf16x8 qr[8];
#pragma unroll
    for (int d0 = 0; d0 < 8; ++d0) qr[d0] = *reinterpret_cast<const bf16x8*>(Qp + (size_t)qpos * ldq + d0 * 16 + hi * 8);
    unsigned kso[2], vso[2];
#pragma unroll
    for (int i = 0; i < 2; ++i) { const int pc = 2 * wid + i, krow = pc * 4 + (lane >> 4), kch = (lane & 15) ^ (krow & 7);
        kso[i] = (unsigned)(krow * ldk + kch * 8) * 2u;
        const int kk = wid * 8 + ((lane & 31) >> 2), vk = (kk & ~0xC) | ((kk & 4) << 1) | ((kk & 8) >> 1), vc = (2 * i + (lane >> 5)) * 32 + (lane & 3) * 8;
        vso[i] = (unsigned)(vk * ldv + vc) * 2u; }
    const int vb0 = (int)(unsigned)(size_t)V_lds + v_rd_base(lane);
    float m_reg = -1e30f, l_reg = 0.f, Rsum = 0.f, den = 0.f, M2row = 0.f, nmrow = 1.f; unsigned sel = 0u;
    if constexpr (MODE == MODE_ML) { for (int i = tid; i < P0 + 256; i += 512) aux[i] = aux0[i]; M2row = aux1[qpos]; nmrow = aux2[qpos]; }
    if constexpr (MODE == MODE_MOBA) { for (int i = tid; i < qb * 128; i += 512) aux[i] = aux0[i]; }
#define TJ(i) ((MODE == MODE_SB) ? (NT - 1 - (i)) : (i))
#define SLOAD(kb_, bf) do { const char* kg_ = (const char*)(Kp + (size_t)(kb_) * ldk); const char* vg_ = (const char*)(Vp + (size_t)(kb_) * ldv); \
        _Pragma("unroll") for (int i_ = 0; i_ < 2; ++i_) { \
            __builtin_amdgcn_global_load_lds((const unsigned*)(kg_ + kso[i_]), (LAS unsigned*)(K_lds + (bf) * SHM + (2 * wid + i_) * 1024), 16, 0, 0); \
            __builtin_amdgcn_global_load_lds((const unsigned*)(vg_ + vso[i_]), (LAS unsigned*)(V_lds + (bf) * SHM + (2 * wid + i_) * 1024), 16, 0, 0); } } while (0)
    float zbnd = 0.f; bool wdone = false; LAS int* dflag = (LAS int*)(lds + OFF_WS);
    if constexpr (MODE == MODE_SB) { float s = 0.f;
#pragma unroll
        for (int d0 = 0; d0 < 8; ++d0) { const u32x4 qw = *reinterpret_cast<const u32x4*>(&qr[d0]);
            s = fmaf(bf_lo(qw.x), bf_lo(qw.x), s); s = fmaf(bf_hi(qw.x), bf_hi(qw.x), s); s = fmaf(bf_lo(qw.y), bf_lo(qw.y), s); s = fmaf(bf_hi(qw.y), bf_hi(qw.y), s);
            s = fmaf(bf_lo(qw.z), bf_lo(qw.z), s); s = fmaf(bf_hi(qw.z), bf_hi(qw.z), s); s = fmaf(bf_lo(qw.w), bf_lo(qw.w), s); s = fmaf(bf_hi(qw.w), bf_hi(qw.w), s); }
        s = pair_sum(s); zbnd = sqrtf(s * aux0[0]) * (C2 * 1.001f) + 0.01f; }
    f32x16 lgm;
    if constexpr (MODE == MODE_DIL) {
#pragma unroll
        for (int r = 0; r < 16; ++r) { const unsigned d0 = (unsigned)(qpos - 4 * hi - ((r & 3) + 8 * (r >> 2))); lgm[r] = ((d0 & 15u) == 0u) ? (1.0f / C2) : (((d0 & 3u) == 0u) ? 0.f : -__builtin_inff()); } }
    SLOAD(TJ(0) * 64, 0); VM_WAIT(); LDS_WAIT(); WG_BAR();
    if constexpr (MODE == MODE_MOBA) {
        if (qb <= 3) sel = (1u << qb) - 1u;
        else {
            float g[7];
#pragma unroll
            for (int n = 0; n < 7; ++n) { g[n] = -__builtin_inff();
                if (n < qb) { float s = 0.f;
#pragma unroll
                    for (int d0 = 0; d0 < 8; ++d0) { const LAS f32x4* kp = (const LAS f32x4*)(aux + n * 128 + d0 * 16 + hi * 8); const f32x4 k0 = kp[0], k1 = kp[1];
                        const u32x4 qw = *reinterpret_cast<const u32x4*>(&qr[d0]);
                        s = fmaf(bf_lo(qw.x), k0[0], s); s = fmaf(bf_hi(qw.x), k0[1], s); s = fmaf(bf_lo(qw.y), k0[2], s); s = fmaf(bf_hi(qw.y), k0[3], s);
                        s = fmaf(bf_lo(qw.z), k1[0], s); s = fmaf(bf_hi(qw.z), k1[1], s); s = fmaf(bf_lo(qw.w), k1[2], s); s = fmaf(bf_hi(qw.w), k1[3], s); }
                    g[n] = pair_sum(s); }
                asm volatile("" ::: "memory"); }
#pragma unroll
            for (int k = 0; k < 3; ++k) { float best = -__builtin_inff(); int bi = 0;
#pragma unroll
                for (int n = 0; n < 7; ++n) if (g[n] > best) { best = g[n]; bi = n; }
                sel |= 1u << bi;
#pragma unroll
                for (int n = 0; n < 7; ++n) g[n] = (bi == n) ? -__builtin_inff() : g[n]; }
        }
    }
    f32x16 o[4];
#pragma unroll
    for (int d_ = 0; d_ < 4; ++d_)
#pragma unroll
        for (int r = 0; r < 16; ++r) o[d_][r] = 0.f;
    for (int i = 0; i < NT; ++i) {
        const int tj = TJ(i), kb = tj * 64, buf = i & 1;
        if constexpr (MODE == MODE_SB) { if (i > 0) { const int f = dflag[(lane & 7) * 64 + ((i - 1) & 1)]; if (__all(f != 0)) break; } }
        if (i + 1 < NT) SLOAD(TJ(i + 1) * 64, buf ^ 1);
        SBAR();
        bool act = (MODE == MODE_SB) ? (kb <= qlo + 30 && !wdone) : (kb <= qlo + 31);
        if constexpr (MODE == MODE_MOBA) { const int n = tj >> 2; if (n != qb) act = act && __any((int)((sel >> n) & 1u)); }
        if (act) {
            f32x16 p0, p1; bf16x8 pa0, pa1, pa2, pa3;
            qkt(p0, p1, K_lds + buf * SHM, r32, hi, qr);
            const int dq = qpos - kb - 4 * hi;
            if constexpr (MODE == MODE_DIL || MODE == MODE_MOBA) {
                if constexpr (MODE == MODE_DIL) {
                  const int dlo = qlo - kb - 63, dhi2 = qlo + 31 - kb;
                  if (dlo > 512) {
#pragma unroll
                    for (int r = 0; r < 16; ++r) { const float t = (lgm[r] > 0.f) ? 0.f : -__builtin_inff(); p0[r] += t; p1[r] += t; }
                  } else if (dlo > 128 && dhi2 <= 512) {
#pragma unroll
                    for (int r = 0; r < 16; ++r) { p0[r] += lgm[r]; p1[r] += lgm[r]; }
                  } else {
#pragma unroll
                    for (int r = 0; r < 16; ++r) { const int c = (r & 3) + 8 * (r >> 2);
                        { const unsigned ud = (unsigned)(dq - c); const int cnt = (int)(ud <= 128u) + (int)(((ud & 3u) == 0u) & (ud <= 512u)) + (int)((ud & 0x8000000Fu) == 0u);
                          p0[r] += __builtin_amdgcn_logf((float)cnt) * (1.0f / C2); }
                        { const unsigned ud = (unsigned)(dq - c - 32); const int cnt = (int)(ud <= 128u) + (int)(((ud & 3u) == 0u) & (ud <= 512u)) + (int)((ud & 0x8000000Fu) == 0u);
                          p1[r] += __builtin_amdgcn_logf((float)cnt) * (1.0f / C2); } }
                  }
                } else {
                    const int n = tj >> 2;
                    if (n == qb) { if (kb + 63 > qlo) mask_tile(p0, p1, dq); }
                    else if (!((sel >> n) & 1u)) {
#pragma unroll
                        for (int r = 0; r < 16; ++r) { p0[r] = -__builtin_inff(); p1[r] = -__builtin_inff(); } }
                }
                float mn, alpha;
                partialSM(p0, p1, m_reg, mn, alpha);
                float ps = 0.f;
#pragma unroll
                for (int r = 0; r < 16; ++r) ps += p0[r];
#pragma unroll
                for (int r = 0; r < 16; ++r) ps += p1[r];
                ps = pair_sum(ps);
                l_reg = l_reg * alpha + ps;
                pack_p(p0, p1, pa0, pa1, pa2, pa3);
                if (__any(alpha < 1.f)) { if (hi == 0) al_l[r32] = alpha; LDS_WAIT();
#pragma unroll
                    for (int d_ = 0; d_ < 4; ++d_)
#pragma unroll
                        for (int r = 0; r < 16; ++r) o[d_][r] *= al_l[crow(r, hi)]; }
            } else if constexpr (MODE == MODE_ML) {
                float dsum = 0.f;
#pragma unroll
                for (int r4 = 0; r4 < 4; ++r4) {
                    const f32x4 a0 = *(const LAS f32x4*)(aux + kb + 8 * r4 + 4 * hi), a1 = *(const LAS f32x4*)(aux + kb + 32 + 8 * r4 + 4 * hi);
#pragma unroll
                    for (int j = 0; j < 4; ++j) { const int r = 4 * r4 + j, c = 8 * r4 + j;
                        float s0 = p0[r] * SCALE * __builtin_amdgcn_exp2f(a0[j] - M2row); s0 = (dq - c < 0) ? 0.f : s0;
                        float s1 = p1[r] * SCALE * __builtin_amdgcn_exp2f(a1[j] - M2row); s1 = (dq - c - 32 < 0) ? 0.f : s1;
                        p0[r] = s0; p1[r] = s1; dsum += s0 + s1; } }
                den += dsum;
                pack_p(p0, p1, pa0, pa1, pa2, pa3);
            } else {
                f32x16 z0, z1; float gs[8];
#pragma unroll
                for (int r = 0; r < 16; ++r) { const int c = (r & 3) + 8 * (r >> 2);
                    { const float z2 = p0[r] * C2; const float sp = fmaxf(z2, 0.f) + __builtin_amdgcn_logf(1.0f + __builtin_amdgcn_exp2f(-fabsf(z2)));
                      z0[r] = z2; const float spm = ((dq - 1 - c) >= 0) ? sp : 0.f; p0[r] = spm; if ((r & 3) == 0) gs[r >> 2] = spm; else gs[r >> 2] += spm; }
                    { const float z2 = p1[r] * C2; const float sp = fmaxf(z2, 0.f) + __builtin_amdgcn_logf(1.0f + __builtin_amdgcn_exp2f(-fabsf(z2)));
                      z1[r] = z2; const float spm = ((dq - 1 - c - 32) >= 0) ? sp : 0.f; p1[r] = spm; if ((r & 3) == 0) gs[4 + (r >> 2)] = spm; else gs[4 + (r >> 2)] += spm; } }
                float aft[8]; float run = 0.f;
#pragma unroll
                for (int i2 = 7; i2 >= 0; --i2) { const float pg = __shfl_xor(gs[i2], 32); aft[i2] = run + (hi == 0 ? pg : 0.f); run += gs[i2] + pg; }
#pragma unroll
                for (int i2 = 0; i2 < 8; ++i2) { float suf = Rsum + aft[i2];
#pragma unroll
                    for (int j = 3; j >= 0; --j) { const int r = 4 * (i2 & 3) + j, c = 8 * (i2 & 3) + j + ((i2 >> 2) ? 32 : 0);
                        const bool ok = (dq - 1 - c) >= 0;
                        if (i2 >> 2) { suf += p1[r]; p1[r] = ok ? __builtin_amdgcn_exp2f(z1[r] - suf) : 0.f; }
                        else { suf += p0[r]; p0[r] = ok ? __builtin_amdgcn_exp2f(z0[r] - suf) : 0.f; } } }
                Rsum += run;
                pack_p(p0, p1, pa0, pa1, pa2, pa3);
            }
            SBAR();
            pv_tile(o, vb0 + buf * SHM, pa0, pa1, pa2, pa3);
        }
        SBAR();
        if constexpr (MODE == MODE_SB) { if (!wdone) wdone = __all(Rsum - zbnd > 64.f) != 0; if (lane == 0) dflag[wid * 64 + (i & 1)] = wdone ? 1 : 0; }
        VM_WAIT(); LDS_WAIT(); WG_BAR();
    }
    if constexpr (MODE == MODE_DIL || MODE == MODE_MOBA) { if (hi == 0) li_l[r32] = l_reg; }
    if constexpr (MODE == MODE_ML) { const float dt = pair_sum(den); if (hi == 0) li_l[r32] = fmaxf(fabsf(dt), nmrow); }
    LDS_WAIT();
    bf16* Ow = Op + (size_t)qlo * ldo;
#pragma unroll
    for (int r = 0; r < 16; ++r) { const int orow = crow(r, hi);
        float rl = 1.f; if constexpr (MODE != MODE_SB) rl = __builtin_amdgcn_rcpf(li_l[orow]);
#pragma unroll
        for (int d0 = 0; d0 < 4; ++d0) { const float v = o[d0][r] * rl; const float vn = __shfl_xor(v, 1);
            if ((r32 & 1) == 0) *(unsigned*)(Ow + (size_t)orow * ldo + d0 * 32 + r32) = cvtpk(v, vn); } }
    LDS_WAIT();
#undef TJ
#undef SLOAD
}
}


struct Frame {
    LAS unsigned char* lds; int tid, lane, wave, vcu, G, gw, NGW;
};

template <bool FOLD>
__device__ __forceinline__ void tr_item(const float* __restrict__ W, int K, int N, bf16* __restrict__ WT, int item, int nblk, LAS unsigned* scr, int lane, int rmode, const float* lg, const float* lb, float* cs, float* bs) {
    const int kb = item / nblk, nb = item - kb * nblk, k0 = kb * 64, n0 = nb * 64;
    const int nq = lane & 15, kr = lane >> 4;
    const bool inb = (n0 + 4 * nq) < N;
    f32x4 a[8], b[8];
#pragma unroll
    for (int s = 0; s < 8; ++s) { const int kp = 4 * s + kr; const float* p = W + (size_t)(k0 + 2 * kp) * N + (inb ? n0 + 4 * nq : 0);
        a[s] = *(const f32x4*)p; b[s] = *(const f32x4*)(p + N); }
    if (!inb) {
#pragma unroll
        for (int s = 0; s < 8; ++s) { a[s] = (f32x4){0.f, 0.f, 0.f, 0.f}; b[s] = (f32x4){0.f, 0.f, 0.f, 0.f}; } }
    f32x4 csum = {0.f, 0.f, 0.f, 0.f}, bsum = {0.f, 0.f, 0.f, 0.f};
    if constexpr (FOLD) {
#pragma unroll
        for (int s = 0; s < 8; ++s) { const int k = k0 + 2 * (4 * s + kr); const f32x2 g2 = *(const f32x2*)(lg + k), b2 = *(const f32x2*)(lb + k);
            bsum += a[s] * b2[0] + b[s] * b2[1]; a[s] = a[s] * g2[0]; b[s] = b[s] * g2[1]; }
    }
#pragma unroll
    for (int s = 0; s < 8; ++s) { const int kp = 4 * s + kr;
#pragma unroll
        for (int i = 0; i < 4; ++i) { const unsigned pk = cvtpk(a[s][i], b[s][i]); scr[(4 * nq + i) * 33 + kp] = pk; if constexpr (FOLD) csum[i] += bf_lo(pk) + bf_hi(pk); } }
    LDS_WAIT();
#pragma unroll
    for (int jj = 0; jj < 8; ++jj) { const int n = (lane >> 3) + 8 * jj, c = lane & 7; const LAS unsigned* s = scr + n * 33 + 4 * c;
        u32x4 o; o.x = s[0]; o.y = s[1]; o.z = s[2]; o.w = s[3];
        const int nn = n0 + n, drow = rmode ? (((nn >> 7) << 8) + (nn & 127) + (rmode == 2 ? 128 : 0)) : nn;
        *(u32x4*)(WT + (size_t)drow * K + k0 + 8 * c) = o; }
    LDS_WAIT();
    if constexpr (FOLD) {
#pragma unroll
        for (int i = 0; i < 4; ++i) { csum[i] += __shfl_xor(csum[i], 16); csum[i] += __shfl_xor(csum[i], 32); bsum[i] += __shfl_xor(bsum[i], 16); bsum[i] += __shfl_xor(bsum[i], 32); }
        LAS float* fs = (LAS float*)scr;
        if (kr == 0) { *(LAS f32x4*)(fs + 4 * nq) = csum; *(LAS f32x4*)(fs + 64 + 4 * nq) = bsum; }
        LDS_WAIT();
        const int nn = n0 + lane, drow = rmode ? (((nn >> 7) << 8) + (nn & 127) + (rmode == 2 ? 128 : 0)) : nn;
        if (nn < N) { unsafeAtomicAdd(cs + drow, fs[lane]); unsafeAtomicAdd(bs + drow, fs[64 + lane]); }
        LDS_WAIT();
    }
}

__device__ __forceinline__ void prologue(const Frame& F_, const Args& a) {
    Frame F = F_; asm volatile("" : "+v"(F.lane), "+v"(F.tid), "+s"(F.gw), "+s"(F.vcu), "+s"(F.wave));
    unsigned char* ws = a.ws;
    LAS unsigned* scr = (LAS unsigned*)(F.lds + F.wave * 8448);
    constexpr int I_INAB = 64 * 192, I_OUT = 64 * 64, I_INCD = 64 * 196, I_UP = 64 * 172, I_DN = 172 * 64;
    constexpr int TOTAL = I_INAB + I_OUT + I_INCD + I_OUT + 4 * I_UP + 2 * I_DN;
    for (int it = F.gw; it < TOTAL; it += F.NGW) {
        int r = it; const float* W; int K, N, nblk; bf16* WT; int rmode = 0; const float* lg = nullptr; const float* lb = nullptr; float* cs = nullptr; float* bs = nullptr;
        unsigned char* ctl = ws + WS_CTL;
        if (r < I_INAB) { W = a.in[1]; K = DM; N = N_AB; nblk = 192; WT = (bf16*)(ws + WS_W_INAB); }
        else if ((r -= I_INAB) < I_OUT) { W = a.in[2]; K = DM; N = DM; nblk = 64; WT = (bf16*)(ws + WS_W_OUTAB); }
        else if ((r -= I_OUT) < I_INCD) { W = a.in[3]; K = DM; N = N_CD; nblk = 196; WT = (bf16*)(ws + WS_W_INCD); lg = a.in[14] + DM; lb = a.in[15] + DM; cs = (float*)(ctl + CTL_CS_INCD); bs = (float*)(ctl + CTL_BS_INCD); }
        else if ((r -= I_INCD) < I_OUT) { W = a.in[8]; K = DM; N = DM; nblk = 64; WT = (bf16*)(ws + WS_W_OUTCD); }
        else if ((r -= I_OUT) < I_UP) { W = a.in[9]; K = DM; N = DFF; nblk = 172; WT = (bf16*)(ws + WS_W_UG0); rmode = 1; lg = a.in[14]; lb = a.in[15]; cs = (float*)(ctl + CTL_CS_UG0); bs = (float*)(ctl + CTL_BS_UG0); }
        else if ((r -= I_UP) < I_UP) { W = a.in[10]; K = DM; N = DFF; nblk = 172; WT = (bf16*)(ws + WS_W_UG0); rmode = 2; lg = a.in[14]; lb = a.in[15]; cs = (float*)(ctl + CTL_CS_UG0); bs = (float*)(ctl + CTL_BS_UG0); }
        else if ((r -= I_UP) < I_DN) { W = a.in[13]; K = DFF; N = DM; nblk = 64; WT = (bf16*)(ws + WS_W_DN0); }
        else if ((r -= I_DN) < I_UP) { W = a.in[9] + (size_t)DM * DFF; K = DM; N = DFF; nblk = 172; WT = (bf16*)(ws + WS_W_UG1); rmode = 1; lg = a.in[14] + 2 * DM; lb = a.in[15] + 2 * DM; cs = (float*)(ctl + CTL_CS_UG1); bs = (float*)(ctl + CTL_BS_UG1); }
        else if ((r -= I_UP) < I_UP) { W = a.in[10] + (size_t)DM * DFF; K = DM; N = DFF; nblk = 172; WT = (bf16*)(ws + WS_W_UG1); rmode = 2; lg = a.in[14] + 2 * DM; lb = a.in[15] + 2 * DM; cs = (float*)(ctl + CTL_CS_UG1); bs = (float*)(ctl + CTL_BS_UG1); }
        else { r -= I_UP; W = a.in[13] + (size_t)DFF * DM; K = DFF; N = DM; nblk = 64; WT = (bf16*)(ws + WS_W_DN1); }
        if (lg) tr_item<true>(W, K, N, WT, r, nblk, scr, F.lane, rmode, lg, lb, cs, bs); else tr_item<false>(W, K, N, WT, r, nblk, scr, F.lane, rmode, lg, lb, cs, bs);
    }
    const f32x4* x4 = (const f32x4*)a.in[0]; u32x2* xb = (u32x2*)(ws + WS_XB);
    for (size_t i = (size_t)F.gw * 64 + F.lane; i < (size_t)M * DM / 4; i += (size_t)F.NGW * 64) { const f32x4 v = x4[i]; u32x2 o; o.x = cvtpk(v[0], v[1]); o.y = cvtpk(v[2], v[3]); xb[i] = o; }
}

__device__ __forceinline__ void ln_phase(const Frame& F_, const float* z, float* xo, bf16* xb, const float* g, const float* b) {
    Frame F = F_; asm volatile("" : "+v"(F.lane), "+v"(F.tid), "+s"(F.gw), "+s"(F.vcu), "+s"(F.wave));
    for (int m = F.gw; m < M; m += F.NGW) {
        const f32x4* zr = (const f32x4*)(z + (size_t)m * DM) + F.lane;
        f32x4 v[16]; float s = 0.f;
#pragma unroll
        for (int j = 0; j < 16; ++j) { v[j] = zr[64 * j]; s += (v[j][0] + v[j][1]) + (v[j][2] + v[j][3]); }
        const float mean = wave_sum(s) * (1.f / DM); float s2 = 0.f;
#pragma unroll
        for (int j = 0; j < 16; ++j) { v[j] = v[j] - mean; s2 += (v[j][0] * v[j][0] + v[j][1] * v[j][1]) + (v[j][2] * v[j][2] + v[j][3] * v[j][3]); }
        const float rstd = 1.f / sqrtf(wave_sum(s2) * (1.f / DM) + LN_EPS);
        f32x4* xr = (f32x4*)(xo + (size_t)m * DM) + F.lane; u32x2* br = (u32x2*)((xb ? xb : (bf16*)xo) + (size_t)m * DM) + F.lane;
        const f32x4* g4 = (const f32x4*)g + F.lane; const f32x4* b4 = (const f32x4*)b + F.lane;
#pragma unroll
        for (int j = 0; j < 16; ++j) { f32x4 o = v[j] * rstd * g4[64 * j] + b4[64 * j]; xr[64 * j] = o;
            if (xb) { u32x2 w; w.x = cvtpk(o[0], o[1]); w.y = cvtpk(o[2], o[3]); br[64 * j] = w; } }
    }
}

__device__ __forceinline__ void ffn_fix_phase(const Frame& F_, bf16* H, const float* EG0, const float* EU0, const float* EGL, const float* cw, const float* cb) {
    Frame F = F_; asm volatile("" : "+v"(F.lane), "+v"(F.tid), "+s"(F.gw), "+s"(F.vcu), "+s"(F.wave));
    constexpr int C4 = DFF / 4;
    for (int idx = F.gw * 64 + F.lane; idx < 64 * C4; idx += F.NGW * 64) {
        const int pm = idx / C4, ch = (idx - pm * C4) * 4;
        f32x4 gl0 = {0.f, 0.f, 0.f, 0.f}, gl1 = gl0;
        if ((pm & 7) != 0) { gl0 = *(const f32x4*)(EGL + (size_t)((pm - 1) * 2) * DFF + ch); gl1 = *(const f32x4*)(EGL + (size_t)((pm - 1) * 2 + 1) * DFF + ch); }
        const f32x4 g0 = *(const f32x4*)(EG0 + (size_t)(pm * 2) * DFF + ch), g1 = *(const f32x4*)(EG0 + (size_t)(pm * 2 + 1) * DFF + ch);
        const f32x4 u0 = *(const f32x4*)(EU0 + (size_t)(pm * 2) * DFF + ch), u1 = *(const f32x4*)(EU0 + (size_t)(pm * 2 + 1) * DFF + ch);
        const f32x4 w0 = *(const f32x4*)(cw + ch), w1 = *(const f32x4*)(cw + DFF + ch), w2 = *(const f32x4*)(cw + 2 * DFF + ch), bb = *(const f32x4*)(cb + ch);
        const f32x4 y0 = w0 * gl0 + w1 * gl1 + w2 * g0 + bb, y1 = w0 * gl1 + w1 * g0 + w2 * g1 + bb;
        u32x2 o0, o1;
        o0.x = cvtpk(silu_f(y0[0]) * u0[0], silu_f(y0[1]) * u0[1]); o0.y = cvtpk(silu_f(y0[2]) * u0[2], silu_f(y0[3]) * u0[3]);
        o1.x = cvtpk(silu_f(y1[0]) * u1[0], silu_f(y1[1]) * u1[1]); o1.y = cvtpk(silu_f(y1[2]) * u1[2], silu_f(y1[3]) * u1[3]);
        *(u32x2*)(H + (size_t)(pm * 256) * DFF + ch) = o0; *(u32x2*)(H + (size_t)(pm * 256 + 1) * DFF + ch) = o1;
    }
}

__device__ __forceinline__ void kmean_phase(const Frame& F_, const bf16* QKV, float* kmean) {
    Frame F = F_; asm volatile("" : "+v"(F.lane), "+v"(F.tid), "+s"(F.gw), "+s"(F.vcu), "+s"(F.wave));
    LAS float* red = (LAS float*)F.lds;
    for (int it = F.vcu; it < 256; it += F.G) {
        const int b = it >> 5, n = (it >> 2) & 7, cbk = it & 3;
        const bf16* src = QKV + (size_t)(b * SEQ + n * 256 + F.wave * 32) * N_AB + 8192 + cbk * 512 + F.lane * 8;
        float acc[8];
#pragma unroll
        for (int j = 0; j < 8; ++j) acc[j] = 0.f;
        for (int r8 = 0; r8 < 32; r8 += 8) { u32x4 v[8];
#pragma unroll
            for (int r = 0; r < 8; ++r) v[r] = *(const u32x4*)(src + (size_t)(r8 + r) * N_AB);
#pragma unroll
            for (int r = 0; r < 8; ++r)
#pragma unroll
                for (int q = 0; q < 4; ++q) { acc[2 * q] += bf_lo(v[r][q]); acc[2 * q + 1] += bf_hi(v[r][q]); } }
#pragma unroll
        for (int j = 0; j < 8; ++j) red[F.wave * 512 + F.lane * 8 + j] = acc[j];
        LDS_WAIT(); WG_BAR();
        float s = 0.f;
#pragma unroll
        for (int w = 0; w < 8; ++w) s += red[w * 512 + F.tid];
        const int col = cbk * 512 + F.tid, h = col >> 7, d = col & 127;
        kmean[((size_t)(b * 16 + h) * 8 + n) * 128 + d] = s * (1.f / 256.f);
        LDS_WAIT(); WG_BAR();
    }
}

__device__ __forceinline__ void cd_pre_phase(const Frame& F_, const bf16* QKV, bf16* QKDC, const float* cw  , const float* cb, const float* gates, const float* bif, float* A2, float* M2, float* NM, unsigned* kn2) {
    Frame F = F_; asm volatile("" : "+v"(F.lane), "+v"(F.tid), "+s"(F.gw), "+s"(F.vcu), "+s"(F.wave));
    for (int it = F.gw; it < (M / 32) * 4; it += F.NGW) {
        const int rb = it >> 2, cbk = it & 3, c0 = cbk * 512 + F.lane * 8, r0 = rb * 32;
        float w[4][8], bb[8];
#pragma unroll
        for (int q = 0; q < 2; ++q) { const f32x4 t3 = *(const f32x4*)(cb + c0 + 4 * q);
#pragma unroll
            for (int j = 0; j < 4; ++j) bb[4 * q + j] = t3[j];
#pragma unroll
            for (int k = 0; k < 4; ++k) { const f32x4 t = *(const f32x4*)(cw + k * 2048 + c0 + 4 * q);
#pragma unroll
                for (int j = 0; j < 4; ++j) w[k][4 * q + j] = t[j]; } }
        const bf16* src = QKV + 6144 + c0;
        u32x4 x3 = {0u, 0u, 0u, 0u}, x2 = x3, x1 = x3;
        if ((r0 & (SEQ - 1)) != 0) { x3 = *(const u32x4*)(src + (size_t)(r0 - 3) * N_AB); x2 = *(const u32x4*)(src + (size_t)(r0 - 2) * N_AB); x1 = *(const u32x4*)(src + (size_t)(r0 - 1) * N_AB); }
        for (int t8 = 0; t8 < 32; t8 += 8) {
            u32x4 xv[8];
#pragma unroll
            for (int t = 0; t < 8; ++t) xv[t] = *(const u32x4*)(src + (size_t)(r0 + t8 + t) * N_AB);
#pragma unroll
            for (int t = 0; t < 8; ++t) { u32x4 ov;
#pragma unroll
                for (int q = 0; q < 4; ++q) {
                    const float y0 = w[0][2 * q] * bf_lo(x3[q]) + w[1][2 * q] * bf_lo(x2[q]) + w[2][2 * q] * bf_lo(x1[q]) + w[3][2 * q] * bf_lo(xv[t][q]) + bb[2 * q];
                    const float y1 = w[0][2 * q + 1] * bf_hi(x3[q]) + w[1][2 * q + 1] * bf_hi(x2[q]) + w[2][2 * q + 1] * bf_hi(x1[q]) + w[3][2 * q + 1] * bf_hi(xv[t][q]) + bb[2 * q + 1];
                    ov[q] = cvtpk(silu_f(y0), silu_f(y1)); }
                *(u32x4*)(QKDC + (size_t)(r0 + t8 + t) * 2048 + c0) = ov; x3 = x2; x2 = x1; x1 = xv[t]; }
        }
    }
    for (int it = F.gw; it < (M / 64) * 16; it += F.NGW) {
        const int rb = it >> 4, h = it & 15, row = rb * 64 + F.lane;
        const u32x4* kp = (const u32x4*)(QKV + (size_t)row * N_AB + 2048 + h * 128); float s = 0.f;
#pragma unroll
        for (int j = 0; j < 16; ++j) { const u32x4 v = kp[j];
            s = fmaf(bf_lo(v.x), bf_lo(v.x), s); s = fmaf(bf_hi(v.x), bf_hi(v.x), s); s = fmaf(bf_lo(v.y), bf_lo(v.y), s); s = fmaf(bf_hi(v.y), bf_hi(v.y), s);
            s = fmaf(bf_lo(v.z), bf_lo(v.z), s); s = fmaf(bf_hi(v.z), bf_hi(v.z), s); s = fmaf(bf_lo(v.w), bf_lo(v.w), s); s = fmaf(bf_hi(v.w), bf_hi(v.w), s); }
#pragma unroll
        for (int o = 1; o < 64; o <<= 1) s = fmaxf(s, __shfl_xor(s, o));
        if (F.lane == 0) atomicMax(kn2 + (row >> 11) * 16 + h, __float_as_uint(s));
    }
    for (int sq = F.gw; sq < 64; sq += F.NGW) {
        const int b = sq >> 3, h = sq & 7; const float bi = bif[h], bfv = bif[8 + h];
        const float* gp = gates + (size_t)(b * SEQ + F.lane * 32) * 16;
        float lf[32], ai[32]; float run = 0.f;
#pragma unroll
        for (int t = 0; t < 32; ++t) { const float f = gp[t * 16 + 8 + h] + bfv; ai[t] = gp[t * 16 + h] + bi;
            const float ls = fminf(f, 0.f) - log1pf(expf(-fabsf(f)));
            run += ls; lf[t] = run; }
        float incl = run;
#pragma unroll
        for (int o = 1; o < 64; o <<= 1) { const float t = __shfl_up(incl, o); if (F.lane >= o) incl += t; }
        const float base = incl - run; float mx = -__builtin_inff();
#pragma unroll
        for (int t = 0; t < 32; ++t) { lf[t] += base; ai[t] -= lf[t]; mx = fmaxf(mx, ai[t]); }
        float minc = mx;
#pragma unroll
        for (int o = 1; o < 64; o <<= 1) { const float t = __shfl_up(minc, o); if (F.lane >= o) minc = fmaxf(minc, t); }
        float mprev = __shfl_up(minc, 1); if (F.lane == 0) mprev = -__builtin_inff();
        float cm = fmaxf(mprev, 0.f);
        float* a2o = A2 + (size_t)sq * SEQ + F.lane * 32; float* m2o = M2 + (size_t)sq * SEQ + F.lane * 32; float* nmo = NM + (size_t)sq * SEQ + F.lane * 32;
#pragma unroll
        for (int t = 0; t < 32; ++t) { cm = fmaxf(cm, ai[t]); a2o[t] = ai[t] * 1.4426950408889634f; m2o[t] = cm * 1.4426950408889634f; nmo[t] = expf(-lf[t] - cm); }
    }
}

__device__ __forceinline__ void cd_post_phase(const Frame& F_, const bf16* HD, const bf16* QKV, bf16* Y, const float* ng) {
    Frame F = F_; asm volatile("" : "+v"(F.lane), "+v"(F.tid), "+s"(F.gw), "+s"(F.vcu), "+s"(F.wave));
    for (int it = F.gw; it < M * 8; it += F.NGW) {
        const int m = it >> 3, h = it & 7, c = h * 256 + F.lane * 4;
        const u32x2 hv = *(const u32x2*)(HD + (size_t)m * 2048 + c); const u32x2 ov = *(const u32x2*)(QKV + (size_t)m * N_AB + 10240 + c);
        const f32x4 g = *(const f32x4*)(ng + c);
        float v0 = bf_lo(hv.x), v1 = bf_hi(hv.x), v2 = bf_lo(hv.y), v3 = bf_hi(hv.y);
        const float mean = wave_sum((v0 + v1) + (v2 + v3)) * (1.f / 256.f);
        v0 -= mean; v1 -= mean; v2 -= mean; v3 -= mean;
        const float rstd = 1.f / sqrtf(wave_sum((v0 * v0 + v1 * v1) + (v2 * v2 + v3 * v3)) * (1.f / 256.f) + LN_EPS);
        const float o0 = bf_lo(ov.x), o1 = bf_hi(ov.x), o2 = bf_lo(ov.y), o3 = bf_hi(ov.y);
        const float y0 = v0 * rstd * g[0] * __builtin_amdgcn_rcpf(1.f + __builtin_amdgcn_exp2f(-1.4426950408889634f * o0));
        const float y1 = v1 * rstd * g[1] * __builtin_amdgcn_rcpf(1.f + __builtin_amdgcn_exp2f(-1.4426950408889634f * o1));
        const float y2 = v2 * rstd * g[2] * __builtin_amdgcn_rcpf(1.f + __builtin_amdgcn_exp2f(-1.4426950408889634f * o2));
        const float y3 = v3 * rstd * g[3] * __builtin_amdgcn_rcpf(1.f + __builtin_amdgcn_exp2f(-1.4426950408889634f * o3));
        u32x2 w; w.x = cvtpk(y0, y1); w.y = cvtpk(y2, y3);
        *(u32x2*)(Y + (size_t)m * DM + 2048 + c) = w;
    }
}


__global__ void __launch_bounds__(NWAVES * 64, 2) mk_fwd(Args args) {
    extern __shared__ __attribute__((aligned(16))) unsigned char lds_raw[];
    Frame F;
    F.lds = (LAS unsigned char*)lds_raw;
    F.tid = threadIdx.x; F.lane = F.tid & 63; F.wave = __builtin_amdgcn_readfirstlane(F.tid >> 6);
    F.G = gridDim.x; { const int bx = blockIdx.x; F.vcu = (F.G % 8 == 0) ? (bx % 8) * (F.G / 8) + bx / 8 : bx; }
    F.gw = F.vcu * NWAVES + F.wave; F.NGW = F.G * NWAVES;
    unsigned char* ws = args.ws;
    volatile LAS unsigned* MISC = (volatile LAS unsigned*)(F.lds + MISC_OFF);
    for (int u = F.tid; u < (LDS_BYTES - RING_BYTES) / 4; u += NWAVES * 64) ((LAS unsigned*)(F.lds + RING_BYTES))[u] = 0u;
    __syncthreads();
    XcdBarrier bar = xcd_barrier_post((unsigned*)(ws + WS_CTL) + CW_BAR, MISC + 8);
#define GRID_BAR() xcd_barrier(bar)

    PH(1) prologue(F, args);
    GRID_BAR();

#define PHASE_BEGIN const int L = opq_i(layer); GAS unsigned char* const W = (GAS unsigned char*)opq_p(ws); (void)L; (void)W;
    for (int layer = 0; layer < 2; ++layer) {
        { PHASE_BEGIN
            pg8::Gemm g{(const bf16*)(W + WS_XB), (const bf16*)(W + (L == 0 ? WS_W_INAB : WS_W_INCD)), M, L == 0 ? N_AB : N_CDP, DM};
            pg8::StaticOrder S; S.init(g.M, g.N, F.G, (int)blockIdx.x);
            pg8::EpiBf16 E{(unsigned char*)W, L};
            PH(2) pg8::gemm_phase<pg8::EpiBf16, pg8::StaticOrder, true, true>(F.lds, g, S, E);
        }
        GRID_BAR();
        { PHASE_BEGIN
            if (L == 0) { PH(4) kmean_phase(F, (const bf16*)(W + WS_QKV), (float*)(W + WS_KMEAN)); }
            else PH(8) cd_pre_phase(F, (const bf16*)(W + WS_QKV), (bf16*)(W + WS_QKDC), (const float*)ldin(args, 5), (const float*)ldin(args, 6), (const float*)(W + WS_GATES), (const float*)ldin(args, 4), (float*)(W + WS_A2), (float*)(W + WS_M2), (float*)(W + WS_NM), (unsigned*)(W + WS_CTL + CTL_KN2));
        }
        GRID_BAR();
        { PHASE_BEGIN
            const bf16* QKV = (const bf16*)(W + WS_QKV); bf16* Y = (bf16*)(W + WS_Y);
            if (L == 0) {
                for (int it = F.vcu; it < 512; it += F.G) { const int bh = it >> 2, pr = it & 3, b = bh >> 4, h = bh & 15;
                    const bf16* base = QKV + (size_t)b * SEQ * N_AB + h * 128; bf16* ob = Y + (size_t)b * SEQ * DM + h * 128;
                    for (int ps = 0; ps < 2; ++ps) PH(16) att::attn_block<att::MODE_DIL>(base, N_AB, base + 2048, N_AB, base + 4096, N_AB, ob, DM, ps ? 7 - pr : pr, (LAS char*)F.lds, nullptr, nullptr, nullptr); }
                const float* KMEAN = (const float*)(W + WS_KMEAN);
                for (int it = F.vcu; it < 512; it += F.G) { const int bh = it >> 2, pr = it & 3, b = bh >> 4, h = bh & 15;
                    const bf16* base = QKV + (size_t)b * SEQ * N_AB + 6144 + h * 128; bf16* ob = Y + (size_t)b * SEQ * DM + 2048 + h * 128;
                    for (int ps = 0; ps < 2; ++ps) PH(32) att::attn_block<att::MODE_MOBA>(base, N_AB, base + 2048, N_AB, base + 4096, N_AB, ob, DM, ps ? 7 - pr : pr, (LAS char*)F.lds, KMEAN + (size_t)bh * 1024, nullptr, nullptr); }
            } else {
                for (int it = F.vcu; it < 512; it += F.G) { const int bh = it >> 2, pr = it & 3, b = bh >> 4, h = bh & 15;
                    const bf16* base = QKV + (size_t)b * SEQ * N_AB + h * 128; bf16* ob = Y + (size_t)b * SEQ * DM + h * 128;
                    for (int ps = 0; ps < 2; ++ps) PH(64) att::attn_block<att::MODE_SB>(base, N_AB, base + 2048, N_AB, base + 4096, N_AB, ob, DM, ps ? 7 - pr : pr, (LAS char*)F.lds, (const float*)(W + WS_CTL + CTL_KN2) + bh, nullptr, nullptr); }
                const bf16* QKDC = (const bf16*)(W + WS_QKDC); bf16* HD = (bf16*)(W + WS_HD); const float* A2 = (const float*)(W + WS_A2); const float* M2 = (const float*)(W + WS_M2); const float* NMv = (const float*)(W + WS_NM);
                for (int it = F.vcu; it < 512; it += F.G) { const int bv = it >> 2, pr = it & 3, b = bv >> 4, vh = bv & 15, h = vh >> 1, half = vh & 1;
                    const bf16* qd = QKDC + (size_t)b * SEQ * 2048 + h * 128; const bf16* vd = QKV + (size_t)b * SEQ * N_AB + 8192 + h * 256 + half * 128;
                    bf16* ob = HD + (size_t)b * SEQ * 2048 + h * 256 + half * 128; const size_t so = (size_t)(b * 8 + h) * SEQ;
                    for (int ps = 0; ps < 2; ++ps) PH(128) att::attn_block<att::MODE_ML>(qd, 2048, qd + 1024, 2048, vd, N_AB, ob, 2048, ps ? 7 - pr : pr, (LAS char*)F.lds, A2 + so, M2 + so, NMv + so); }
            }
        }
        if (layer == 1) { GRID_BAR(); PHASE_BEGIN PH(256) cd_post_phase(F, (const bf16*)(W + WS_HD), (const bf16*)(W + WS_QKV), (bf16*)(W + WS_Y), (const float*)ldin(args, 7)); }
        GRID_BAR();
        { PHASE_BEGIN
            pg8::Gemm g{(const bf16*)(W + WS_Y), (const bf16*)(W + (L == 0 ? WS_W_OUTAB : WS_W_OUTCD)), M, DM, DM};
            pg8::StaticOrder S; S.init(g.M, g.N, F.G, (int)blockIdx.x);
            pg8::EpiResid E{&args, (unsigned char*)W, L, 0, F.lds};
            PH(512) pg8::gemm_phase<pg8::EpiResid, pg8::StaticOrder, true, true>(F.lds, g, S, E);
        }
        GRID_BAR();
        { PHASE_BEGIN
            pg8::Gemm g{(const bf16*)(W + WS_XB), (const bf16*)(W + (L == 0 ? WS_W_UG0 : WS_W_UG1)), M, 2 * DFF, DM};
            pg8::StaticOrder S; S.init(g.M, g.N, F.G, (int)blockIdx.x);
            pg8::EpiFfnAct E{&args, (unsigned char*)W, L, F.lds};
            PH(2048) pg8::gemm_phase<pg8::EpiFfnAct, pg8::StaticOrder, true, true>(F.lds, g, S, E);
        }
        GRID_BAR();
        { PHASE_BEGIN PH(4096) ffn_fix_phase(F, (bf16*)(W + WS_U), (const float*)(W + WS_G), (const float*)(W + WS_G + 8 * MiB), (const float*)(W + WS_G + 16 * MiB), (const float*)ldin(args, 11) + (size_t)L * 3 * DFF, (const float*)ldin(args, 12) + (size_t)L * DFF); }
        GRID_BAR();
        { PHASE_BEGIN
            pg8::Gemm g{(const bf16*)(W + WS_U), (const bf16*)(W + (L == 0 ? WS_W_DN0 : WS_W_DN1)), M, DM, DFF};
            pg8::StaticOrder S; S.init(g.M, g.N, F.G, (int)blockIdx.x);
            pg8::EpiResid E{&args, (unsigned char*)W, L, 1, F.lds};
            PH(8192) pg8::gemm_phase<pg8::EpiResid, pg8::StaticOrder, true, true>(F.lds, g, S, E);
        }
        GRID_BAR();
        if (layer == 1) { PHASE_BEGIN
            PH(1024) ln_phase(F, args.out, args.out, nullptr, (const float*)ldin(args, 14) + (size_t)3 * DM, (const float*)ldin(args, 15) + (size_t)3 * DM); }
    }
#undef PHASE_BEGIN
}

extern "C" void kernel_launch(void* const* d_in, const int* in_sizes, int n_in, void* d_out, int out_size, void* d_ws, size_t ws_size, hipStream_t stream) {
    static int grid = 0;
    if (grid == 0) {
        if (n_in != 16 || in_sizes[0] != M * DM || out_size != M * DM || ws_size < WS_END) { fprintf(stderr, "kernel_launch: unexpected shapes (n_in %d, in0 %d, out %d, ws %zu < %zu)\n", n_in, n_in > 0 ? in_sizes[0] : -1, out_size, ws_size, (size_t)WS_END); grid = -1; return; }
        int dev = 0, cus = 0;
        if (hipGetDevice(&dev) != hipSuccess || hipDeviceGetAttribute(&cus, hipDeviceAttributeMultiprocessorCount, dev) != hipSuccess) { grid = -1; return; }
        if (hipFuncSetAttribute((const void*)mk_fwd, hipFuncAttributeMaxDynamicSharedMemorySize, LDS_BYTES) != hipSuccess) { fprintf(stderr, "kernel_launch: hipFuncSetAttribute failed\n"); grid = -1; return; }
        int per_cu = 0;
        if (hipOccupancyMaxActiveBlocksPerMultiprocessor(&per_cu, (const void*)mk_fwd, NWAVES * 64, LDS_BYTES) != hipSuccess || per_cu < 1) fprintf(stderr, "kernel_launch: occupancy query says %d\n", per_cu);
        (void)hipGetLastError();
        grid = cus;
    }
    if (grid < 0) return;
    if (hipMemsetAsync((char*)d_ws + WS_CTL, 0, CTL_ZERO_BYTES, stream) != hipSuccess) return;
    Args a{};
    for (int i = 0; i < 16; ++i) a.in[i] = (const float*)d_in[i];
    a.out = (float*)d_out; a.ws = (unsigned char*)d_ws;
    hipLaunchKernelGGL(mk_fwd, dim3(grid), dim3(NWAVES * 64), LDS_BYTES, stream, a);
}
```

```cpp
#include <hip/hip_runtime.h>
#include <cstdio>
#include <cstdint>

#define LAS __attribute__((address_space(3)))
#define GAS __attribute__((address_space(1)))
typedef unsigned short bf16;
typedef short bf16x8 __attribute__((ext_vector_type(8)));
typedef short s16x4 __attribute__((ext_vector_type(4)));
typedef float f32x16 __attribute__((ext_vector_type(16)));
typedef float f32x4 __attribute__((ext_vector_type(4)));
typedef float f32x2 __attribute__((ext_vector_type(2)));
typedef unsigned u32x4 __attribute__((ext_vector_type(4)));
typedef unsigned u32x2 __attribute__((ext_vector_type(2)));

#ifndef PH_MASK
#define PH_MASK 0xFFFF
#endif
#define PH(x) if constexpr ((PH_MASK & (x)) != 0)

constexpr int BATCH = 8, SEQ = 2048, DM = 4096, M = BATCH * SEQ;
constexpr int DFF = 11008, N_AB = 12288, N_CD = 12304, N_CDP = 12544;
constexpr float ALPHA = 1.4142135623730951f;
constexpr float LN_EPS = 1e-5f;
constexpr int NWAVES = 8;

constexpr size_t MiB = 1u << 20;
constexpr size_t WS_CTL = 0, CTL_ZERO_BYTES = 1 * MiB;
constexpr size_t WS_KMEAN = 1 * MiB;
constexpr size_t WS_GATES = 2 * MiB;
constexpr size_t WS_A2 = 3 * MiB;
constexpr size_t WS_M2 = 3 * MiB + 512 * 1024;
constexpr size_t WS_NM = 4 * MiB;
constexpr size_t WS_W_INAB = 8 * MiB, WS_W_OUTAB = 104 * MiB, WS_W_UG0 = 136 * MiB, WS_W_DN0 = 308 * MiB;
constexpr size_t WS_W_INCD = 394 * MiB, WS_W_OUTCD = 492 * MiB, WS_W_UG1 = 524 * MiB, WS_W_DN1 = 696 * MiB;
constexpr size_t WS_XB = 782 * MiB;
constexpr size_t WS_R = 910 * MiB;
constexpr size_t WS_QKV = WS_R, WS_Y = WS_R + 384 * MiB, WS_QKDC = WS_R + 512 * MiB, WS_HD = WS_R + 576 * MiB;
constexpr size_t WS_U = WS_R, WS_G = WS_R + 344 * MiB;
constexpr size_t WS_END = WS_R + 688 * MiB;
static_assert((size_t)M * DFF * 2 == 344 * MiB, "u/g size");
constexpr int CW_BAR = 4096;
constexpr size_t CTL_KN2 = 32768;
constexpr size_t CTL_STATS = 65536;
constexpr size_t CTL_CS_UG0 = 524288, CTL_BS_UG0 = CTL_CS_UG0 + 88064, CTL_CS_INCD = CTL_BS_UG0 + 88064, CTL_BS_INCD = CTL_CS_INCD + 50176, CTL_CS_UG1 = CTL_BS_INCD + 50176, CTL_BS_UG1 = CTL_CS_UG1 + 88064;
static_assert(CTL_BS_UG1 + 88064 <= CTL_ZERO_BYTES && CTL_STATS + 3 * (size_t)M * 8 <= CTL_CS_UG0, "CTL map");

constexpr int RING_BYTES = 131072;
constexpr int MISC_OFF = RING_BYTES + 320;
constexpr int LDS_BYTES = 147456;

#define LDS_WAIT() asm volatile("s_waitcnt lgkmcnt(0)" ::: "memory")
#define VM_WAIT() asm volatile("s_waitcnt vmcnt(0)" ::: "memory")
#define SBAR() __builtin_amdgcn_sched_barrier(0)
#define WG_BAR() do { asm volatile("" ::: "memory"); __builtin_amdgcn_s_barrier(); asm volatile("" ::: "memory"); } while (0)

__device__ __forceinline__ unsigned cvtpk(float lo, float hi) { unsigned r; asm volatile("v_cvt_pk_bf16_f32 %0, %1, %2" : "=v"(r) : "v"(lo), "v"(hi)); return r; }
__device__ __forceinline__ float bf_lo(unsigned w) { return __uint_as_float(w << 16); }
__device__ __forceinline__ float bf_hi(unsigned w) { return __uint_as_float(w & 0xffff0000u); }
__device__ __forceinline__ float wave_sum(float v) {
#pragma unroll
    for (int o = 1; o < 64; o <<= 1) v += __shfl_xor(v, o);
    return v;
}
__device__ __forceinline__ float silu_f(float y) { return y * __builtin_amdgcn_rcpf(1.0f + __builtin_amdgcn_exp2f(-1.4426950408889634f * y)); }

struct Args { const float* in[16]; float* out; unsigned char* ws; };
static_assert(sizeof(Args) == 18 * 8, "Args has no padding");
__device__ __forceinline__ const GAS float* ldin(const Args& a, int i) { asm volatile("" : "+s"(i)); return (const GAS float*)a.in[i]; }
__device__ __forceinline__ int opq_i(int v) { asm volatile("" : "+s"(v)); return v; }
__device__ __forceinline__ unsigned char* opq_p(unsigned char* p) { asm volatile("" : "+s"(p)); return p; }

namespace pg8 {
typedef unsigned short bf16_t;
constexpr int BM = 256, BK = 64, HALF = 128, HTB = HALF * BK * 2, STAGE_BYTES = 8 * HTB, NXCD = 8, WGM = 8;
__host__ __device__ __forceinline__ int lds_byte(int r, int c) { const int st = (r >> 4) * 2 + (c >> 5), rr = r & 15, cc = c & 31, ob = rr * 64 + cc * 2; return st * 1024 + (ob ^ (((ob >> 9) & 1) << 5)); }
__host__ __device__ __forceinline__ void stage_rc(int b, int& R, int& C) { const int st = b / 1024, sb = b % 1024, swz = sb ^ (((sb >> 9) & 1) << 5); R = (st >> 1) * 16 + swz / 64; C = (st & 1) * 32 + (swz % 64) / 2; }
__host__ __device__ __forceinline__ int perm32(int rho) { const int n = rho >> 4, i = rho & 15; return 8 * (i >> 2) + 4 * n + (i & 3); }
struct Unit { int pm, pn; };
struct Gemm { const bf16_t* A; const bf16_t* Bt; int M, N, K; };
struct StaticOrder {
    int nM, nN, nwg, G, c;
    __host__ __device__ void init(int M_, int N_, int G_, int c_) { nM = M_ / BM; nN = N_ / BM; nwg = nM * nN; G = G_; c = c_; }
    __host__ __device__ bool next(int i, Unit& u) const {
        const long L = (long)i * G + c; if (L >= nwg) return false;
        int wgid = (int)L; { const int q = nwg / NXCD, r = nwg % NXCD, xcd = wgid % NXCD, off = wgid / NXCD; wgid = (xcd < r ? xcd * (q + 1) : r * (q + 1) + (xcd - r) * q) + off; }
        const int nig = WGM * nN, gid = wgid / nig, fm = gid * WGM, gsz = (nM - fm) < WGM ? (nM - fm) : WGM;
        u.pm = fm + ((wgid % nig) % gsz); u.pn = (wgid % nig) / gsz; return true;
    }
    __device__ __forceinline__ void a_ready(const Unit&) const {}
    __device__ __forceinline__ void done(const Unit&) const {}
};
struct EpiBf16 {
    static constexpr bool PERM = true, AFTER_DRAIN = false;
    unsigned char* W; int L;
    __device__ __forceinline__ void operator()(const f32x4 (&acc)[2][2][4][2], const Unit& u, int wr_, int wc_, int fr_, int fq_) const {
        int tid_ = threadIdx.x; asm volatile("" : "+v"(tid_));
        GAS unsigned char* const Wg = (GAS unsigned char*)W;
        GAS bf16_t* const O = (GAS bf16_t*)(Wg + WS_QKV); constexpr int ldc = N_AB, split_cols = 0; constexpr size_t split_stride = 0; GAS float* const gates = (GAS float*)(Wg + WS_GATES); const int gate_pn = L == 0 ? -1 : 48;
        const GAS float* const st = L == 0 ? nullptr : (const GAS float*)(Wg + WS_CTL + CTL_STATS) + (size_t)1 * M * 2;
        const GAS float* const cs = (const GAS float*)(Wg + WS_CTL + CTL_CS_INCD); const GAS float* const bs = (const GAS float*)(Wg + WS_CTL + CTL_BS_INCD);
        const int wid = __builtin_amdgcn_readfirstlane(tid_ >> 6), wr = wid >> 2, wc = wid & 3, fr = tid_ & 15, fq = (tid_ & 63) >> 4;
        const int row0 = u.pm * BM + wr * 64 + fr;
        const int colg = u.pn * BM + wc * 32 + 8 * fq;
        f32x4 csv[2][2], bsv[2][2];
        if (st) {
#pragma unroll
            for (int bj = 0; bj < 2; ++bj)
#pragma unroll
                for (int n = 0; n < 2; ++n) { csv[bj][n] = *(const f32x4*)(cs + colg + bj * HALF + 4 * n); bsv[bj][n] = *(const f32x4*)(bs + colg + bj * HALF + 4 * n); }
        }
        int colt = u.pn * BM; GAS bf16_t* base = O;
        if (split_cols) { const int t = colt / split_cols; base += (size_t)t * split_stride; colt -= t * split_cols; }
        const int col0 = colt + wc * 32 + 8 * fq;
        const GAS float* stp = st + (size_t)row0 * 2;
#pragma unroll
        for (int ai = 0; ai < 2; ++ai)
#pragma unroll
            for (int m = 0; m < 4; ++m) { const int row = row0 + ai * HALF + m * 16;
                float mu = 0.f, rs = 1.f;
                if (st) { const f32x2 sv = *(const f32x2*)(stp + (ai * HALF + m * 16) * 2); mu = sv[0] * (1.f / DM); rs = __builtin_amdgcn_rsqf(sv[1] * (1.f / DM) - mu * mu + LN_EPS); }
                f32x4 v[2][2];
#pragma unroll
                for (int bj = 0; bj < 2; ++bj)
#pragma unroll
                    for (int n = 0; n < 2; ++n) v[bj][n] = st ? (acc[ai][bj][m][n] - csv[bj][n] * mu) * rs + bsv[bj][n] : acc[ai][bj][m][n];
                if (u.pn == gate_pn) { if (wc == 0 && fq < 2) { GAS float* gp = gates + (size_t)row * 16 + 8 * fq; *(GAS f32x4*)gp = v[0][0]; *(GAS f32x4*)(gp + 4) = v[0][1]; } }
                else { GAS bf16_t* rowp = base + (size_t)row * ldc + col0;
#pragma unroll
                    for (int bj = 0; bj < 2; ++bj) { u32x4 w; w.x = cvtpk(v[bj][0][0], v[bj][0][1]); w.y = cvtpk(v[bj][0][2], v[bj][0][3]); w.z = cvtpk(v[bj][1][0], v[bj][1][1]); w.w = cvtpk(v[bj][1][2], v[bj][1][3]);
                        *(u32x4*)(rowp + bj * HALF) = w; } } }
    }
};
struct EpiResid {
    static constexpr bool PERM = true, AFTER_DRAIN = false;
    const Args* ap; unsigned char* W; int L, which; LAS unsigned char* lds;
    __device__ __forceinline__ void operator()(const f32x4 (&acc)[2][2][4][2], const Unit& u, int wr_, int wc_, int fr_, int fq_) const {
        int tid_ = threadIdx.x; asm volatile("" : "+v"(tid_));
        const int wid = __builtin_amdgcn_readfirstlane(tid_ >> 6), wr = wid >> 2, wc = wid & 3, lane = tid_ & 63, fr = tid_ & 15, fq = (tid_ & 63) >> 4;
        GAS unsigned char* const Wg = (GAS unsigned char*)W; GAS float* const STATS = (GAS float*)(Wg + WS_CTL + CTL_STATS);
        const bool lastsub = (which == 1 && L == 1);
        const GAS bf16_t* const zbin = (const GAS bf16_t*)(Wg + WS_XB); GAS bf16_t* const zb = lastsub ? nullptr : (GAS bf16_t*)(Wg + WS_XB); GAS float* const out32 = lastsub ? (GAS float*)ap->out : nullptr;
        const GAS float* const st_in = which == 0 ? (L == 0 ? nullptr : STATS + (size_t)1 * M * 2) : STATS + (size_t)(L == 0 ? 0 : 2) * M * 2;
        GAS float* const st_out = which == 0 ? STATS + (size_t)(L == 0 ? 0 : 2) * M * 2 : (L == 0 ? STATS + (size_t)1 * M * 2 : nullptr);
        const int lnoff = which == 0 ? DM : 2 * L * DM;
        const GAS float* const lg = ldin(*ap, 14) + lnoff; const GAS float* const lb = ldin(*ap, 15) + lnoff;
        constexpr float alpha = ALPHA; LAS float* const red = (LAS float*)(lds + RING_BYTES + 1024);
        constexpr int ldc = DM;
        const int row0 = u.pm * BM + wr * 64 + fr, col0 = u.pn * BM + wc * 32 + 8 * fq;
        LAS float* myred = red + wid * 256;
#pragma unroll
        for (int ai = 0; ai < 2; ++ai) { u32x4 xr[4][2]; f32x2 sv[4]; f32x4 s1 = {0.f, 0.f, 0.f, 0.f}, s2 = {0.f, 0.f, 0.f, 0.f};
#pragma unroll
            for (int m = 0; m < 4; ++m) { const size_t off = (size_t)(row0 + ai * HALF + m * 16) * ldc + col0;
                xr[m][0] = *(const GAS u32x4*)(zbin + off); xr[m][1] = *(const GAS u32x4*)(zbin + off + HALF); sv[m] = st_in ? *(const GAS f32x2*)(st_in + (size_t)row0 * 2 + (ai * HALF + m * 16) * 2) : (f32x2){0.f, 0.f}; }
#pragma unroll
            for (int bj = 0; bj < 2; ++bj) {
                f32x4 gv[2], bv[2];
#pragma unroll
                for (int n = 0; n < 2; ++n) { gv[n] = st_in ? *(const GAS f32x4*)(lg + col0 + bj * HALF + 4 * n) : (f32x4){1.f, 1.f, 1.f, 1.f}; bv[n] = st_in ? *(const GAS f32x4*)(lb + col0 + bj * HALF + 4 * n) : (f32x4){0.f, 0.f, 0.f, 0.f}; }
#pragma unroll
                for (int m = 0; m < 4; ++m) { const float mu = sv[m][0] * (1.f / DM), rs = st_in ? __builtin_amdgcn_rsqf(sv[m][1] * (1.f / DM) - mu * mu + LN_EPS) : 1.f;
                    const u32x4 r = xr[m][bj]; const size_t off = (size_t)(row0 + ai * HALF + m * 16) * ldc + col0 + bj * HALF;
                    const f32x4 z0 = (((f32x4){bf_lo(r.x), bf_hi(r.x), bf_lo(r.y), bf_hi(r.y)} - mu) * rs * gv[0] + bv[0]) * alpha + acc[ai][bj][m][0];
                    const f32x4 z1 = (((f32x4){bf_lo(r.z), bf_hi(r.z), bf_lo(r.w), bf_hi(r.w)} - mu) * rs * gv[1] + bv[1]) * alpha + acc[ai][bj][m][1];
                    if (out32) { *(GAS f32x4*)(out32 + off) = z0; *(GAS f32x4*)(out32 + off + 4) = z1; }
                    if (zb) { u32x4 w; w.x = cvtpk(z0[0], z0[1]); w.y = cvtpk(z0[2], z0[3]); w.z = cvtpk(z1[0], z1[1]); w.w = cvtpk(z1[2], z1[3]); *(GAS u32x4*)(zb + off) = w; }
                    s1[m] += (z0[0] + z0[1]) + (z0[2] + z0[3]) + (z1[0] + z1[1]) + (z1[2] + z1[3]);
                    s2[m] += (z0[0] * z0[0] + z0[1] * z0[1]) + (z0[2] * z0[2] + z0[3] * z0[3]) + (z1[0] * z1[0] + z1[1] * z1[1]) + (z1[2] * z1[2] + z1[3] * z1[3]); }
            }
            if (st_out) {
#pragma unroll
                for (int m = 0; m < 4; ++m) { float a1 = s1[m], a2 = s2[m]; a1 += __shfl_xor(a1, 16); a1 += __shfl_xor(a1, 32); a2 += __shfl_xor(a2, 16); a2 += __shfl_xor(a2, 32);
                    if (fq == 0) *(LAS f32x2*)(myred + ((ai * 4 + m) * 16 + fr) * 2) = (f32x2){a1, a2}; } }
            asm volatile("" ::: "memory"); }
        if (st_out) {
            asm volatile("s_waitcnt lgkmcnt(0)" ::: "memory");
            GAS float* sp = st_out + (size_t)(u.pm * BM + wr * 64) * 2;
#pragma unroll
            for (int j = 0; j < 4; ++j) { const int idx = j * 64 + lane, g = idx >> 5, r = (idx & 31) >> 1, c = idx & 1;
                unsafeAtomicAdd((float*)(sp + ((g >> 2) * HALF + (g & 3) * 16 + r) * 2 + c), myred[idx]); }
            asm volatile("s_waitcnt lgkmcnt(0)" ::: "memory");
        }
    }
};

__device__ __forceinline__ float dpp_ror1(float x) { return __int_as_float(__builtin_amdgcn_update_dpp(0, __float_as_int(x), 0x121, 0xF, 0xF, false)); }
__device__ __forceinline__ float dpp_ror2(float x) { return __int_as_float(__builtin_amdgcn_update_dpp(0, __float_as_int(x), 0x122, 0xF, 0xF, false)); }
struct EpiFfnAct {
    static constexpr bool PERM = true, AFTER_DRAIN = false;
    const Args* ap; unsigned char* W; int L; LAS unsigned char* lds;
    __device__ __forceinline__ void operator()(f32x4 (&acc)[2][2][4][2], const Unit& u, int wr_, int wc_, int fr_, int fq_) const {
        int tid_ = threadIdx.x; asm volatile("" : "+v"(tid_));
        GAS unsigned char* const Wg = (GAS unsigned char*)W;
        GAS bf16_t* const H = (GAS bf16_t*)(Wg + WS_U); const GAS float* const cw = ldin(*ap, 11) + (size_t)L * 3 * DFF; const GAS float* const cb = ldin(*ap, 12) + (size_t)L * DFF;
        GAS float* const EG0 = (GAS float*)(Wg + WS_G); GAS float* const EU0 = (GAS float*)(Wg + WS_G + 8 * MiB); GAS float* const EGL = (GAS float*)(Wg + WS_G + 16 * MiB); LAS float* const edge = (LAS float*)(lds + RING_BYTES + 1024);
        const GAS float* const st = (const GAS float*)(Wg + WS_CTL + CTL_STATS) + (size_t)(L == 0 ? 0 : 2) * M * 2;
        const GAS float* const cs = (const GAS float*)(Wg + WS_CTL + (L == 0 ? CTL_CS_UG0 : CTL_CS_UG1)); const GAS float* const bs = (const GAS float*)(Wg + WS_CTL + (L == 0 ? CTL_BS_UG0 : CTL_BS_UG1));
        const int wid = __builtin_amdgcn_readfirstlane(tid_ >> 6), wr = wid >> 2, wc = wid & 3, fr = tid_ & 15, fq = (tid_ & 63) >> 4;
        const int ch0 = u.pn * 128 + wc * 32 + fq * 8, row0 = u.pm * BM + wr * 64 + fr, colg = u.pn * BM + wc * 32 + 8 * fq;
        const GAS float* stp = st + (size_t)row0 * 2;
        f32x2 sv[2][4]; f32x4 csg[2], bsg[2];
#pragma unroll
        for (int ai = 0; ai < 2; ++ai)
#pragma unroll
            for (int m = 0; m < 4; ++m) sv[ai][m] = *(const f32x2*)(stp + (ai * HALF + m * 16) * 2);
#pragma unroll
        for (int n = 0; n < 2; ++n) { csg[n] = *(const f32x4*)(cs + colg + HALF + 4 * n); bsg[n] = *(const f32x4*)(bs + colg + HALF + 4 * n); }
        float mu[2][4], rs[2][4];
#pragma unroll
        for (int ai = 0; ai < 2; ++ai)
#pragma unroll
            for (int m = 0; m < 4; ++m) { mu[ai][m] = sv[ai][m][0] * (1.f / DM); rs[ai][m] = __builtin_amdgcn_rsqf(sv[ai][m][1] * (1.f / DM) - mu[ai][m] * mu[ai][m] + LN_EPS);
#pragma unroll
                for (int n = 0; n < 2; ++n) acc[ai][1][m][n] = (acc[ai][1][m][n] - csg[n] * mu[ai][m]) * rs[ai][m] + bsg[n];
                asm volatile("" : "+v"(acc[ai][1][m][0]), "+v"(acc[ai][1][m][1])); }
        asm volatile("" ::: "memory");
        f32x4 csu[2], bsu[2], wt[4][2];
#pragma unroll
        for (int n = 0; n < 2; ++n) { csu[n] = *(const f32x4*)(cs + colg + 4 * n); bsu[n] = *(const f32x4*)(bs + colg + 4 * n);
            wt[0][n] = *(const f32x4*)(cw + ch0 + 4 * n); wt[1][n] = *(const f32x4*)(cw + DFF + ch0 + 4 * n); wt[2][n] = *(const f32x4*)(cw + 2 * DFF + ch0 + 4 * n); wt[3][n] = *(const f32x4*)(cb + ch0 + 4 * n); }
#define FFN_G(ai, m, n) (acc[ai][1][m][n])
#define FFN_U(ai, m, n) ((acc[ai][0][m][n] - csu[n] * mu[ai][m]) * rs[ai][m] + bsu[n])
        if (fr >= 14) {
#pragma unroll
            for (int ai = 0; ai < 2; ++ai) { LAS float* e = edge + ((((ai * 2 + wr) * 4 + wc) * 4 + fq) * 2 + (fr - 14)) * 8; *(LAS f32x4*)e = FFN_G(ai, 3, 0); *(LAS f32x4*)(e + 4) = FFN_G(ai, 3, 1); }
            if (wr == 1) { GAS float* p = EGL + (size_t)(u.pm * 2 + (fr - 14)) * DFF + ch0; *(GAS f32x4*)p = FFN_G(1, 3, 0); *(GAS f32x4*)(p + 4) = FFN_G(1, 3, 1); }
        }
        if (wr == 0 && fr < 2) { GAS float* pg = EG0 + (size_t)(u.pm * 2 + fr) * DFF + ch0; GAS float* pu = EU0 + (size_t)(u.pm * 2 + fr) * DFF + ch0;
            *(GAS f32x4*)pg = FFN_G(0, 0, 0); *(GAS f32x4*)(pg + 4) = FFN_G(0, 0, 1); *(GAS f32x4*)pu = FFN_U(0, 0, 0); *(GAS f32x4*)(pu + 4) = FFN_U(0, 0, 1); }
        asm volatile("s_waitcnt lgkmcnt(0)" ::: "memory"); __builtin_amdgcn_s_barrier(); asm volatile("" ::: "memory");
#pragma unroll
        for (int ai = 0; ai < 2; ++ai) {
            f32x4 e14[2] = {(f32x4){0.f, 0.f, 0.f, 0.f}, (f32x4){0.f, 0.f, 0.f, 0.f}}, e15[2] = {(f32x4){0.f, 0.f, 0.f, 0.f}, (f32x4){0.f, 0.f, 0.f, 0.f}};
            if (wr == 1 || ai == 1) { const int sa = (wr == 1) ? ai : 0, sw = (wr == 1) ? 0 : 1; const LAS float* e = edge + (((sa * 2 + sw) * 4 + wc) * 4 + fq) * 16;
                e14[0] = *(const LAS f32x4*)e; e14[1] = *(const LAS f32x4*)(e + 4); e15[0] = *(const LAS f32x4*)(e + 8); e15[1] = *(const LAS f32x4*)(e + 12); }
#pragma unroll
            for (int m = 0; m < 4; ++m) {
                float hv[8];
#pragma unroll
                for (int n = 0; n < 2; ++n) { const f32x4 uu = FFN_U(ai, m, n);
#pragma unroll
                    for (int j = 0; j < 4; ++j) { const int c = 4 * n + j; const float gc = acc[ai][1][m][n][j]; const float r1 = dpp_ror1(gc), r2 = dpp_ror2(gc);
                        float q1, q2;
                        if (m == 0) { q1 = e15[n][j]; q2 = (fr == 0) ? e14[n][j] : e15[n][j]; }
                        else { const float gpv = acc[ai][1][m > 0 ? m - 1 : 0][n][j]; q1 = dpp_ror1(gpv); q2 = dpp_ror2(gpv); }
                        const float p1 = (fr == 0) ? q1 : r1, p2 = (fr < 2) ? q2 : r2;
                        const float y = wt[0][n][j] * p2 + wt[1][n][j] * p1 + wt[2][n][j] * gc + wt[3][n][j];
                        hv[c] = silu_f(y) * uu[j]; } }
                if (!(ai == 0 && m == 0 && wr == 0 && fr < 2)) { u32x4 w; w.x = cvtpk(hv[0], hv[1]); w.y = cvtpk(hv[2], hv[3]); w.z = cvtpk(hv[4], hv[5]); w.w = cvtpk(hv[6], hv[7]);
                    *(u32x4*)(H + (size_t)(row0 + ai * HALF + m * 16) * DFF + ch0) = w; }
            }
        }
#undef FFN_G
#undef FFN_U
    }
};

template <class Epi, class Sched, bool ALIGN_EPI = false, bool SP2 = false>
__device__ __forceinline__ void gemm_phase(LAS unsigned char* lds, const Gemm g, const Sched& S, const Epi& E) {
    int tid_ = threadIdx.x; asm volatile("" : "+v"(tid_));
    const int tid = tid_, wid = __builtin_amdgcn_readfirstlane(tid >> 6), lane = tid & 63, wr = wid >> 2, wc = wid & 3, fr = lane & 15, fq = lane >> 4;
    const int K = g.K, nt = K / BK;
    unsigned voffA[2], voffB[2];
#pragma unroll
    for (int i = 0; i < 2; ++i) { int R, C; stage_rc(tid * 16 + i * 8192, R, C); const int Rb = Epi::PERM ? ((R & ~31) + perm32(R & 31)) : R;
        voffA[i] = (unsigned)(R * K + C) * 2u; voffB[i] = (unsigned)(Rb * K + C) * 2u; }
    const size_t kstep = (size_t)(BK * 2);
    const size_t hstep = (size_t)HALF * K * 2;
    const size_t tstep = 2 * hstep;
    const unsigned ldsw = (unsigned)wid * 1024u;
    const int aoff = lds_byte(wr * 64 + fr, fq * 8), boff = lds_byte(wc * 32 + fr, fq * 8);
#define PG8_SA(b, h) (((b) * 2 + (h)) * HTB)
#define PG8_SB(b, h) ((4 + (b) * 2 + (h)) * HTB)
#define PG8_STAGE(bufoff, gbase, voff) do { _Pragma("unroll") for (int _i = 0; _i < 2; ++_i) \
        __builtin_amdgcn_global_load_lds((const unsigned*)((const char*)(gbase) + (voff)[_i]), (LAS unsigned*)(lds + (bufoff) + ldsw + _i * 8192), 16, 0, 0); } while (0)
#define PG8_LDA(dst, b, h) do { _Pragma("unroll") for (int m = 0; m < 4; ++m) _Pragma("unroll") for (int k = 0; k < 2; ++k) dst[m][k] = *(const LAS bf16x8*)(lds + PG8_SA(b, h) + aoff + m * 2048 + k * 1024); } while (0)
#define PG8_LDB(dst, b, h) do { _Pragma("unroll") for (int n = 0; n < 2; ++n) _Pragma("unroll") for (int k = 0; k < 2; ++k) dst[n][k] = *(const LAS bf16x8*)(lds + PG8_SB(b, h) + boff + n * 2048 + k * 1024); } while (0)
#define PG8_MMA(ai, bj, At, Bt) do { __builtin_amdgcn_s_setprio(1); _Pragma("unroll") for (int m = 0; m < 4; ++m) _Pragma("unroll") for (int n = 0; n < 2; ++n) _Pragma("unroll") for (int k = 0; k < 2; ++k) \
        acc[ai][bj][m][n] = __builtin_amdgcn_mfma_f32_16x16x32_bf16(Bt[n][k], At[m][k], acc[ai][bj][m][n], 0, 0, 0); __builtin_amdgcn_s_setprio(0); } while (0)
#define PG8_WAIT_V(n) asm volatile("s_waitcnt vmcnt(" #n ")" ::: "memory")
#define PG8_WAIT_L(n) asm volatile("s_waitcnt lgkmcnt(" #n ")" ::: "memory")
#define PG8_BAR __builtin_amdgcn_s_barrier()
#define PG8_SCHED __builtin_amdgcn_sched_barrier(0)
    Unit cur, nxt; int ui = 0;
    if (!S.next(0, cur)) return;
    f32x4 acc[2][2][4][2];
#pragma unroll
    for (int a = 0; a < 2; ++a)
#pragma unroll
        for (int b = 0; b < 2; ++b)
#pragma unroll
            for (int m = 0; m < 4; ++m)
#pragma unroll
                for (int n = 0; n < 2; ++n) acc[a][b][m][n] = (f32x4){0.f, 0.f, 0.f, 0.f};
    bf16x8 At[4][2], B0[2][2], B1[2][2];
    const char* cA = (const char*)g.A + (size_t)cur.pm * tstep; const char* cB = (const char*)g.Bt + (size_t)cur.pn * tstep;
    S.a_ready(cur);
    if constexpr (SP2) {
        PG8_STAGE(PG8_SB(0, 0), cB, voffB); PG8_STAGE(PG8_SB(0, 1), cB + hstep, voffB); PG8_STAGE(PG8_SA(0, 0), cA, voffA); PG8_STAGE(PG8_SA(0, 1), cA + hstep, voffA);
        if (wr == 1) PG8_BAR;
        PG8_WAIT_V(2); PG8_BAR;
        PG8_STAGE(PG8_SB(1, 0), cB + kstep, voffB); PG8_STAGE(PG8_SA(1, 0), cA + kstep, voffA); PG8_STAGE(PG8_SB(1, 1), cB + hstep + kstep, voffB);
        PG8_WAIT_V(6); PG8_BAR;
    } else {
        PG8_STAGE(PG8_SB(0, 0), cB, voffB); PG8_STAGE(PG8_SA(0, 0), cA, voffA); PG8_STAGE(PG8_SB(0, 1), cB + hstep, voffB); PG8_STAGE(PG8_SA(0, 1), cA + hstep, voffA);
        if (wr == 1) PG8_BAR;
        PG8_WAIT_V(4); PG8_BAR;
        PG8_STAGE(PG8_SB(1, 0), cB + kstep, voffB); PG8_STAGE(PG8_SA(1, 0), cA + kstep, voffA); PG8_STAGE(PG8_SB(1, 1), cB + hstep + kstep, voffB);
        PG8_WAIT_V(6); PG8_BAR;
    }
    for (;;) {
        const bool has_next = S.next(ui + 1, nxt);
        const char* nA = has_next ? (const char*)g.A + (size_t)nxt.pm * tstep : cA; const char* nB = has_next ? (const char*)g.Bt + (size_t)nxt.pn * tstep : cB;
        for (int t = 0; t < nt; t += 2) {
            const bool last = (t == nt - 2);
            const char* a1 = cA + (size_t)(t + 1) * kstep;
            const char* a2 = last ? nA : cA + (size_t)(t + 2) * kstep; const char* b2 = last ? nB : cB + (size_t)(t + 2) * kstep;
            const char* a3 = a2 + kstep; const char* b3 = b2 + kstep;
            if (last && has_next) S.a_ready(nxt);
            if constexpr (SP2) {
            PG8_LDB(B0, 0, 0); PG8_LDB(B1, 0, 1); PG8_SCHED; PG8_LDA(At, 0, 0); PG8_STAGE(PG8_SA(1, 1), a1 + hstep, voffA);
            PG8_WAIT_V(8); PG8_WAIT_L(0); PG8_BAR; PG8_MMA(0, 0, At, B0); PG8_MMA(0, 1, At, B1); PG8_BAR; PG8_SCHED;
            PG8_LDA(At, 0, 1); PG8_STAGE(PG8_SB(0, 0), b2, voffB); PG8_STAGE(PG8_SB(0, 1), b2 + hstep, voffB); PG8_STAGE(PG8_SA(0, 0), a2, voffA);
            PG8_WAIT_V(8); PG8_WAIT_L(0); PG8_BAR; PG8_MMA(1, 0, At, B0); PG8_MMA(1, 1, At, B1); PG8_BAR; PG8_SCHED;
            PG8_LDB(B0, 1, 0); PG8_LDB(B1, 1, 1); PG8_SCHED; PG8_LDA(At, 1, 0); PG8_STAGE(PG8_SA(0, 1), a2 + hstep, voffA);
            PG8_WAIT_V(8); PG8_WAIT_L(0); PG8_BAR; PG8_MMA(0, 0, At, B0); PG8_MMA(0, 1, At, B1); PG8_BAR; PG8_SCHED;
            PG8_LDA(At, 1, 1); PG8_STAGE(PG8_SB(1, 0), b3, voffB); PG8_STAGE(PG8_SB(1, 1), b3 + hstep, voffB); PG8_STAGE(PG8_SA(1, 0), a3, voffA);
            PG8_WAIT_V(8); PG8_WAIT_L(0); PG8_BAR; PG8_MMA(1, 0, At, B0); PG8_MMA(1, 1, At, B1); PG8_BAR; PG8_SCHED;
            } else {
            PG8_LDB(B0, 0, 0); PG8_SCHED; PG8_LDA(At, 0, 0); PG8_STAGE(PG8_SA(1, 1), a1 + hstep, voffA);
            PG8_WAIT_L(8); PG8_BAR; PG8_WAIT_L(0); PG8_MMA(0, 0, At, B0); PG8_BAR; PG8_SCHED;
            PG8_LDB(B1, 0, 1); PG8_STAGE(PG8_SB(0, 0), b2, voffB);
            PG8_BAR; PG8_WAIT_L(0); PG8_MMA(0, 1, At, B1); PG8_BAR;
            PG8_LDA(At, 0, 1); PG8_STAGE(PG8_SA(0, 0), a2, voffA);
            PG8_BAR; PG8_WAIT_L(0); PG8_MMA(1, 0, At, B0); PG8_BAR; PG8_SCHED;
            PG8_STAGE(PG8_SB(0, 1), b2 + hstep, voffB);
            PG8_WAIT_V(6); PG8_BAR; PG8_MMA(1, 1, At, B1); PG8_BAR;
            PG8_LDB(B0, 1, 0); PG8_SCHED; PG8_LDA(At, 1, 0); PG8_STAGE(PG8_SA(0, 1), a2 + hstep, voffA);
            PG8_WAIT_L(8); PG8_BAR; PG8_WAIT_L(0); PG8_MMA(0, 0, At, B0); PG8_BAR; PG8_SCHED;
            PG8_LDB(B1, 1, 1); PG8_STAGE(PG8_SB(1, 0), b3, voffB);
            PG8_BAR; PG8_WAIT_L(0); PG8_MMA(0, 1, At, B1); PG8_BAR;
            PG8_LDA(At, 1, 1); PG8_STAGE(PG8_SA(1, 0), a3, voffA);
            PG8_BAR; PG8_WAIT_L(0); PG8_MMA(1, 0, At, B0); PG8_BAR; PG8_SCHED;
            PG8_STAGE(PG8_SB(1, 1), b3 + hstep, voffB);
            PG8_WAIT_V(6); PG8_BAR; PG8_MMA(1, 1, At, B1); PG8_BAR;
            }
        }
        if constexpr (ALIGN_EPI) { if (wr == 0) PG8_BAR; }
        if constexpr (!Epi::AFTER_DRAIN) { E(acc, cur, wr, wc, fr, fq); S.done(cur); }
        if (!has_next) break;
#pragma unroll
        for (int a = 0; a < 2; ++a)
#pragma unroll
            for (int b = 0; b < 2; ++b)
#pragma unroll
                for (int m = 0; m < 4; ++m)
#pragma unroll
                    for (int n = 0; n < 2; ++n) acc[a][b][m][n] = (f32x4){0.f, 0.f, 0.f, 0.f};
        cur = nxt; cA = nA; cB = nB; ++ui;
        if constexpr (ALIGN_EPI) { if (wr == 1) PG8_BAR; }
    }
    PG8_WAIT_V(0);
    if constexpr (!ALIGN_EPI) { if (wr == 0) PG8_BAR; }
    PG8_BAR;
#undef PG8_SA
#undef PG8_SB
#undef PG8_STAGE
#undef PG8_LDA
#undef PG8_LDB
#undef PG8_MMA
#undef PG8_WAIT_V
#undef PG8_WAIT_L
#undef PG8_BAR
#undef PG8_SCHED
}
}

#define XB_TMO      128
#define XB_XCNT(j)  (256  + 64 * (j))
#define XB_XSUB(j)  (1280 + 64 * (j))
#define XB_XGEN(j)  (2304 + 64 * (j))
#define XB_TOP      3328
#define XB_TOPGEN   3392
#define XCD_BAR_WORDS 3456
#define XB_SPIN_CAP (1u << 18)
__device__ __forceinline__ unsigned xb_ld(unsigned* p)              { return __hip_atomic_load((GAS unsigned*)p, __ATOMIC_RELAXED, __HIP_MEMORY_SCOPE_AGENT); }
__device__ __forceinline__ unsigned xb_add(unsigned* p, unsigned v) { return __hip_atomic_fetch_add((GAS unsigned*)p, v, __ATOMIC_RELAXED, __HIP_MEMORY_SCOPE_AGENT); }
__device__ __forceinline__ unsigned xb_xcc_id() { return (unsigned)__builtin_amdgcn_s_getreg((3 << 11) | 20) & 0xFu; }
#define XB_SPIN(cond, bar) do { unsigned _sp = 0; while (cond) { __builtin_amdgcn_s_sleep(1); \
    if ((++_sp & 255u) == 0u) { if (xb_ld(&(bar)[XB_TMO])) break; if (_sp > XB_SPIN_CAP) { (void)xb_add(&(bar)[XB_TMO], 1u); break; } } } } while (0)
struct XcdBarrier { unsigned* bar; unsigned x; volatile LAS unsigned* st; };
__device__ __forceinline__ XcdBarrier xcd_barrier_post(unsigned* bar, volatile LAS unsigned* st) {
    XcdBarrier b; b.bar = bar; b.x = xb_xcc_id(); b.st = st;
    if (threadIdx.x == 0) (void)xb_add(&bar[XB_XCNT(b.x)], 1u);
    return b;
}
__device__ __forceinline__ void xcd_barrier_complete(unsigned* bar, unsigned x, unsigned& nloc, unsigned& nx) {
    const unsigned G = gridDim.x * gridDim.y * gridDim.z;
    unsigned sum, cnt, mine, sp = 0u;
    for (;;) {
        sum = 0u; cnt = 0u; mine = 0u;
#pragma unroll
        for (unsigned j = 0; j < 16; ++j) { const unsigned c = xb_ld(&bar[XB_XCNT(j)]); sum += c; cnt += (c > 0u) ? 1u : 0u; mine = (j == x) ? c : mine; }
        if (sum == G) break;
        __builtin_amdgcn_s_sleep(1);
        if ((++sp & 255u) == 0u) { if (xb_ld(&bar[XB_TMO])) break; if (sp > XB_SPIN_CAP) { (void)xb_add(&bar[XB_TMO], 1u); break; } }
    }
    nloc = mine > 0u ? mine : 1u; nx = cnt > 0u ? cnt : 1u;
}
__device__ __forceinline__ void xcd_barrier(const XcdBarrier& b) {
    asm volatile("s_waitcnt vmcnt(0)" ::: "memory");
    __syncthreads();
    if (threadIdx.x == 0) {
        unsigned* bar = b.bar; unsigned bx = b.x;
        asm volatile("" : "+s"(bar), "+s"(bx));
        __builtin_amdgcn_s_waitcnt(0);
        unsigned nloc = b.st[0], nx = b.st[1];
        if (nloc == 0u) { xcd_barrier_complete(bar, bx, nloc, nx); b.st[0] = nloc; b.st[1] = nx; }
        const unsigned old = xb_add(&bar[XB_XSUB(bx)], 1u);
        const unsigned gen = old / nloc;
        if (old + 1u == (gen + 1u) * nloc) {
            __builtin_amdgcn_fence(__ATOMIC_RELEASE, "agent");
            asm volatile("s_waitcnt vmcnt(0)" ::: "memory");
            const unsigned og = xb_add(&bar[XB_TOP], 1u);
            const unsigned tg = og / nx;
            if (og + 1u == (tg + 1u) * nx) xb_add(&bar[XB_TOPGEN], 1u);
            else XB_SPIN(xb_ld(&bar[XB_TOPGEN]) == tg, bar);
            __builtin_amdgcn_fence(__ATOMIC_ACQUIRE, "agent");
            xb_add(&bar[XB_XGEN(bx)], 1u);
            asm volatile("s_waitcnt vmcnt(0)" ::: "memory");
        } else {
            XB_SPIN(xb_ld(&bar[XB_XGEN(bx)]) == gen, bar);
            __builtin_amdgcn_fence(__ATOMIC_ACQUIRE, "agent");
            asm volatile("s_waitcnt vmcnt(0)" ::: "memory");
        }
    }
    __syncthreads();
}

namespace att {
constexpr int D = 128, SHM = 16384;
constexpr int OFF_V = 0, OFF_K = 2 * SHM, OFF_WS = 4 * SHM, OFF_AUX = 4 * SHM + 2048, LDS_USED = 4 * SHM + 2048 + 8192;
constexpr float SCALE = 0.08838834764831845f;
constexpr float C2 = 1.4426950408889634f * SCALE;
constexpr float THR = 8.f;
enum { MODE_DIL = 0, MODE_MOBA = 1, MODE_SB = 2, MODE_ML = 3 };
#define KSWZ(row, colB) ((row) * 256 + ((colB) ^ (((row) & 7) << 4)))
__device__ __forceinline__ int v_st(int k, int c) { const int kk = (k & ~0xC) | ((k & 4) << 1) | ((k & 8) >> 1); return ((kk >> 3) * 4 + (c >> 5)) * 512 + ((kk & 7) * 32 + (c & 31)) * 2; }
__device__ __forceinline__ int v_rd_base(int lane) { return ((lane & 3) << 3) | (((lane >> 2) & 3) << 6) | (((lane >> 4) & 1) << 5) | (((lane >> 5) & 1) << 8); }
__device__ __forceinline__ int crow(int r, int hi) { return (r & 3) + 8 * (r >> 2) + 4 * hi; }
__device__ __forceinline__ void mask_tile(f32x16& p0, f32x16& p1, int dq) {
    const float NEG = -__builtin_inff();
#pragma unroll
    for (int r = 0; r < 16; ++r) {
        const int c = (r & 3) + 8 * (r >> 2);
        if (dq - c < 0) p0[r] = NEG;
        if (dq - c - 32 < 0) p1[r] = NEG;
    }
}
__device__ __forceinline__ void partialSM(f32x16& p0, f32x16& p1, float& m_reg, float& mn, float& alpha) {
    float pmax = p0[0];
#pragma unroll
    for (int r = 1; r < 16; ++r) pmax = fmaxf(pmax, p0[r]);
#pragma unroll
    for (int r = 0; r < 16; ++r) pmax = fmaxf(pmax, p1[r]);
    { auto rr = __builtin_amdgcn_permlane32_swap(__float_as_uint(pmax), __float_as_uint(pmax), false, false);
      pmax = fmaxf(__uint_as_float(rr[0]), __uint_as_float(rr[1])); }
    if (__builtin_expect(__all((pmax - m_reg) * SCALE <= THR), 1)) { mn = m_reg; alpha = 1.f; }
    else { mn = fmaxf(m_reg, pmax); alpha = __builtin_amdgcn_exp2f((m_reg - mn) * C2); m_reg = mn; }
    const float mnL = -mn * C2;
#pragma unroll
    for (int r = 0; r < 16; ++r) p0[r] = fmaf(p0[r], C2, mnL);
#pragma unroll
    for (int r = 0; r < 16; ++r) p1[r] = fmaf(p1[r], C2, mnL);
#pragma unroll
    for (int r = 0; r < 16; ++r) p0[r] = __builtin_amdgcn_exp2f(p0[r]);
#pragma unroll
    for (int r = 0; r < 16; ++r) p1[r] = __builtin_amdgcn_exp2f(p1[r]);
}
#define ATT_PK4(P, B_, OUT) do { unsigned a0 = cvtpk(P[B_+0], P[B_+1]), a1 = cvtpk(P[B_+2], P[B_+3]);                          \
        unsigned b0 = cvtpk(P[B_+4], P[B_+5]), b1 = cvtpk(P[B_+6], P[B_+7]);                                             \
        auto r0 = __builtin_amdgcn_permlane32_swap(a0, b0, false, false); auto r1 = __builtin_amdgcn_permlane32_swap(a1, b1, false, false); \
        u32x4 w = {r0[0], r1[0], r0[1], r1[1]}; OUT = *reinterpret_cast<bf16x8*>(&w); } while (0)
__device__ __forceinline__ void pack_p(const f32x16& p0, const f32x16& p1, bf16x8& pa0, bf16x8& pa1, bf16x8& pa2, bf16x8& pa3) {
    ATT_PK4(p0, 0, pa0); ATT_PK4(p0, 8, pa1); ATT_PK4(p1, 0, pa2); ATT_PK4(p1, 8, pa3);
}
__device__ __forceinline__ float pair_sum(float v) {
    auto rr = __builtin_amdgcn_permlane32_swap(__float_as_uint(v), __float_as_uint(v), false, false);
    return __uint_as_float(rr[0]) + __uint_as_float(rr[1]);
}
__device__ __forceinline__ void qkt(f32x16& p0, f32x16& p1, const LAS char* Kb, int r32, int hi, const bf16x8* qr) {
#pragma unroll
    for (int r = 0; r < 16; ++r) { p0[r] = 0.f; p1[r] = 0.f; }
    const LAS char* kb[4];
#pragma unroll
    for (int dd = 0; dd < 4; ++dd) kb[dd] = Kb + KSWZ(r32, (dd * 16 + hi * 8) * 2);
#pragma unroll
    for (int d0 = 0; d0 < 8; ++d0) { const LAS char* a = kb[d0 & 3] + (d0 >> 2) * 128;
        const bf16x8 b0 = *reinterpret_cast<const LAS bf16x8*>(a);
        const bf16x8 b1 = *reinterpret_cast<const LAS bf16x8*>(a + 32 * 256);
        p0 = __builtin_amdgcn_mfma_f32_32x32x16_bf16(b0, qr[d0], p0, 0, 0, 0);
        p1 = __builtin_amdgcn_mfma_f32_32x32x16_bf16(b1, qr[d0], p1, 0, 0, 0); }
}
__device__ __forceinline__ void pv_tile(f32x16* o, int vb0, bf16x8 pa0, bf16x8 pa1, bf16x8 pa2, bf16x8 pa3) {
#define TRRD(dst, off) asm volatile("ds_read_b64_tr_b16 %0, %1 offset:%2" : "=&v"(dst) : "v"(vb0), "i"(off) : "memory")
#define PV_D0(d0) do { s16x4 l0, l1, l2, l3, h0, h1, h2, h3; constexpr int b_ = (d0) * 512; \
        TRRD(l0, b_); TRRD(h0, b_ + 2048); TRRD(l1, b_ + 4096); TRRD(h1, b_ + 6144); TRRD(l2, b_ + 8192); TRRD(h2, b_ + 10240); TRRD(l3, b_ + 12288); TRRD(h3, b_ + 14336); \
        asm volatile("s_waitcnt lgkmcnt(0)" ::: "memory"); SBAR();   \
        o[d0] = __builtin_amdgcn_mfma_f32_32x32x16_bf16(pa0, (bf16x8){l0[0], l0[1], l0[2], l0[3], h0[0], h0[1], h0[2], h0[3]}, o[d0], 0, 0, 0);   \
        o[d0] = __builtin_amdgcn_mfma_f32_32x32x16_bf16(pa1, (bf16x8){l1[0], l1[1], l1[2], l1[3], h1[0], h1[1], h1[2], h1[3]}, o[d0], 0, 0, 0);   \
        o[d0] = __builtin_amdgcn_mfma_f32_32x32x16_bf16(pa2, (bf16x8){l2[0], l2[1], l2[2], l2[3], h2[0], h2[1], h2[2], h2[3]}, o[d0], 0, 0, 0);   \
        o[d0] = __builtin_amdgcn_mfma_f32_32x32x16_bf16(pa3, (bf16x8){l3[0], l3[1], l3[2], l3[3], h3[0], h3[1], h3[2], h3[3]}, o[d0], 0, 0, 0); } while (0)
    PV_D0(0); PV_D0(1); PV_D0(2); PV_D0(3);
#undef PV_D0
#undef TRRD
}

template <int MODE>
__device__ __forceinline__ void attn_block(const bf16* __restrict__ Qp, int ldq, const bf16* __restrict__ Kp, int ldk, const bf16* __restrict__ Vp, int ldv, bf16* __restrict__ Op, int ldo,
                                           int qb, LAS char* lds, const float* __restrict__ aux0, const float* __restrict__ aux1, const float* __restrict__ aux2) {
    int tid_ = threadIdx.x; asm volatile("" : "+v"(tid_));
    const int tid = tid_, wid = __builtin_amdgcn_readfirstlane(tid >> 6), lane = tid & 63, r32 = lane & 31, hi = lane >> 5;
    const int P0 = qb * 256, qlo = P0 + wid * 32, qpos = qlo + r32;
    const int NT = 4 * qb + 4;
    LAS char* V_lds = lds + OFF_V; LAS char* K_lds = lds + OFF_K;
    LAS float* wsf = (LAS float*)(lds + OFF_WS) + wid * 64; LAS float* li_l = wsf; LAS float* al_l = wsf + 32;
    LAS float* aux = (LAS float*)(lds + OFF_AUX);
    bf16x8 qr[8];
#pragma unroll
    for (int d0 = 0; d0 < 8; ++d0) qr[d0] = *reinterpret_cast<const bf16x8*>(Qp + (size_t)qpos * ldq + d0 * 16 + hi * 8);
    unsigned kso[2], vso[2];
#pragma unroll
    for (int i = 0; i < 2; ++i) { const int pc = 2 * wid + i, krow = pc * 4 + (lane >> 4), kch = (lane & 15) ^ (krow & 7);
        kso[i] = (unsigned)(krow * ldk + kch * 8) * 2u;
        const int kk = wid * 8 + ((lane & 31) >> 2), vk = (kk & ~0xC) | ((kk & 4) << 1) | ((kk & 8) >> 1), vc = (2 * i + (lane >> 5)) * 32 + (lane & 3) * 8;
        vso[i] = (unsigned)(vk * ldv + vc) * 2u; }
    const int vb0 = (int)(unsigned)(size_t)V_lds + v_rd_base(lane);
    float m_reg = -1e30f, l_reg = 0.f, Rsum = 0.f, den = 0.f, M2row = 0.f, nmrow = 1.f; unsigned sel = 0u;
    if constexpr (MODE == MODE_ML) { for (int i = tid; i < P0 + 256; i += 512) aux[i] = aux0[i]; M2row = aux1[qpos]; nmrow = aux2[qpos]; }
    if constexpr (MODE == MODE_MOBA) { for (int i = tid; i < qb * 128; i += 512) aux[i] = aux0[i]; }
#define TJ(i) ((MODE == MODE_SB) ? (NT - 1 - (i)) : (i))
#define SLOAD(kb_, bf) do { const char* kg_ = (const char*)(Kp + (size_t)(kb_) * ldk); const char* vg_ = (const char*)(Vp + (size_t)(kb_) * ldv); \
        _Pragma("unroll") for (int i_ = 0; i_ < 2; ++i_) { \
            __builtin_amdgcn_global_load_lds((const unsigned*)(kg_ + kso[i_]), (LAS unsigned*)(K_lds + (bf) * SHM + (2 * wid + i_) * 1024), 16, 0, 0); \
            __builtin_amdgcn_global_load_lds((const unsigned*)(vg_ + vso[i_]), (LAS unsigned*)(V_lds + (bf) * SHM + (2 * wid + i_) * 1024), 16, 0, 0); } } while (0)
    float zbnd = 0.f; bool wdone = false; LAS int* dflag = (LAS int*)(lds + OFF_WS);
    if constexpr (MODE == MODE_SB) { float s = 0.f;
#pragma unroll
        for (int d0 = 0; d0 < 8; ++d0) { const u32x4 qw = *reinterpret_cast<const u32x4*>(&qr[d0]);
            s = fmaf(bf_lo(qw.x), bf_lo(qw.x), s); s = fmaf(bf_hi(qw.x), bf_hi(qw.x), s); s = fmaf(bf_lo(qw.y), bf_lo(qw.y), s); s = fmaf(bf_hi(qw.y), bf_hi(qw.y), s);
            s = fmaf(bf_lo(qw.z), bf_lo(qw.z), s); s = fmaf(bf_hi(qw.z), bf_hi(qw.z), s); s = fmaf(bf_lo(qw.w), bf_lo(qw.w), s); s = fmaf(bf_hi(qw.w), bf_hi(qw.w), s); }
        s = pair_sum(s); zbnd = sqrtf(s * aux0[0]) * (C2 * 1.001f) + 0.01f; }
    f32x16 lgm;
    if constexpr (MODE == MODE_DIL) {
#pragma unroll
        for (int r = 0; r < 16; ++r) { const unsigned d0 = (unsigned)(qpos - 4 * hi - ((r & 3) + 8 * (r >> 2))); lgm[r] = ((d0 & 15u) == 0u) ? (1.0f / C2) : (((d0 & 3u) == 0u) ? 0.f : -__builtin_inff()); } }
    SLOAD(TJ(0) * 64, 0); VM_WAIT(); LDS_WAIT(); WG_BAR();
    if constexpr (MODE == MODE_MOBA) {
        if (qb <= 3) sel = (1u << qb) - 1u;
        else {
            float g[7];
#pragma unroll
            for (int n = 0; n < 7; ++n) { g[n] = -__builtin_inff();
                if (n < qb) { float s = 0.f;
#pragma unroll
                    for (int d0 = 0; d0 < 8; ++d0) { const LAS f32x4* kp = (const LAS f32x4*)(aux + n * 128 + d0 * 16 + hi * 8); const f32x4 k0 = kp[0], k1 = kp[1];
                        const u32x4 qw = *reinterpret_cast<const u32x4*>(&qr[d0]);
                        s = fmaf(bf_lo(qw.x), k0[0], s); s = fmaf(bf_hi(qw.x), k0[1], s); s = fmaf(bf_lo(qw.y), k0[2], s); s = fmaf(bf_hi(qw.y), k0[3], s);
                        s = fmaf(bf_lo(qw.z), k1[0], s); s = fmaf(bf_hi(qw.z), k1[1], s); s = fmaf(bf_lo(qw.w), k1[2], s); s = fmaf(bf_hi(qw.w), k1[3], s); }
                    g[n] = pair_sum(s); }
                asm volatile("" ::: "memory"); }
#pragma unroll
            for (int k = 0; k < 3; ++k) { float best = -__builtin_inff(); int bi = 0;
#pragma unroll
                for (int n = 0; n < 7; ++n) if (g[n] > best) { best = g[n]; bi = n; }
                sel |= 1u << bi;
#pragma unroll
                for (int n = 0; n < 7; ++n) g[n] = (bi == n) ? -__builtin_inff() : g[n]; }
        }
    }
    f32x16 o[4];
#pragma unroll
    for (int d_ = 0; d_ < 4; ++d_)
#pragma unroll
        for (int r = 0; r < 16; ++r) o[d_][r] = 0.f;
    for (int i = 0; i < NT; ++i) {
        const int tj = TJ(i), kb = tj * 64, buf = i & 1;
        if constexpr (MODE == MODE_SB) { if (i > 0) { const int f = dflag[(lane & 7) * 64 + ((i - 1) & 1)]; if (__all(f != 0)) break; } }
        if (i + 1 < NT) SLOAD(TJ(i + 1) * 64, buf ^ 1);
        SBAR();
        bool act = (MODE == MODE_SB) ? (kb <= qlo + 30 && !wdone) : (kb <= qlo + 31);
        if constexpr (MODE == MODE_MOBA) { const int n = tj >> 2; if (n != qb) act = act && __any((int)((sel >> n) & 1u)); }
        if (act) {
            f32x16 p0, p1; bf16x8 pa0, pa1, pa2, pa3;
            qkt(p0, p1, K_lds + buf * SHM, r32, hi, qr);
            const int dq = qpos - kb - 4 * hi;
            if constexpr (MODE == MODE_DIL || MODE == MODE_MOBA) {
                if constexpr (MODE == MODE_DIL) {
                  const int dlo = qlo - kb - 63, dhi2 = qlo + 31 - kb;
                  if (dlo > 512) {
#pragma unroll
                    for (int r = 0; r < 16; ++r) { const float t = (lgm[r] > 0.f) ? 0.f : -__builtin_inff(); p0[r] += t; p1[r] += t; }
                  } else if (dlo > 128 && dhi2 <= 512) {
#pragma unroll
                    for (int r = 0; r < 16; ++r) { p0[r] += lgm[r]; p1[r] += lgm[r]; }
                  } else {
#pragma unroll
                    for (int r = 0; r < 16; ++r) { const int c = (r & 3) + 8 * (r >> 2);
                        { const unsigned ud = (unsigned)(dq - c); const int cnt = (int)(ud <= 128u) + (int)(((ud & 3u) == 0u) & (ud <= 512u)) + (int)((ud & 0x8000000Fu) == 0u);
                          p0[r] += __builtin_amdgcn_logf((float)cnt) * (1.0f / C2); }
                        { const unsigned ud = (unsigned)(dq - c - 32); const int cnt = (int)(ud <= 128u) + (int)(((ud & 3u) == 0u) & (ud <= 512u)) + (int)((ud & 0x8000000Fu) == 0u);
                          p1[r] += __builtin_amdgcn_logf((float)cnt) * (1.0f / C2); } }
                  }
                } else {
                    const int n = tj >> 2;
                    if (n == qb) { if (kb + 63 > qlo) mask_tile(p0, p1, dq); }
                    else if (!((sel >> n) & 1u)) {
#pragma unroll
                        for (int r = 0; r < 16; ++r) { p0[r] = -__builtin_inff(); p1[r] = -__builtin_inff(); } }
                }
                float mn, alpha;
                partialSM(p0, p1, m_reg, mn, alpha);
                float ps = 0.f;
#pragma unroll
                for (int r = 0; r < 16; ++r) ps += p0[r];
#pragma unroll
                for (int r = 0; r < 16; ++r) ps += p1[r];
                ps = pair_sum(ps);
                l_reg = l_reg * alpha + ps;
                pack_p(p0, p1, pa0, pa1, pa2, pa3);
                if (__any(alpha < 1.f)) { if (hi == 0) al_l[r32] = alpha; LDS_WAIT();
#pragma unroll
                    for (int d_ = 0; d_ < 4; ++d_)
#pragma unroll
                        for (int r = 0; r < 16; ++r) o[d_][r] *= al_l[crow(r, hi)]; }
            } else if constexpr (MODE == MODE_ML) {
                float dsum = 0.f;
#pragma unroll
                for (int r4 = 0; r4 < 4; ++r4) {
                    const f32x4 a0 = *(const LAS f32x4*)(aux + kb + 8 * r4 + 4 * hi), a1 = *(const LAS f32x4*)(aux + kb + 32 + 8 * r4 + 4 * hi);
#pragma unroll
                    for (int j = 0; j < 4; ++j) { const int r = 4 * r4 + j, c = 8 * r4 + j;
                        float s0 = p0[r] * SCALE * __builtin_amdgcn_exp2f(a0[j] - M2row); s0 = (dq - c < 0) ? 0.f : s0;
                        float s1 = p1[r] * SCALE * __builtin_amdgcn_exp2f(a1[j] - M2row); s1 = (dq - c - 32 < 0) ? 0.f : s1;
                        p0[r] = s0; p1[r] = s1; dsum += s0 + s1; } }
                den += dsum;
                pack_p(p0, p1, pa0, pa1, pa2, pa3);
            } else {
                f32x16 z0, z1; float gs[8];
#pragma unroll
                for (int r = 0; r < 16; ++r) { const int c = (r & 3) + 8 * (r >> 2);
                    { const float z2 = p0[r] * C2; const float sp = fmaxf(z2, 0.f) + __builtin_amdgcn_logf(1.0f + __builtin_amdgcn_exp2f(-fabsf(z2)));
                      z0[r] = z2; const float spm = ((dq - 1 - c) >= 0) ? sp : 0.f; p0[r] = spm; if ((r & 3) == 0) gs[r >> 2] = spm; else gs[r >> 2] += spm; }
                    { const float z2 = p1[r] * C2; const float sp = fmaxf(z2, 0.f) + __builtin_amdgcn_logf(1.0f + __builtin_amdgcn_exp2f(-fabsf(z2)));
                      z1[r] = z2; const float spm = ((dq - 1 - c - 32) >= 0) ? sp : 0.f; p1[r] = spm; if ((r & 3) == 0) gs[4 + (r >> 2)] = spm; else gs[4 + (r >> 2)] += spm; } }
                float aft[8]; float run = 0.f;
#pragma unroll
                for (int i2 = 7; i2 >= 0; --i2) { const float pg = __shfl_xor(gs[i2], 32); aft[i2] = run + (hi == 0 ? pg : 0.f); run += gs[i2] + pg; }
#pragma unroll
                for (int i2 = 0; i2 < 8; ++i2) { float suf = Rsum + aft[i2];
#pragma unroll
                    for (int j = 3; j >= 0; --j) { const int r = 4 * (i2 & 3) + j, c = 8 * (i2 & 3) + j + ((i2 >> 2) ? 32 : 0);
                        const bool ok = (dq - 1 - c) >= 0;
                        if (i2 >> 2) { suf += p1[r]; p1[r] = ok ? __builtin_amdgcn_exp2f(z1[r] - suf) : 0.f; }
                        else { suf += p0[r]; p0[r] = ok ? __builtin_amdgcn_exp2f(z0[r] - suf) : 0.f; } } }
                Rsum += run;
                pack_p(p0, p1, pa0, pa1, pa2, pa3);
            }
            SBAR();
            pv_tile(o, vb0 + buf * SHM, pa0, pa1, pa2, pa3);
        }
        SBAR();
        if constexpr (MODE == MODE_SB) { if (!wdone) wdone = __all(Rsum - zbnd > 64.f) != 0; if (lane == 0) dflag[wid * 64 + (i & 1)] = wdone ? 1 : 0; }
        VM_WAIT(); LDS_WAIT(); WG_BAR();
    }
    if constexpr (MODE == MODE_DIL || MODE == MODE_MOBA) { if (hi == 0) li_l[r32] = l_reg; }
    if constexpr (MODE == MODE_ML) { const float dt = pair_sum(den); if (hi == 0) li_l[r32] = fmaxf(fabsf(dt), nmrow); }
    LDS_WAIT();
    bf16* Ow = Op + (size_t)qlo * ldo;
#pragma unroll
    for (int r = 0; r < 16; ++r) { const int orow = crow(r, hi);
        float rl = 1.f; if constexpr (MODE != MODE_SB) rl = __builtin_amdgcn_rcpf(li_l[orow]);
#pragma unroll
        for (int d0 = 0; d0 < 4; ++d0) { const float v = o[d0][r] * rl; const float vn = __shfl_xor(v, 1);
            if ((r32 & 1) == 0) *(unsigned*)(Ow + (size_t)orow * ldo + d0 * 32 + r32) = cvtpk(v, vn); } }
    LDS_WAIT();
#undef TJ
#undef SLOAD
}
}


struct Frame {
    LAS unsigned char* lds; int tid, lane, wave, vcu, G, gw, NGW;
};

template <bool FOLD>
__device__ __forceinline__ void tr_item(const float* __restrict__ W, int K, int N, bf16* __restrict__ WT, int item, int nblk, LAS unsigned* scr, int lane, int rmode, const float* lg, const float* lb, float* cs, float* bs) {
    const int kb = item / nblk, nb = item - kb * nblk, k0 = kb * 64, n0 = nb * 64;
    const int nq = lane & 15, kr = lane >> 4;
    const bool inb = (n0 + 4 * nq) < N;
    f32x4 a[8], b[8];
#pragma unroll
    for (int s = 0; s < 8; ++s) { const int kp = 4 * s + kr; const float* p = W + (size_t)(k0 + 2 * kp) * N + (inb ? n0 + 4 * nq : 0);
        a[s] = *(const f32x4*)p; b[s] = *(const f32x4*)(p + N); }
    if (!inb) {
#pragma unroll
        for (int s = 0; s < 8; ++s) { a[s] = (f32x4){0.f, 0.f, 0.f, 0.f}; b[s] = (f32x4){0.f, 0.f, 0.f, 0.f}; } }
    f32x4 csum = {0.f, 0.f, 0.f, 0.f}, bsum = {0.f, 0.f, 0.f, 0.f};
    if constexpr (FOLD) {
#pragma unroll
        for (int s = 0; s < 8; ++s) { const int k = k0 + 2 * (4 * s + kr); const f32x2 g2 = *(const f32x2*)(lg + k), b2 = *(const f32x2*)(lb + k);
            bsum += a[s] * b2[0] + b[s] * b2[1]; a[s] = a[s] * g2[0]; b[s] = b[s] * g2[1]; }
    }
#pragma unroll
    for (int s = 0; s < 8; ++s) { const int kp = 4 * s + kr;
#pragma unroll
        for (int i = 0; i < 4; ++i) { const unsigned pk = cvtpk(a[s][i], b[s][i]); scr[(4 * nq + i) * 33 + kp] = pk; if constexpr (FOLD) csum[i] += bf_lo(pk) + bf_hi(pk); } }
    LDS_WAIT();
#pragma unroll
    for (int jj = 0; jj < 8; ++jj) { const int n = (lane >> 3) + 8 * jj, c = lane & 7; const LAS unsigned* s = scr + n * 33 + 4 * c;
        u32x4 o; o.x = s[0]; o.y = s[1]; o.z = s[2]; o.w = s[3];
        const int nn = n0 + n, drow = rmode ? (((nn >> 7) << 8) + (nn & 127) + (rmode == 2 ? 128 : 0)) : nn;
        *(u32x4*)(WT + (size_t)drow * K + k0 + 8 * c) = o; }
    LDS_WAIT();
    if constexpr (FOLD) {
#pragma unroll
        for (int i = 0; i < 4; ++i) { csum[i] += __shfl_xor(csum[i], 16); csum[i] += __shfl_xor(csum[i], 32); bsum[i] += __shfl_xor(bsum[i], 16); bsum[i] += __shfl_xor(bsum[i], 32); }
        LAS float* fs = (LAS float*)scr;
        if (kr == 0) { *(LAS f32x4*)(fs + 4 * nq) = csum; *(LAS f32x4*)(fs + 64 + 4 * nq) = bsum; }
        LDS_WAIT();
        const int nn = n0 + lane, drow = rmode ? (((nn >> 7) << 8) + (nn & 127) + (rmode == 2 ? 128 : 0)) : nn;
        if (nn < N) { unsafeAtomicAdd(cs + drow, fs[lane]); unsafeAtomicAdd(bs + drow, fs[64 + lane]); }
        LDS_WAIT();
    }
}

__device__ __forceinline__ void prologue(const Frame& F_, const Args& a) {
    Frame F = F_; asm volatile("" : "+v"(F.lane), "+v"(F.tid), "+s"(F.gw), "+s"(F.vcu), "+s"(F.wave));
    unsigned char* ws = a.ws;
    LAS unsigned* scr = (LAS unsigned*)(F.lds + F.wave * 8448);
    constexpr int I_INAB = 64 * 192, I_OUT = 64 * 64, I_INCD = 64 * 196, I_UP = 64 * 172, I_DN = 172 * 64;
    constexpr int TOTAL = I_INAB + I_OUT + I_INCD + I_OUT + 4 * I_UP + 2 * I_DN;
    for (int it = F.gw; it < TOTAL; it += F.NGW) {
        int r = it; const float* W; int K, N, nblk; bf16* WT; int rmode = 0; const float* lg = nullptr; const float* lb = nullptr; float* cs = nullptr; float* bs = nullptr;
        unsigned char* ctl = ws + WS_CTL;
        if (r < I_INAB) { W = a.in[1]; K = DM; N = N_AB; nblk = 192; WT = (bf16*)(ws + WS_W_INAB); }
        else if ((r -= I_INAB) < I_OUT) { W = a.in[2]; K = DM; N = DM; nblk = 64; WT = (bf16*)(ws + WS_W_OUTAB); }
        else if ((r -= I_OUT) < I_INCD) { W = a.in[3]; K = DM; N = N_CD; nblk = 196; WT = (bf16*)(ws + WS_W_INCD); lg = a.in[14] + DM; lb = a.in[15] + DM; cs = (float*)(ctl + CTL_CS_INCD); bs = (float*)(ctl + CTL_BS_INCD); }
        else if ((r -= I_INCD) < I_OUT) { W = a.in[8]; K = DM; N = DM; nblk = 64; WT = (bf16*)(ws + WS_W_OUTCD); }
        else if ((r -= I_OUT) < I_UP) { W = a.in[9]; K = DM; N = DFF; nblk = 172; WT = (bf16*)(ws + WS_W_UG0); rmode = 1; lg = a.in[14]; lb = a.in[15]; cs = (float*)(ctl + CTL_CS_UG0); bs = (float*)(ctl + CTL_BS_UG0); }
        else if ((r -= I_UP) < I_UP) { W = a.in[10]; K = DM; N = DFF; nblk = 172; WT = (bf16*)(ws + WS_W_UG0); rmode = 2; lg = a.in[14]; lb = a.in[15]; cs = (float*)(ctl + CTL_CS_UG0); bs = (float*)(ctl + CTL_BS_UG0); }
        else if ((r -= I_UP) < I_DN) { W = a.in[13]; K = DFF; N = DM; nblk = 64; WT = (bf16*)(ws + WS_W_DN0); }
        else if ((r -= I_DN) < I_UP) { W = a.in[9] + (size_t)DM * DFF; K = DM; N = DFF; nblk = 172; WT = (bf16*)(ws + WS_W_UG1); rmode = 1; lg = a.in[14] + 2 * DM; lb = a.in[15] + 2 * DM; cs = (float*)(ctl + CTL_CS_UG1); bs = (float*)(ctl + CTL_BS_UG1); }
        else if ((r -= I_UP) < I_UP) { W = a.in[10] + (size_t)DM * DFF; K = DM; N = DFF; nblk = 172; WT = (bf16*)(ws + WS_W_UG1); rmode = 2; lg = a.in[14] + 2 * DM; lb = a.in[15] + 2 * DM; cs = (float*)(ctl + CTL_CS_UG1); bs = (float*)(ctl + CTL_BS_UG1); }
        else { r -= I_UP; W = a.in[13] + (size_t)DFF * DM; K = DFF; N = DM; nblk = 64; WT = (bf16*)(ws + WS_W_DN1); }
        if (lg) tr_item<true>(W, K, N, WT, r, nblk, scr, F.lane, rmode, lg, lb, cs, bs); else tr_item<false>(W, K, N, WT, r, nblk, scr, F.lane, rmode, lg, lb, cs, bs);
    }
    const f32x4* x4 = (const f32x4*)a.in[0]; u32x2* xb = (u32x2*)(ws + WS_XB);
    for (size_t i = (size_t)F.gw * 64 + F.lane; i < (size_t)M * DM / 4; i += (size_t)F.NGW * 64) { const f32x4 v = x4[i]; u32x2 o; o.x = cvtpk(v[0], v[1]); o.y = cvtpk(v[2], v[3]); xb[i] = o; }
}

__device__ __forceinline__ void ln_phase(const Frame& F_, const float* z, float* xo, bf16* xb, const float* g, const float* b) {
    Frame F = F_; asm volatile("" : "+v"(F.lane), "+v"(F.tid), "+s"(F.gw), "+s"(F.vcu), "+s"(F.wave));
    for (int m = F.gw; m < M; m += F.NGW) {
        const f32x4* zr = (const f32x4*)(z + (size_t)m * DM) + F.lane;
        f32x4 v[16]; float s = 0.f;
#pragma unroll
        for (int j = 0; j < 16; ++j) { v[j] = zr[64 * j]; s += (v[j][0] + v[j][1]) + (v[j][2] + v[j][3]); }
        const float mean = wave_sum(s) * (1.f / DM); float s2 = 0.f;
#pragma unroll
        for (int j = 0; j < 16; ++j) { v[j] = v[j] - mean; s2 += (v[j][0] * v[j][0] + v[j][1] * v[j][1]) + (v[j][2] * v[j][2] + v[j][3] * v[j][3]); }
        const float rstd = 1.f / sqrtf(wave_sum(s2) * (1.f / DM) + LN_EPS);
        f32x4* xr = (f32x4*)(xo + (size_t)m * DM) + F.lane; u32x2* br = (u32x2*)((xb ? xb : (bf16*)xo) + (size_t)m * DM) + F.lane;
        const f32x4* g4 = (const f32x4*)g + F.lane; const f32x4* b4 = (const f32x4*)b + F.lane;
#pragma unroll
        for (int j = 0; j < 16; ++j) { f32x4 o = v[j] * rstd * g4[64 * j] + b4[64 * j]; xr[64 * j] = o;
            if (xb) { u32x2 w; w.x = cvtpk(o[0], o[1]); w.y = cvtpk(o[2], o[3]); br[64 * j] = w; } }
    }
}

__device__ __forceinline__ void ffn_fix_phase(const Frame& F_, bf16* H, const float* EG0, const float* EU0, const float* EGL, const float* cw, const float* cb) {
    Frame F = F_; asm volatile("" : "+v"(F.lane), "+v"(F.tid), "+s"(F.gw), "+s"(F.vcu), "+s"(F.wave));
    constexpr int C4 = DFF / 4;
    for (int idx = F.gw * 64 + F.lane; idx < 64 * C4; idx += F.NGW * 64) {
        const int pm = idx / C4, ch = (idx - pm * C4) * 4;
        f32x4 gl0 = {0.f, 0.f, 0.f, 0.f}, gl1 = gl0;
        if ((pm & 7) != 0) { gl0 = *(const f32x4*)(EGL + (size_t)((pm - 1) * 2) * DFF + ch); gl1 = *(const f32x4*)(EGL + (size_t)((pm - 1) * 2 + 1) * DFF + ch); }
        const f32x4 g0 = *(const f32x4*)(EG0 + (size_t)(pm * 2) * DFF + ch), g1 = *(const f32x4*)(EG0 + (size_t)(pm * 2 + 1) * DFF + ch);
        const f32x4 u0 = *(const f32x4*)(EU0 + (size_t)(pm * 2) * DFF + ch), u1 = *(const f32x4*)(EU0 + (size_t)(pm * 2 + 1) * DFF + ch);
        const f32x4 w0 = *(const f32x4*)(cw + ch), w1 = *(const f32x4*)(cw + DFF + ch), w2 = *(const f32x4*)(cw + 2 * DFF + ch), bb = *(const f32x4*)(cb + ch);
        const f32x4 y0 = w0 * gl0 + w1 * gl1 + w2 * g0 + bb, y1 = w0 * gl1 + w1 * g0 + w2 * g1 + bb;
        u32x2 o0, o1;
        o0.x = cvtpk(silu_f(y0[0]) * u0[0], silu_f(y0[1]) * u0[1]); o0.y = cvtpk(silu_f(y0[2]) * u0[2], silu_f(y0[3]) * u0[3]);
        o1.x = cvtpk(silu_f(y1[0]) * u1[0], silu_f(y1[1]) * u1[1]); o1.y = cvtpk(silu_f(y1[2]) * u1[2], silu_f(y1[3]) * u1[3]);
        *(u32x2*)(H + (size_t)(pm * 256) * DFF + ch) = o0; *(u32x2*)(H + (size_t)(pm * 256 + 1) * DFF + ch) = o1;
    }
}

__device__ __forceinline__ void kmean_phase(const Frame& F_, const bf16* QKV, float* kmean) {
    Frame F = F_; asm volatile("" : "+v"(F.lane), "+v"(F.tid), "+s"(F.gw), "+s"(F.vcu), "+s"(F.wave));
    LAS float* red = (LAS float*)F.lds;
    for (int it = F.vcu; it < 256; it += F.G) {
        const int b = it >> 5, n = (it >> 2) & 7, cbk = it & 3;
        const bf16* src = QKV + (size_t)(b * SEQ + n * 256 + F.wave * 32) * N_AB + 8192 + cbk * 512 + F.lane * 8;
        float acc[8];
#pragma unroll
        for (int j = 0; j < 8; ++j) acc[j] = 0.f;
        for (int r8 = 0; r8 < 32; r8 += 8) { u32x4 v[8];
#pragma unroll
            for (int r = 0; r < 8; ++r) v[r] = *(const u32x4*)(src + (size_t)(r8 + r) * N_AB);
#pragma unroll
            for (int r = 0; r < 8; ++r)
#pragma unroll
                for (int q = 0; q < 4; ++q) { acc[2 * q] += bf_lo(v[r][q]); acc[2 * q + 1] += bf_hi(v[r][q]); } }
#pragma unroll
        for (int j = 0; j < 8; ++j) red[F.wave * 512 + F.lane * 8 + j] = acc[j];
        LDS_WAIT(); WG_BAR();
        float s = 0.f;
#pragma unroll
        for (int w = 0; w < 8; ++w) s += red[w * 512 + F.tid];
        const int col = cbk * 512 + F.tid, h = col >> 7, d = col & 127;
        kmean[((size_t)(b * 16 + h) * 8 + n) * 128 + d] = s * (1.f / 256.f);
        LDS_WAIT(); WG_BAR();
    }
}

__device__ __forceinline__ void cd_pre_phase(const Frame& F_, const bf16* QKV, bf16* QKDC, const float* cw  , const float* cb, const float* gates, const float* bif, float* A2, float* M2, float* NM, unsigned* kn2) {
    Frame F = F_; asm volatile("" : "+v"(F.lane), "+v"(F.tid), "+s"(F.gw), "+s"(F.vcu), "+s"(F.wave));
    for (int it = F.gw; it < (M / 32) * 4; it += F.NGW) {
        const int rb = it >> 2, cbk = it & 3, c0 = cbk * 512 + F.lane * 8, r0 = rb * 32;
        float w[4][8], bb[8];
#pragma unroll
        for (int q = 0; q < 2; ++q) { const f32x4 t3 = *(const f32x4*)(cb + c0 + 4 * q);
#pragma unroll
            for (int j = 0; j < 4; ++j) bb[4 * q + j] = t3[j];
#pragma unroll
            for (int k = 0; k < 4; ++k) { const f32x4 t = *(const f32x4*)(cw + k * 2048 + c0 + 4 * q);
#pragma unroll
                for (int j = 0; j < 4; ++j) w[k][4 * q + j] = t[j]; } }
        const bf16* src = QKV + 6144 + c0;
        u32x4 x3 = {0u, 0u, 0u, 0u}, x2 = x3, x1 = x3;
        if ((r0 & (SEQ - 1)) != 0) { x3 = *(const u32x4*)(src + (size_t)(r0 - 3) * N_AB); x2 = *(const u32x4*)(src + (size_t)(r0 - 2) * N_AB); x1 = *(const u32x4*)(src + (size_t)(r0 - 1) * N_AB); }
        for (int t8 = 0; t8 < 32; t8 += 8) {
            u32x4 xv[8];
#pragma unroll
            for (int t = 0; t < 8; ++t) xv[t] = *(const u32x4*)(src + (size_t)(r0 + t8 + t) * N_AB);
#pragma unroll
            for (int t = 0; t < 8; ++t) { u32x4 ov;
#pragma unroll
                for (int q = 0; q < 4; ++q) {
                    const float y0 = w[0][2 * q] * bf_lo(x3[q]) + w[1][2 * q] * bf_lo(x2[q]) + w[2][2 * q] * bf_lo(x1[q]) + w[3][2 * q] * bf_lo(xv[t][q]) + bb[2 * q];
                    const float y1 = w[0][2 * q + 1] * bf_hi(x3[q]) + w[1][2 * q + 1] * bf_hi(x2[q]) + w[2][2 * q + 1] * bf_hi(x1[q]) + w[3][2 * q + 1] * bf_hi(xv[t][q]) + bb[2 * q + 1];
                    ov[q] = cvtpk(silu_f(y0), silu_f(y1)); }
                *(u32x4*)(QKDC + (size_t)(r0 + t8 + t) * 2048 + c0) = ov; x3 = x2; x2 = x1; x1 = xv[t]; }
        }
    }
    for (int it = F.gw; it < (M / 64) * 16; it += F.NGW) {
        const int rb = it >> 4, h = it & 15, row = rb * 64 + F.lane;
        const u32x4* kp = (const u32x4*)(QKV + (size_t)row * N_AB + 2048 + h * 128); float s = 0.f;
#pragma unroll
        for (int j = 0; j < 16; ++j) { const u32x4 v = kp[j];
            s = fmaf(bf_lo(v.x), bf_lo(v.x), s); s = fmaf(bf_hi(v.x), bf_hi(v.x), s); s = fmaf(bf_lo(v.y), bf_lo(v.y), s); s = fmaf(bf_hi(v.y), bf_hi(v.y), s);
            s = fmaf(bf_lo(v.z), bf_lo(v.z), s); s = fmaf(bf_hi(v.z), bf_hi(v.z), s); s = fmaf(bf_lo(v.w), bf_lo(v.w), s); s = fmaf(bf_hi(v.w), bf_hi(v.w), s); }
#pragma unroll
        for (int o = 1; o < 64; o <<= 1) s = fmaxf(s, __shfl_xor(s, o));
        if (F.lane == 0) atomicMax(kn2 + (row >> 11) * 16 + h, __float_as_uint(s));
    }
    for (int sq = F.gw; sq < 64; sq += F.NGW) {
        const int b = sq >> 3, h = sq & 7; const float bi = bif[h], bfv = bif[8 + h];
        const float* gp = gates + (size_t)(b * SEQ + F.lane * 32) * 16;
        float lf[32], ai[32]; float run = 0.f;
#pragma unroll
        for (int t = 0; t < 32; ++t) { const float f = gp[t * 16 + 8 + h] + bfv; ai[t] = gp[t * 16 + h] + bi;
            const float ls = fminf(f, 0.f) - log1pf(expf(-fabsf(f)));
            run += ls; lf[t] = run; }
        float incl = run;
#pragma unroll
        for (int o = 1; o < 64; o <<= 1) { const float t = __shfl_up(incl, o); if (F.lane >= o) incl += t; }
        const float base = incl - run; float mx = -__builtin_inff();
#pragma unroll
        for (int t = 0; t < 32; ++t) { lf[t] += base; ai[t] -= lf[t]; mx = fmaxf(mx, ai[t]); }
        float minc = mx;
#pragma unroll
        for (int o = 1; o < 64; o <<= 1) { const float t = __shfl_up(minc, o); if (F.lane >= o) minc = fmaxf(minc, t); }
        float mprev = __shfl_up(minc, 1); if (F.lane == 0) mprev = -__builtin_inff();
        float cm = fmaxf(mprev, 0.f);
        float* a2o = A2 + (size_t)sq * SEQ + F.lane * 32; float* m2o = M2 + (size_t)sq * SEQ + F.lane * 32; float* nmo = NM + (size_t)sq * SEQ + F.lane * 32;
#pragma unroll
        for (int t = 0; t < 32; ++t) { cm = fmaxf(cm, ai[t]); a2o[t] = ai[t] * 1.4426950408889634f; m2o[t] = cm * 1.4426950408889634f; nmo[t] = expf(-lf[t] - cm); }
    }
}

__device__ __forceinline__ void cd_post_phase(const Frame& F_, const bf16* HD, const bf16* QKV, bf16* Y, const float* ng) {
    Frame F = F_; asm volatile("" : "+v"(F.lane), "+v"(F.tid), "+s"(F.gw), "+s"(F.vcu), "+s"(F.wave));
    for (int m = F.gw; m < M; m += F.NGW) {
        u32x2 hv[8], ov[8]; f32x4 g[8];
#pragma unroll
        for (int h = 0; h < 8; ++h) { const int c = h * 256 + F.lane * 4; hv[h] = *(const u32x2*)(HD + (size_t)m * 2048 + c); ov[h] = *(const u32x2*)(QKV + (size_t)m * N_AB + 10240 + c); g[h] = *(const f32x4*)(ng + c); }
        float v[8][4], s1[8], s2[8];
#pragma unroll
        for (int h = 0; h < 8; ++h) { v[h][0] = bf_lo(hv[h].x); v[h][1] = bf_hi(hv[h].x); v[h][2] = bf_lo(hv[h].y); v[h][3] = bf_hi(hv[h].y); s1[h] = (v[h][0] + v[h][1]) + (v[h][2] + v[h][3]); }
#pragma unroll
        for (int o = 1; o < 64; o <<= 1)
#pragma unroll
            for (int h = 0; h < 8; ++h) s1[h] += __shfl_xor(s1[h], o);
#pragma unroll
        for (int h = 0; h < 8; ++h) { const float mean = s1[h] * (1.f / 256.f);
#pragma unroll
            for (int j = 0; j < 4; ++j) v[h][j] -= mean;
            s2[h] = (v[h][0] * v[h][0] + v[h][1] * v[h][1]) + (v[h][2] * v[h][2] + v[h][3] * v[h][3]); }
#pragma unroll
        for (int o = 1; o < 64; o <<= 1)
#pragma unroll
            for (int h = 0; h < 8; ++h) s2[h] += __shfl_xor(s2[h], o);
#pragma unroll
        for (int h = 0; h < 8; ++h) { const float rstd = 1.f / sqrtf(s2[h] * (1.f / 256.f) + LN_EPS);
            const float o0 = bf_lo(ov[h].x), o1 = bf_hi(ov[h].x), o2 = bf_lo(ov[h].y), o3 = bf_hi(ov[h].y);
            const float y0 = v[h][0] * rstd * g[h][0] * __builtin_amdgcn_rcpf(1.f + __builtin_amdgcn_exp2f(-1.4426950408889634f * o0));
            const float y1 = v[h][1] * rstd * g[h][1] * __builtin_amdgcn_rcpf(1.f + __builtin_amdgcn_exp2f(-1.4426950408889634f * o1));
            const float y2 = v[h][2] * rstd * g[h][2] * __builtin_amdgcn_rcpf(1.f + __builtin_amdgcn_exp2f(-1.4426950408889634f * o2));
            const float y3 = v[h][3] * rstd * g[h][3] * __builtin_amdgcn_rcpf(1.f + __builtin_amdgcn_exp2f(-1.4426950408889634f * o3));
            u32x2 w; w.x = cvtpk(y0, y1); w.y = cvtpk(y2, y3);
            *(u32x2*)(Y + (size_t)m * DM + 2048 + h * 256 + F.lane * 4) = w; }
    }
}


__global__ void __launch_bounds__(NWAVES * 64, 2) mk_fwd(Args args) {
    extern __shared__ __attribute__((aligned(16))) unsigned char lds_raw[];
    Frame F;
    F.lds = (LAS unsigned char*)lds_raw;
    F.tid = threadIdx.x; F.lane = F.tid & 63; F.wave = __builtin_amdgcn_readfirstlane(F.tid >> 6);
    F.G = gridDim.x; { const int bx = blockIdx.x; F.vcu = (F.G % 8 == 0) ? (bx % 8) * (F.G / 8) + bx / 8 : bx; }
    F.gw = F.vcu * NWAVES + F.wave; F.NGW = F.G * NWAVES;
    unsigned char* ws = args.ws;
    volatile LAS unsigned* MISC = (volatile LAS unsigned*)(F.lds + MISC_OFF);
    for (int u = F.tid; u < (LDS_BYTES - RING_BYTES) / 4; u += NWAVES * 64) ((LAS unsigned*)(F.lds + RING_BYTES))[u] = 0u;
    __syncthreads();
    XcdBarrier bar = xcd_barrier_post((unsigned*)(ws + WS_CTL) + CW_BAR, MISC + 8);
#define GRID_BAR() xcd_barrier(bar)

    PH(1) prologue(F, args);
    GRID_BAR();

#define PHASE_BEGIN const int L = opq_i(layer); GAS unsigned char* const W = (GAS unsigned char*)opq_p(ws); (void)L; (void)W;
    for (int layer = 0; layer < 2; ++layer) {
        { PHASE_BEGIN
            pg8::Gemm g{(const bf16*)(W + WS_XB), (const bf16*)(W + (L == 0 ? WS_W_INAB : WS_W_INCD)), M, L == 0 ? N_AB : N_CDP, DM};
            pg8::StaticOrder S; S.init(g.M, g.N, F.G, (int)blockIdx.x);
            pg8::EpiBf16 E{(unsigned char*)W, L};
            PH(2) pg8::gemm_phase<pg8::EpiBf16, pg8::StaticOrder, true, true>(F.lds, g, S, E);
        }
        GRID_BAR();
        { PHASE_BEGIN
            if (L == 0) { PH(4) kmean_phase(F, (const bf16*)(W + WS_QKV), (float*)(W + WS_KMEAN)); }
            else PH(8) cd_pre_phase(F, (const bf16*)(W + WS_QKV), (bf16*)(W + WS_QKDC), (const float*)ldin(args, 5), (const float*)ldin(args, 6), (const float*)(W + WS_GATES), (const float*)ldin(args, 4), (float*)(W + WS_A2), (float*)(W + WS_M2), (float*)(W + WS_NM), (unsigned*)(W + WS_CTL + CTL_KN2));
        }
        GRID_BAR();
        { PHASE_BEGIN
            const bf16* QKV = (const bf16*)(W + WS_QKV); bf16* Y = (bf16*)(W + WS_Y);
            if (L == 0) {
                for (int it = F.vcu; it < 512; it += F.G) { const int bh = it >> 2, pr = it & 3, b = bh >> 4, h = bh & 15;
                    const bf16* base = QKV + (size_t)b * SEQ * N_AB + h * 128; bf16* ob = Y + (size_t)b * SEQ * DM + h * 128;
                    for (int ps = 0; ps < 2; ++ps) PH(16) att::attn_block<att::MODE_DIL>(base, N_AB, base + 2048, N_AB, base + 4096, N_AB, ob, DM, ps ? 7 - pr : pr, (LAS char*)F.lds, nullptr, nullptr, nullptr); }
                const float* KMEAN = (const float*)(W + WS_KMEAN);
                for (int it = F.vcu; it < 512; it += F.G) { const int bh = it >> 2, pr = it & 3, b = bh >> 4, h = bh & 15;
                    const bf16* base = QKV + (size_t)b * SEQ * N_AB + 6144 + h * 128; bf16* ob = Y + (size_t)b * SEQ * DM + 2048 + h * 128;
                    for (int ps = 0; ps < 2; ++ps) PH(32) att::attn_block<att::MODE_MOBA>(base, N_AB, base + 2048, N_AB, base + 4096, N_AB, ob, DM, ps ? 7 - pr : pr, (LAS char*)F.lds, KMEAN + (size_t)bh * 1024, nullptr, nullptr); }
            } else {
                for (int it = F.vcu; it < 512; it += F.G) { const int bh = it >> 2, pr = it & 3, b = bh >> 4, h = bh & 15;
                    const bf16* base = QKV + (size_t)b * SEQ * N_AB + h * 128; bf16* ob = Y + (size_t)b * SEQ * DM + h * 128;
                    for (int ps = 0; ps < 2; ++ps) PH(64) att::attn_block<att::MODE_SB>(base, N_AB, base + 2048, N_AB, base + 4096, N_AB, ob, DM, ps ? 7 - pr : pr, (LAS char*)F.lds, (const float*)(W + WS_CTL + CTL_KN2) + bh, nullptr, nullptr); }
                const bf16* QKDC = (const bf16*)(W + WS_QKDC); bf16* HD = (bf16*)(W + WS_HD); const float* A2 = (const float*)(W + WS_A2); const float* M2 = (const float*)(W + WS_M2); const float* NMv = (const float*)(W + WS_NM);
                for (int it = F.vcu; it < 512; it += F.G) { const int bv = it >> 2, pr = it & 3, b = bv >> 4, vh = bv & 15, h = vh >> 1, half = vh & 1;
                    const bf16* qd = QKDC + (size_t)b * SEQ * 2048 + h * 128; const bf16* vd = QKV + (size_t)b * SEQ * N_AB + 8192 + h * 256 + half * 128;
                    bf16* ob = HD + (size_t)b * SEQ * 2048 + h * 256 + half * 128; const size_t so = (size_t)(b * 8 + h) * SEQ;
                    for (int ps = 0; ps < 2; ++ps) PH(128) att::attn_block<att::MODE_ML>(qd, 2048, qd + 1024, 2048, vd, N_AB, ob, 2048, ps ? 7 - pr : pr, (LAS char*)F.lds, A2 + so, M2 + so, NMv + so); }
            }
        }
        if (layer == 1) { GRID_BAR(); PHASE_BEGIN PH(256) cd_post_phase(F, (const bf16*)(W + WS_HD), (const bf16*)(W + WS_QKV), (bf16*)(W + WS_Y), (const float*)ldin(args, 7)); }
        GRID_BAR();
        { PHASE_BEGIN
            pg8::Gemm g{(const bf16*)(W + WS_Y), (const bf16*)(W + (L == 0 ? WS_W_OUTAB : WS_W_OUTCD)), M, DM, DM};
            pg8::StaticOrder S; S.init(g.M, g.N, F.G, (int)blockIdx.x);
            pg8::EpiResid E{&args, (unsigned char*)W, L, 0, F.lds};
            PH(512) pg8::gemm_phase<pg8::EpiResid, pg8::StaticOrder, true, true>(F.lds, g, S, E);
        }
        GRID_BAR();
        { PHASE_BEGIN
            pg8::Gemm g{(const bf16*)(W + WS_XB), (const bf16*)(W + (L == 0 ? WS_W_UG0 : WS_W_UG1)), M, 2 * DFF, DM};
            pg8::StaticOrder S; S.init(g.M, g.N, F.G, (int)blockIdx.x);
            pg8::EpiFfnAct E{&args, (unsigned char*)W, L, F.lds};
            PH(2048) pg8::gemm_phase<pg8::EpiFfnAct, pg8::StaticOrder, true, true>(F.lds, g, S, E);
        }
        GRID_BAR();
        { PHASE_BEGIN PH(4096) ffn_fix_phase(F, (bf16*)(W + WS_U), (const float*)(W + WS_G), (const float*)(W + WS_G + 8 * MiB), (const float*)(W + WS_G + 16 * MiB), (const float*)ldin(args, 11) + (size_t)L * 3 * DFF, (const float*)ldin(args, 12) + (size_t)L * DFF); }
        GRID_BAR();
        { PHASE_BEGIN
            pg8::Gemm g{(const bf16*)(W + WS_U), (const bf16*)(W + (L == 0 ? WS_W_DN0 : WS_W_DN1)), M, DM, DFF};
            pg8::StaticOrder S; S.init(g.M, g.N, F.G, (int)blockIdx.x);
            pg8::EpiResid E{&args, (unsigned char*)W, L, 1, F.lds};
            PH(8192) pg8::gemm_phase<pg8::EpiResid, pg8::StaticOrder, true, true>(F.lds, g, S, E);
        }
        GRID_BAR();
        if (layer == 1) { PHASE_BEGIN
            PH(1024) ln_phase(F, args.out, args.out, nullptr, (const float*)ldin(args, 14) + (size_t)3 * DM, (const float*)ldin(args, 15) + (size_t)3 * DM); }
    }
#undef PHASE_BEGIN
}

extern "C" void kernel_launch(void* const* d_in, const int* in_sizes, int n_in, void* d_out, int out_size, void* d_ws, size_t ws_size, hipStream_t stream) {
    static int grid = 0;
    if (grid == 0) {
        if (n_in != 16 || in_sizes[0] != M * DM || out_size != M * DM || ws_size < WS_END) { fprintf(stderr, "kernel_launch: unexpected shapes (n_in %d, in0 %d, out %d, ws %zu < %zu)\n", n_in, n_in > 0 ? in_sizes[0] : -1, out_size, ws_size, (size_t)WS_END); grid = -1; return; }
        int dev = 0, cus = 0;
        if (hipGetDevice(&dev) != hipSuccess || hipDeviceGetAttribute(&cus, hipDeviceAttributeMultiprocessorCount, dev) != hipSuccess) { grid = -1; return; }
        if (hipFuncSetAttribute((const void*)mk_fwd, hipFuncAttributeMaxDynamicSharedMemorySize, LDS_BYTES) != hipSuccess) { fprintf(stderr, "kernel_launch: hipFuncSetAttribute failed\n"); grid = -1; return; }
        int per_cu = 0;
        if (hipOccupancyMaxActiveBlocksPerMultiprocessor(&per_cu, (const void*)mk_fwd, NWAVES * 64, LDS_BYTES) != hipSuccess || per_cu < 1) fprintf(stderr, "kernel_launch: occupancy query says %d\n", per_cu);
        (void)hipGetLastError();
        grid = cus;
    }
    if (grid < 0) return;
    if (hipMemsetAsync((char*)d_ws + WS_CTL, 0, CTL_ZERO_BYTES, stream) != hipSuccess) return;
    Args a{};
    for (int i = 0; i < 16; ++i) a.in[i] = (const float*)d_in[i];
    a.out = (float*)d_out; a.ws = (unsigned char*)d_ws;
    hipLaunchKernelGGL(mk_fwd, dim3(grid), dim3(NWAVES * 64), LDS_BYTES, stream, a);
}
```

```cpp
#include <hip/hip_runtime.h>
#include <cstdio>
#include <cstdint>

#define LAS __attribute__((address_space(3)))
#define GAS __attribute__((address_space(1)))
typedef unsigned short bf16;
typedef short bf16x8 __attribute__((ext_vector_type(8)));
typedef short s16x4 __attribute__((ext_vector_type(4)));
typedef float f32x16 __attribute__((ext_vector_type(16)));
typedef float f32x8 __attribute__((ext_vector_type(8)));
typedef float f32x4 __attribute__((ext_vector_type(4)));
typedef float f32x2 __attribute__((ext_vector_type(2)));
typedef unsigned u32x4 __attribute__((ext_vector_type(4)));
typedef unsigned u32x2 __attribute__((ext_vector_type(2)));

#ifndef PH_MASK
#define PH_MASK 0xFFFF
#endif
#define PH(x) if constexpr ((PH_MASK & (x)) != 0)

constexpr int BATCH = 8, SEQ = 2048, DM = 4096, M = BATCH * SEQ;
constexpr int DFF = 11008, N_AB = 12288, N_CD = 12304, N_CDP = 12544;
constexpr float ALPHA = 1.4142135623730951f;
constexpr float LN_EPS = 1e-5f;
constexpr int NWAVES = 8;

constexpr size_t MiB = 1u << 20;
constexpr size_t WS_CTL = 0, CTL_ZERO_BYTES = 1 * MiB;
constexpr size_t WS_KMEAN = 1 * MiB;
constexpr size_t WS_GATES = 2 * MiB;
constexpr size_t WS_A2 = 3 * MiB;
constexpr size_t WS_M2 = 3 * MiB + 512 * 1024;
constexpr size_t WS_NM = 4 * MiB;
constexpr size_t WS_W_INAB = 8 * MiB, WS_W_OUTAB = 104 * MiB, WS_W_UG0 = 136 * MiB, WS_W_DN0 = 308 * MiB;
constexpr size_t WS_W_INCD = 394 * MiB, WS_W_OUTCD = 492 * MiB, WS_W_UG1 = 524 * MiB, WS_W_DN1 = 696 * MiB;
constexpr size_t WS_XB = 782 * MiB;
constexpr size_t WS_R = 910 * MiB;
constexpr size_t WS_QKV = WS_R, WS_Y = WS_R + 384 * MiB, WS_QKDC = WS_R + 512 * MiB, WS_HD = WS_R + 576 * MiB;
constexpr size_t WS_U = WS_R, WS_G = WS_R + 344 * MiB;
constexpr size_t WS_END = WS_R + 688 * MiB;
static_assert((size_t)M * DFF * 2 == 344 * MiB, "u/g size");
constexpr int CW_BAR = 4096;
constexpr size_t CTL_KN2 = 32768;
constexpr size_t CTL_QUEUE = 45056;
constexpr size_t CTL_STATS = 65536;
constexpr size_t CTL_CS_UG0 = 524288, CTL_BS_UG0 = CTL_CS_UG0 + 88064, CTL_CS_INCD = CTL_BS_UG0 + 88064, CTL_BS_INCD = CTL_CS_INCD + 50176, CTL_CS_UG1 = CTL_BS_INCD + 50176, CTL_BS_UG1 = CTL_CS_UG1 + 88064;
static_assert(CTL_BS_UG1 + 88064 <= CTL_ZERO_BYTES && CTL_STATS + 3 * (size_t)M * 8 <= CTL_CS_UG0, "CTL map");

constexpr int RING_BYTES = 131072;
constexpr int CTRL_OFF = 143360;
constexpr int MISC_OFF = CTRL_OFF + 320;
constexpr int SIDE_OFF = CTRL_OFF + 1024 + 4096;
constexpr int SIDE_BYTES = 6144;
constexpr int SIDE_OFF_R = CTRL_OFF + 1024 + 8192;
constexpr int LDS_BYTES = 163840;

#define LDS_WAIT() asm volatile("s_waitcnt lgkmcnt(0)" ::: "memory")
#define VM_WAIT() asm volatile("s_waitcnt vmcnt(0)" ::: "memory")
#define SBAR() __builtin_amdgcn_sched_barrier(0)
#define WG_BAR() do { asm volatile("" ::: "memory"); __builtin_amdgcn_s_barrier(); asm volatile("" ::: "memory"); } while (0)

__device__ __forceinline__ unsigned cvtpk(float lo, float hi) { unsigned r; asm volatile("v_cvt_pk_bf16_f32 %0, %1, %2" : "=v"(r) : "v"(lo), "v"(hi)); return r; }
__device__ __forceinline__ float bf_lo(unsigned w) { return __uint_as_float(w << 16); }
__device__ __forceinline__ float bf_hi(unsigned w) { return __uint_as_float(w & 0xffff0000u); }
__device__ __forceinline__ float wave_sum(float v) {
#pragma unroll
    for (int o = 1; o < 64; o <<= 1) v += __shfl_xor(v, o);
    return v;
}
__device__ __forceinline__ float silu_f(float y) { return y * __builtin_amdgcn_rcpf(1.0f + __builtin_amdgcn_exp2f(-1.4426950408889634f * y)); }

struct Args { const float* in[16]; float* out; unsigned char* ws; };
static_assert(sizeof(Args) == 18 * 8, "Args has no padding");
__device__ __forceinline__ const GAS float* ldin(const Args& a, int i) { asm volatile("" : "+s"(i)); return (const GAS float*)a.in[i]; }
__device__ __forceinline__ int opq_i(int v) { asm volatile("" : "+s"(v)); return v; }
__device__ __forceinline__ unsigned char* opq_p(unsigned char* p) { asm volatile("" : "+s"(p)); return p; }

__device__ __forceinline__ int tid_of(int wave) { int l; asm volatile("v_mbcnt_lo_u32_b32 %0, -1, 0\n\tv_mbcnt_hi_u32_b32 %0, -1, %0" : "=v"(l)); return (wave << 6) | l; }
namespace pg8 {
typedef unsigned short bf16_t;
constexpr int BM = 256, BK = 64, HALF = 128, HTB = HALF * BK * 2, STAGE_BYTES = 8 * HTB, NXCD = 8, WGM = 8;
__host__ __device__ __forceinline__ int lds_byte(int r, int c) { const int st = (r >> 4) * 2 + (c >> 5), rr = r & 15, cc = c & 31, ob = rr * 64 + cc * 2; return st * 1024 + (ob ^ (((ob >> 9) & 1) << 5)); }
__host__ __device__ __forceinline__ void stage_rc(int b, int& R, int& C) { const int st = b / 1024, sb = b % 1024, swz = sb ^ (((sb >> 9) & 1) << 5); R = (st >> 1) * 16 + swz / 64; C = (st & 1) * 32 + (swz % 64) / 2; }
__host__ __device__ __forceinline__ int perm32(int rho) { const int n = rho >> 4, i = rho & 15; return 8 * (i >> 2) + 4 * n + (i & 3); }
struct Unit { int pm, pn, par; };
struct Gemm { const bf16_t* A; const bf16_t* Bt; int M, N, K; };
struct StaticOrder {
    int nM, nN, nwg, G, c, wgm;
    __host__ __device__ void init(int M_, int N_, int G_, int c_, int wgm_ = WGM) { nM = M_ / BM; nN = N_ / BM; nwg = nM * nN; G = G_; c = c_; wgm = wgm_; }
    __host__ __device__ bool next(int i, Unit& u) const {
        const long L = (long)i * G + c; if (L >= nwg) return false;
        int wgid = (int)L; { const int q = nwg / NXCD, r = nwg % NXCD, xcd = wgid % NXCD, off = wgid / NXCD; wgid = (xcd < r ? xcd * (q + 1) : r * (q + 1) + (xcd - r) * q) + off; }
        const int nig = wgm * nN, gid = wgid / nig, fm = gid * wgm, gsz = (nM - fm) < wgm ? (nM - fm) : wgm;
        u.pm = fm + ((wgid % nig) % gsz); u.pn = (wgid % nig) / gsz; return true;
    }
    __device__ __forceinline__ void a_ready(const Unit&) const {}
    __device__ __forceinline__ void done(const Unit&) const {}
};
struct EpiBf16 {
    static constexpr bool PERM = true, AFTER_DRAIN = false;
    unsigned char* W; int L, wave; LAS unsigned char* lds;
    __device__ __forceinline__ void prefetch(const Unit& u) const {
        if (L == 0) return;
        int tid_ = tid_of(wave); asm volatile("" : "+v"(tid_));
        const int wid = __builtin_amdgcn_readfirstlane(tid_ >> 6), lane = tid_ & 63;
        if (wid >= 4) return;
        GAS unsigned char* const Wg = (GAS unsigned char*)W;
        const GAS float* src;
        if (wid < 2) src = (const GAS float*)(Wg + WS_CTL + CTL_STATS) + (size_t)1 * M * 2 + (size_t)(u.pm * BM + wid * 128) * 2 + lane * 4;
        else src = (const GAS float*)(Wg + WS_CTL + (wid == 2 ? CTL_CS_INCD : CTL_BS_INCD)) + u.pn * BM + lane * 4;
        __builtin_amdgcn_global_load_lds((const unsigned*)src, (LAS unsigned*)(lds + SIDE_OFF + u.par * SIDE_BYTES + wid * 1024), 16, 0, 0);
    }
    __device__ __forceinline__ void operator()(const f32x4 (&acc)[2][2][4][2], const Unit& u, int wr_, int wc_, int fr_, int fq_) const {
        int tid_ = tid_of(wave); asm volatile("" : "+v"(tid_));
        GAS unsigned char* const Wg = (GAS unsigned char*)W;
        GAS bf16_t* const O = (GAS bf16_t*)(Wg + WS_QKV); constexpr int ldc = N_AB; GAS float* const gates = (GAS float*)(Wg + WS_GATES); const int gate_pn = L == 0 ? -1 : 48;
        const bool st = L != 0;
        const int wid = __builtin_amdgcn_readfirstlane(tid_ >> 6), wr = wid >> 2, wc = wid & 3, fr = tid_ & 15, fq = (tid_ & 63) >> 4;
        const int row0 = u.pm * BM + wr * 64 + fr;
        const LAS float* const side = (const LAS float*)(lds + SIDE_OFF + u.par * SIDE_BYTES);
        f32x4 csv[2][2], bsv[2][2]; f32x2 svv[2][4];
        if (st) {
#pragma unroll
            for (int bj = 0; bj < 2; ++bj)
#pragma unroll
                for (int n = 0; n < 2; ++n) { csv[bj][n] = *(const LAS f32x4*)(side + 512 + wc * 32 + 8 * fq + bj * HALF + 4 * n); bsv[bj][n] = *(const LAS f32x4*)(side + 768 + wc * 32 + 8 * fq + bj * HALF + 4 * n); }
#pragma unroll
            for (int ai = 0; ai < 2; ++ai)
#pragma unroll
                for (int m = 0; m < 4; ++m) svv[ai][m] = *(const LAS f32x2*)(side + (wr * 64 + fr + ai * HALF + m * 16) * 2);
        }
        const int col0 = u.pn * BM + wc * 32 + 8 * fq;
#pragma unroll
        for (int ai = 0; ai < 2; ++ai)
#pragma unroll
            for (int m = 0; m < 4; ++m) { const int row = row0 + ai * HALF + m * 16;
                float mu = 0.f, rs = 1.f;
                if (st) { const f32x2 sv = svv[ai][m]; mu = sv[0] * (1.f / DM); rs = __builtin_amdgcn_rsqf(sv[1] * (1.f / DM) - mu * mu + LN_EPS); }
                f32x4 v[2][2];
#pragma unroll
                for (int bj = 0; bj < 2; ++bj)
#pragma unroll
                    for (int n = 0; n < 2; ++n) v[bj][n] = st ? (acc[ai][bj][m][n] - csv[bj][n] * mu) * rs + bsv[bj][n] : acc[ai][bj][m][n];
                if (u.pn == gate_pn) { if (wc == 0 && fq < 2) { GAS float* gp = gates + (size_t)row * 16 + 8 * fq; *(GAS f32x4*)gp = v[0][0]; *(GAS f32x4*)(gp + 4) = v[0][1]; } }
                else { GAS bf16_t* rowp = O + (size_t)row * ldc + col0;
#pragma unroll
                    for (int bj = 0; bj < 2; ++bj) { u32x4 w; w.x = cvtpk(v[bj][0][0], v[bj][0][1]); w.y = cvtpk(v[bj][0][2], v[bj][0][3]); w.z = cvtpk(v[bj][1][0], v[bj][1][1]); w.w = cvtpk(v[bj][1][2], v[bj][1][3]);
                        __builtin_nontemporal_store(w, (GAS u32x4*)(rowp + bj * HALF)); } } }
    }
};
struct EpiResid {
    static constexpr bool PERM = true, AFTER_DRAIN = false;
    const Args* ap; unsigned char* W; int L, which; LAS unsigned char* lds; int wave;
    __device__ __forceinline__ void prefetch(const Unit& u) const {
        if (which == 0 && L == 0) return;
        int tid_ = tid_of(wave); asm volatile("" : "+v"(tid_));
        const int wid = __builtin_amdgcn_readfirstlane(tid_ >> 6), lane = tid_ & 63;
        if (wid >= 4) return;
        GAS unsigned char* const Wg = (GAS unsigned char*)W;
        const int lnoff = which == 0 ? DM : 2 * L * DM;
        const GAS float* src;
        if (wid < 2) src = (const GAS float*)(Wg + WS_CTL + CTL_STATS) + (size_t)(which == 0 ? 1 : (L == 0 ? 0 : 2)) * M * 2 + (size_t)(u.pm * BM + wid * 128) * 2 + lane * 4;
        else src = ldin(*ap, wid == 2 ? 14 : 15) + lnoff + u.pn * BM + lane * 4;
        __builtin_amdgcn_global_load_lds((const unsigned*)src, (LAS unsigned*)(lds + SIDE_OFF_R + u.par * 4096 + wid * 1024), 16, 0, 0);
    }
    __device__ __forceinline__ void operator()(const f32x4 (&acc)[2][2][4][2], const Unit& u, int wr_, int wc_, int fr_, int fq_) const {
        int tid_ = tid_of(wave); asm volatile("" : "+v"(tid_));
        const int wid = __builtin_amdgcn_readfirstlane(tid_ >> 6), wr = wid >> 2, wc = wid & 3, lane = tid_ & 63, fr = tid_ & 15, fq = (tid_ & 63) >> 4;
        GAS unsigned char* const Wg = (GAS unsigned char*)W; GAS float* const STATS = (GAS float*)(Wg + WS_CTL + CTL_STATS);
        const bool lastsub = (which == 1 && L == 1);
        const bool has_in = !(which == 0 && L == 0);
        const GAS bf16_t* const zbin = (const GAS bf16_t*)(Wg + WS_XB); GAS bf16_t* const zb = (GAS bf16_t*)(Wg + WS_XB); GAS float* const out32 = nullptr; (void)lastsub;
        GAS float* const st_out = which == 0 ? STATS + (size_t)(L == 0 ? 0 : 2) * M * 2 : (L == 0 ? STATS + (size_t)1 * M * 2 : nullptr);
        constexpr float alpha = ALPHA; LAS float* const red = (LAS float*)(lds + CTRL_OFF + 1024);
        const LAS float* const side = (const LAS float*)(lds + SIDE_OFF_R + u.par * 4096);
        constexpr int ldc = DM;
        const int row0 = u.pm * BM + wr * 64 + fr, col0 = u.pn * BM + wc * 32 + 8 * fq, cl = wc * 32 + 8 * fq;
        LAS float* myred = red + wid * 256;
        const unsigned boff0 = ((unsigned)row0 * ldc + (unsigned)col0) * 2u;
        u32x4 xr[2][4][2];
#pragma unroll
        for (int ai = 0; ai < 2; ++ai)
#pragma unroll
            for (int m = 0; m < 4; ++m) { const unsigned bo = boff0 + (unsigned)((ai * HALF + m * 16) * ldc * 2);
                xr[ai][m][0] = *(const GAS u32x4*)((const GAS char*)zbin + bo); xr[ai][m][1] = *(const GAS u32x4*)((const GAS char*)zbin + bo + HALF * 2); }
#pragma unroll
        for (int ai = 0; ai < 2; ++ai) { f32x4 s1 = {0.f, 0.f, 0.f, 0.f}, s2 = {0.f, 0.f, 0.f, 0.f};
#pragma unroll
            for (int bj = 0; bj < 2; ++bj) {
                f32x4 gv[2], bv[2];
                if (has_in) {
#pragma unroll
                    for (int n = 0; n < 2; ++n) { gv[n] = *(const LAS f32x4*)(side + 512 + cl + bj * HALF + 4 * n); bv[n] = *(const LAS f32x4*)(side + 768 + cl + bj * HALF + 4 * n); } }
#pragma unroll
                for (int m = 0; m < 4; ++m) { float mu = 0.f, rs = 1.f;
                    if (has_in) { const f32x2 sv = *(const LAS f32x2*)(side + (wr * 64 + fr + ai * HALF + m * 16) * 2); mu = sv[0] * (1.f / DM); rs = __builtin_amdgcn_rsqf(sv[1] * (1.f / DM) - mu * mu + LN_EPS); }
                    const u32x4 r = xr[ai][m][bj]; const unsigned bo = boff0 + (unsigned)(((ai * HALF + m * 16) * ldc + bj * HALF) * 2);
                    f32x4 x0 = (f32x4){bf_lo(r.x), bf_hi(r.x), bf_lo(r.y), bf_hi(r.y)}, x1 = (f32x4){bf_lo(r.z), bf_hi(r.z), bf_lo(r.w), bf_hi(r.w)};
                    if (has_in) { x0 = (x0 - mu) * rs * gv[0] + bv[0]; x1 = (x1 - mu) * rs * gv[1] + bv[1]; }
                    const f32x4 z0 = x0 * alpha + acc[ai][bj][m][0];
                    const f32x4 z1 = x1 * alpha + acc[ai][bj][m][1];
                    if (out32) { *(GAS f32x4*)((GAS char*)out32 + 2u * bo) = z0; *(GAS f32x4*)((GAS char*)out32 + 2u * bo + 16) = z1; }
                    if (zb) { u32x4 w; w.x = cvtpk(z0[0], z0[1]); w.y = cvtpk(z0[2], z0[3]); w.z = cvtpk(z1[0], z1[1]); w.w = cvtpk(z1[2], z1[3]); *(GAS u32x4*)((GAS char*)zb + bo) = w; }
                    s1[m] += (z0[0] + z0[1]) + (z0[2] + z0[3]) + (z1[0] + z1[1]) + (z1[2] + z1[3]);
                    s2[m] += (z0[0] * z0[0] + z0[1] * z0[1]) + (z0[2] * z0[2] + z0[3] * z0[3]) + (z1[0] * z1[0] + z1[1] * z1[1]) + (z1[2] * z1[2] + z1[3] * z1[3]); }
            }
            if (st_out) {
#pragma unroll
                for (int m = 0; m < 4; ++m) { float a1 = s1[m], a2 = s2[m]; a1 += __shfl_xor(a1, 16); a1 += __shfl_xor(a1, 32); a2 += __shfl_xor(a2, 16); a2 += __shfl_xor(a2, 32);
                    if (fq == 0) *(LAS f32x2*)(myred + ((ai * 4 + m) * 16 + fr) * 2) = (f32x2){a1, a2}; } }
        }
        if (st_out) {
            asm volatile("s_waitcnt lgkmcnt(0)" ::: "memory"); __builtin_amdgcn_s_barrier(); asm volatile("" ::: "memory");
            const int idx = wid * 64 + lane, r = idx >> 1, c = idx & 1;
            const LAS float* q = red + ((r >> 6) & 1) * 1024 + ((((r >> 7) * 4 + ((r >> 4) & 3)) * 16 + (r & 15)) * 2 + c);
            const float sum = (q[0] + q[256]) + (q[512] + q[768]);
            unsafeAtomicAdd((float*)(st_out + (size_t)(u.pm * BM + r) * 2 + c), sum);
        }
    }
};

__device__ __forceinline__ float dpp_ror1(float x) { return __int_as_float(__builtin_amdgcn_update_dpp(0, __float_as_int(x), 0x121, 0xF, 0xF, false)); }
__device__ __forceinline__ float dpp_ror2(float x) { return __int_as_float(__builtin_amdgcn_update_dpp(0, __float_as_int(x), 0x122, 0xF, 0xF, false)); }
struct EpiFfnAct {
    static constexpr bool PERM = true, AFTER_DRAIN = false;
    const Args* ap; unsigned char* W; int L; LAS unsigned char* lds; int wave;
    __device__ __forceinline__ void prefetch(const Unit& u) const {
        int tid_ = tid_of(wave); asm volatile("" : "+v"(tid_));
        const int wid = __builtin_amdgcn_readfirstlane(tid_ >> 6), lane = tid_ & 63;
        if (wid >= 6) return;
        GAS unsigned char* const Wg = (GAS unsigned char*)W;
        const GAS float* src;
        if (wid < 2) src = (const GAS float*)(Wg + WS_CTL + CTL_STATS) + (size_t)(L == 0 ? 0 : 2) * M * 2 + (size_t)(u.pm * BM + wid * 128) * 2 + lane * 4;
        else if (wid == 2) src = (const GAS float*)(Wg + WS_CTL + (L == 0 ? CTL_CS_UG0 : CTL_CS_UG1)) + u.pn * BM + lane * 4;
        else if (wid == 3) src = (const GAS float*)(Wg + WS_CTL + (L == 0 ? CTL_BS_UG0 : CTL_BS_UG1)) + u.pn * BM + lane * 4;
        else { const int q = (wid - 4) * 2 + (lane >> 5);
            src = (q < 3 ? ldin(*ap, 11) + (size_t)L * 3 * DFF + (size_t)q * DFF : ldin(*ap, 12) + (size_t)L * DFF) + u.pn * 128 + (lane & 31) * 4; }
        __builtin_amdgcn_global_load_lds((const unsigned*)src, (LAS unsigned*)(lds + SIDE_OFF + u.par * SIDE_BYTES + wid * 1024), 16, 0, 0);
    }
    __device__ __forceinline__ void operator()(f32x4 (&acc)[2][2][4][2], const Unit& u, int wr_, int wc_, int fr_, int fq_) const {
        int tid_ = tid_of(wave); asm volatile("" : "+v"(tid_));
        GAS unsigned char* const Wg = (GAS unsigned char*)W;
        GAS bf16_t* const H = (GAS bf16_t*)(Wg + WS_U);
        GAS float* const EG0 = (GAS float*)(Wg + WS_G); GAS float* const EU0 = (GAS float*)(Wg + WS_G + 8 * MiB); GAS float* const EGL = (GAS float*)(Wg + WS_G + 16 * MiB); LAS float* const edge = (LAS float*)(lds + CTRL_OFF + 1024);
        const int wid = __builtin_amdgcn_readfirstlane(tid_ >> 6), wr = wid >> 2, wc = wid & 3, fr = tid_ & 15, fq = (tid_ & 63) >> 4;
        const int ch0 = u.pn * 128 + wc * 32 + fq * 8, row0 = u.pm * BM + wr * 64 + fr;
        const LAS float* const side = (const LAS float*)(lds + SIDE_OFF + u.par * SIDE_BYTES);
        const int cl = wc * 32 + 8 * fq;
        f32x2 sv[2][4]; f32x4 csg[2], bsg[2];
#pragma unroll
        for (int ai = 0; ai < 2; ++ai)
#pragma unroll
            for (int m = 0; m < 4; ++m) sv[ai][m] = *(const LAS f32x2*)(side + (wr * 64 + fr + ai * HALF + m * 16) * 2);
#pragma unroll
        for (int n = 0; n < 2; ++n) { csg[n] = *(const LAS f32x4*)(side + 512 + cl + HALF + 4 * n); bsg[n] = *(const LAS f32x4*)(side + 768 + cl + HALF + 4 * n); }
        float mu[2][4], rs[2][4];
#pragma unroll
        for (int ai = 0; ai < 2; ++ai)
#pragma unroll
            for (int m = 0; m < 4; ++m) { mu[ai][m] = sv[ai][m][0] * (1.f / DM); rs[ai][m] = __builtin_amdgcn_rsqf(sv[ai][m][1] * (1.f / DM) - mu[ai][m] * mu[ai][m] + LN_EPS);
#pragma unroll
                for (int n = 0; n < 2; ++n) acc[ai][1][m][n] = (acc[ai][1][m][n] - csg[n] * mu[ai][m]) * rs[ai][m] + bsg[n];
                asm volatile("" : "+v"(acc[ai][1][m][0]), "+v"(acc[ai][1][m][1])); }
        asm volatile("" ::: "memory");
        f32x4 csu[2], bsu[2], wt[4][2];
#pragma unroll
        for (int n = 0; n < 2; ++n) { csu[n] = *(const LAS f32x4*)(side + 512 + cl + 4 * n); bsu[n] = *(const LAS f32x4*)(side + 768 + cl + 4 * n);
#pragma unroll
            for (int q = 0; q < 4; ++q) wt[q][n] = *(const LAS f32x4*)(side + 1024 + q * 128 + cl + 4 * n); }
#define FFN_G(ai, m, n) (acc[ai][1][m][n])
#define FFN_U(ai, m, n) ((acc[ai][0][m][n] - csu[n] * mu[ai][m]) * rs[ai][m] + bsu[n])
        if (fr >= 14) {
#pragma unroll
            for (int ai = 0; ai < 2; ++ai) { LAS float* e = edge + ((((ai * 2 + wr) * 4 + wc) * 4 + fq) * 2 + (fr - 14)) * 8; *(LAS f32x4*)e = FFN_G(ai, 3, 0); *(LAS f32x4*)(e + 4) = FFN_G(ai, 3, 1); }
            if (wr == 1) { GAS float* p = EGL + (size_t)(u.pm * 2 + (fr - 14)) * DFF + ch0; *(GAS f32x4*)p = FFN_G(1, 3, 0); *(GAS f32x4*)(p + 4) = FFN_G(1, 3, 1); }
        }
        if (wr == 0 && fr < 2) { GAS float* pg = EG0 + (size_t)(u.pm * 2 + fr) * DFF + ch0; GAS float* pu = EU0 + (size_t)(u.pm * 2 + fr) * DFF + ch0;
            *(GAS f32x4*)pg = FFN_G(0, 0, 0); *(GAS f32x4*)(pg + 4) = FFN_G(0, 0, 1); *(GAS f32x4*)pu = FFN_U(0, 0, 0); *(GAS f32x4*)(pu + 4) = FFN_U(0, 0, 1); }
        asm volatile("s_waitcnt lgkmcnt(0)" ::: "memory"); __builtin_amdgcn_s_barrier(); asm volatile("" ::: "memory");
#pragma unroll
        for (int ai = 0; ai < 2; ++ai) {
            f32x4 e14[2] = {(f32x4){0.f, 0.f, 0.f, 0.f}, (f32x4){0.f, 0.f, 0.f, 0.f}}, e15[2] = {(f32x4){0.f, 0.f, 0.f, 0.f}, (f32x4){0.f, 0.f, 0.f, 0.f}};
            if (wr == 1 || ai == 1) { const int sa = (wr == 1) ? ai : 0, sw = (wr == 1) ? 0 : 1; const LAS float* e = edge + (((sa * 2 + sw) * 4 + wc) * 4 + fq) * 16;
                e14[0] = *(const LAS f32x4*)e; e14[1] = *(const LAS f32x4*)(e + 4); e15[0] = *(const LAS f32x4*)(e + 8); e15[1] = *(const LAS f32x4*)(e + 12); }
#pragma unroll
            for (int m = 0; m < 4; ++m) {
                float hv[8];
#pragma unroll
                for (int n = 0; n < 2; ++n) { const f32x4 uu = FFN_U(ai, m, n);
#pragma unroll
                    for (int jp = 0; jp < 2; ++jp) {
                        f32x2 P1, P2, GC;
#pragma unroll
                        for (int t = 0; t < 2; ++t) { const int j = 2 * jp + t; const float gc = acc[ai][1][m][n][j]; const float r1 = dpp_ror1(gc), r2 = dpp_ror2(gc);
                            float q1, q2;
                            if (m == 0) { q1 = e15[n][j]; q2 = (fr == 0) ? e14[n][j] : e15[n][j]; }
                            else { const float gpv = acc[ai][1][m > 0 ? m - 1 : 0][n][j]; q1 = dpp_ror1(gpv); q2 = dpp_ror2(gpv); }
                            P1[t] = (fr == 0) ? q1 : r1; P2[t] = (fr < 2) ? q2 : r2; GC[t] = gc; }
                        const f32x2 W0 = {wt[0][n][2 * jp], wt[0][n][2 * jp + 1]}, W1 = {wt[1][n][2 * jp], wt[1][n][2 * jp + 1]}, W2 = {wt[2][n][2 * jp], wt[2][n][2 * jp + 1]}, BB = {wt[3][n][2 * jp], wt[3][n][2 * jp + 1]};
                        const f32x2 U2 = {uu[2 * jp], uu[2 * jp + 1]};
                        const f32x2 Y = W0 * P2 + W1 * P1 + W2 * GC + BB;
                        const f32x2 T = Y * -1.4426950408889634f;
                        const f32x2 D = (f32x2){__builtin_amdgcn_exp2f(T[0]), __builtin_amdgcn_exp2f(T[1])} + 1.0f;
                        const f32x2 HH = Y * (f32x2){__builtin_amdgcn_rcpf(D[0]), __builtin_amdgcn_rcpf(D[1])} * U2;
                        hv[4 * n + 2 * jp] = HH[0]; hv[4 * n + 2 * jp + 1] = HH[1]; } }
                if (!(ai == 0 && m == 0 && wr == 0 && fr < 2)) { u32x4 w; w.x = cvtpk(hv[0], hv[1]); w.y = cvtpk(hv[2], hv[3]); w.z = cvtpk(hv[4], hv[5]); w.w = cvtpk(hv[6], hv[7]);
                    __builtin_nontemporal_store(w, (GAS u32x4*)(H + (size_t)(row0 + ai * HALF + m * 16) * DFF + ch0)); }
            }
        }
#undef FFN_G
#undef FFN_U
    }
};

template <class Epi, class Sched, bool ALIGN_EPI = false, bool SP2 = false>
__device__ __forceinline__ void gemm_phase(LAS unsigned char* lds, const Gemm g, const Sched& S, const Epi& E) {
    int tid_ = tid_of(E.wave); asm volatile("" : "+v"(tid_));
    const int tid = tid_, wid = __builtin_amdgcn_readfirstlane(tid >> 6), lane = tid & 63, wr = wid >> 2, wc = wid & 3, fr = lane & 15, fq = lane >> 4;
    const int K = g.K, nt = K / BK;
    unsigned voffA[2], voffB[2];
#pragma unroll
    for (int i = 0; i < 2; ++i) { int R, C; stage_rc(tid * 16 + i * 8192, R, C); const int Rb = Epi::PERM ? ((R & ~31) + perm32(R & 31)) : R;
        voffA[i] = (unsigned)(R * K + C) * 2u; voffB[i] = (unsigned)(Rb * K + C) * 2u; }
    const size_t kstep = (size_t)(BK * 2);
    const size_t hstep = (size_t)HALF * K * 2;
    const size_t tstep = 2 * hstep;
    const unsigned ldsw = (unsigned)wid * 1024u;
    const int aoff = lds_byte(wr * 64 + fr, fq * 8), boff = lds_byte(wc * 32 + fr, fq * 8);
#define PG8_SA(b, h) (((b) * 2 + (h)) * HTB)
#define PG8_SB(b, h) ((4 + (b) * 2 + (h)) * HTB)
#define PG8_STAGE(bufoff, gbase, voff) do { _Pragma("unroll") for (int _i = 0; _i < 2; ++_i) \
        __builtin_amdgcn_global_load_lds((const unsigned*)((const char*)(gbase) + (voff)[_i]), (LAS unsigned*)(lds + (bufoff) + ldsw + _i * 8192), 16, 0, 0); } while (0)
#define PG8_LDA(dst, b, h) do { _Pragma("unroll") for (int m = 0; m < 4; ++m) _Pragma("unroll") for (int k = 0; k < 2; ++k) dst[m][k] = *(const LAS bf16x8*)(lds + PG8_SA(b, h) + aoff + m * 2048 + k * 1024); } while (0)
#define PG8_LDB(dst, b, h) do { _Pragma("unroll") for (int n = 0; n < 2; ++n) _Pragma("unroll") for (int k = 0; k < 2; ++k) dst[n][k] = *(const LAS bf16x8*)(lds + PG8_SB(b, h) + boff + n * 2048 + k * 1024); } while (0)
#define PG8_MMA(ai, bj, At, Bt) do { __builtin_amdgcn_s_setprio(1); _Pragma("unroll") for (int m = 0; m < 4; ++m) _Pragma("unroll") for (int n = 0; n < 2; ++n) _Pragma("unroll") for (int k = 0; k < 2; ++k) \
        acc[ai][bj][m][n] = __builtin_amdgcn_mfma_f32_16x16x32_bf16(Bt[n][k], At[m][k], acc[ai][bj][m][n], 0, 0, 0); __builtin_amdgcn_s_setprio(0); } while (0)
#define PG8_WAIT_V(n) asm volatile("s_waitcnt vmcnt(" #n ")" ::: "memory")
#define PG8_WAIT_L(n) asm volatile("s_waitcnt lgkmcnt(" #n ")" ::: "memory")
#define PG8_BAR __builtin_amdgcn_s_barrier()
#define PG8_SCHED __builtin_amdgcn_sched_barrier(0)
    Unit cur, nxt; int ui = 0;
    if (!S.next(0, cur)) return;
    f32x4 acc[2][2][4][2];
#pragma unroll
    for (int a = 0; a < 2; ++a)
#pragma unroll
        for (int b = 0; b < 2; ++b)
#pragma unroll
            for (int m = 0; m < 4; ++m)
#pragma unroll
                for (int n = 0; n < 2; ++n) acc[a][b][m][n] = (f32x4){0.f, 0.f, 0.f, 0.f};
    bf16x8 At[4][2], B0[2][2], B1[2][2];
    const char* cA = (const char*)g.A + (size_t)cur.pm * tstep; const char* cB = (const char*)g.Bt + (size_t)cur.pn * tstep;
    cur.par = 0;
    S.a_ready(cur);
    if constexpr (SP2) {
        PG8_STAGE(PG8_SB(0, 0), cB, voffB); PG8_STAGE(PG8_SB(0, 1), cB + hstep, voffB); PG8_STAGE(PG8_SA(0, 0), cA, voffA); PG8_STAGE(PG8_SA(0, 1), cA + hstep, voffA);
        if (wr == 1) PG8_BAR;
        PG8_WAIT_V(2); PG8_BAR;
        PG8_STAGE(PG8_SB(1, 0), cB + kstep, voffB); PG8_STAGE(PG8_SA(1, 0), cA + kstep, voffA); PG8_STAGE(PG8_SB(1, 1), cB + hstep + kstep, voffB);
        PG8_WAIT_V(6); PG8_BAR;
    } else {
        PG8_STAGE(PG8_SB(0, 0), cB, voffB); PG8_STAGE(PG8_SA(0, 0), cA, voffA); PG8_STAGE(PG8_SB(0, 1), cB + hstep, voffB); PG8_STAGE(PG8_SA(0, 1), cA + hstep, voffA);
        if (wr == 1) PG8_BAR;
        PG8_WAIT_V(4); PG8_BAR;
        PG8_STAGE(PG8_SB(1, 0), cB + kstep, voffB); PG8_STAGE(PG8_SA(1, 0), cA + kstep, voffA); PG8_STAGE(PG8_SB(1, 1), cB + hstep + kstep, voffB);
        PG8_WAIT_V(6); PG8_BAR;
    }
    E.prefetch(cur);
    for (;;) {
        const bool has_next = S.next(ui + 1, nxt);
        const char* nA = has_next ? (const char*)g.A + (size_t)nxt.pm * tstep : cA; const char* nB = has_next ? (const char*)g.Bt + (size_t)nxt.pn * tstep : cB;
        for (int t = 0; t < nt; t += 2) {
            const bool last = (t == nt - 2);
            const char* a1 = cA + (size_t)(t + 1) * kstep;
            const char* a2 = last ? nA : cA + (size_t)(t + 2) * kstep; const char* b2 = last ? nB : cB + (size_t)(t + 2) * kstep;
            const char* a3 = a2 + kstep; const char* b3 = b2 + kstep;
            if (last && has_next) S.a_ready(nxt);
            if constexpr (SP2) {
            PG8_LDB(B0, 0, 0); PG8_LDB(B1, 0, 1); PG8_SCHED; PG8_LDA(At, 0, 0); PG8_STAGE(PG8_SA(1, 1), a1 + hstep, voffA);
            PG8_WAIT_V(8); PG8_WAIT_L(0); PG8_BAR; PG8_MMA(0, 0, At, B0); PG8_MMA(0, 1, At, B1); PG8_BAR; PG8_SCHED;
            PG8_LDA(At, 0, 1); PG8_STAGE(PG8_SB(0, 0), b2, voffB); PG8_STAGE(PG8_SB(0, 1), b2 + hstep, voffB); PG8_STAGE(PG8_SA(0, 0), a2, voffA);
            PG8_WAIT_V(8); PG8_WAIT_L(0); PG8_BAR; PG8_MMA(1, 0, At, B0); PG8_MMA(1, 1, At, B1); PG8_BAR; PG8_SCHED;
            PG8_LDB(B0, 1, 0); PG8_LDB(B1, 1, 1); PG8_SCHED; PG8_LDA(At, 1, 0); PG8_STAGE(PG8_SA(0, 1), a2 + hstep, voffA);
            PG8_WAIT_V(8); PG8_WAIT_L(0); PG8_BAR; PG8_MMA(0, 0, At, B0); PG8_MMA(0, 1, At, B1); PG8_BAR; PG8_SCHED;
            PG8_LDA(At, 1, 1); PG8_STAGE(PG8_SB(1, 0), b3, voffB); PG8_STAGE(PG8_SB(1, 1), b3 + hstep, voffB); PG8_STAGE(PG8_SA(1, 0), a3, voffA);
            PG8_WAIT_V(8); PG8_WAIT_L(0); PG8_BAR; PG8_MMA(1, 0, At, B0); PG8_MMA(1, 1, At, B1); PG8_BAR; PG8_SCHED;
            } else {
            PG8_LDB(B0, 0, 0); PG8_SCHED; PG8_LDA(At, 0, 0); PG8_STAGE(PG8_SA(1, 1), a1 + hstep, voffA);
            PG8_WAIT_L(8); PG8_BAR; PG8_WAIT_L(0); PG8_MMA(0, 0, At, B0); PG8_BAR; PG8_SCHED;
            PG8_LDB(B1, 0, 1); PG8_STAGE(PG8_SB(0, 0), b2, voffB);
            PG8_BAR; PG8_WAIT_L(0); PG8_MMA(0, 1, At, B1); PG8_BAR;
            PG8_LDA(At, 0, 1); PG8_STAGE(PG8_SA(0, 0), a2, voffA);
            PG8_BAR; PG8_WAIT_L(0); PG8_MMA(1, 0, At, B0); PG8_BAR; PG8_SCHED;
            PG8_STAGE(PG8_SB(0, 1), b2 + hstep, voffB);
            PG8_WAIT_V(6); PG8_BAR; PG8_MMA(1, 1, At, B1); PG8_BAR;
            PG8_LDB(B0, 1, 0); PG8_SCHED; PG8_LDA(At, 1, 0); PG8_STAGE(PG8_SA(0, 1), a2 + hstep, voffA);
            PG8_WAIT_L(8); PG8_BAR; PG8_WAIT_L(0); PG8_MMA(0, 0, At, B0); PG8_BAR; PG8_SCHED;
            PG8_LDB(B1, 1, 1); PG8_STAGE(PG8_SB(1, 0), b3, voffB);
            PG8_BAR; PG8_WAIT_L(0); PG8_MMA(0, 1, At, B1); PG8_BAR;
            PG8_LDA(At, 1, 1); PG8_STAGE(PG8_SA(1, 0), a3, voffA);
            PG8_BAR; PG8_WAIT_L(0); PG8_MMA(1, 0, At, B0); PG8_BAR; PG8_SCHED;
            PG8_STAGE(PG8_SB(1, 1), b3 + hstep, voffB);
            PG8_WAIT_V(6); PG8_BAR; PG8_MMA(1, 1, At, B1); PG8_BAR;
            }
        }
        if constexpr (ALIGN_EPI) { if (wr == 0) PG8_BAR; }
        if constexpr (!Epi::AFTER_DRAIN) { E(acc, cur, wr, wc, fr, fq); S.done(cur); }
        if (!has_next) break;
#pragma unroll
        for (int a = 0; a < 2; ++a)
#pragma unroll
            for (int b = 0; b < 2; ++b)
#pragma unroll
                for (int m = 0; m < 4; ++m)
#pragma unroll
                    for (int n = 0; n < 2; ++n) acc[a][b][m][n] = (f32x4){0.f, 0.f, 0.f, 0.f};
        cur = nxt; cA = nA; cB = nB; ++ui; cur.par = ui & 1;
        E.prefetch(cur);
        if constexpr (ALIGN_EPI) { if (wr == 1) PG8_BAR; }
    }
    PG8_WAIT_V(0);
    if constexpr (!ALIGN_EPI) { if (wr == 0) PG8_BAR; }
    PG8_BAR;
#undef PG8_SA
#undef PG8_SB
#undef PG8_STAGE
#undef PG8_LDA
#undef PG8_LDB
#undef PG8_MMA
#undef PG8_WAIT_V
#undef PG8_WAIT_L
#undef PG8_BAR
#undef PG8_SCHED
}
}

#define XB_TMO      128
#define XB_XCNT(j)  (256  + 64 * (j))
#define XB_XSUB(j)  (1280 + 64 * (j))
#define XB_XGEN(j)  (2304 + 64 * (j))
#define XB_TOP      3328
#define XB_TOPGEN   3392
#define XCD_BAR_WORDS 3456
#define XB_SPIN_CAP (1u << 18)
__device__ __forceinline__ unsigned xb_ld(unsigned* p)              { return __hip_atomic_load((GAS unsigned*)p, __ATOMIC_RELAXED, __HIP_MEMORY_SCOPE_AGENT); }
__device__ __forceinline__ unsigned xb_add(unsigned* p, unsigned v) { return __hip_atomic_fetch_add((GAS unsigned*)p, v, __ATOMIC_RELAXED, __HIP_MEMORY_SCOPE_AGENT); }
__device__ __forceinline__ unsigned xb_xcc_id() { return (unsigned)__builtin_amdgcn_s_getreg((3 << 11) | 20) & 0xFu; }
#define XB_SPIN(cond, bar) do { unsigned _sp = 0; while (cond) { __builtin_amdgcn_s_sleep(1); \
    if ((++_sp & 255u) == 0u) { if (xb_ld(&(bar)[XB_TMO])) break; if (_sp > XB_SPIN_CAP) { (void)xb_add(&(bar)[XB_TMO], 1u); break; } } } } while (0)
struct XcdBarrier { unsigned* bar; unsigned x; volatile LAS unsigned* st; int wave; };
__device__ __forceinline__ XcdBarrier xcd_barrier_post(unsigned* bar, volatile LAS unsigned* st, int wave) {
    XcdBarrier b; b.bar = bar; b.x = xb_xcc_id(); b.st = st; b.wave = wave;
    if (tid_of(wave) == 0) (void)xb_add(&bar[XB_XCNT(b.x)], 1u);
    return b;
}
__device__ __forceinline__ void xcd_barrier_complete(unsigned* bar, unsigned x, unsigned& nloc, unsigned& nx) {
    const unsigned G = gridDim.x * gridDim.y * gridDim.z;
    unsigned sum, cnt, mine, sp = 0u;
    for (;;) {
        sum = 0u; cnt = 0u; mine = 0u;
#pragma unroll
        for (unsigned j = 0; j < 16; ++j) { const unsigned c = xb_ld(&bar[XB_XCNT(j)]); sum += c; cnt += (c > 0u) ? 1u : 0u; mine = (j == x) ? c : mine; }
        if (sum == G) break;
        __builtin_amdgcn_s_sleep(1);
        if ((++sp & 255u) == 0u) { if (xb_ld(&bar[XB_TMO])) break; if (sp > XB_SPIN_CAP) { (void)xb_add(&bar[XB_TMO], 1u); break; } }
    }
    nloc = mine > 0u ? mine : 1u; nx = cnt > 0u ? cnt : 1u;
}
__device__ __forceinline__ void xcd_barrier(const XcdBarrier& b) {
    asm volatile("s_waitcnt vmcnt(0)" ::: "memory");
    __syncthreads();
    if (tid_of(b.wave) == 0) {
        unsigned* bar = b.bar; unsigned bx = b.x;
        asm volatile("" : "+s"(bar), "+s"(bx));
        __builtin_amdgcn_s_waitcnt(0);
        unsigned nloc = b.st[0], nx = b.st[1];
        if (nloc == 0u) { xcd_barrier_complete(bar, bx, nloc, nx); b.st[0] = nloc; b.st[1] = nx; }
        const unsigned old = xb_add(&bar[XB_XSUB(bx)], 1u);
        const unsigned gen = old / nloc;
        if (old + 1u == (gen + 1u) * nloc) {
            __builtin_amdgcn_fence(__ATOMIC_RELEASE, "agent");
            asm volatile("s_waitcnt vmcnt(0)" ::: "memory");
            const unsigned og = xb_add(&bar[XB_TOP], 1u);
            const unsigned tg = og / nx;
            if (og + 1u == (tg + 1u) * nx) xb_add(&bar[XB_TOPGEN], 1u);
            else XB_SPIN(xb_ld(&bar[XB_TOPGEN]) == tg, bar);
            __builtin_amdgcn_fence(__ATOMIC_ACQUIRE, "agent");
            xb_add(&bar[XB_XGEN(bx)], 1u);
            asm volatile("s_waitcnt vmcnt(0)" ::: "memory");
        } else {
            XB_SPIN(xb_ld(&bar[XB_XGEN(bx)]) == gen, bar);
            __builtin_amdgcn_fence(__ATOMIC_ACQUIRE, "agent");
            asm volatile("s_waitcnt vmcnt(0)" ::: "memory");
        }
    }
    __syncthreads();
}

namespace att {
constexpr int D = 128, SHM = 16384;
constexpr int OFF_V = 0, OFF_K = 2 * SHM, OFF_WS = 4 * SHM, OFF_AUX = 4 * SHM + 2048, OFF_Q = 4 * SHM + 2048 + 8192  , LDS_USED = OFF_Q + 65536;
static_assert(LDS_USED <= CTRL_OFF, "attention LDS map");
static_assert(SIDE_OFF + 2 * SIDE_BYTES <= LDS_BYTES && SIDE_OFF_R + 2 * 4096 <= LDS_BYTES, "side tables");
constexpr float SCALE = 0.08838834764831845f;
constexpr float C2 = 1.4426950408889634f * SCALE;
constexpr float THR = 8.f;
enum { MODE_DIL = 0, MODE_MOBA = 1, MODE_SB = 2, MODE_ML = 3 };
#define KSWZ(row, colB) ((row) * 256 + ((colB) ^ (((row) & 7) << 4)))
__device__ __forceinline__ int v_st(int k, int c) { const int kk = (k & ~0xC) | ((k & 4) << 1) | ((k & 8) >> 1); return ((kk >> 3) * 4 + (c >> 5)) * 512 + ((kk & 7) * 32 + (c & 31)) * 2; }
__device__ __forceinline__ int v_rd_base(int lane) { return ((lane & 3) << 3) | (((lane >> 2) & 3) << 6) | (((lane >> 4) & 1) << 5) | (((lane >> 5) & 1) << 8); }
__device__ __forceinline__ int crow(int r, int hi) { return (r & 3) + 8 * (r >> 2) + 4 * hi; }
__device__ __forceinline__ void glds16(const void* gsrc, unsigned lds_dst) { unsigned keep;
    asm volatile("s_mov_b32 %0, m0\n\ts_mov_b32 m0, %2\n\ts_nop 0\n\tglobal_load_lds_dwordx4 %1, off\n\ts_mov_b32 m0, %0" : "=&s"(keep) : "v"(gsrc), "s"(lds_dst) : "memory"); }
__device__ __forceinline__ void mask_tile(f32x16& p0, f32x16& p1, int dq) {
    const float NEG = -__builtin_inff();
#pragma unroll
    for (int r = 0; r < 16; ++r) {
        const int c = (r & 3) + 8 * (r >> 2);
        if (dq - c < 0) p0[r] = NEG;
        if (dq - c - 32 < 0) p1[r] = NEG;
    }
}
__device__ __forceinline__ void partialSM(f32x16& p0, f32x16& p1, float& m_reg, float& mn, float& alpha) {
    float pmax = p0[0];
#pragma unroll
    for (int r = 1; r < 16; ++r) pmax = fmaxf(pmax, p0[r]);
#pragma unroll
    for (int r = 0; r < 16; ++r) pmax = fmaxf(pmax, p1[r]);
    { auto rr = __builtin_amdgcn_permlane32_swap(__float_as_uint(pmax), __float_as_uint(pmax), false, false);
      pmax = fmaxf(__uint_as_float(rr[0]), __uint_as_float(rr[1])); }
    if (__builtin_expect(__all((pmax - m_reg) * SCALE <= THR), 1)) { mn = m_reg; alpha = 1.f; }
    else { mn = fmaxf(m_reg, pmax); alpha = __builtin_amdgcn_exp2f((m_reg - mn) * C2); m_reg = mn; }
    const float mnL = -mn * C2;
#pragma unroll
    for (int r = 0; r < 16; ++r) p0[r] = fmaf(p0[r], C2, mnL);
#pragma unroll
    for (int r = 0; r < 16; ++r) p1[r] = fmaf(p1[r], C2, mnL);
#pragma unroll
    for (int r = 0; r < 16; ++r) p0[r] = __builtin_amdgcn_exp2f(p0[r]);
#pragma unroll
    for (int r = 0; r < 16; ++r) p1[r] = __builtin_amdgcn_exp2f(p1[r]);
}
#define ATT_PK4(P, B_, OUT) do { unsigned a0 = cvtpk(P[B_+0], P[B_+1]), a1 = cvtpk(P[B_+2], P[B_+3]);                          \
        unsigned b0 = cvtpk(P[B_+4], P[B_+5]), b1 = cvtpk(P[B_+6], P[B_+7]);                                             \
        auto r0 = __builtin_amdgcn_permlane32_swap(a0, b0, false, false); auto r1 = __builtin_amdgcn_permlane32_swap(a1, b1, false, false); \
        u32x4 w = {r0[0], r1[0], r0[1], r1[1]}; OUT = *reinterpret_cast<bf16x8*>(&w); } while (0)
__device__ __forceinline__ void pack_p(const f32x16& p0, const f32x16& p1, bf16x8& pa0, bf16x8& pa1, bf16x8& pa2, bf16x8& pa3) {
    ATT_PK4(p0, 0, pa0); ATT_PK4(p0, 8, pa1); ATT_PK4(p1, 0, pa2); ATT_PK4(p1, 8, pa3);
}
__device__ __forceinline__ float pair_sum(float v) {
    auto rr = __builtin_amdgcn_permlane32_swap(__float_as_uint(v), __float_as_uint(v), false, false);
    return __uint_as_float(rr[0]) + __uint_as_float(rr[1]);
}
__device__ __forceinline__ void qkt(f32x16& p0, f32x16& p1, const LAS char* Kb, int r32, int hi, const bf16x8* qr) {
#pragma unroll
    for (int r = 0; r < 16; ++r) { p0[r] = 0.f; p1[r] = 0.f; }
    const LAS char* kb[4];
#pragma unroll
    for (int dd = 0; dd < 4; ++dd) kb[dd] = Kb + KSWZ(r32, (dd * 16 + hi * 8) * 2);
#pragma unroll
    for (int d0 = 0; d0 < 8; ++d0) { const LAS char* a = kb[d0 & 3] + (d0 >> 2) * 128;
        const bf16x8 b0 = *reinterpret_cast<const LAS bf16x8*>(a);
        const bf16x8 b1 = *reinterpret_cast<const LAS bf16x8*>(a + 32 * 256);
        p0 = __builtin_amdgcn_mfma_f32_32x32x16_bf16(b0, qr[d0], p0, 0, 0, 0);
        p1 = __builtin_amdgcn_mfma_f32_32x32x16_bf16(b1, qr[d0], p1, 0, 0, 0); }
}
__device__ __forceinline__ void qkt_lq(f32x16& p0, f32x16& p1, const LAS char* Kb, int r32, int hi, const LAS char* Qw) {
#pragma unroll
    for (int r = 0; r < 16; ++r) { p0[r] = 0.f; p1[r] = 0.f; }
    const LAS char* kb[4];
#pragma unroll
    for (int dd = 0; dd < 4; ++dd) kb[dd] = Kb + KSWZ(r32, (dd * 16 + hi * 8) * 2);
#pragma unroll
    for (int d0 = 0; d0 < 8; ++d0) { const LAS char* a = kb[d0 & 3] + (d0 >> 2) * 128;
        const bf16x8 b0 = *reinterpret_cast<const LAS bf16x8*>(a);
        const bf16x8 b1 = *reinterpret_cast<const LAS bf16x8*>(a + 32 * 256);
        const bf16x8 q = *reinterpret_cast<const LAS bf16x8*>(Qw + d0 * 1024);
        p0 = __builtin_amdgcn_mfma_f32_32x32x16_bf16(b0, q, p0, 0, 0, 0);
        p1 = __builtin_amdgcn_mfma_f32_32x32x16_bf16(b1, q, p1, 0, 0, 0); }
}
__device__ __forceinline__ void pv_tile(f32x16* o, int vb0, bf16x8 pa0, bf16x8 pa1, bf16x8 pa2, bf16x8 pa3) {
#define TRRD(dst, off) asm volatile("ds_read_b64_tr_b16 %0, %1 offset:%2" : "=&v"(dst) : "v"(vb0), "i"(off) : "memory")
#define PV_D0(d0) do { s16x4 l0, l1, l2, l3, h0, h1, h2, h3; constexpr int b_ = (d0) * 512; \
        TRRD(l0, b_); TRRD(h0, b_ + 2048); TRRD(l1, b_ + 4096); TRRD(h1, b_ + 6144); TRRD(l2, b_ + 8192); TRRD(h2, b_ + 10240); TRRD(l3, b_ + 12288); TRRD(h3, b_ + 14336); \
        asm volatile("s_waitcnt lgkmcnt(0)" ::: "memory"); SBAR();   \
        o[d0] = __builtin_amdgcn_mfma_f32_32x32x16_bf16(pa0, (bf16x8){l0[0], l0[1], l0[2], l0[3], h0[0], h0[1], h0[2], h0[3]}, o[d0], 0, 0, 0);   \
        o[d0] = __builtin_amdgcn_mfma_f32_32x32x16_bf16(pa1, (bf16x8){l1[0], l1[1], l1[2], l1[3], h1[0], h1[1], h1[2], h1[3]}, o[d0], 0, 0, 0);   \
        o[d0] = __builtin_amdgcn_mfma_f32_32x32x16_bf16(pa2, (bf16x8){l2[0], l2[1], l2[2], l2[3], h2[0], h2[1], h2[2], h2[3]}, o[d0], 0, 0, 0);   \
        o[d0] = __builtin_amdgcn_mfma_f32_32x32x16_bf16(pa3, (bf16x8){l3[0], l3[1], l3[2], l3[3], h3[0], h3[1], h3[2], h3[3]}, o[d0], 0, 0, 0); } while (0)
    PV_D0(0); PV_D0(1); PV_D0(2); PV_D0(3);
#undef PV_D0
#undef TRRD
}


__device__ __forceinline__ void softmax_start(f32x16& p0, f32x16& p1, float& m_reg, float& alpha) {
    float pmax = p0[0];
#pragma unroll
    for (int r = 1; r < 16; ++r) pmax = fmaxf(pmax, p0[r]);
#pragma unroll
    for (int r = 0; r < 16; ++r) pmax = fmaxf(pmax, p1[r]);
    { auto rr = __builtin_amdgcn_permlane32_swap(__float_as_uint(pmax), __float_as_uint(pmax), false, false);
      pmax = fmaxf(__uint_as_float(rr[0]), __uint_as_float(rr[1])); }
    float mn;
    if (__builtin_expect(__all((pmax - m_reg) * SCALE <= THR), 1)) { mn = m_reg; alpha = 1.f; }
    else { mn = fmaxf(m_reg, pmax); alpha = __builtin_amdgcn_exp2f((m_reg - mn) * C2); m_reg = mn; }
    const float mnL = -mn * C2;
#pragma unroll
    for (int r = 0; r < 16; ++r) p0[r] = fmaf(p0[r], C2, mnL);
#pragma unroll
    for (int r = 0; r < 16; ++r) p1[r] = fmaf(p1[r], C2, mnL);
#pragma unroll
    for (int r = 0; r < 16; ++r) p0[r] = __builtin_amdgcn_exp2f(p0[r]);
}
template <bool PACKSUM>
__device__ __forceinline__ void softmax_finish(f32x16& p0, f32x16& p1, float alpha, float& l_reg, bf16x8& pa0, bf16x8& pa1, bf16x8& pa2, bf16x8& pa3) {
#pragma unroll
    for (int r = 0; r < 16; ++r) p1[r] = __builtin_amdgcn_exp2f(p1[r]);
    float ps = 0.f;
    if constexpr (!PACKSUM) {
#pragma unroll
        for (int r = 0; r < 16; ++r) ps += p0[r];
#pragma unroll
        for (int r = 0; r < 16; ++r) ps += p1[r];
    } else
    { const f32x16 t = p0 + p1;
      const f32x8 a = __builtin_shufflevector(t, t, 0, 1, 2, 3, 4, 5, 6, 7) + __builtin_shufflevector(t, t, 8, 9, 10, 11, 12, 13, 14, 15);
      const f32x4 b = __builtin_shufflevector(a, a, 0, 1, 2, 3) + __builtin_shufflevector(a, a, 4, 5, 6, 7);
      const f32x2 c = __builtin_shufflevector(b, b, 0, 1) + __builtin_shufflevector(b, b, 2, 3);
      ps = c[0] + c[1]; }
    ps = pair_sum(ps);
    l_reg = l_reg * alpha + ps;
    pack_p(p0, p1, pa0, pa1, pa2, pa3);
}
template <int MODE>
__device__ __forceinline__ void stage_b1(f32x16& p0, f32x16& p1, float& alpha, float& m_reg, int tj, int qb, int qlo, int qpos, int hi, unsigned sel, unsigned m16, unsigned m4, const LAS float* aux, float M2row) {
    const int kb = tj * 64, dq = qpos - kb - 4 * hi;
    if constexpr (MODE == MODE_DIL) {
        const int dlo = qlo - kb - 63, dhi2 = qlo + 31 - kb;
        if (dlo > 512) {
#pragma unroll
            for (int r = 0; r < 16; ++r) { const float t = ((m16 >> r) & 1u) ? 0.f : -__builtin_inff(); p0[r] += t; p1[r] += t; }
        } else if (dlo > 128 && dhi2 <= 512) {
#pragma unroll
            for (int r = 0; r < 16; ++r) { const float t = ((m16 >> r) & 1u) ? (1.0f / C2) : (((m4 >> r) & 1u) ? 0.f : -__builtin_inff()); p0[r] += t; p1[r] += t; }
        } else {
#pragma unroll
            for (int r = 0; r < 16; ++r) { const int c = (r & 3) + 8 * (r >> 2);
                { const unsigned ud = (unsigned)(dq - c); const int cnt = (int)(ud <= 128u) + (int)(((ud & 3u) == 0u) & (ud <= 512u)) + (int)((ud & 0x8000000Fu) == 0u);
                  p0[r] += __builtin_amdgcn_logf((float)cnt) * (1.0f / C2); }
                { const unsigned ud = (unsigned)(dq - c - 32); const int cnt = (int)(ud <= 128u) + (int)(((ud & 3u) == 0u) & (ud <= 512u)) + (int)((ud & 0x8000000Fu) == 0u);
                  p1[r] += __builtin_amdgcn_logf((float)cnt) * (1.0f / C2); } }
        }
        softmax_start(p0, p1, m_reg, alpha);
    } else if constexpr (MODE == MODE_MOBA) {
        const int n = tj >> 2;
        if (n == qb) { if (kb + 63 > qlo) mask_tile(p0, p1, dq); }
        else { const bool keep = ((sel >> n) & 1u) != 0u;
#pragma unroll
            for (int r = 0; r < 16; ++r) { p0[r] = keep ? p0[r] : -__builtin_inff(); p1[r] = keep ? p1[r] : -__builtin_inff(); } }
        softmax_start(p0, p1, m_reg, alpha);
    } else {
#pragma unroll
        for (int r4 = 0; r4 < 4; ++r4) { const f32x4 a0 = *(const LAS f32x4*)(aux + kb + 8 * r4 + 4 * hi);
            const float rf = SCALE * __builtin_amdgcn_exp2f(a0[0] - M2row);
#pragma unroll
            for (int j = 0; j < 4; ++j) { const int r = 4 * r4 + j, c = 8 * r4 + j;
                float s0 = p0[r] * (j == 0 ? rf : rf * a0[j]); s0 = (dq - c < 0) ? 0.f : s0; p0[r] = s0; } }
        alpha = 1.f;
    }
}
template <int MODE>
__device__ __forceinline__ void stage_b2(f32x16& p0, f32x16& p1, float alpha, float& l_reg, float& den, int tj, int qpos, int hi, const LAS float* aux, float M2row, bf16x8& pa0, bf16x8& pa1, bf16x8& pa2, bf16x8& pa3) {
    if constexpr (MODE == MODE_ML) {
        const int kb = tj * 64, dq = qpos - kb - 4 * hi; float dsum = 0.f;
#pragma unroll
        for (int r4 = 0; r4 < 4; ++r4) { const f32x4 a1 = *(const LAS f32x4*)(aux + kb + 32 + 8 * r4 + 4 * hi);
            const float rf = SCALE * __builtin_amdgcn_exp2f(a1[0] - M2row);
#pragma unroll
            for (int j = 0; j < 4; ++j) { const int r = 4 * r4 + j, c = 8 * r4 + j;
                float s1 = p1[r] * (j == 0 ? rf : rf * a1[j]); s1 = (dq - c - 32 < 0) ? 0.f : s1; p1[r] = s1; dsum += p0[r] + s1; } }
        den += dsum;
        pack_p(p0, p1, pa0, pa1, pa2, pa3);
    } else softmax_finish<MODE != MODE_DIL>(p0, p1, alpha, l_reg, pa0, pa1, pa2, pa3);
}

template <int MODE>
__device__ __forceinline__ void attn_block(const bf16* __restrict__ Qp, int ldq, const bf16* __restrict__ Kp, int ldk, const bf16* __restrict__ Vp, int ldv, bf16* __restrict__ Op, int ldo,
                                           int qb, LAS char* lds, const float* __restrict__ aux0, const float* __restrict__ aux1, const float* __restrict__ aux2, int wave) {
    int tid_ = tid_of(wave); asm volatile("" : "+v"(tid_));
    const int tid = tid_, wid = __builtin_amdgcn_readfirstlane(tid >> 6), lane = tid & 63, r32 = lane & 31, hi = lane >> 5;
    const int P0 = qb * 256, qlo = P0 + wid * 32, qpos = qlo + r32;
    const int NT = 4 * qb + 4;
    LAS char* V_lds = lds + OFF_V; LAS char* K_lds = lds + OFF_K;
    LAS float* wsf = (LAS float*)(lds + OFF_WS) + wid * 64; LAS float* li_l = wsf; LAS float* al_l = wsf + 32;
    LAS float* aux = (LAS float*)(lds + OFF_AUX);
    bf16x8 qr[8];
#pragma unroll
    for (int d0 = 0; d0 < 8; ++d0) qr[d0] = *reinterpret_cast<const bf16x8*>(Qp + (size_t)qpos * ldq + d0 * 16 + hi * 8);
    unsigned kso[2], vso[2];
#pragma unroll
    for (int i = 0; i < 2; ++i) { const int pc = 2 * wid + i, krow = pc * 4 + (lane >> 4), kch = (lane & 15) ^ (krow & 7);
        kso[i] = (unsigned)(krow * ldk + kch * 8) * 2u;
        const int kk = wid * 8 + ((lane & 31) >> 2), vk = (kk & ~0xC) | ((kk & 4) << 1) | ((kk & 8) >> 1), vc = (2 * i + (lane >> 5)) * 32 + (lane & 3) * 8;
        vso[i] = (unsigned)(vk * ldv + vc) * 2u; }
    const int vb0 = (int)(unsigned)(size_t)V_lds + v_rd_base(lane);
    float m_reg = -1e30f, l_reg = 0.f, Rsum = 0.f, den = 0.f, M2row = 0.f, nmrow = 1.f; unsigned sel = 0u;
    if constexpr (MODE == MODE_ML) {
        for (int i = tid; i < P0 + 256; i += 512) { const float a = aux0[i]; const float base = __shfl(a, lane & ~3); aux[i] = (i & 3) == 0 ? a : __builtin_amdgcn_exp2f(a - base); }
        M2row = aux1[qpos]; nmrow = aux2[qpos]; }
    if constexpr (MODE == MODE_MOBA) { for (int i = tid; i < qb * 128; i += 512) aux[i] = aux0[i]; }
#define TJ(i) ((MODE == MODE_SB) ? (NT - 1 - (i)) : (i))
#define SLOAD(kb_, bf) do { const char* kg_ = (const char*)(Kp + (size_t)(kb_) * ldk); const char* vg_ = (const char*)(Vp + (size_t)(kb_) * ldv); \
        _Pragma("unroll") for (int i_ = 0; i_ < 2; ++i_) { \
            glds16(kg_ + kso[i_], (unsigned)__builtin_amdgcn_readfirstlane((int)(unsigned)(size_t)(K_lds + (bf) * SHM + (2 * wid + i_) * 1024))); \
            glds16(vg_ + vso[i_], (unsigned)__builtin_amdgcn_readfirstlane((int)(unsigned)(size_t)(V_lds + (bf) * SHM + (2 * wid + i_) * 1024))); } } while (0)
    float zbnd = 0.f; bool wdone = false; LAS int* dflag = (LAS int*)(lds + OFF_WS);
    if constexpr (MODE == MODE_SB) { float s = 0.f;
#pragma unroll
        for (int d0 = 0; d0 < 8; ++d0) { const u32x4 qw = *reinterpret_cast<const u32x4*>(&qr[d0]);
            s = fmaf(bf_lo(qw.x), bf_lo(qw.x), s); s = fmaf(bf_hi(qw.x), bf_hi(qw.x), s); s = fmaf(bf_lo(qw.y), bf_lo(qw.y), s); s = fmaf(bf_hi(qw.y), bf_hi(qw.y), s);
            s = fmaf(bf_lo(qw.z), bf_lo(qw.z), s); s = fmaf(bf_hi(qw.z), bf_hi(qw.z), s); s = fmaf(bf_lo(qw.w), bf_lo(qw.w), s); s = fmaf(bf_hi(qw.w), bf_hi(qw.w), s); }
        s = pair_sum(s); zbnd = sqrtf(s * aux0[0]) * (C2 * 1.001f) + 0.01f; }
    unsigned dm16 = 0u, dm4 = 0u;
    if constexpr (MODE == MODE_DIL) {
#pragma unroll
        for (int r = 0; r < 16; ++r) { const unsigned d0 = (unsigned)(qpos - 4 * hi - ((r & 3) + 8 * (r >> 2))); dm16 |= ((d0 & 15u) == 0u ? 1u : 0u) << r; dm4 |= ((d0 & 3u) == 0u ? 1u : 0u) << r; } }
    SLOAD(TJ(0) * 64, 0); VM_WAIT(); LDS_WAIT(); WG_BAR();
#pragma unroll
    for (int d0 = 0; d0 < 8; ++d0) asm volatile("" : "+v"(qr[d0]));
    asm volatile("" : "+v"(M2row), "+v"(nmrow), "+v"(zbnd));
    if constexpr (MODE == MODE_MOBA) {
        if (qb <= 3) sel = (1u << qb) - 1u;
        else {
            float g[7];
#pragma unroll
            for (int n = 0; n < 7; ++n) { g[n] = -__builtin_inff();
                if (n < qb) { float s = 0.f;
#pragma unroll
                    for (int d0 = 0; d0 < 8; ++d0) { const LAS f32x4* kp = (const LAS f32x4*)(aux + n * 128 + d0 * 16 + hi * 8); const f32x4 k0 = kp[0], k1 = kp[1];
                        const u32x4 qw = *reinterpret_cast<const u32x4*>(&qr[d0]);
                        s = fmaf(bf_lo(qw.x), k0[0], s); s = fmaf(bf_hi(qw.x), k0[1], s); s = fmaf(bf_lo(qw.y), k0[2], s); s = fmaf(bf_hi(qw.y), k0[3], s);
                        s = fmaf(bf_lo(qw.z), k1[0], s); s = fmaf(bf_hi(qw.z), k1[1], s); s = fmaf(bf_lo(qw.w), k1[2], s); s = fmaf(bf_hi(qw.w), k1[3], s); }
                    g[n] = pair_sum(s); }
                asm volatile("" ::: "memory"); }
#pragma unroll
            for (int k = 0; k < 3; ++k) { float best = -__builtin_inff(); int bi = 0;
#pragma unroll
                for (int n = 0; n < 7; ++n) if (g[n] > best) { best = g[n]; bi = n; }
                sel |= 1u << bi;
#pragma unroll
                for (int n = 0; n < 7; ++n) g[n] = (bi == n) ? -__builtin_inff() : g[n]; }
        }
    }
    f32x16 o[4];
#pragma unroll
    for (int d_ = 0; d_ < 4; ++d_)
#pragma unroll
        for (int r = 0; r < 16; ++r) o[d_][r] = 0.f;
    if constexpr (MODE == MODE_MOBA || MODE == MODE_ML || MODE == MODE_DIL) {
#define SLOADK(kb_, bf) do { const char* kg_ = (const char*)(Kp + (size_t)(kb_) * ldk); _Pragma("unroll") for (int i_ = 0; i_ < 2; ++i_) \
            glds16(kg_ + kso[i_], (unsigned)__builtin_amdgcn_readfirstlane((int)(unsigned)(size_t)(K_lds + (bf) * SHM + (2 * wid + i_) * 1024))); } while (0)
#define SLOADV(kb_, bf) do { const char* vg_ = (const char*)(Vp + (size_t)(kb_) * ldv); _Pragma("unroll") for (int i_ = 0; i_ < 2; ++i_) \
            glds16(vg_ + vso[i_], (unsigned)__builtin_amdgcn_readfirstlane((int)(unsigned)(size_t)(V_lds + (bf) * SHM + (2 * wid + i_) * 1024))); } while (0)
#define RESC(a) do { if (MODE != MODE_ML) { if (__any((a) < 1.f)) { if (hi == 0) al_l[r32] = (a); LDS_WAIT(); \
            _Pragma("unroll") for (int d_ = 0; d_ < 4; ++d_) _Pragma("unroll") for (int r = 0; r < 16; ++r) o[d_][r] *= al_l[crow(r, hi)]; } } } while (0)
#define HALF_STEP(PX0, PX1, alX, PY0, PY1, alY, t_) do { const int ht_ = (t_); \
            if (ht_ + 1 < NT) SLOADK((ht_ + 1) * 64, (ht_ + 1) & 1); SLOADV(ht_ * 64, ht_ & 1); SBAR(); \
            bf16x8 pa0, pa1, pa2, pa3; \
            qkt_lq(PX0, PX1, K_lds + (ht_ & 1) * SHM, r32, hi, Qw); stage_b2<MODE>(PY0, PY1, alY, l_reg, den, ht_ - 1, qpos, hi, aux, M2row, pa0, pa1, pa2, pa3); \
            SBAR(); \
            RESC(alY); pv_tile(o, vb0 + ((ht_ - 1) & 1) * SHM, pa0, pa1, pa2, pa3); stage_b1<MODE>(PX0, PX1, alX, m_reg, ht_, qb, qlo, qpos, hi, sel, dm16, dm4, aux, M2row); \
            SBAR(); VM_WAIT(); LDS_WAIT(); WG_BAR(); } while (0)
        f32x16 pA0, pA1, pB0, pB1; float alA = 1.f, alB = 1.f;
        LAS char* const Qw = lds + OFF_Q + wid * 8192 + lane * 16;
#pragma unroll
        for (int d0 = 0; d0 < 8; ++d0) *reinterpret_cast<LAS bf16x8*>(Qw + d0 * 1024) = qr[d0];
        SLOADK(64, 1); SBAR();
        qkt_lq(pA0, pA1, K_lds, r32, hi, Qw);
        stage_b1<MODE>(pA0, pA1, alA, m_reg, 0, qb, qlo, qpos, hi, sel, dm16, dm4, aux, M2row);
        SBAR(); VM_WAIT(); LDS_WAIT(); WG_BAR();
        for (int t = 1; t + 1 < NT; t += 2) { HALF_STEP(pB0, pB1, alB, pA0, pA1, alA, t); HALF_STEP(pA0, pA1, alA, pB0, pB1, alB, t + 1); }
        HALF_STEP(pB0, pB1, alB, pA0, pA1, alA, NT - 1);
        { bf16x8 pa0, pa1, pa2, pa3;
            stage_b2<MODE>(pB0, pB1, alB, l_reg, den, NT - 1, qpos, hi, aux, M2row, pa0, pa1, pa2, pa3);
            RESC(alB); pv_tile(o, vb0 + ((NT - 1) & 1) * SHM, pa0, pa1, pa2, pa3); }
        LDS_WAIT(); WG_BAR();
#undef HALF_STEP
#undef RESC
#undef SLOADV
#undef SLOADK
    } else
    for (int i = 0; i < NT; ++i) {
        const int tj = TJ(i), kb = tj * 64, buf = i & 1;
        if constexpr (MODE == MODE_SB) { if (i > 0) { const int f = dflag[(lane & 7) * 64 + ((i - 1) & 1)]; if (__all(f != 0)) break; } }
        if (i + 1 < NT) SLOAD(TJ(i + 1) * 64, buf ^ 1);
        SBAR();
        bool act = (MODE == MODE_SB) ? (kb <= qlo + 30 && !wdone) : (kb <= qlo + 31);
        if constexpr (MODE == MODE_MOBA) { const int n = tj >> 2; if (n != qb) act = act && __any((int)((sel >> n) & 1u)); }
        if (act) {
            f32x16 p0, p1; bf16x8 pa0, pa1, pa2, pa3;
            qkt(p0, p1, K_lds + buf * SHM, r32, hi, qr);
            const int dq = qpos - kb - 4 * hi;
            if constexpr (MODE == MODE_DIL || MODE == MODE_MOBA) {
                if constexpr (MODE == MODE_DIL) {
                  const int dlo = qlo - kb - 63, dhi2 = qlo + 31 - kb;
                  if (dlo > 512) {
#pragma unroll
                    for (int r = 0; r < 16; ++r) { const float t = ((dm16 >> r) & 1u) ? 0.f : -__builtin_inff(); p0[r] += t; p1[r] += t; }
                  } else if (dlo > 128 && dhi2 <= 512) {
#pragma unroll
                    for (int r = 0; r < 16; ++r) { const float t = ((dm16 >> r) & 1u) ? (1.0f / C2) : (((dm4 >> r) & 1u) ? 0.f : -__builtin_inff()); p0[r] += t; p1[r] += t; }
                  } else {
#pragma unroll
                    for (int r = 0; r < 16; ++r) { const int c = (r & 3) + 8 * (r >> 2);
                        { const unsigned ud = (unsigned)(dq - c); const int cnt = (int)(ud <= 128u) + (int)(((ud & 3u) == 0u) & (ud <= 512u)) + (int)((ud & 0x8000000Fu) == 0u);
                          p0[r] += __builtin_amdgcn_logf((float)cnt) * (1.0f / C2); }
                        { const unsigned ud = (unsigned)(dq - c - 32); const int cnt = (int)(ud <= 128u) + (int)(((ud & 3u) == 0u) & (ud <= 512u)) + (int)((ud & 0x8000000Fu) == 0u);
                          p1[r] += __builtin_amdgcn_logf((float)cnt) * (1.0f / C2); } }
                  }
                } else {
                    const int n = tj >> 2;
                    if (n == qb) { if (kb + 63 > qlo) mask_tile(p0, p1, dq); }
                    else if (!((sel >> n) & 1u)) {
#pragma unroll
                        for (int r = 0; r < 16; ++r) { p0[r] = -__builtin_inff(); p1[r] = -__builtin_inff(); } }
                }
                float mn, alpha;
                partialSM(p0, p1, m_reg, mn, alpha);
                float ps = 0.f;
#pragma unroll
                for (int r = 0; r < 16; ++r) ps += p0[r];
#pragma unroll
                for (int r = 0; r < 16; ++r) ps += p1[r];
                ps = pair_sum(ps);
                l_reg = l_reg * alpha + ps;
                pack_p(p0, p1, pa0, pa1, pa2, pa3);
                if (__any(alpha < 1.f)) { if (hi == 0) al_l[r32] = alpha; LDS_WAIT();
#pragma unroll
                    for (int d_ = 0; d_ < 4; ++d_)
#pragma unroll
                        for (int r = 0; r < 16; ++r) o[d_][r] *= al_l[crow(r, hi)]; }
            } else if constexpr (MODE == MODE_ML) {
                float dsum = 0.f;
#pragma unroll
                for (int r4 = 0; r4 < 4; ++r4) {
                    const f32x4 a0 = *(const LAS f32x4*)(aux + kb + 8 * r4 + 4 * hi), a1 = *(const LAS f32x4*)(aux + kb + 32 + 8 * r4 + 4 * hi);
                    const float rf0 = SCALE * __builtin_amdgcn_exp2f(a0[0] - M2row), rf1 = SCALE * __builtin_amdgcn_exp2f(a1[0] - M2row);
#pragma unroll
                    for (int j = 0; j < 4; ++j) { const int r = 4 * r4 + j, c = 8 * r4 + j;
                        float s0 = p0[r] * (j == 0 ? rf0 : rf0 * a0[j]); s0 = (dq - c < 0) ? 0.f : s0;
                        float s1 = p1[r] * (j == 0 ? rf1 : rf1 * a1[j]); s1 = (dq - c - 32 < 0) ? 0.f : s1;
                        p0[r] = s0; p1[r] = s1; dsum += s0 + s1; } }
                den += dsum;
                pack_p(p0, p1, pa0, pa1, pa2, pa3);
            } else {
                f32x16 z0, z1; float gs[8];
#pragma unroll
                for (int r = 0; r < 16; ++r) { const int c = (r & 3) + 8 * (r >> 2);
                    { const float z2 = p0[r] * C2; const float sp = fmaxf(z2, 0.f) + __builtin_amdgcn_logf(1.0f + __builtin_amdgcn_exp2f(-fabsf(z2)));
                      z0[r] = z2; const float spm = ((dq - 1 - c) >= 0) ? sp : 0.f; p0[r] = spm; if ((r & 3) == 0) gs[r >> 2] = spm; else gs[r >> 2] += spm; }
                    { const float z2 = p1[r] * C2; const float sp = fmaxf(z2, 0.f) + __builtin_amdgcn_logf(1.0f + __builtin_amdgcn_exp2f(-fabsf(z2)));
                      z1[r] = z2; const float spm = ((dq - 1 - c - 32) >= 0) ? sp : 0.f; p1[r] = spm; if ((r & 3) == 0) gs[4 + (r >> 2)] = spm; else gs[4 + (r >> 2)] += spm; } }
                float aft[8]; float run = 0.f;
#pragma unroll
                for (int i2 = 7; i2 >= 0; --i2) { const float pg = __shfl_xor(gs[i2], 32); aft[i2] = run + (hi == 0 ? pg : 0.f); run += gs[i2] + pg; }
#pragma unroll
                for (int i2 = 0; i2 < 8; ++i2) { float suf = Rsum + aft[i2];
#pragma unroll
                    for (int j = 3; j >= 0; --j) { const int r = 4 * (i2 & 3) + j, c = 8 * (i2 & 3) + j + ((i2 >> 2) ? 32 : 0);
                        const bool ok = (dq - 1 - c) >= 0;
                        if (i2 >> 2) { suf += p1[r]; p1[r] = ok ? __builtin_amdgcn_exp2f(z1[r] - suf) : 0.f; }
                        else { suf += p0[r]; p0[r] = ok ? __builtin_amdgcn_exp2f(z0[r] - suf) : 0.f; } } }
                Rsum += run;
                pack_p(p0, p1, pa0, pa1, pa2, pa3);
            }
            SBAR();
            pv_tile(o, vb0 + buf * SHM, pa0, pa1, pa2, pa3);
        }
        SBAR();
        if constexpr (MODE == MODE_SB) { if (!wdone) wdone = __all(Rsum - zbnd > 64.f) != 0; if (lane == 0) dflag[wid * 64 + (i & 1)] = wdone ? 1 : 0; }
        VM_WAIT(); LDS_WAIT(); WG_BAR();
    }
    if constexpr (MODE == MODE_DIL || MODE == MODE_MOBA) { if (hi == 0) li_l[r32] = l_reg; }
    if constexpr (MODE == MODE_ML) { const float dt = pair_sum(den); if (hi == 0) li_l[r32] = fmaxf(fabsf(dt), nmrow); }
    LDS_WAIT();
    LAS char* const Ost = lds + OFF_Q + wid * 8192;
#pragma unroll
    for (int r = 0; r < 16; ++r) { const int orow = crow(r, hi);
        float rl = 1.f; if constexpr (MODE != MODE_SB) rl = __builtin_amdgcn_rcpf(li_l[orow]);
#pragma unroll
        for (int d0 = 0; d0 < 4; ++d0) { const float v = o[d0][r] * rl;
            *(LAS unsigned short*)(Ost + orow * 256 + (((d0 * 32 + r32) * 2) ^ ((orow & 4) << 4))) = (unsigned short)cvtpk(v, v); } }
    LDS_WAIT();
    bf16* Ow = Op + (size_t)qlo * ldo;
#pragma unroll
    for (int j = 0; j < 8; ++j) { const int row = j * 4 + (lane >> 4), cb = (lane & 15) * 16;
        const u32x4 w = *(const LAS u32x4*)(Ost + row * 256 + (cb ^ ((row & 4) << 4)));
        *(u32x4*)((char*)(Ow + (size_t)row * ldo) + cb) = w; }
    LDS_WAIT();
#undef TJ
#undef SLOAD
}
}


struct Frame {
    LAS unsigned char* lds; int tid, lane, wave, vcu, G, gw, NGW;
};

template <bool FOLD>
__device__ __forceinline__ void tr_item(const float* __restrict__ W, int K, int N, bf16* __restrict__ WT, int item, int nblk, LAS unsigned* scr, int lane, int rmode, const float* lg, const float* lb, float* cs, float* bs) {
    const int kb = item / nblk, nb = item - kb * nblk, k0 = kb * 64, n0 = nb * 64;
    const int nq = lane & 15, kr = lane >> 4;
    const bool inb = (n0 + 4 * nq) < N;
    f32x4 a[8], b[8];
#pragma unroll
    for (int s = 0; s < 8; ++s) { const int kp = 4 * s + kr; const float* p = W + (size_t)(k0 + 2 * kp) * N + (inb ? n0 + 4 * nq : 0);
        a[s] = __builtin_nontemporal_load((const f32x4*)p); b[s] = __builtin_nontemporal_load((const f32x4*)(p + N)); }
    if (!inb) {
#pragma unroll
        for (int s = 0; s < 8; ++s) { a[s] = (f32x4){0.f, 0.f, 0.f, 0.f}; b[s] = (f32x4){0.f, 0.f, 0.f, 0.f}; } }
    f32x4 csum = {0.f, 0.f, 0.f, 0.f}, bsum = {0.f, 0.f, 0.f, 0.f};
    if constexpr (FOLD) {
#pragma unroll
        for (int s = 0; s < 8; ++s) { const int k = k0 + 2 * (4 * s + kr); const f32x2 g2 = *(const f32x2*)(lg + k), b2 = *(const f32x2*)(lb + k);
            bsum += a[s] * b2[0] + b[s] * b2[1]; a[s] = a[s] * g2[0]; b[s] = b[s] * g2[1]; }
    }
#pragma unroll
    for (int s = 0; s < 8; ++s) { const int kp = 4 * s + kr;
#pragma unroll
        for (int i = 0; i < 4; ++i) { const unsigned pk = cvtpk(a[s][i], b[s][i]); scr[(4 * nq + i) * 33 + kp] = pk; if constexpr (FOLD) csum[i] += bf_lo(pk) + bf_hi(pk); } }
    LDS_WAIT();
#pragma unroll
    for (int jj = 0; jj < 8; ++jj) { const int n = (lane >> 3) + 8 * jj, c = lane & 7; const LAS unsigned* s = scr + n * 33 + 4 * c;
        u32x4 o; o.x = s[0]; o.y = s[1]; o.z = s[2]; o.w = s[3];
        const int nn = n0 + n, drow = rmode ? (((nn >> 7) << 8) + (nn & 127) + (rmode == 2 ? 128 : 0)) : nn;
        *(u32x4*)(WT + (size_t)drow * K + k0 + 8 * c) = o; }
    LDS_WAIT();
    if constexpr (FOLD) {
#pragma unroll
        for (int i = 0; i < 4; ++i) { csum[i] += __shfl_xor(csum[i], 16); csum[i] += __shfl_xor(csum[i], 32); bsum[i] += __shfl_xor(bsum[i], 16); bsum[i] += __shfl_xor(bsum[i], 32); }
        LAS float* fs = (LAS float*)scr;
        if (kr == 0) { *(LAS f32x4*)(fs + 4 * nq) = csum; *(LAS f32x4*)(fs + 64 + 4 * nq) = bsum; }
        LDS_WAIT();
        const int nn = n0 + lane, drow = rmode ? (((nn >> 7) << 8) + (nn & 127) + (rmode == 2 ? 128 : 0)) : nn;
        if (nn < N) { unsafeAtomicAdd(cs + drow, fs[lane]); unsafeAtomicAdd(bs + drow, fs[64 + lane]); }
        LDS_WAIT();
    }
}

constexpr int I_INAB = 64 * 192, I_OUT = 64 * 64, I_INCD = 64 * 196, I_UP = 64 * 172, I_DN = 172 * 64;
constexpr int Q_OUTAB = I_OUT, Q_UG0 = Q_OUTAB + 2 * I_UP, Q_DN0 = Q_UG0 + I_DN, Q_INCD = Q_DN0 + I_INCD, Q_OUTCD = Q_INCD + I_OUT, Q_UG1 = Q_OUTCD + 2 * I_UP, Q_TOTAL = Q_UG1 + I_DN;
__device__ __forceinline__ void conv_queue_item(const Args& a, int q, LAS unsigned* scr, int lane) {
    unsigned char* ws = a.ws; unsigned char* ctl = ws + WS_CTL;
    int r = q; const float* W; int K, N, nblk; bf16* WT; int rmode = 0; const float* lg = nullptr; const float* lb = nullptr; float* cs = nullptr; float* bs = nullptr;
    if (r < I_OUT) { W = a.in[2]; K = DM; N = DM; nblk = 64; WT = (bf16*)(ws + WS_W_OUTAB); }
    else if ((r -= I_OUT) < I_UP) { W = a.in[9]; K = DM; N = DFF; nblk = 172; WT = (bf16*)(ws + WS_W_UG0); rmode = 1; lg = a.in[14]; lb = a.in[15]; cs = (float*)(ctl + CTL_CS_UG0); bs = (float*)(ctl + CTL_BS_UG0); }
    else if ((r -= I_UP) < I_UP) { W = a.in[10]; K = DM; N = DFF; nblk = 172; WT = (bf16*)(ws + WS_W_UG0); rmode = 2; lg = a.in[14]; lb = a.in[15]; cs = (float*)(ctl + CTL_CS_UG0); bs = (float*)(ctl + CTL_BS_UG0); }
    else if ((r -= I_UP) < I_DN) { W = a.in[13]; K = DFF; N = DM; nblk = 64; WT = (bf16*)(ws + WS_W_DN0); }
    else if ((r -= I_DN) < I_INCD) { W = a.in[3]; K = DM; N = N_CD; nblk = 196; WT = (bf16*)(ws + WS_W_INCD); lg = a.in[14] + DM; lb = a.in[15] + DM; cs = (float*)(ctl + CTL_CS_INCD); bs = (float*)(ctl + CTL_BS_INCD); }
    else if ((r -= I_INCD) < I_OUT) { W = a.in[8]; K = DM; N = DM; nblk = 64; WT = (bf16*)(ws + WS_W_OUTCD); }
    else if ((r -= I_OUT) < I_UP) { W = a.in[9] + (size_t)DM * DFF; K = DM; N = DFF; nblk = 172; WT = (bf16*)(ws + WS_W_UG1); rmode = 1; lg = a.in[14] + 2 * DM; lb = a.in[15] + 2 * DM; cs = (float*)(ctl + CTL_CS_UG1); bs = (float*)(ctl + CTL_BS_UG1); }
    else if ((r -= I_UP) < I_UP) { W = a.in[10] + (size_t)DM * DFF; K = DM; N = DFF; nblk = 172; WT = (bf16*)(ws + WS_W_UG1); rmode = 2; lg = a.in[14] + 2 * DM; lb = a.in[15] + 2 * DM; cs = (float*)(ctl + CTL_CS_UG1); bs = (float*)(ctl + CTL_BS_UG1); }
    else { r -= I_UP; W = a.in[13] + (size_t)DFF * DM; K = DFF; N = DM; nblk = 64; WT = (bf16*)(ws + WS_W_DN1); }
    if (lg) tr_item<true>(W, K, N, WT, r, nblk, scr, lane, rmode, lg, lb, cs, bs); else tr_item<false>(W, K, N, WT, r, nblk, scr, lane, rmode, lg, lb, cs, bs);
}
__device__ __forceinline__ void prologue(const Frame& F_, const Args& a) {
    Frame F = F_; F.tid = tid_of(F.wave); F.lane = F.tid & 63; asm volatile("" : "+v"(F.lane), "+v"(F.tid), "+s"(F.gw), "+s"(F.vcu), "+s"(F.wave));
    unsigned char* ws = a.ws;
    LAS unsigned* scr = (LAS unsigned*)(F.lds + F.wave * 8448);
    for (int it = F.gw; it < I_INAB; it += F.NGW)
        tr_item<false>(a.in[1], DM, N_AB, (bf16*)(ws + WS_W_INAB), it, 192, scr, F.lane, 0, nullptr, nullptr, nullptr, nullptr);
    const f32x4* x4 = (const f32x4*)a.in[0]; u32x2* xb = (u32x2*)(ws + WS_XB);
    for (size_t i = (size_t)F.gw * 64 + F.lane; i < (size_t)M * DM / 4; i += (size_t)F.NGW * 64) { const f32x4 v = __builtin_nontemporal_load(x4 + i); u32x2 o; o.x = cvtpk(v[0], v[1]); o.y = cvtpk(v[2], v[3]); xb[i] = o; }
}
template <int SEAM>
__device__ __forceinline__ void seam_wait(const Frame& F_, const Args& args, const XcdBarrier& bar, unsigned char* ws_, int limit) {
    Frame F = F_; F.tid = tid_of(F.wave); F.lane = F.tid & 63; asm volatile("" : "+v"(F.lane), "+v"(F.tid), "+s"(F.wave));
    unsigned* qw = (unsigned*)(opq_p(ws_) + WS_CTL + CTL_QUEUE);
    volatile LAS unsigned* sh = (volatile LAS unsigned*)(F.lds + CTRL_OFF + 768);
    LAS unsigned* scr = (LAS unsigned*)(F.lds + F.wave * 8448);
    const unsigned G = (unsigned)F.G;
    asm volatile("s_waitcnt vmcnt(0)" ::: "memory");
    __syncthreads();
    unsigned arrived = 0u;
    if (F.tid == 0) arrived = xb_add(&qw[64 * (SEAM + 1)], 1u) + 1u;
    for (;;) {
        if (F.tid == 0) {
            unsigned h = 0xffffffffu;
            const unsigned hp = xb_ld(&qw[0]);
            if (hp < (unsigned)Q_TOTAL) {
                if (arrived < G) arrived = xb_ld(&qw[64 * (SEAM + 1)]);
                if (arrived < G || hp < (unsigned)limit) h = xb_add(&qw[0], 8u);
            }
            sh[0] = h;
        }
        __syncthreads();
        const unsigned h = sh[0];
        __syncthreads();
        if (h >= (unsigned)Q_TOTAL) break;
        const int q = (int)h + F.wave;
        if (q < Q_TOTAL) conv_queue_item(args, q, scr, F.lane);
    }
    xcd_barrier(bar);
}

__device__ __forceinline__ void ln_phase(const Frame& F_, const bf16* zb, float* xo, const float* g, const float* b) {
    Frame F = F_; F.tid = tid_of(F.wave); F.lane = F.tid & 63; asm volatile("" : "+v"(F.lane), "+v"(F.tid), "+s"(F.gw), "+s"(F.vcu), "+s"(F.wave));
    f32x4 gv[8][2], bv[8][2];
#pragma unroll
    for (int j = 0; j < 8; ++j) { const float* gp = g + 8 * (F.lane + 64 * j); const float* bp = b + 8 * (F.lane + 64 * j);
        gv[j][0] = *(const f32x4*)gp; gv[j][1] = *(const f32x4*)(gp + 4); bv[j][0] = *(const f32x4*)bp; bv[j][1] = *(const f32x4*)(bp + 4); }
    for (int m = F.gw; m < M; m += F.NGW) {
        const u32x4* zr = (const u32x4*)(zb + (size_t)m * DM) + F.lane;
        u32x4 w[8];
#pragma unroll
        for (int j = 0; j < 8; ++j) w[j] = __builtin_nontemporal_load(zr + 64 * j);
        f32x4 v[8][2]; float s = 0.f;
#pragma unroll
        for (int j = 0; j < 8; ++j) { v[j][0] = (f32x4){bf_lo(w[j].x), bf_hi(w[j].x), bf_lo(w[j].y), bf_hi(w[j].y)}; v[j][1] = (f32x4){bf_lo(w[j].z), bf_hi(w[j].z), bf_lo(w[j].w), bf_hi(w[j].w)};
            s += ((v[j][0][0] + v[j][0][1]) + (v[j][0][2] + v[j][0][3])) + ((v[j][1][0] + v[j][1][1]) + (v[j][1][2] + v[j][1][3])); }
        const float mean = wave_sum(s) * (1.f / DM); float s2 = 0.f;
#pragma unroll
        for (int j = 0; j < 8; ++j)
#pragma unroll
            for (int h = 0; h < 2; ++h) { v[j][h] = v[j][h] - mean; s2 += (v[j][h][0] * v[j][h][0] + v[j][h][1] * v[j][h][1]) + (v[j][h][2] * v[j][h][2] + v[j][h][3] * v[j][h][3]); }
        const float rstd = 1.f / sqrtf(wave_sum(s2) * (1.f / DM) + LN_EPS);
        float* xr = xo + (size_t)m * DM + 8 * F.lane;
#pragma unroll
        for (int j = 0; j < 8; ++j)
#pragma unroll
            for (int h = 0; h < 2; ++h) __builtin_nontemporal_store(v[j][h] * rstd * gv[j][h] + bv[j][h], (f32x4*)(xr + 512 * j + 4 * h));
    }
}

__device__ __forceinline__ void ffn_fix_phase(const Frame& F_, bf16* H, const float* EG0, const float* EU0, const float* EGL, const float* cw, const float* cb) {
    Frame F = F_; F.tid = tid_of(F.wave); F.lane = F.tid & 63; asm volatile("" : "+v"(F.lane), "+v"(F.tid), "+s"(F.gw), "+s"(F.vcu), "+s"(F.wave));
    constexpr int C4 = DFF / 4;
    for (int idx = F.gw * 64 + F.lane; idx < 64 * C4; idx += F.NGW * 64) {
        const int pm = idx / C4, ch = (idx - pm * C4) * 4;
        f32x4 gl0 = {0.f, 0.f, 0.f, 0.f}, gl1 = gl0;
        if ((pm & 7) != 0) { gl0 = *(const f32x4*)(EGL + (size_t)((pm - 1) * 2) * DFF + ch); gl1 = *(const f32x4*)(EGL + (size_t)((pm - 1) * 2 + 1) * DFF + ch); }
        const f32x4 g0 = *(const f32x4*)(EG0 + (size_t)(pm * 2) * DFF + ch), g1 = *(const f32x4*)(EG0 + (size_t)(pm * 2 + 1) * DFF + ch);
        const f32x4 u0 = *(const f32x4*)(EU0 + (size_t)(pm * 2) * DFF + ch), u1 = *(const f32x4*)(EU0 + (size_t)(pm * 2 + 1) * DFF + ch);
        const f32x4 w0 = *(const f32x4*)(cw + ch), w1 = *(const f32x4*)(cw + DFF + ch), w2 = *(const f32x4*)(cw + 2 * DFF + ch), bb = *(const f32x4*)(cb + ch);
        const f32x4 y0 = w0 * gl0 + w1 * gl1 + w2 * g0 + bb, y1 = w0 * gl1 + w1 * g0 + w2 * g1 + bb;
        u32x2 o0, o1;
        o0.x = cvtpk(silu_f(y0[0]) * u0[0], silu_f(y0[1]) * u0[1]); o0.y = cvtpk(silu_f(y0[2]) * u0[2], silu_f(y0[3]) * u0[3]);
        o1.x = cvtpk(silu_f(y1[0]) * u1[0], silu_f(y1[1]) * u1[1]); o1.y = cvtpk(silu_f(y1[2]) * u1[2], silu_f(y1[3]) * u1[3]);
        *(u32x2*)(H + (size_t)(pm * 256) * DFF + ch) = o0; *(u32x2*)(H + (size_t)(pm * 256 + 1) * DFF + ch) = o1;
    }
}

__device__ __forceinline__ void kmean_phase(const Frame& F_, const bf16* QKV, float* kmean) {
    Frame F = F_; F.tid = tid_of(F.wave); F.lane = F.tid & 63; asm volatile("" : "+v"(F.lane), "+v"(F.tid), "+s"(F.gw), "+s"(F.vcu), "+s"(F.wave));
    LAS float* red = (LAS float*)F.lds;
    for (int it = F.vcu; it < 256; it += F.G) {
        const int b = it >> 5, n = (it >> 2) & 7, cbk = it & 3;
        const bf16* src = QKV + (size_t)(b * SEQ + n * 256 + F.wave * 32) * N_AB + 8192 + cbk * 512 + F.lane * 8;
        float acc[8];
#pragma unroll
        for (int j = 0; j < 8; ++j) acc[j] = 0.f;
        for (int r8 = 0; r8 < 32; r8 += 8) { u32x4 v[8];
#pragma unroll
            for (int r = 0; r < 8; ++r) v[r] = *(const u32x4*)(src + (size_t)(r8 + r) * N_AB);
#pragma unroll
            for (int r = 0; r < 8; ++r)
#pragma unroll
                for (int q = 0; q < 4; ++q) { acc[2 * q] += bf_lo(v[r][q]); acc[2 * q + 1] += bf_hi(v[r][q]); } }
#pragma unroll
        for (int j = 0; j < 8; ++j) red[F.wave * 512 + F.lane * 8 + j] = acc[j];
        LDS_WAIT(); WG_BAR();
        float s = 0.f;
#pragma unroll
        for (int w = 0; w < 8; ++w) s += red[w * 512 + F.tid];
        const int col = cbk * 512 + F.tid, h = col >> 7, d = col & 127;
        kmean[((size_t)(b * 16 + h) * 8 + n) * 128 + d] = s * (1.f / 256.f);
        LDS_WAIT(); WG_BAR();
    }
}

__device__ __forceinline__ void cd_pre_phase(const Frame& F_, const bf16* QKV, bf16* QKDC, const float* cw  , const float* cb, const float* gates, const float* bif, float* A2, float* M2, float* NM, unsigned* kn2) {
    Frame F = F_; F.tid = tid_of(F.wave); F.lane = F.tid & 63; asm volatile("" : "+v"(F.lane), "+v"(F.tid), "+s"(F.gw), "+s"(F.vcu), "+s"(F.wave));
    for (int it = F.gw; it < (M / 32) * 4; it += F.NGW) {
        const int rb = it >> 2, cbk = it & 3, c0 = cbk * 512 + F.lane * 8, r0 = rb * 32;
        float w[4][8], bb[8];
#pragma unroll
        for (int q = 0; q < 2; ++q) { const f32x4 t3 = *(const f32x4*)(cb + c0 + 4 * q);
#pragma unroll
            for (int j = 0; j < 4; ++j) bb[4 * q + j] = t3[j];
#pragma unroll
            for (int k = 0; k < 4; ++k) { const f32x4 t = *(const f32x4*)(cw + k * 2048 + c0 + 4 * q);
#pragma unroll
                for (int j = 0; j < 4; ++j) w[k][4 * q + j] = t[j]; } }
        const bf16* src = QKV + 6144 + c0;
        u32x4 x3 = {0u, 0u, 0u, 0u}, x2 = x3, x1 = x3;
        if ((r0 & (SEQ - 1)) != 0) { x3 = *(const u32x4*)(src + (size_t)(r0 - 3) * N_AB); x2 = *(const u32x4*)(src + (size_t)(r0 - 2) * N_AB); x1 = *(const u32x4*)(src + (size_t)(r0 - 1) * N_AB); }
        for (int t8 = 0; t8 < 32; t8 += 8) {
            u32x4 xv[8];
#pragma unroll
            for (int t = 0; t < 8; ++t) xv[t] = *(const u32x4*)(src + (size_t)(r0 + t8 + t) * N_AB);
#pragma unroll
            for (int t = 0; t < 8; ++t) { u32x4 ov;
#pragma unroll
                for (int q = 0; q < 4; ++q) {
                    const float y0 = w[0][2 * q] * bf_lo(x3[q]) + w[1][2 * q] * bf_lo(x2[q]) + w[2][2 * q] * bf_lo(x1[q]) + w[3][2 * q] * bf_lo(xv[t][q]) + bb[2 * q];
                    const float y1 = w[0][2 * q + 1] * bf_hi(x3[q]) + w[1][2 * q + 1] * bf_hi(x2[q]) + w[2][2 * q + 1] * bf_hi(x1[q]) + w[3][2 * q + 1] * bf_hi(xv[t][q]) + bb[2 * q + 1];
                    ov[q] = cvtpk(silu_f(y0), silu_f(y1)); }
                *(u32x4*)(QKDC + (size_t)(r0 + t8 + t) * 2048 + c0) = ov; x3 = x2; x2 = x1; x1 = xv[t]; }
        }
    }
    for (int it = F.gw; it < (M / 64) * 16; it += F.NGW) {
        const int rb = it >> 4, h = it & 15, row = rb * 64 + F.lane;
        const u32x4* kp = (const u32x4*)(QKV + (size_t)row * N_AB + 2048 + h * 128); float s = 0.f;
#pragma unroll
        for (int j = 0; j < 16; ++j) { const u32x4 v = kp[j];
            s = fmaf(bf_lo(v.x), bf_lo(v.x), s); s = fmaf(bf_hi(v.x), bf_hi(v.x), s); s = fmaf(bf_lo(v.y), bf_lo(v.y), s); s = fmaf(bf_hi(v.y), bf_hi(v.y), s);
            s = fmaf(bf_lo(v.z), bf_lo(v.z), s); s = fmaf(bf_hi(v.z), bf_hi(v.z), s); s = fmaf(bf_lo(v.w), bf_lo(v.w), s); s = fmaf(bf_hi(v.w), bf_hi(v.w), s); }
#pragma unroll
        for (int o = 1; o < 64; o <<= 1) s = fmaxf(s, __shfl_xor(s, o));
        if (F.lane == 0) atomicMax(kn2 + (row >> 11) * 16 + h, __float_as_uint(s));
    }
    for (int sq = F.gw; sq < 64; sq += F.NGW) {
        const int b = sq >> 3, h = sq & 7; const float bi = bif[h], bfv = bif[8 + h];
        const float* gp = gates + (size_t)(b * SEQ + F.lane * 32) * 16;
        float lf[32], ai[32]; float run = 0.f;
#pragma unroll
        for (int t = 0; t < 32; ++t) { lf[t] = gp[t * 16 + 8 + h]; ai[t] = gp[t * 16 + h]; }
#pragma unroll
        for (int t = 0; t < 32; ++t) asm volatile("" : "+v"(lf[t]), "+v"(ai[t]));
#pragma unroll
        for (int t = 0; t < 32; ++t) { const float f = lf[t] + bfv; ai[t] += bi;
            const float ls = fminf(f, 0.f) - log1pf(expf(-fabsf(f)));
            run += ls; lf[t] = run; }
        float incl = run;
#pragma unroll
        for (int o = 1; o < 64; o <<= 1) { const float t = __shfl_up(incl, o); if (F.lane >= o) incl += t; }
        const float base = incl - run; float mx = -__builtin_inff();
#pragma unroll
        for (int t = 0; t < 32; ++t) { lf[t] += base; ai[t] -= lf[t]; mx = fmaxf(mx, ai[t]); }
        float minc = mx;
#pragma unroll
        for (int o = 1; o < 64; o <<= 1) { const float t = __shfl_up(minc, o); if (F.lane >= o) minc = fmaxf(minc, t); }
        float mprev = __shfl_up(minc, 1); if (F.lane == 0) mprev = -__builtin_inff();
        float cm = fmaxf(mprev, 0.f);
        float* a2o = A2 + (size_t)sq * SEQ + F.lane * 32; float* m2o = M2 + (size_t)sq * SEQ + F.lane * 32; float* nmo = NM + (size_t)sq * SEQ + F.lane * 32;
#pragma unroll
        for (int t = 0; t < 32; ++t) { cm = fmaxf(cm, ai[t]); a2o[t] = ai[t] * 1.4426950408889634f; m2o[t] = cm * 1.4426950408889634f; nmo[t] = expf(-lf[t] - cm); }
    }
}

__device__ __forceinline__ void cd_post_phase(const Frame& F_, const bf16* HD, const bf16* QKV, bf16* Y, const float* ng) {
    Frame F = F_; F.tid = tid_of(F.wave); F.lane = F.tid & 63; asm volatile("" : "+v"(F.lane), "+v"(F.tid), "+s"(F.gw), "+s"(F.vcu), "+s"(F.wave));
    for (int m = F.gw; m < M; m += F.NGW) {
        u32x2 hv[8], ov[8]; f32x4 g[8];
#pragma unroll
        for (int h = 0; h < 8; ++h) { const int c = h * 256 + F.lane * 4; hv[h] = *(const u32x2*)(HD + (size_t)m * 2048 + c); ov[h] = *(const u32x2*)(QKV + (size_t)m * N_AB + 10240 + c); g[h] = *(const f32x4*)(ng + c); }
        float v[8][4], s1[8], s2[8];
#pragma unroll
        for (int h = 0; h < 8; ++h) { v[h][0] = bf_lo(hv[h].x); v[h][1] = bf_hi(hv[h].x); v[h][2] = bf_lo(hv[h].y); v[h][3] = bf_hi(hv[h].y); s1[h] = (v[h][0] + v[h][1]) + (v[h][2] + v[h][3]); }
#pragma unroll
        for (int o = 1; o < 64; o <<= 1)
#pragma unroll
            for (int h = 0; h < 8; ++h) s1[h] += __shfl_xor(s1[h], o);
#pragma unroll
        for (int h = 0; h < 8; ++h) { const float mean = s1[h] * (1.f / 256.f);
#pragma unroll
            for (int j = 0; j < 4; ++j) v[h][j] -= mean;
            s2[h] = (v[h][0] * v[h][0] + v[h][1] * v[h][1]) + (v[h][2] * v[h][2] + v[h][3] * v[h][3]); }
#pragma unroll
        for (int o = 1; o < 64; o <<= 1)
#pragma unroll
            for (int h = 0; h < 8; ++h) s2[h] += __shfl_xor(s2[h], o);
#pragma unroll
        for (int h = 0; h < 8; ++h) { const float rstd = 1.f / sqrtf(s2[h] * (1.f / 256.f) + LN_EPS);
            const float o0 = bf_lo(ov[h].x), o1 = bf_hi(ov[h].x), o2 = bf_lo(ov[h].y), o3 = bf_hi(ov[h].y);
            const float y0 = v[h][0] * rstd * g[h][0] * __builtin_amdgcn_rcpf(1.f + __builtin_amdgcn_exp2f(-1.4426950408889634f * o0));
            const float y1 = v[h][1] * rstd * g[h][1] * __builtin_amdgcn_rcpf(1.f + __builtin_amdgcn_exp2f(-1.4426950408889634f * o1));
            const float y2 = v[h][2] * rstd * g[h][2] * __builtin_amdgcn_rcpf(1.f + __builtin_amdgcn_exp2f(-1.4426950408889634f * o2));
            const float y3 = v[h][3] * rstd * g[h][3] * __builtin_amdgcn_rcpf(1.f + __builtin_amdgcn_exp2f(-1.4426950408889634f * o3));
            u32x2 w; w.x = cvtpk(y0, y1); w.y = cvtpk(y2, y3);
            *(u32x2*)(Y + (size_t)m * DM + 2048 + h * 256 + F.lane * 4) = w; }
    }
}


#define GRID_BAR() xcd_barrier(bar)
#define PHASE_BEGIN constexpr int L = LAYER; GAS unsigned char* const W = (GAS unsigned char*)opq_p(ws); (void)L; (void)W;
template <int LAYER>
__device__ __forceinline__ void layer_body(const Frame& F, const Args& args, const XcdBarrier& bar, unsigned char* ws) {
    constexpr int layer = LAYER;
        { PHASE_BEGIN
            pg8::Gemm g{(const bf16*)(W + WS_XB), (const bf16*)(W + (L == 0 ? WS_W_INAB : WS_W_INCD)), M, L == 0 ? N_AB : N_CDP, DM};
            pg8::StaticOrder S; S.init(g.M, g.N, F.G, (int)blockIdx.x);
            pg8::EpiBf16 E{(unsigned char*)W, L, F.wave, F.lds};
            PH(2) pg8::gemm_phase<pg8::EpiBf16, pg8::StaticOrder, true, true>(F.lds, g, S, E);
        }
        seam_wait<LAYER * 8 + 0>(F, args, bar, ws, (LAYER == 0 ? 0 : Q_INCD));
        { PHASE_BEGIN
            if (L == 0) { PH(4) kmean_phase(F, (const bf16*)(W + WS_QKV), (float*)(W + WS_KMEAN)); }
            else PH(8) cd_pre_phase(F, (const bf16*)(W + WS_QKV), (bf16*)(W + WS_QKDC), (const float*)ldin(args, 5), (const float*)ldin(args, 6), (const float*)(W + WS_GATES), (const float*)ldin(args, 4), (float*)(W + WS_A2), (float*)(W + WS_M2), (float*)(W + WS_NM), (unsigned*)(W + WS_CTL + CTL_KN2));
        }
        seam_wait<LAYER * 8 + 1>(F, args, bar, ws, (LAYER == 0 ? 0 : Q_INCD));
        { PHASE_BEGIN
            const bf16* QKV = (const bf16*)(W + WS_QKV); bf16* Y = (bf16*)(W + WS_Y);
            if (L == 0) {
                for (int it = F.vcu; it < 512; it += F.G) { const int bh = it >> 2, pr = it & 3, b = bh >> 4, h = bh & 15;
                    const bf16* base = QKV + (size_t)b * SEQ * N_AB + h * 128; bf16* ob = Y + (size_t)b * SEQ * DM + h * 128;
                    for (int ps = 0; ps < 2; ++ps) PH(16) att::attn_block<att::MODE_DIL>(base, N_AB, base + 2048, N_AB, base + 4096, N_AB, ob, DM, ps ? 7 - pr : pr, (LAS char*)F.lds, nullptr, nullptr, nullptr, F.wave); }
                const float* KMEAN = (const float*)(W + WS_KMEAN);
                for (int it = F.vcu; it < 512; it += F.G) { const int bh = it >> 2, pr = it & 3, b = bh >> 4, h = bh & 15;
                    const bf16* base = QKV + (size_t)b * SEQ * N_AB + 6144 + h * 128; bf16* ob = Y + (size_t)b * SEQ * DM + 2048 + h * 128;
                    for (int ps = 0; ps < 2; ++ps) PH(32) att::attn_block<att::MODE_MOBA>(base, N_AB, base + 2048, N_AB, base + 4096, N_AB, ob, DM, ps ? 7 - pr : pr, (LAS char*)F.lds, KMEAN + (size_t)bh * 1024, nullptr, nullptr, F.wave); }
            } else {
                for (int it = F.vcu; it < 512; it += F.G) { const int bh = it >> 2, pr = it & 3, b = bh >> 4, h = bh & 15;
                    const bf16* base = QKV + (size_t)b * SEQ * N_AB + h * 128; bf16* ob = Y + (size_t)b * SEQ * DM + h * 128;
                    for (int ps = 0; ps < 2; ++ps) PH(64) att::attn_block<att::MODE_SB>(base, N_AB, base + 2048, N_AB, base + 4096, N_AB, ob, DM, ps ? 7 - pr : pr, (LAS char*)F.lds, (const float*)(W + WS_CTL + CTL_KN2) + bh, nullptr, nullptr, F.wave); }
                const bf16* QKDC = (const bf16*)(W + WS_QKDC); bf16* HD = (bf16*)(W + WS_HD); const float* A2 = (const float*)(W + WS_A2); const float* M2 = (const float*)(W + WS_M2); const float* NMv = (const float*)(W + WS_NM);
                for (int it = F.vcu; it < 512; it += F.G) { const int bv = it >> 2, pr = it & 3, b = bv >> 4, vh = bv & 15, h = vh >> 1, half = vh & 1;
                    const bf16* qd = QKDC + (size_t)b * SEQ * 2048 + h * 128; const bf16* vd = QKV + (size_t)b * SEQ * N_AB + 8192 + h * 256 + half * 128;
                    bf16* ob = HD + (size_t)b * SEQ * 2048 + h * 256 + half * 128; const size_t so = (size_t)(b * 8 + h) * SEQ;
                    for (int ps = 0; ps < 2; ++ps) PH(128) att::attn_block<att::MODE_ML>(qd, 2048, qd + 1024, 2048, vd, N_AB, ob, 2048, ps ? 7 - pr : pr, (LAS char*)F.lds, A2 + so, M2 + so, NMv + so, F.wave); }
            }
        }
        if (layer == 1) { seam_wait<LAYER * 8 + 2>(F, args, bar, ws, Q_INCD); PHASE_BEGIN PH(256) cd_post_phase(F, (const bf16*)(W + WS_HD), (const bf16*)(W + WS_QKV), (bf16*)(W + WS_Y), (const float*)ldin(args, 7)); }
        seam_wait<LAYER * 8 + 3>(F, args, bar, ws, (LAYER == 0 ? Q_OUTAB : Q_OUTCD));
        { PHASE_BEGIN
            pg8::Gemm g{(const bf16*)(W + WS_Y), (const bf16*)(W + (L == 0 ? WS_W_OUTAB : WS_W_OUTCD)), M, DM, DM};
            pg8::StaticOrder S; S.init(g.M, g.N, F.G, (int)blockIdx.x);
            pg8::EpiResid E{&args, (unsigned char*)W, L, 0, F.lds, F.wave};
            PH(512) pg8::gemm_phase<pg8::EpiResid, pg8::StaticOrder, true, true>(F.lds, g, S, E);
        }
        seam_wait<LAYER * 8 + 4>(F, args, bar, ws, (LAYER == 0 ? Q_UG0 : Q_UG1));
        { PHASE_BEGIN
            pg8::Gemm g{(const bf16*)(W + WS_XB), (const bf16*)(W + (L == 0 ? WS_W_UG0 : WS_W_UG1)), M, 2 * DFF, DM};
            pg8::StaticOrder S; S.init(g.M, g.N, F.G, (int)blockIdx.x);
            pg8::EpiFfnAct E{&args, (unsigned char*)W, L, F.lds, F.wave};
            PH(2048) pg8::gemm_phase<pg8::EpiFfnAct, pg8::StaticOrder, true, true>(F.lds, g, S, E);
        }
        seam_wait<LAYER * 8 + 5>(F, args, bar, ws, (LAYER == 0 ? Q_UG0 : Q_UG1));
        { PHASE_BEGIN PH(4096) ffn_fix_phase(F, (bf16*)(W + WS_U), (const float*)(W + WS_G), (const float*)(W + WS_G + 8 * MiB), (const float*)(W + WS_G + 16 * MiB), (const float*)ldin(args, 11) + (size_t)L * 3 * DFF, (const float*)ldin(args, 12) + (size_t)L * DFF); }
        seam_wait<LAYER * 8 + 6>(F, args, bar, ws, (LAYER == 0 ? Q_DN0 : Q_TOTAL));
        { PHASE_BEGIN
            pg8::Gemm g{(const bf16*)(W + WS_U), (const bf16*)(W + (L == 0 ? WS_W_DN0 : WS_W_DN1)), M, DM, DFF};
            pg8::StaticOrder S; S.init(g.M, g.N, F.G, (int)blockIdx.x, 2);
            pg8::EpiResid E{&args, (unsigned char*)W, L, 1, F.lds, F.wave};
            PH(8192) pg8::gemm_phase<pg8::EpiResid, pg8::StaticOrder, true, true>(F.lds, g, S, E);
        }
        seam_wait<LAYER * 8 + 7>(F, args, bar, ws, (LAYER == 0 ? Q_INCD : Q_TOTAL));
        if (layer == 1) { PHASE_BEGIN
            PH(1024) ln_phase(F, (const bf16*)(W + WS_XB), args.out, (const float*)ldin(args, 14) + (size_t)3 * DM, (const float*)ldin(args, 15) + (size_t)3 * DM); }
}
#undef PHASE_BEGIN

__global__ void __launch_bounds__(NWAVES * 64, 2) mk_fwd(Args args) {
    extern __shared__ __attribute__((aligned(16))) unsigned char lds_raw[];
    Frame F;
    F.lds = (LAS unsigned char*)lds_raw;
    F.tid = threadIdx.x; F.lane = F.tid & 63; F.wave = __builtin_amdgcn_readfirstlane(F.tid >> 6);
    F.G = gridDim.x; { const int bx = blockIdx.x; F.vcu = (F.G % 8 == 0) ? (bx % 8) * (F.G / 8) + bx / 8 : bx; }
    F.gw = F.vcu * NWAVES + F.wave; F.NGW = F.G * NWAVES;
    unsigned char* ws = args.ws;
    volatile LAS unsigned* MISC = (volatile LAS unsigned*)(F.lds + MISC_OFF);
    for (int u = F.tid; u < (LDS_BYTES - CTRL_OFF) / 4; u += NWAVES * 64) ((LAS unsigned*)(F.lds + CTRL_OFF))[u] = 0u;
    __syncthreads();
    XcdBarrier bar = xcd_barrier_post((unsigned*)(ws + WS_CTL) + CW_BAR, MISC + 8, F.wave);

    PH(1) prologue(F, args);
    GRID_BAR();

    layer_body<0>(F, args, bar, ws);
    layer_body<1>(F, args, bar, ws);
}

extern "C" void kernel_launch(void* const* d_in, const int* in_sizes, int n_in, void* d_out, int out_size, void* d_ws, size_t ws_size, hipStream_t stream) {
    static int grid = 0;
    if (grid == 0) {
        if (n_in != 16 || in_sizes[0] != M * DM || out_size != M * DM || ws_size < WS_END) { fprintf(stderr, "kernel_launch: unexpected shapes (n_in %d, in0 %d, out %d, ws %zu < %zu)\n", n_in, n_in > 0 ? in_sizes[0] : -1, out_size, ws_size, (size_t)WS_END); grid = -1; return; }
        int dev = 0, cus = 0;
        if (hipGetDevice(&dev) != hipSuccess || hipDeviceGetAttribute(&cus, hipDeviceAttributeMultiprocessorCount, dev) != hipSuccess) { grid = -1; return; }
        if (hipFuncSetAttribute((const void*)mk_fwd, hipFuncAttributeMaxDynamicSharedMemorySize, LDS_BYTES) != hipSuccess) { fprintf(stderr, "kernel_launch: hipFuncSetAttribute failed\n"); grid = -1; return; }
        int per_cu = 0;
        if (hipOccupancyMaxActiveBlocksPerMultiprocessor(&per_cu, (const void*)mk_fwd, NWAVES * 64, LDS_BYTES) != hipSuccess || per_cu < 1) fprintf(stderr, "kernel_launch: occupancy query says %d\n", per_cu);
        (void)hipGetLastError();
        grid = cus;
    }
    if (grid < 0) return;
    if (hipMemsetAsync((char*)d_ws + WS_CTL, 0, CTL_ZERO_BYTES, stream) != hipSuccess) return;
    Args a{};
    for (int i = 0; i < 16; ++i) a.in[i] = (const float*)d_in[i];
    a.out = (float*)d_out; a.ws = (unsigned char*)d_ws;
    hipLaunchKernelGGL(mk_fwd, dim3(grid), dim3(NWAVES * 64), LDS_BYTES, stream, a);
}
```

```cpp
#include <hip/hip_runtime.h>
#include <cstdio>
#include <cstdint>

#define LAS __attribute__((address_space(3)))
#define GAS __attribute__((address_space(1)))
typedef unsigned short bf16;
typedef short bf16x8 __attribute__((ext_vector_type(8)));
typedef short s16x4 __attribute__((ext_vector_type(4)));
typedef float f32x16 __attribute__((ext_vector_type(16)));
typedef float f32x4 __attribute__((ext_vector_type(4)));
typedef float f32x2 __attribute__((ext_vector_type(2)));
typedef unsigned u32x4 __attribute__((ext_vector_type(4)));
typedef unsigned u32x2 __attribute__((ext_vector_type(2)));

#ifndef PH_MASK
#define PH_MASK 0xFFFF
#endif
#define PH(x) if constexpr ((PH_MASK & (x)) != 0)

constexpr int BATCH = 8, SEQ = 2048, DM = 4096, M = BATCH * SEQ;
constexpr int DFF = 11008, N_AB = 12288, N_CD = 12304, N_CDP = 12544;
constexpr float ALPHA = 1.4142135623730951f;
constexpr float LN_EPS = 1e-5f;
constexpr int NWAVES = 8;

constexpr size_t MiB = 1u << 20;
constexpr size_t WS_CTL = 0, CTL_ZERO_BYTES = 1 * MiB;
constexpr size_t WS_KMEAN = 1 * MiB;
constexpr size_t WS_GATES = 2 * MiB;
constexpr size_t WS_A2 = 3 * MiB;
constexpr size_t WS_M2 = 3 * MiB + 512 * 1024;
constexpr size_t WS_NM = 4 * MiB;
constexpr size_t WS_W_INAB = 8 * MiB, WS_W_OUTAB = 104 * MiB, WS_W_UG0 = 136 * MiB, WS_W_DN0 = 308 * MiB;
constexpr size_t WS_W_INCD = 394 * MiB, WS_W_OUTCD = 492 * MiB, WS_W_UG1 = 524 * MiB, WS_W_DN1 = 696 * MiB;
constexpr size_t WS_XB = 782 * MiB;
constexpr size_t WS_R = 910 * MiB;
constexpr size_t WS_QKV = WS_R, WS_Y = WS_R + 384 * MiB, WS_QKDC = WS_R + 512 * MiB, WS_HD = WS_R + 576 * MiB;
constexpr size_t WS_U = WS_R, WS_G = WS_R + 344 * MiB;
constexpr size_t WS_END = WS_R + 688 * MiB;
static_assert((size_t)M * DFF * 2 == 344 * MiB, "u/g size");
constexpr int CW_BAR = 4096;
constexpr size_t CTL_KN2 = 32768;
constexpr size_t CTL_QUEUE = 45056;
constexpr size_t CTL_STATS = 65536;
constexpr size_t CTL_CS_UG0 = 524288, CTL_BS_UG0 = CTL_CS_UG0 + 88064, CTL_CS_INCD = CTL_BS_UG0 + 88064, CTL_BS_INCD = CTL_CS_INCD + 50176, CTL_CS_UG1 = CTL_BS_INCD + 50176, CTL_BS_UG1 = CTL_CS_UG1 + 88064;
static_assert(CTL_BS_UG1 + 88064 <= CTL_ZERO_BYTES && CTL_STATS + 3 * (size_t)M * 8 <= CTL_CS_UG0, "CTL map");

constexpr int RING_BYTES = 131072;
constexpr int CTRL_OFF = 143360;
constexpr int MISC_OFF = CTRL_OFF + 320;
constexpr int SIDE_OFF = CTRL_OFF + 1024 + 4096;
constexpr int SIDE_BYTES = 6144;
constexpr int SIDE_OFF_R = CTRL_OFF + 1024 + 8192;
constexpr int LDS_BYTES = 163840;

#define LDS_WAIT() asm volatile("s_waitcnt lgkmcnt(0)" ::: "memory")
#define VM_WAIT() asm volatile("s_waitcnt vmcnt(0)" ::: "memory")
#define SBAR() __builtin_amdgcn_sched_barrier(0)
#define WG_BAR() do { asm volatile("" ::: "memory"); __builtin_amdgcn_s_barrier(); asm volatile("" ::: "memory"); } while (0)

__device__ __forceinline__ unsigned cvtpk(float lo, float hi) { unsigned r; asm volatile("v_cvt_pk_bf16_f32 %0, %1, %2" : "=v"(r) : "v"(lo), "v"(hi)); return r; }
__device__ __forceinline__ float bf_lo(unsigned w) { return __uint_as_float(w << 16); }
__device__ __forceinline__ float bf_hi(unsigned w) { return __uint_as_float(w & 0xffff0000u); }
__device__ __forceinline__ float wave_sum(float v) {
#pragma unroll
    for (int o = 1; o < 64; o <<= 1) v += __shfl_xor(v, o);
    return v;
}
__device__ __forceinline__ float silu_f(float y) { return y * __builtin_amdgcn_rcpf(1.0f + __builtin_amdgcn_exp2f(-1.4426950408889634f * y)); }

struct Args { const float* in[16]; float* out; unsigned char* ws; };
static_assert(sizeof(Args) == 18 * 8, "Args has no padding");
__device__ __forceinline__ const GAS float* ldin(const Args& a, int i) { asm volatile("" : "+s"(i)); return (const GAS float*)a.in[i]; }
__device__ __forceinline__ int opq_i(int v) { asm volatile("" : "+s"(v)); return v; }
__device__ __forceinline__ unsigned char* opq_p(unsigned char* p) { asm volatile("" : "+s"(p)); return p; }

__device__ __forceinline__ int tid_of(int wave) { int l; asm volatile("v_mbcnt_lo_u32_b32 %0, -1, 0\n\tv_mbcnt_hi_u32_b32 %0, -1, %0" : "=v"(l)); return (wave << 6) | l; }
namespace pg8 {
typedef unsigned short bf16_t;
constexpr int BM = 256, BK = 64, HALF = 128, HTB = HALF * BK * 2, STAGE_BYTES = 8 * HTB, NXCD = 8, WGM = 8;
__host__ __device__ __forceinline__ int lds_byte(int r, int c) { const int st = (r >> 4) * 2 + (c >> 5), rr = r & 15, cc = c & 31, ob = rr * 64 + cc * 2; return st * 1024 + (ob ^ (((ob >> 9) & 1) << 5)); }
__host__ __device__ __forceinline__ void stage_rc(int b, int& R, int& C) { const int st = b / 1024, sb = b % 1024, swz = sb ^ (((sb >> 9) & 1) << 5); R = (st >> 1) * 16 + swz / 64; C = (st & 1) * 32 + (swz % 64) / 2; }
__host__ __device__ __forceinline__ int perm32(int rho) { const int n = rho >> 4, i = rho & 15; return 8 * (i >> 2) + 4 * n + (i & 3); }
struct Unit { int pm, pn, par; };
struct Gemm { const bf16_t* A; const bf16_t* Bt; int M, N, K; };
struct StaticOrder {
    int nM, nN, nwg, G, c, wgm;
    __host__ __device__ void init(int M_, int N_, int G_, int c_, int wgm_ = WGM) { nM = M_ / BM; nN = N_ / BM; nwg = nM * nN; G = G_; c = c_; wgm = wgm_; }
    __host__ __device__ bool next(int i, Unit& u) const {
        const long L = (long)i * G + c; if (L >= nwg) return false;
        int wgid = (int)L; { const int q = nwg / NXCD, r = nwg % NXCD, xcd = wgid % NXCD, off = wgid / NXCD; wgid = (xcd < r ? xcd * (q + 1) : r * (q + 1) + (xcd - r) * q) + off; }
        const int nig = wgm * nN, gid = wgid / nig, fm = gid * wgm, gsz = (nM - fm) < wgm ? (nM - fm) : wgm;
        u.pm = fm + ((wgid % nig) % gsz); u.pn = (wgid % nig) / gsz; return true;
    }
    __device__ __forceinline__ void a_ready(const Unit&) const {}
    __device__ __forceinline__ void done(const Unit&) const {}
};
struct EpiBf16 {
    static constexpr bool PERM = true, AFTER_DRAIN = false;
    unsigned char* W; int L, wave; LAS unsigned char* lds;
    __device__ __forceinline__ void prefetch(const Unit& u) const {
        if (L == 0) return;
        int tid_ = tid_of(wave); asm volatile("" : "+v"(tid_));
        const int wid = __builtin_amdgcn_readfirstlane(tid_ >> 6), lane = tid_ & 63;
        if (wid >= 4) return;
        GAS unsigned char* const Wg = (GAS unsigned char*)W;
        const GAS float* src;
        if (wid < 2) src = (const GAS float*)(Wg + WS_CTL + CTL_STATS) + (size_t)1 * M * 2 + (size_t)(u.pm * BM + wid * 128) * 2 + lane * 4;
        else src = (const GAS float*)(Wg + WS_CTL + (wid == 2 ? CTL_CS_INCD : CTL_BS_INCD)) + u.pn * BM + lane * 4;
        __builtin_amdgcn_global_load_lds((const unsigned*)src, (LAS unsigned*)(lds + SIDE_OFF + u.par * SIDE_BYTES + wid * 1024), 16, 0, 0);
    }
    __device__ __forceinline__ void operator()(const f32x4 (&acc)[2][2][4][2], const Unit& u, int wr_, int wc_, int fr_, int fq_) const {
        int tid_ = tid_of(wave); asm volatile("" : "+v"(tid_));
        GAS unsigned char* const Wg = (GAS unsigned char*)W;
        GAS bf16_t* const O = (GAS bf16_t*)(Wg + WS_QKV); constexpr int ldc = N_AB; GAS float* const gates = (GAS float*)(Wg + WS_GATES); const int gate_pn = L == 0 ? -1 : 48;
        const bool st = L != 0;
        const int wid = __builtin_amdgcn_readfirstlane(tid_ >> 6), wr = wid >> 2, wc = wid & 3, fr = tid_ & 15, fq = (tid_ & 63) >> 4;
        const int row0 = u.pm * BM + wr * 64 + fr;
        const LAS float* const side = (const LAS float*)(lds + SIDE_OFF + u.par * SIDE_BYTES);
        f32x4 csv[2][2], bsv[2][2]; f32x2 svv[2][4];
        if (st) {
#pragma unroll
            for (int bj = 0; bj < 2; ++bj)
#pragma unroll
                for (int n = 0; n < 2; ++n) { csv[bj][n] = *(const LAS f32x4*)(side + 512 + wc * 32 + 8 * fq + bj * HALF + 4 * n); bsv[bj][n] = *(const LAS f32x4*)(side + 768 + wc * 32 + 8 * fq + bj * HALF + 4 * n); }
#pragma unroll
            for (int ai = 0; ai < 2; ++ai)
#pragma unroll
                for (int m = 0; m < 4; ++m) svv[ai][m] = *(const LAS f32x2*)(side + (wr * 64 + fr + ai * HALF + m * 16) * 2);
        }
        const int col0 = u.pn * BM + wc * 32 + 8 * fq;
#pragma unroll
        for (int ai = 0; ai < 2; ++ai)
#pragma unroll
            for (int m = 0; m < 4; ++m) { const int row = row0 + ai * HALF + m * 16;
                float mu = 0.f, rs = 1.f;
                if (st) { const f32x2 sv = svv[ai][m]; mu = sv[0] * (1.f / DM); rs = __builtin_amdgcn_rsqf(sv[1] * (1.f / DM) - mu * mu + LN_EPS); }
                f32x4 v[2][2];
#pragma unroll
                for (int bj = 0; bj < 2; ++bj)
#pragma unroll
                    for (int n = 0; n < 2; ++n) v[bj][n] = st ? (acc[ai][bj][m][n] - csv[bj][n] * mu) * rs + bsv[bj][n] : acc[ai][bj][m][n];
                if (u.pn == gate_pn) { if (wc == 0 && fq < 2) { GAS float* gp = gates + (size_t)row * 16 + 8 * fq; *(GAS f32x4*)gp = v[0][0]; *(GAS f32x4*)(gp + 4) = v[0][1]; } }
                else { GAS bf16_t* rowp = O + (size_t)row * ldc + col0;
#pragma unroll
                    for (int bj = 0; bj < 2; ++bj) { u32x4 w; w.x = cvtpk(v[bj][0][0], v[bj][0][1]); w.y = cvtpk(v[bj][0][2], v[bj][0][3]); w.z = cvtpk(v[bj][1][0], v[bj][1][1]); w.w = cvtpk(v[bj][1][2], v[bj][1][3]);
                        __builtin_nontemporal_store(w, (GAS u32x4*)(rowp + bj * HALF)); } } }
    }
};
struct EpiResid {
    static constexpr bool PERM = true, AFTER_DRAIN = false;
    const Args* ap; unsigned char* W; int L, which; LAS unsigned char* lds; int wave;
    __device__ __forceinline__ void prefetch(const Unit& u) const {
        if (which == 0 && L == 0) return;
        int tid_ = tid_of(wave); asm volatile("" : "+v"(tid_));
        const int wid = __builtin_amdgcn_readfirstlane(tid_ >> 6), lane = tid_ & 63;
        if (wid >= 4) return;
        GAS unsigned char* const Wg = (GAS unsigned char*)W;
        const int lnoff = which == 0 ? DM : 2 * L * DM;
        const GAS float* src;
        if (wid < 2) src = (const GAS float*)(Wg + WS_CTL + CTL_STATS) + (size_t)(which == 0 ? 1 : (L == 0 ? 0 : 2)) * M * 2 + (size_t)(u.pm * BM + wid * 128) * 2 + lane * 4;
        else src = ldin(*ap, wid == 2 ? 14 : 15) + lnoff + u.pn * BM + lane * 4;
        __builtin_amdgcn_global_load_lds((const unsigned*)src, (LAS unsigned*)(lds + SIDE_OFF_R + u.par * 4096 + wid * 1024), 16, 0, 0);
    }
    __device__ __forceinline__ void operator()(const f32x4 (&acc)[2][2][4][2], const Unit& u, int wr_, int wc_, int fr_, int fq_) const {
        int tid_ = tid_of(wave); asm volatile("" : "+v"(tid_));
        const int wid = __builtin_amdgcn_readfirstlane(tid_ >> 6), wr = wid >> 2, wc = wid & 3, lane = tid_ & 63, fr = tid_ & 15, fq = (tid_ & 63) >> 4;
        GAS unsigned char* const Wg = (GAS unsigned char*)W; GAS float* const STATS = (GAS float*)(Wg + WS_CTL + CTL_STATS);
        const bool lastsub = (which == 1 && L == 1);
        const bool has_in = !(which == 0 && L == 0);
        const GAS bf16_t* const zbin = (const GAS bf16_t*)(Wg + WS_XB); GAS bf16_t* const zb = (GAS bf16_t*)(Wg + WS_XB); GAS float* const out32 = nullptr; (void)lastsub;
        GAS float* const st_out = which == 0 ? STATS + (size_t)(L == 0 ? 0 : 2) * M * 2 : (L == 0 ? STATS + (size_t)1 * M * 2 : nullptr);
        constexpr float alpha = ALPHA; LAS float* const red = (LAS float*)(lds + CTRL_OFF + 1024);
        const LAS float* const side = (const LAS float*)(lds + SIDE_OFF_R + u.par * 4096);
        constexpr int ldc = DM;
        const int row0 = u.pm * BM + wr * 64 + fr, col0 = u.pn * BM + wc * 32 + 8 * fq, cl = wc * 32 + 8 * fq;
        LAS float* myred = red + wid * 256;
        const unsigned boff0 = ((unsigned)row0 * ldc + (unsigned)col0) * 2u;
        u32x4 xr[2][4][2];
#pragma unroll
        for (int ai = 0; ai < 2; ++ai)
#pragma unroll
            for (int m = 0; m < 4; ++m) { const unsigned bo = boff0 + (unsigned)((ai * HALF + m * 16) * ldc * 2);
                xr[ai][m][0] = *(const GAS u32x4*)((const GAS char*)zbin + bo); xr[ai][m][1] = *(const GAS u32x4*)((const GAS char*)zbin + bo + HALF * 2); }
#pragma unroll
        for (int ai = 0; ai < 2; ++ai) { f32x4 s1 = {0.f, 0.f, 0.f, 0.f}, s2 = {0.f, 0.f, 0.f, 0.f};
#pragma unroll
            for (int bj = 0; bj < 2; ++bj) {
                f32x4 gv[2], bv[2];
                if (has_in) {
#pragma unroll
                    for (int n = 0; n < 2; ++n) { gv[n] = *(const LAS f32x4*)(side + 512 + cl + bj * HALF + 4 * n); bv[n] = *(const LAS f32x4*)(side + 768 + cl + bj * HALF + 4 * n); } }
#pragma unroll
                for (int m = 0; m < 4; ++m) { float mu = 0.f, rs = 1.f;
                    if (has_in) { const f32x2 sv = *(const LAS f32x2*)(side + (wr * 64 + fr + ai * HALF + m * 16) * 2); mu = sv[0] * (1.f / DM); rs = __builtin_amdgcn_rsqf(sv[1] * (1.f / DM) - mu * mu + LN_EPS); }
                    const u32x4 r = xr[ai][m][bj]; const unsigned bo = boff0 + (unsigned)(((ai * HALF + m * 16) * ldc + bj * HALF) * 2);
                    f32x4 x0 = (f32x4){bf_lo(r.x), bf_hi(r.x), bf_lo(r.y), bf_hi(r.y)}, x1 = (f32x4){bf_lo(r.z), bf_hi(r.z), bf_lo(r.w), bf_hi(r.w)};
                    if (has_in) { x0 = (x0 - mu) * rs * gv[0] + bv[0]; x1 = (x1 - mu) * rs * gv[1] + bv[1]; }
                    const f32x4 z0 = x0 * alpha + acc[ai][bj][m][0];
                    const f32x4 z1 = x1 * alpha + acc[ai][bj][m][1];
                    if (out32) { *(GAS f32x4*)((GAS char*)out32 + 2u * bo) = z0; *(GAS f32x4*)((GAS char*)out32 + 2u * bo + 16) = z1; }
                    if (zb) { u32x4 w; w.x = cvtpk(z0[0], z0[1]); w.y = cvtpk(z0[2], z0[3]); w.z = cvtpk(z1[0], z1[1]); w.w = cvtpk(z1[2], z1[3]); *(GAS u32x4*)((GAS char*)zb + bo) = w; }
                    s1[m] += (z0[0] + z0[1]) + (z0[2] + z0[3]) + (z1[0] + z1[1]) + (z1[2] + z1[3]);
                    s2[m] += (z0[0] * z0[0] + z0[1] * z0[1]) + (z0[2] * z0[2] + z0[3] * z0[3]) + (z1[0] * z1[0] + z1[1] * z1[1]) + (z1[2] * z1[2] + z1[3] * z1[3]); }
            }
            if (st_out) {
#pragma unroll
                for (int m = 0; m < 4; ++m) { float a1 = s1[m], a2 = s2[m]; a1 += __shfl_xor(a1, 16); a1 += __shfl_xor(a1, 32); a2 += __shfl_xor(a2, 16); a2 += __shfl_xor(a2, 32);
                    if (fq == 0) *(LAS f32x2*)(myred + ((ai * 4 + m) * 16 + fr) * 2) = (f32x2){a1, a2}; } }
        }
        if (st_out) {
            asm volatile("s_waitcnt lgkmcnt(0)" ::: "memory"); __builtin_amdgcn_s_barrier(); asm volatile("" ::: "memory");
            const int idx = wid * 64 + lane, r = idx >> 1, c = idx & 1;
            const LAS float* q = red + ((r >> 6) & 1) * 1024 + ((((r >> 7) * 4 + ((r >> 4) & 3)) * 16 + (r & 15)) * 2 + c);
            const float sum = (q[0] + q[256]) + (q[512] + q[768]);
            unsafeAtomicAdd((float*)(st_out + (size_t)(u.pm * BM + r) * 2 + c), sum);
        }
    }
};

__device__ __forceinline__ float dpp_ror1(float x) { return __int_as_float(__builtin_amdgcn_update_dpp(0, __float_as_int(x), 0x121, 0xF, 0xF, false)); }
__device__ __forceinline__ float dpp_ror2(float x) { return __int_as_float(__builtin_amdgcn_update_dpp(0, __float_as_int(x), 0x122, 0xF, 0xF, false)); }
struct EpiFfnAct {
    static constexpr bool PERM = true, AFTER_DRAIN = false;
    const Args* ap; unsigned char* W; int L; LAS unsigned char* lds; int wave;
    __device__ __forceinline__ void prefetch(const Unit& u) const {
        int tid_ = tid_of(wave); asm volatile("" : "+v"(tid_));
        const int wid = __builtin_amdgcn_readfirstlane(tid_ >> 6), lane = tid_ & 63;
        if (wid >= 6) return;
        GAS unsigned char* const Wg = (GAS unsigned char*)W;
        const GAS float* src;
        if (wid < 2) src = (const GAS float*)(Wg + WS_CTL + CTL_STATS) + (size_t)(L == 0 ? 0 : 2) * M * 2 + (size_t)(u.pm * BM + wid * 128) * 2 + lane * 4;
        else if (wid == 2) src = (const GAS float*)(Wg + WS_CTL + (L == 0 ? CTL_CS_UG0 : CTL_CS_UG1)) + u.pn * BM + lane * 4;
        else if (wid == 3) src = (const GAS float*)(Wg + WS_CTL + (L == 0 ? CTL_BS_UG0 : CTL_BS_UG1)) + u.pn * BM + lane * 4;
        else { const int q = (wid - 4) * 2 + (lane >> 5);
            src = (q < 3 ? ldin(*ap, 11) + (size_t)L * 3 * DFF + (size_t)q * DFF : ldin(*ap, 12) + (size_t)L * DFF) + u.pn * 128 + (lane & 31) * 4; }
        __builtin_amdgcn_global_load_lds((const unsigned*)src, (LAS unsigned*)(lds + SIDE_OFF + u.par * SIDE_BYTES + wid * 1024), 16, 0, 0);
    }
    __device__ __forceinline__ void operator()(f32x4 (&acc)[2][2][4][2], const Unit& u, int wr_, int wc_, int fr_, int fq_) const {
        int tid_ = tid_of(wave); asm volatile("" : "+v"(tid_));
        GAS unsigned char* const Wg = (GAS unsigned char*)W;
        GAS bf16_t* const H = (GAS bf16_t*)(Wg + WS_U);
        GAS float* const EG0 = (GAS float*)(Wg + WS_G); GAS float* const EU0 = (GAS float*)(Wg + WS_G + 8 * MiB); GAS float* const EGL = (GAS float*)(Wg + WS_G + 16 * MiB); LAS float* const edge = (LAS float*)(lds + CTRL_OFF + 1024);
        const int wid = __builtin_amdgcn_readfirstlane(tid_ >> 6), wr = wid >> 2, wc = wid & 3, fr = tid_ & 15, fq = (tid_ & 63) >> 4;
        const int ch0 = u.pn * 128 + wc * 32 + fq * 8, row0 = u.pm * BM + wr * 64 + fr;
        const LAS float* const side = (const LAS float*)(lds + SIDE_OFF + u.par * SIDE_BYTES);
        const int cl = wc * 32 + 8 * fq;
        f32x2 sv[2][4]; f32x4 csg[2], bsg[2];
#pragma unroll
        for (int ai = 0; ai < 2; ++ai)
#pragma unroll
            for (int m = 0; m < 4; ++m) sv[ai][m] = *(const LAS f32x2*)(side + (wr * 64 + fr + ai * HALF + m * 16) * 2);
#pragma unroll
        for (int n = 0; n < 2; ++n) { csg[n] = *(const LAS f32x4*)(side + 512 + cl + HALF + 4 * n); bsg[n] = *(const LAS f32x4*)(side + 768 + cl + HALF + 4 * n); }
        float mu[2][4], rs[2][4];
#pragma unroll
        for (int ai = 0; ai < 2; ++ai)
#pragma unroll
            for (int m = 0; m < 4; ++m) { mu[ai][m] = sv[ai][m][0] * (1.f / DM); rs[ai][m] = __builtin_amdgcn_rsqf(sv[ai][m][1] * (1.f / DM) - mu[ai][m] * mu[ai][m] + LN_EPS);
#pragma unroll
                for (int n = 0; n < 2; ++n) acc[ai][1][m][n] = (acc[ai][1][m][n] - csg[n] * mu[ai][m]) * rs[ai][m] + bsg[n];
                asm volatile("" : "+v"(acc[ai][1][m][0]), "+v"(acc[ai][1][m][1])); }
        asm volatile("" ::: "memory");
        f32x4 csu[2], bsu[2], wt[4][2];
#pragma unroll
        for (int n = 0; n < 2; ++n) { csu[n] = *(const LAS f32x4*)(side + 512 + cl + 4 * n); bsu[n] = *(const LAS f32x4*)(side + 768 + cl + 4 * n);
#pragma unroll
            for (int q = 0; q < 4; ++q) wt[q][n] = *(const LAS f32x4*)(side + 1024 + q * 128 + cl + 4 * n); }
#define FFN_G(ai, m, n) (acc[ai][1][m][n])
#define FFN_U(ai, m, n) ((acc[ai][0][m][n] - csu[n] * mu[ai][m]) * rs[ai][m] + bsu[n])
        if (fr >= 14) {
#pragma unroll
            for (int ai = 0; ai < 2; ++ai) { LAS float* e = edge + ((((ai * 2 + wr) * 4 + wc) * 4 + fq) * 2 + (fr - 14)) * 8; *(LAS f32x4*)e = FFN_G(ai, 3, 0); *(LAS f32x4*)(e + 4) = FFN_G(ai, 3, 1); }
            if (wr == 1) { GAS float* p = EGL + (size_t)(u.pm * 2 + (fr - 14)) * DFF + ch0; *(GAS f32x4*)p = FFN_G(1, 3, 0); *(GAS f32x4*)(p + 4) = FFN_G(1, 3, 1); }
        }
        if (wr == 0 && fr < 2) { GAS float* pg = EG0 + (size_t)(u.pm * 2 + fr) * DFF + ch0; GAS float* pu = EU0 + (size_t)(u.pm * 2 + fr) * DFF + ch0;
            *(GAS f32x4*)pg = FFN_G(0, 0, 0); *(GAS f32x4*)(pg + 4) = FFN_G(0, 0, 1); *(GAS f32x4*)pu = FFN_U(0, 0, 0); *(GAS f32x4*)(pu + 4) = FFN_U(0, 0, 1); }
        asm volatile("s_waitcnt lgkmcnt(0)" ::: "memory"); __builtin_amdgcn_s_barrier(); asm volatile("" ::: "memory");
#pragma unroll
        for (int ai = 0; ai < 2; ++ai) {
            f32x4 e14[2] = {(f32x4){0.f, 0.f, 0.f, 0.f}, (f32x4){0.f, 0.f, 0.f, 0.f}}, e15[2] = {(f32x4){0.f, 0.f, 0.f, 0.f}, (f32x4){0.f, 0.f, 0.f, 0.f}};
            if (wr == 1 || ai == 1) { const int sa = (wr == 1) ? ai : 0, sw = (wr == 1) ? 0 : 1; const LAS float* e = edge + (((sa * 2 + sw) * 4 + wc) * 4 + fq) * 16;
                e14[0] = *(const LAS f32x4*)e; e14[1] = *(const LAS f32x4*)(e + 4); e15[0] = *(const LAS f32x4*)(e + 8); e15[1] = *(const LAS f32x4*)(e + 12); }
#pragma unroll
            for (int m = 0; m < 4; ++m) {
                float hv[8];
#pragma unroll
                for (int n = 0; n < 2; ++n) { const f32x4 uu = FFN_U(ai, m, n);
#pragma unroll
                    for (int jp = 0; jp < 2; ++jp) {
                        f32x2 P1, P2, GC;
#pragma unroll
                        for (int t = 0; t < 2; ++t) { const int j = 2 * jp + t; const float gc = acc[ai][1][m][n][j]; const float r1 = dpp_ror1(gc), r2 = dpp_ror2(gc);
                            float q1, q2;
                            if (m == 0) { q1 = e15[n][j]; q2 = (fr == 0) ? e14[n][j] : e15[n][j]; }
                            else { const float gpv = acc[ai][1][m > 0 ? m - 1 : 0][n][j]; q1 = dpp_ror1(gpv); q2 = dpp_ror2(gpv); }
                            P1[t] = (fr == 0) ? q1 : r1; P2[t] = (fr < 2) ? q2 : r2; GC[t] = gc; }
                        const f32x2 W0 = {wt[0][n][2 * jp], wt[0][n][2 * jp + 1]}, W1 = {wt[1][n][2 * jp], wt[1][n][2 * jp + 1]}, W2 = {wt[2][n][2 * jp], wt[2][n][2 * jp + 1]}, BB = {wt[3][n][2 * jp], wt[3][n][2 * jp + 1]};
                        const f32x2 U2 = {uu[2 * jp], uu[2 * jp + 1]};
                        const f32x2 Y = W0 * P2 + W1 * P1 + W2 * GC + BB;
                        const f32x2 T = Y * -1.4426950408889634f;
                        const f32x2 D = (f32x2){__builtin_amdgcn_exp2f(T[0]), __builtin_amdgcn_exp2f(T[1])} + 1.0f;
                        const f32x2 HH = Y * (f32x2){__builtin_amdgcn_rcpf(D[0]), __builtin_amdgcn_rcpf(D[1])} * U2;
                        hv[4 * n + 2 * jp] = HH[0]; hv[4 * n + 2 * jp + 1] = HH[1]; } }
                if (!(ai == 0 && m == 0 && wr == 0 && fr < 2)) { u32x4 w; w.x = cvtpk(hv[0], hv[1]); w.y = cvtpk(hv[2], hv[3]); w.z = cvtpk(hv[4], hv[5]); w.w = cvtpk(hv[6], hv[7]);
                    __builtin_nontemporal_store(w, (GAS u32x4*)(H + (size_t)(row0 + ai * HALF + m * 16) * DFF + ch0)); }
            }
        }
#undef FFN_G
#undef FFN_U
    }
};

template <class Epi, class Sched, bool ALIGN_EPI = false, bool SP2 = false>
__device__ __forceinline__ void gemm_phase(LAS unsigned char* lds, const Gemm g, const Sched& S, const Epi& E) {
    int tid_ = tid_of(E.wave); asm volatile("" : "+v"(tid_));
    const int tid = tid_, wid = __builtin_amdgcn_readfirstlane(tid >> 6), lane = tid & 63, wr = wid >> 2, wc = wid & 3, fr = lane & 15, fq = lane >> 4;
    const int K = g.K, nt = K / BK;
    unsigned voffA[2], voffB[2];
#pragma unroll
    for (int i = 0; i < 2; ++i) { int R, C; stage_rc(tid * 16 + i * 8192, R, C); const int Rb = Epi::PERM ? ((R & ~31) + perm32(R & 31)) : R;
        voffA[i] = (unsigned)(R * K + C) * 2u; voffB[i] = (unsigned)(Rb * K + C) * 2u; }
    const size_t kstep = (size_t)(BK * 2);
    const size_t hstep = (size_t)HALF * K * 2;
    const size_t tstep = 2 * hstep;
    const unsigned ldsw = (unsigned)wid * 1024u;
    const int aoff = lds_byte(wr * 64 + fr, fq * 8), boff = lds_byte(wc * 32 + fr, fq * 8);
#define PG8_SA(b, h) (((b) * 2 + (h)) * HTB)
#define PG8_SB(b, h) ((4 + (b) * 2 + (h)) * HTB)
#define PG8_STAGE(bufoff, gbase, voff) do { _Pragma("unroll") for (int _i = 0; _i < 2; ++_i) \
        __builtin_amdgcn_global_load_lds((const unsigned*)((const char*)(gbase) + (voff)[_i]), (LAS unsigned*)(lds + (bufoff) + ldsw + _i * 8192), 16, 0, 0); } while (0)
#define PG8_LDA(dst, b, h) do { _Pragma("unroll") for (int m = 0; m < 4; ++m) _Pragma("unroll") for (int k = 0; k < 2; ++k) dst[m][k] = *(const LAS bf16x8*)(lds + PG8_SA(b, h) + aoff + m * 2048 + k * 1024); } while (0)
#define PG8_LDB(dst, b, h) do { _Pragma("unroll") for (int n = 0; n < 2; ++n) _Pragma("unroll") for (int k = 0; k < 2; ++k) dst[n][k] = *(const LAS bf16x8*)(lds + PG8_SB(b, h) + boff + n * 2048 + k * 1024); } while (0)
#define PG8_MMA(ai, bj, At, Bt) do { __builtin_amdgcn_s_setprio(1); _Pragma("unroll") for (int m = 0; m < 4; ++m) _Pragma("unroll") for (int n = 0; n < 2; ++n) _Pragma("unroll") for (int k = 0; k < 2; ++k) \
        acc[ai][bj][m][n] = __builtin_amdgcn_mfma_f32_16x16x32_bf16(Bt[n][k], At[m][k], acc[ai][bj][m][n], 0, 0, 0); __builtin_amdgcn_s_setprio(0); } while (0)
#define PG8_WAIT_V(n) asm volatile("s_waitcnt vmcnt(" #n ")" ::: "memory")
#define PG8_WAIT_L(n) asm volatile("s_waitcnt lgkmcnt(" #n ")" ::: "memory")
#define PG8_BAR __builtin_amdgcn_s_barrier()
#define PG8_SCHED __builtin_amdgcn_sched_barrier(0)
    Unit cur, nxt; int ui = 0;
    if (!S.next(0, cur)) return;
    f32x4 acc[2][2][4][2];
#pragma unroll
    for (int a = 0; a < 2; ++a)
#pragma unroll
        for (int b = 0; b < 2; ++b)
#pragma unroll
            for (int m = 0; m < 4; ++m)
#pragma unroll
                for (int n = 0; n < 2; ++n) acc[a][b][m][n] = (f32x4){0.f, 0.f, 0.f, 0.f};
    bf16x8 At[4][2], B0[2][2], B1[2][2];
    const char* cA = (const char*)g.A + (size_t)cur.pm * tstep; const char* cB = (const char*)g.Bt + (size_t)cur.pn * tstep;
    cur.par = 0;
    S.a_ready(cur);
    if constexpr (SP2) {
        PG8_STAGE(PG8_SB(0, 0), cB, voffB); PG8_STAGE(PG8_SB(0, 1), cB + hstep, voffB); PG8_STAGE(PG8_SA(0, 0), cA, voffA); PG8_STAGE(PG8_SA(0, 1), cA + hstep, voffA);
        if (wr == 1) PG8_BAR;
        PG8_WAIT_V(2); PG8_BAR;
        PG8_STAGE(PG8_SB(1, 0), cB + kstep, voffB); PG8_STAGE(PG8_SA(1, 0), cA + kstep, voffA); PG8_STAGE(PG8_SB(1, 1), cB + hstep + kstep, voffB);
        PG8_WAIT_V(6); PG8_BAR;
    } else {
        PG8_STAGE(PG8_SB(0, 0), cB, voffB); PG8_STAGE(PG8_SA(0, 0), cA, voffA); PG8_STAGE(PG8_SB(0, 1), cB + hstep, voffB); PG8_STAGE(PG8_SA(0, 1), cA + hstep, voffA);
        if (wr == 1) PG8_BAR;
        PG8_WAIT_V(4); PG8_BAR;
        PG8_STAGE(PG8_SB(1, 0), cB + kstep, voffB); PG8_STAGE(PG8_SA(1, 0), cA + kstep, voffA); PG8_STAGE(PG8_SB(1, 1), cB + hstep + kstep, voffB);
        PG8_WAIT_V(6); PG8_BAR;
    }
    E.prefetch(cur);
    for (;;) {
        const bool has_next = S.next(ui + 1, nxt);
        const char* nA = has_next ? (const char*)g.A + (size_t)nxt.pm * tstep : cA; const char* nB = has_next ? (const char*)g.Bt + (size_t)nxt.pn * tstep : cB;
        for (int t = 0; t < nt; t += 2) {
            const bool last = (t == nt - 2);
            const char* a1 = cA + (size_t)(t + 1) * kstep;
            const char* a2 = last ? nA : cA + (size_t)(t + 2) * kstep; const char* b2 = last ? nB : cB + (size_t)(t + 2) * kstep;
            const char* a3 = a2 + kstep; const char* b3 = b2 + kstep;
            if (last && has_next) S.a_ready(nxt);
            if constexpr (SP2) {
            PG8_LDB(B0, 0, 0); PG8_LDB(B1, 0, 1); PG8_SCHED; PG8_LDA(At, 0, 0); PG8_STAGE(PG8_SA(1, 1), a1 + hstep, voffA);
            PG8_WAIT_V(8); PG8_WAIT_L(0); PG8_BAR; PG8_MMA(0, 0, At, B0); PG8_MMA(0, 1, At, B1); PG8_BAR; PG8_SCHED;
            PG8_LDA(At, 0, 1); PG8_STAGE(PG8_SB(0, 0), b2, voffB); PG8_STAGE(PG8_SB(0, 1), b2 + hstep, voffB); PG8_STAGE(PG8_SA(0, 0), a2, voffA);
            PG8_WAIT_V(8); PG8_WAIT_L(0); PG8_BAR; PG8_MMA(1, 0, At, B0); PG8_MMA(1, 1, At, B1); PG8_BAR; PG8_SCHED;
            PG8_LDB(B0, 1, 0); PG8_LDB(B1, 1, 1); PG8_SCHED; PG8_LDA(At, 1, 0); PG8_STAGE(PG8_SA(0, 1), a2 + hstep, voffA);
            PG8_WAIT_V(8); PG8_WAIT_L(0); PG8_BAR; PG8_MMA(0, 0, At, B0); PG8_MMA(0, 1, At, B1); PG8_BAR; PG8_SCHED;
            PG8_LDA(At, 1, 1); PG8_STAGE(PG8_SB(1, 0), b3, voffB); PG8_STAGE(PG8_SB(1, 1), b3 + hstep, voffB); PG8_STAGE(PG8_SA(1, 0), a3, voffA);
            PG8_WAIT_V(8); PG8_WAIT_L(0); PG8_BAR; PG8_MMA(1, 0, At, B0); PG8_MMA(1, 1, At, B1); PG8_BAR; PG8_SCHED;
            } else {
            PG8_LDB(B0, 0, 0); PG8_SCHED; PG8_LDA(At, 0, 0); PG8_STAGE(PG8_SA(1, 1), a1 + hstep, voffA);
            PG8_WAIT_L(8); PG8_BAR; PG8_WAIT_L(0); PG8_MMA(0, 0, At, B0); PG8_BAR; PG8_SCHED;
            PG8_LDB(B1, 0, 1); PG8_STAGE(PG8_SB(0, 0), b2, voffB);
            PG8_BAR; PG8_WAIT_L(0); PG8_MMA(0, 1, At, B1); PG8_BAR;
            PG8_LDA(At, 0, 1); PG8_STAGE(PG8_SA(0, 0), a2, voffA);
            PG8_BAR; PG8_WAIT_L(0); PG8_MMA(1, 0, At, B0); PG8_BAR; PG8_SCHED;
            PG8_STAGE(PG8_SB(0, 1), b2 + hstep, voffB);
            PG8_WAIT_V(6); PG8_BAR; PG8_MMA(1, 1, At, B1); PG8_BAR;
            PG8_LDB(B0, 1, 0); PG8_SCHED; PG8_LDA(At, 1, 0); PG8_STAGE(PG8_SA(0, 1), a2 + hstep, voffA);
            PG8_WAIT_L(8); PG8_BAR; PG8_WAIT_L(0); PG8_MMA(0, 0, At, B0); PG8_BAR; PG8_SCHED;
            PG8_LDB(B1, 1, 1); PG8_STAGE(PG8_SB(1, 0), b3, voffB);
            PG8_BAR; PG8_WAIT_L(0); PG8_MMA(0, 1, At, B1); PG8_BAR;
            PG8_LDA(At, 1, 1); PG8_STAGE(PG8_SA(1, 0), a3, voffA);
            PG8_BAR; PG8_WAIT_L(0); PG8_MMA(1, 0, At, B0); PG8_BAR; PG8_SCHED;
            PG8_STAGE(PG8_SB(1, 1), b3 + hstep, voffB);
            PG8_WAIT_V(6); PG8_BAR; PG8_MMA(1, 1, At, B1); PG8_BAR;
            }
        }
        if constexpr (ALIGN_EPI) { if (wr == 0) PG8_BAR; }
        if constexpr (!Epi::AFTER_DRAIN) { E(acc, cur, wr, wc, fr, fq); S.done(cur); }
        if (!has_next) break;
#pragma unroll
        for (int a = 0; a < 2; ++a)
#pragma unroll
            for (int b = 0; b < 2; ++b)
#pragma unroll
                for (int m = 0; m < 4; ++m)
#pragma unroll
                    for (int n = 0; n < 2; ++n) acc[a][b][m][n] = (f32x4){0.f, 0.f, 0.f, 0.f};
        cur = nxt; cA = nA; cB = nB; ++ui; cur.par = ui & 1;
        E.prefetch(cur);
        if constexpr (ALIGN_EPI) { if (wr == 1) PG8_BAR; }
    }
    PG8_WAIT_V(0);
    if constexpr (!ALIGN_EPI) { if (wr == 0) PG8_BAR; }
    PG8_BAR;
#undef PG8_SA
#undef PG8_SB
#undef PG8_STAGE
#undef PG8_LDA
#undef PG8_LDB
#undef PG8_MMA
#undef PG8_WAIT_V
#undef PG8_WAIT_L
#undef PG8_BAR
#undef PG8_SCHED
}
}

#define XB_TMO      128
#define XB_XCNT(j)  (256  + 64 * (j))
#define XB_XSUB(j)  (1280 + 64 * (j))
#define XB_XGEN(j)  (2304 + 64 * (j))
#define XB_TOP      3328
#define XB_TOPGEN   3392
#define XCD_BAR_WORDS 3456
#define XB_SPIN_CAP (1u << 18)
__device__ __forceinline__ unsigned xb_ld(unsigned* p)              { return __hip_atomic_load((GAS unsigned*)p, __ATOMIC_RELAXED, __HIP_MEMORY_SCOPE_AGENT); }
__device__ __forceinline__ unsigned xb_add(unsigned* p, unsigned v) { return __hip_atomic_fetch_add((GAS unsigned*)p, v, __ATOMIC_RELAXED, __HIP_MEMORY_SCOPE_AGENT); }
__device__ __forceinline__ unsigned xb_xcc_id() { return (unsigned)__builtin_amdgcn_s_getreg((3 << 11) | 20) & 0xFu; }
#define XB_SPIN(cond, bar) do { unsigned _sp = 0; while (cond) { __builtin_amdgcn_s_sleep(1); \
    if ((++_sp & 255u) == 0u) { if (xb_ld(&(bar)[XB_TMO])) break; if (_sp > XB_SPIN_CAP) { (void)xb_add(&(bar)[XB_TMO], 1u); break; } } } } while (0)
struct XcdBarrier { unsigned* bar; unsigned x; volatile LAS unsigned* st; int wave; };
__device__ __forceinline__ XcdBarrier xcd_barrier_post(unsigned* bar, volatile LAS unsigned* st, int wave) {
    XcdBarrier b; b.bar = bar; b.x = xb_xcc_id(); b.st = st; b.wave = wave;
    if (tid_of(wave) == 0) (void)xb_add(&bar[XB_XCNT(b.x)], 1u);
    return b;
}
__device__ __forceinline__ void xcd_barrier_complete(unsigned* bar, unsigned x, unsigned& nloc, unsigned& nx) {
    const unsigned G = gridDim.x * gridDim.y * gridDim.z;
    unsigned sum, cnt, mine, sp = 0u;
    for (;;) {
        sum = 0u; cnt = 0u; mine = 0u;
#pragma unroll
        for (unsigned j = 0; j < 16; ++j) { const unsigned c = xb_ld(&bar[XB_XCNT(j)]); sum += c; cnt += (c > 0u) ? 1u : 0u; mine = (j == x) ? c : mine; }
        if (sum == G) break;
        __builtin_amdgcn_s_sleep(1);
        if ((++sp & 255u) == 0u) { if (xb_ld(&bar[XB_TMO])) break; if (sp > XB_SPIN_CAP) { (void)xb_add(&bar[XB_TMO], 1u); break; } }
    }
    nloc = mine > 0u ? mine : 1u; nx = cnt > 0u ? cnt : 1u;
}
__device__ __forceinline__ void xcd_barrier(const XcdBarrier& b) {
    asm volatile("s_waitcnt vmcnt(0)" ::: "memory");
    __syncthreads();
    if (tid_of(b.wave) == 0) {
        unsigned* bar = b.bar; unsigned bx = b.x;
        asm volatile("" : "+s"(bar), "+s"(bx));
        __builtin_amdgcn_s_waitcnt(0);
        unsigned nloc = b.st[0], nx = b.st[1];
        if (nloc == 0u) { xcd_barrier_complete(bar, bx, nloc, nx); b.st[0] = nloc; b.st[1] = nx; }
        const unsigned old = xb_add(&bar[XB_XSUB(bx)], 1u);
        const unsigned gen = old / nloc;
        if (old + 1u == (gen + 1u) * nloc) {
            __builtin_amdgcn_fence(__ATOMIC_RELEASE, "agent");
            asm volatile("s_waitcnt vmcnt(0)" ::: "memory");
            const unsigned og = xb_add(&bar[XB_TOP], 1u);
            const unsigned tg = og / nx;
            if (og + 1u == (tg + 1u) * nx) xb_add(&bar[XB_TOPGEN], 1u);
            else XB_SPIN(xb_ld(&bar[XB_TOPGEN]) == tg, bar);
            __builtin_amdgcn_fence(__ATOMIC_ACQUIRE, "agent");
            xb_add(&bar[XB_XGEN(bx)], 1u);
            asm volatile("s_waitcnt vmcnt(0)" ::: "memory");
        } else {
            XB_SPIN(xb_ld(&bar[XB_XGEN(bx)]) == gen, bar);
            __builtin_amdgcn_fence(__ATOMIC_ACQUIRE, "agent");
            asm volatile("s_waitcnt vmcnt(0)" ::: "memory");
        }
    }
    __syncthreads();
}

namespace att {
constexpr int D = 128, SHM = 16384;
constexpr int OFF_V = 0, OFF_K = 2 * SHM, OFF_WS = 4 * SHM, OFF_AUX = 4 * SHM + 2048, OFF_Q = 4 * SHM + 2048 + 8192  , LDS_USED = OFF_Q + 65536;
static_assert(LDS_USED <= CTRL_OFF, "attention LDS map");
static_assert(SIDE_OFF + 2 * SIDE_BYTES <= LDS_BYTES && SIDE_OFF_R + 2 * 4096 <= LDS_BYTES, "side tables");
constexpr float SCALE = 0.08838834764831845f;
constexpr float C2 = 1.4426950408889634f * SCALE;
constexpr float THR = 8.f;
enum { MODE_DIL = 0, MODE_MOBA = 1, MODE_SB = 2, MODE_ML = 3 };
#define KSWZ(row, colB) ((row) * 256 + ((colB) ^ (((row) & 7) << 4)))
__device__ __forceinline__ int v_st(int k, int c) { const int kk = (k & ~0xC) | ((k & 4) << 1) | ((k & 8) >> 1); return ((kk >> 3) * 4 + (c >> 5)) * 512 + ((kk & 7) * 32 + (c & 31)) * 2; }
__device__ __forceinline__ int v_rd_base(int lane) { return ((lane & 3) << 3) | (((lane >> 2) & 3) << 6) | (((lane >> 4) & 1) << 5) | (((lane >> 5) & 1) << 8); }
__device__ __forceinline__ int crow(int r, int hi) { return (r & 3) + 8 * (r >> 2) + 4 * hi; }
__device__ __forceinline__ void glds16(const void* gsrc, unsigned lds_dst) { unsigned keep;
    asm volatile("s_mov_b32 %0, m0\n\ts_mov_b32 m0, %2\n\ts_nop 0\n\tglobal_load_lds_dwordx4 %1, off\n\ts_mov_b32 m0, %0" : "=&s"(keep) : "v"(gsrc), "s"(lds_dst) : "memory"); }
__device__ __forceinline__ void mask_tile(f32x16& p0, f32x16& p1, int dq) {
    const float NEG = -__builtin_inff();
#pragma unroll
    for (int r = 0; r < 16; ++r) {
        const int c = (r & 3) + 8 * (r >> 2);
        if (dq - c < 0) p0[r] = NEG;
        if (dq - c - 32 < 0) p1[r] = NEG;
    }
}
__device__ __forceinline__ void partialSM(f32x16& p0, f32x16& p1, float& m_reg, float& mn, float& alpha) {
    float pmax = p0[0];
#pragma unroll
    for (int r = 1; r < 16; ++r) pmax = fmaxf(pmax, p0[r]);
#pragma unroll
    for (int r = 0; r < 16; ++r) pmax = fmaxf(pmax, p1[r]);
    { auto rr = __builtin_amdgcn_permlane32_swap(__float_as_uint(pmax), __float_as_uint(pmax), false, false);
      pmax = fmaxf(__uint_as_float(rr[0]), __uint_as_float(rr[1])); }
    if (__builtin_expect(__all((pmax - m_reg) * SCALE <= THR), 1)) { mn = m_reg; alpha = 1.f; }
    else { mn = fmaxf(m_reg, pmax); alpha = __builtin_amdgcn_exp2f((m_reg - mn) * C2); m_reg = mn; }
    const float mnL = -mn * C2;
#pragma unroll
    for (int r = 0; r < 16; ++r) p0[r] = fmaf(p0[r], C2, mnL);
#pragma unroll
    for (int r = 0; r < 16; ++r) p1[r] = fmaf(p1[r], C2, mnL);
#pragma unroll
    for (int r = 0; r < 16; ++r) p0[r] = __builtin_amdgcn_exp2f(p0[r]);
#pragma unroll
    for (int r = 0; r < 16; ++r) p1[r] = __builtin_amdgcn_exp2f(p1[r]);
}
#define ATT_PK4(P, B_, OUT) do { unsigned a0 = cvtpk(P[B_+0], P[B_+1]), a1 = cvtpk(P[B_+2], P[B_+3]);                          \
        unsigned b0 = cvtpk(P[B_+4], P[B_+5]), b1 = cvtpk(P[B_+6], P[B_+7]);                                             \
        auto r0 = __builtin_amdgcn_permlane32_swap(a0, b0, false, false); auto r1 = __builtin_amdgcn_permlane32_swap(a1, b1, false, false); \
        u32x4 w = {r0[0], r1[0], r0[1], r1[1]}; OUT = *reinterpret_cast<bf16x8*>(&w); } while (0)
__device__ __forceinline__ void pack_p(const f32x16& p0, const f32x16& p1, bf16x8& pa0, bf16x8& pa1, bf16x8& pa2, bf16x8& pa3) {
    ATT_PK4(p0, 0, pa0); ATT_PK4(p0, 8, pa1); ATT_PK4(p1, 0, pa2); ATT_PK4(p1, 8, pa3);
}
__device__ __forceinline__ float pair_sum(float v) {
    auto rr = __builtin_amdgcn_permlane32_swap(__float_as_uint(v), __float_as_uint(v), false, false);
    return __uint_as_float(rr[0]) + __uint_as_float(rr[1]);
}
__device__ __forceinline__ void qkt(f32x16& p0, f32x16& p1, const LAS char* Kb, int r32, int hi, const bf16x8* qr) {
#pragma unroll
    for (int r = 0; r < 16; ++r) { p0[r] = 0.f; p1[r] = 0.f; }
    const LAS char* kb[4];
#pragma unroll
    for (int dd = 0; dd < 4; ++dd) kb[dd] = Kb + KSWZ(r32, (dd * 16 + hi * 8) * 2);
#pragma unroll
    for (int d0 = 0; d0 < 8; ++d0) { const LAS char* a = kb[d0 & 3] + (d0 >> 2) * 128;
        const bf16x8 b0 = *reinterpret_cast<const LAS bf16x8*>(a);
        const bf16x8 b1 = *reinterpret_cast<const LAS bf16x8*>(a + 32 * 256);
        p0 = __builtin_amdgcn_mfma_f32_32x32x16_bf16(b0, qr[d0], p0, 0, 0, 0);
        p1 = __builtin_amdgcn_mfma_f32_32x32x16_bf16(b1, qr[d0], p1, 0, 0, 0); }
}
__device__ __forceinline__ void qkt_lq(f32x16& p0, f32x16& p1, const LAS char* Kb, int r32, int hi, const LAS char* Qw) {
#pragma unroll
    for (int r = 0; r < 16; ++r) { p0[r] = 0.f; p1[r] = 0.f; }
    const LAS char* kb[4];
#pragma unroll
    for (int dd = 0; dd < 4; ++dd) kb[dd] = Kb + KSWZ(r32, (dd * 16 + hi * 8) * 2);
#pragma unroll
    for (int d0 = 0; d0 < 8; ++d0) { const LAS char* a = kb[d0 & 3] + (d0 >> 2) * 128;
        const bf16x8 b0 = *reinterpret_cast<const LAS bf16x8*>(a);
        const bf16x8 b1 = *reinterpret_cast<const LAS bf16x8*>(a + 32 * 256);
        const bf16x8 q = *reinterpret_cast<const LAS bf16x8*>(Qw + d0 * 1024);
        p0 = __builtin_amdgcn_mfma_f32_32x32x16_bf16(b0, q, p0, 0, 0, 0);
        p1 = __builtin_amdgcn_mfma_f32_32x32x16_bf16(b1, q, p1, 0, 0, 0); }
}
__device__ __forceinline__ void pv_tile(f32x16* o, int vb0, bf16x8 pa0, bf16x8 pa1, bf16x8 pa2, bf16x8 pa3) {
#define TRRD(dst, off) asm volatile("ds_read_b64_tr_b16 %0, %1 offset:%2" : "=&v"(dst) : "v"(vb0), "i"(off) : "memory")
#define PV_D0(d0) do { s16x4 l0, l1, l2, l3, h0, h1, h2, h3; constexpr int b_ = (d0) * 512; \
        TRRD(l0, b_); TRRD(h0, b_ + 2048); TRRD(l1, b_ + 4096); TRRD(h1, b_ + 6144); TRRD(l2, b_ + 8192); TRRD(h2, b_ + 10240); TRRD(l3, b_ + 12288); TRRD(h3, b_ + 14336); \
        asm volatile("s_waitcnt lgkmcnt(0)" ::: "memory"); SBAR();   \
        o[d0] = __builtin_amdgcn_mfma_f32_32x32x16_bf16(pa0, (bf16x8){l0[0], l0[1], l0[2], l0[3], h0[0], h0[1], h0[2], h0[3]}, o[d0], 0, 0, 0);   \
        o[d0] = __builtin_amdgcn_mfma_f32_32x32x16_bf16(pa1, (bf16x8){l1[0], l1[1], l1[2], l1[3], h1[0], h1[1], h1[2], h1[3]}, o[d0], 0, 0, 0);   \
        o[d0] = __builtin_amdgcn_mfma_f32_32x32x16_bf16(pa2, (bf16x8){l2[0], l2[1], l2[2], l2[3], h2[0], h2[1], h2[2], h2[3]}, o[d0], 0, 0, 0);   \
        o[d0] = __builtin_amdgcn_mfma_f32_32x32x16_bf16(pa3, (bf16x8){l3[0], l3[1], l3[2], l3[3], h3[0], h3[1], h3[2], h3[3]}, o[d0], 0, 0, 0); } while (0)
    PV_D0(0); PV_D0(1); PV_D0(2); PV_D0(3);
#undef PV_D0
#undef TRRD
}


__device__ __forceinline__ void softmax_start(f32x16& p0, f32x16& p1, float& m_reg, float& alpha) {
    float pmax = p0[0];
#pragma unroll
    for (int r = 1; r < 16; ++r) pmax = fmaxf(pmax, p0[r]);
#pragma unroll
    for (int r = 0; r < 16; ++r) pmax = fmaxf(pmax, p1[r]);
    { auto rr = __builtin_amdgcn_permlane32_swap(__float_as_uint(pmax), __float_as_uint(pmax), false, false);
      pmax = fmaxf(__uint_as_float(rr[0]), __uint_as_float(rr[1])); }
    float mn;
    if (__builtin_expect(__all((pmax - m_reg) * SCALE <= THR), 1)) { mn = m_reg; alpha = 1.f; }
    else { mn = fmaxf(m_reg, pmax); alpha = __builtin_amdgcn_exp2f((m_reg - mn) * C2); m_reg = mn; }
    const float mnL = -mn * C2;
#pragma unroll
    for (int r = 0; r < 16; ++r) p0[r] = fmaf(p0[r], C2, mnL);
#pragma unroll
    for (int r = 0; r < 16; ++r) p1[r] = fmaf(p1[r], C2, mnL);
#pragma unroll
    for (int r = 0; r < 16; ++r) p0[r] = __builtin_amdgcn_exp2f(p0[r]);
}
__device__ __forceinline__ void softmax_finish(f32x16& p0, f32x16& p1, float alpha, float& l_reg, bf16x8& pa0, bf16x8& pa1, bf16x8& pa2, bf16x8& pa3) {
#pragma unroll
    for (int r = 0; r < 16; ++r) p1[r] = __builtin_amdgcn_exp2f(p1[r]);
    float ps = 0.f;
#pragma unroll
    for (int r = 0; r < 16; ++r) ps += p0[r];
#pragma unroll
    for (int r = 0; r < 16; ++r) ps += p1[r];
    ps = pair_sum(ps);
    l_reg = l_reg * alpha + ps;
    pack_p(p0, p1, pa0, pa1, pa2, pa3);
}
template <int MODE>
__device__ __forceinline__ void stage_b1(f32x16& p0, f32x16& p1, float& alpha, float& m_reg, int tj, int qb, int qlo, int qpos, int hi, unsigned sel, unsigned m16, unsigned m4, const LAS float* aux, float M2row) {
    const int kb = tj * 64, dq = qpos - kb - 4 * hi;
    if constexpr (MODE == MODE_DIL) {
        const int dlo = qlo - kb - 63, dhi2 = qlo + 31 - kb;
        if (dlo > 512) {
#pragma unroll
            for (int r = 0; r < 16; ++r) { const float t = ((m16 >> r) & 1u) ? 0.f : -__builtin_inff(); p0[r] += t; p1[r] += t; }
        } else if (dlo > 128 && dhi2 <= 512) {
#pragma unroll
            for (int r = 0; r < 16; ++r) { const float t = ((m16 >> r) & 1u) ? (1.0f / C2) : (((m4 >> r) & 1u) ? 0.f : -__builtin_inff()); p0[r] += t; p1[r] += t; }
        } else {
#pragma unroll
            for (int r = 0; r < 16; ++r) { const int c = (r & 3) + 8 * (r >> 2);
                { const unsigned ud = (unsigned)(dq - c); const int cnt = (int)(ud <= 128u) + (int)(((ud & 3u) == 0u) & (ud <= 512u)) + (int)((ud & 0x8000000Fu) == 0u);
                  p0[r] += __builtin_amdgcn_logf((float)cnt) * (1.0f / C2); }
                { const unsigned ud = (unsigned)(dq - c - 32); const int cnt = (int)(ud <= 128u) + (int)(((ud & 3u) == 0u) & (ud <= 512u)) + (int)((ud & 0x8000000Fu) == 0u);
                  p1[r] += __builtin_amdgcn_logf((float)cnt) * (1.0f / C2); } }
        }
        softmax_start(p0, p1, m_reg, alpha);
    } else if constexpr (MODE == MODE_MOBA) {
        const int n = tj >> 2;
        if (n == qb) { if (kb + 63 > qlo) mask_tile(p0, p1, dq); }
        else { const bool keep = ((sel >> n) & 1u) != 0u;
#pragma unroll
            for (int r = 0; r < 16; ++r) { p0[r] = keep ? p0[r] : -__builtin_inff(); p1[r] = keep ? p1[r] : -__builtin_inff(); } }
        softmax_start(p0, p1, m_reg, alpha);
    } else {
#pragma unroll
        for (int r4 = 0; r4 < 4; ++r4) { const f32x4 a0 = *(const LAS f32x4*)(aux + kb + 8 * r4 + 4 * hi);
            const float rf = SCALE * __builtin_amdgcn_exp2f(a0[0] - M2row);
#pragma unroll
            for (int j = 0; j < 4; ++j) { const int r = 4 * r4 + j, c = 8 * r4 + j;
                float s0 = p0[r] * (j == 0 ? rf : rf * a0[j]); s0 = (dq - c < 0) ? 0.f : s0; p0[r] = s0; } }
        alpha = 1.f;
    }
}
template <int MODE>
__device__ __forceinline__ void stage_b2(f32x16& p0, f32x16& p1, float alpha, float& l_reg, float& den, int tj, int qpos, int hi, const LAS float* aux, float M2row, bf16x8& pa0, bf16x8& pa1, bf16x8& pa2, bf16x8& pa3) {
    if constexpr (MODE == MODE_ML) {
        const int kb = tj * 64, dq = qpos - kb - 4 * hi; float dsum = 0.f;
#pragma unroll
        for (int r4 = 0; r4 < 4; ++r4) { const f32x4 a1 = *(const LAS f32x4*)(aux + kb + 32 + 8 * r4 + 4 * hi);
            const float rf = SCALE * __builtin_amdgcn_exp2f(a1[0] - M2row);
#pragma unroll
            for (int j = 0; j < 4; ++j) { const int r = 4 * r4 + j, c = 8 * r4 + j;
                float s1 = p1[r] * (j == 0 ? rf : rf * a1[j]); s1 = (dq - c - 32 < 0) ? 0.f : s1; p1[r] = s1; dsum += p0[r] + s1; } }
        den += dsum;
        pack_p(p0, p1, pa0, pa1, pa2, pa3);
    } else softmax_finish(p0, p1, alpha, l_reg, pa0, pa1, pa2, pa3);
}

template <int MODE>
__device__ __forceinline__ void attn_block(const bf16* __restrict__ Qp, int ldq, const bf16* __restrict__ Kp, int ldk, const bf16* __restrict__ Vp, int ldv, bf16* __restrict__ Op, int ldo,
                                           int qb, LAS char* lds, const float* __restrict__ aux0, const float* __restrict__ aux1, const float* __restrict__ aux2, int wave) {
    int tid_ = tid_of(wave); asm volatile("" : "+v"(tid_));
    const int tid = tid_, wid = __builtin_amdgcn_readfirstlane(tid >> 6), lane = tid & 63, r32 = lane & 31, hi = lane >> 5;
    const int P0 = qb * 256, qlo = P0 + wid * 32, qpos = qlo + r32;
    const int NT = 4 * qb + 4;
    LAS char* V_lds = lds + OFF_V; LAS char* K_lds = lds + OFF_K;
    LAS float* wsf = (LAS float*)(lds + OFF_WS) + wid * 64; LAS float* li_l = wsf; LAS float* al_l = wsf + 32;
    LAS float* aux = (LAS float*)(lds + OFF_AUX);
    bf16x8 qr[8];
#pragma unroll
    for (int d0 = 0; d0 < 8; ++d0) qr[d0] = __builtin_nontemporal_load(reinterpret_cast<const bf16x8*>(Qp + (size_t)qpos * ldq + d0 * 16 + hi * 8));
    unsigned kso[2], vso[2];
#pragma unroll
    for (int i = 0; i < 2; ++i) { const int pc = 2 * wid + i, krow = pc * 4 + (lane >> 4), kch = (lane & 15) ^ (krow & 7);
        kso[i] = (unsigned)(krow * ldk + kch * 8) * 2u;
        const int kk = wid * 8 + ((lane & 31) >> 2), vk = (kk & ~0xC) | ((kk & 4) << 1) | ((kk & 8) >> 1), vc = (2 * i + (lane >> 5)) * 32 + (lane & 3) * 8;
        vso[i] = (unsigned)(vk * ldv + vc) * 2u; }
    const int vb0 = (int)(unsigned)(size_t)V_lds + v_rd_base(lane);
    float m_reg = -1e30f, l_reg = 0.f, Rsum = 0.f, den = 0.f, M2row = 0.f, nmrow = 1.f; unsigned sel = 0u;
    if constexpr (MODE == MODE_ML) {
        for (int i = tid; i < P0 + 256; i += 512) { const float a = aux0[i]; const float base = __shfl(a, lane & ~3); aux[i] = (i & 3) == 0 ? a : __builtin_amdgcn_exp2f(a - base); }
        M2row = aux1[qpos]; nmrow = aux2[qpos]; }
    if constexpr (MODE == MODE_MOBA) { for (int i = tid; i < qb * 128; i += 512) aux[i] = aux0[i]; }
#define TJ(i) ((MODE == MODE_SB) ? (NT - 1 - (i)) : (i))
#define SLOAD(kb_, bf) do { const char* kg_ = (const char*)(Kp + (size_t)(kb_) * ldk); const char* vg_ = (const char*)(Vp + (size_t)(kb_) * ldv); \
        _Pragma("unroll") for (int i_ = 0; i_ < 2; ++i_) { \
            glds16(kg_ + kso[i_], (unsigned)__builtin_amdgcn_readfirstlane((int)(unsigned)(size_t)(K_lds + (bf) * SHM + (2 * wid + i_) * 1024))); \
            glds16(vg_ + vso[i_], (unsigned)__builtin_amdgcn_readfirstlane((int)(unsigned)(size_t)(V_lds + (bf) * SHM + (2 * wid + i_) * 1024))); } } while (0)
    float zbnd = 0.f; bool wdone = false; LAS int* dflag = (LAS int*)(lds + OFF_WS);
    if constexpr (MODE == MODE_SB) { float s = 0.f;
#pragma unroll
        for (int d0 = 0; d0 < 8; ++d0) { const u32x4 qw = *reinterpret_cast<const u32x4*>(&qr[d0]);
            s = fmaf(bf_lo(qw.x), bf_lo(qw.x), s); s = fmaf(bf_hi(qw.x), bf_hi(qw.x), s); s = fmaf(bf_lo(qw.y), bf_lo(qw.y), s); s = fmaf(bf_hi(qw.y), bf_hi(qw.y), s);
            s = fmaf(bf_lo(qw.z), bf_lo(qw.z), s); s = fmaf(bf_hi(qw.z), bf_hi(qw.z), s); s = fmaf(bf_lo(qw.w), bf_lo(qw.w), s); s = fmaf(bf_hi(qw.w), bf_hi(qw.w), s); }
        s = pair_sum(s); zbnd = sqrtf(s * aux0[0]) * (C2 * 1.001f) + 0.01f; }
    unsigned dm16 = 0u, dm4 = 0u;
    if constexpr (MODE == MODE_DIL) {
#pragma unroll
        for (int r = 0; r < 16; ++r) { const unsigned d0 = (unsigned)(qpos - 4 * hi - ((r & 3) + 8 * (r >> 2))); dm16 |= ((d0 & 15u) == 0u ? 1u : 0u) << r; dm4 |= ((d0 & 3u) == 0u ? 1u : 0u) << r; } }
    SLOAD(TJ(0) * 64, 0); VM_WAIT(); LDS_WAIT(); WG_BAR();
#pragma unroll
    for (int d0 = 0; d0 < 8; ++d0) asm volatile("" : "+v"(qr[d0]));
    asm volatile("" : "+v"(M2row), "+v"(nmrow), "+v"(zbnd));
    if constexpr (MODE == MODE_MOBA) {
        if (qb <= 3) sel = (1u << qb) - 1u;
        else {
            float g[7];
#pragma unroll
            for (int n = 0; n < 7; ++n) { g[n] = -__builtin_inff();
                if (n < qb) { float s = 0.f;
#pragma unroll
                    for (int d0 = 0; d0 < 8; ++d0) { const LAS f32x4* kp = (const LAS f32x4*)(aux + n * 128 + d0 * 16 + hi * 8); const f32x4 k0 = kp[0], k1 = kp[1];
                        const u32x4 qw = *reinterpret_cast<const u32x4*>(&qr[d0]);
                        s = fmaf(bf_lo(qw.x), k0[0], s); s = fmaf(bf_hi(qw.x), k0[1], s); s = fmaf(bf_lo(qw.y), k0[2], s); s = fmaf(bf_hi(qw.y), k0[3], s);
                        s = fmaf(bf_lo(qw.z), k1[0], s); s = fmaf(bf_hi(qw.z), k1[1], s); s = fmaf(bf_lo(qw.w), k1[2], s); s = fmaf(bf_hi(qw.w), k1[3], s); }
                    g[n] = pair_sum(s); }
                asm volatile("" ::: "memory"); }
#pragma unroll
            for (int k = 0; k < 3; ++k) { float best = -__builtin_inff(); int bi = 0;
#pragma unroll
                for (int n = 0; n < 7; ++n) if (g[n] > best) { best = g[n]; bi = n; }
                sel |= 1u << bi;
#pragma unroll
                for (int n = 0; n < 7; ++n) g[n] = (bi == n) ? -__builtin_inff() : g[n]; }
        }
    }
    f32x16 o[4];
#pragma unroll
    for (int d_ = 0; d_ < 4; ++d_)
#pragma unroll
        for (int r = 0; r < 16; ++r) o[d_][r] = 0.f;
    if constexpr (MODE == MODE_MOBA || MODE == MODE_ML || MODE == MODE_DIL) {
#define SLOADK(kb_, bf) do { const char* kg_ = (const char*)(Kp + (size_t)(kb_) * ldk); _Pragma("unroll") for (int i_ = 0; i_ < 2; ++i_) \
            glds16(kg_ + kso[i_], (unsigned)__builtin_amdgcn_readfirstlane((int)(unsigned)(size_t)(K_lds + (bf) * SHM + (2 * wid + i_) * 1024))); } while (0)
#define SLOADV(kb_, bf) do { const char* vg_ = (const char*)(Vp + (size_t)(kb_) * ldv); _Pragma("unroll") for (int i_ = 0; i_ < 2; ++i_) \
            glds16(vg_ + vso[i_], (unsigned)__builtin_amdgcn_readfirstlane((int)(unsigned)(size_t)(V_lds + (bf) * SHM + (2 * wid + i_) * 1024))); } while (0)
#define RESC(a) do { if (MODE != MODE_ML) { if (__any((a) < 1.f)) { if (hi == 0) al_l[r32] = (a); LDS_WAIT(); \
            _Pragma("unroll") for (int d_ = 0; d_ < 4; ++d_) _Pragma("unroll") for (int r = 0; r < 16; ++r) o[d_][r] *= al_l[crow(r, hi)]; } } } while (0)
#define HALF_STEP(PX0, PX1, alX, PY0, PY1, alY, t_) do { const int ht_ = (t_); \
            if (ht_ + 1 < NT) SLOADK((ht_ + 1) * 64, (ht_ + 1) & 1); SLOADV(ht_ * 64, ht_ & 1); SBAR(); \
            bf16x8 pa0, pa1, pa2, pa3; \
            qkt_lq(PX0, PX1, K_lds + (ht_ & 1) * SHM, r32, hi, Qw); stage_b2<MODE>(PY0, PY1, alY, l_reg, den, ht_ - 1, qpos, hi, aux, M2row, pa0, pa1, pa2, pa3); \
            SBAR(); \
            RESC(alY); pv_tile(o, vb0 + ((ht_ - 1) & 1) * SHM, pa0, pa1, pa2, pa3); stage_b1<MODE>(PX0, PX1, alX, m_reg, ht_, qb, qlo, qpos, hi, sel, dm16, dm4, aux, M2row); \
            SBAR(); VM_WAIT(); LDS_WAIT(); WG_BAR(); } while (0)
        f32x16 pA0, pA1, pB0, pB1; float alA = 1.f, alB = 1.f;
        LAS char* const Qw = lds + OFF_Q + wid * 8192 + lane * 16;
#pragma unroll
        for (int d0 = 0; d0 < 8; ++d0) *reinterpret_cast<LAS bf16x8*>(Qw + d0 * 1024) = qr[d0];
        SLOADK(64, 1); SBAR();
        qkt_lq(pA0, pA1, K_lds, r32, hi, Qw);
        stage_b1<MODE>(pA0, pA1, alA, m_reg, 0, qb, qlo, qpos, hi, sel, dm16, dm4, aux, M2row);
        SBAR(); VM_WAIT(); LDS_WAIT(); WG_BAR();
        for (int t = 1; t + 1 < NT; t += 2) { HALF_STEP(pB0, pB1, alB, pA0, pA1, alA, t); HALF_STEP(pA0, pA1, alA, pB0, pB1, alB, t + 1); }
        HALF_STEP(pB0, pB1, alB, pA0, pA1, alA, NT - 1);
        { bf16x8 pa0, pa1, pa2, pa3;
            stage_b2<MODE>(pB0, pB1, alB, l_reg, den, NT - 1, qpos, hi, aux, M2row, pa0, pa1, pa2, pa3);
            RESC(alB); pv_tile(o, vb0 + ((NT - 1) & 1) * SHM, pa0, pa1, pa2, pa3); }
        LDS_WAIT(); WG_BAR();
#undef HALF_STEP
#undef RESC
#undef SLOADV
#undef SLOADK
    } else
    for (int i = 0; i < NT; ++i) {
        const int tj = TJ(i), kb = tj * 64, buf = i & 1;
        if constexpr (MODE == MODE_SB) { if (i > 0) { const int f = dflag[(lane & 7) * 64 + ((i - 1) & 1)]; if (__all(f != 0)) break; } }
        if (i + 1 < NT) SLOAD(TJ(i + 1) * 64, buf ^ 1);
        SBAR();
        bool act = (MODE == MODE_SB) ? (kb <= qlo + 30 && !wdone) : (kb <= qlo + 31);
        if constexpr (MODE == MODE_MOBA) { const int n = tj >> 2; if (n != qb) act = act && __any((int)((sel >> n) & 1u)); }
        if (act) {
            f32x16 p0, p1; bf16x8 pa0, pa1, pa2, pa3;
            qkt(p0, p1, K_lds + buf * SHM, r32, hi, qr);
            const int dq = qpos - kb - 4 * hi;
            if constexpr (MODE == MODE_DIL || MODE == MODE_MOBA) {
                if constexpr (MODE == MODE_DIL) {
                  const int dlo = qlo - kb - 63, dhi2 = qlo + 31 - kb;
                  if (dlo > 512) {
#pragma unroll
                    for (int r = 0; r < 16; ++r) { const float t = ((dm16 >> r) & 1u) ? 0.f : -__builtin_inff(); p0[r] += t; p1[r] += t; }
                  } else if (dlo > 128 && dhi2 <= 512) {
#pragma unroll
                    for (int r = 0; r < 16; ++r) { const float t = ((dm16 >> r) & 1u) ? (1.0f / C2) : (((dm4 >> r) & 1u) ? 0.f : -__builtin_inff()); p0[r] += t; p1[r] += t; }
                  } else {
#pragma unroll
                    for (int r = 0; r < 16; ++r) { const int c = (r & 3) + 8 * (r >> 2);
                        { const unsigned ud = (unsigned)(dq - c); const int cnt = (int)(ud <= 128u) + (int)(((ud & 3u) == 0u) & (ud <= 512u)) + (int)((ud & 0x8000000Fu) == 0u);
                          p0[r] += __builtin_amdgcn_logf((float)cnt) * (1.0f / C2); }
                        { const unsigned ud = (unsigned)(dq - c - 32); const int cnt = (int)(ud <= 128u) + (int)(((ud & 3u) == 0u) & (ud <= 512u)) + (int)((ud & 0x8000000Fu) == 0u);
                          p1[r] += __builtin_amdgcn_logf((float)cnt) * (1.0f / C2); } }
                  }
                } else {
                    const int n = tj >> 2;
                    if (n == qb) { if (kb + 63 > qlo) mask_tile(p0, p1, dq); }
                    else if (!((sel >> n) & 1u)) {
#pragma unroll
                        for (int r = 0; r < 16; ++r) { p0[r] = -__builtin_inff(); p1[r] = -__builtin_inff(); } }
                }
                float mn, alpha;
                partialSM(p0, p1, m_reg, mn, alpha);
                float ps = 0.f;
#pragma unroll
                for (int r = 0; r < 16; ++r) ps += p0[r];
#pragma unroll
                for (int r = 0; r < 16; ++r) ps += p1[r];
                ps = pair_sum(ps);
                l_reg = l_reg * alpha + ps;
                pack_p(p0, p1, pa0, pa1, pa2, pa3);
                if (__any(alpha < 1.f)) { if (hi == 0) al_l[r32] = alpha; LDS_WAIT();
#pragma unroll
                    for (int d_ = 0; d_ < 4; ++d_)
#pragma unroll
                        for (int r = 0; r < 16; ++r) o[d_][r] *= al_l[crow(r, hi)]; }
            } else if constexpr (MODE == MODE_ML) {
                float dsum = 0.f;
#pragma unroll
                for (int r4 = 0; r4 < 4; ++r4) {
                    const f32x4 a0 = *(const LAS f32x4*)(aux + kb + 8 * r4 + 4 * hi), a1 = *(const LAS f32x4*)(aux + kb + 32 + 8 * r4 + 4 * hi);
                    const float rf0 = SCALE * __builtin_amdgcn_exp2f(a0[0] - M2row), rf1 = SCALE * __builtin_amdgcn_exp2f(a1[0] - M2row);
#pragma unroll
                    for (int j = 0; j < 4; ++j) { const int r = 4 * r4 + j, c = 8 * r4 + j;
                        float s0 = p0[r] * (j == 0 ? rf0 : rf0 * a0[j]); s0 = (dq - c < 0) ? 0.f : s0;
                        float s1 = p1[r] * (j == 0 ? rf1 : rf1 * a1[j]); s1 = (dq - c - 32 < 0) ? 0.f : s1;
                        p0[r] = s0; p1[r] = s1; dsum += s0 + s1; } }
                den += dsum;
                pack_p(p0, p1, pa0, pa1, pa2, pa3);
            } else {
                f32x16 z0, z1; float gs[8];
#pragma unroll
                for (int r = 0; r < 16; ++r) { const int c = (r & 3) + 8 * (r >> 2);
                    { const float z2 = p0[r] * C2; const float sp = fmaxf(z2, 0.f) + __builtin_amdgcn_logf(1.0f + __builtin_amdgcn_exp2f(-fabsf(z2)));
                      z0[r] = z2; const float spm = ((dq - 1 - c) >= 0) ? sp : 0.f; p0[r] = spm; if ((r & 3) == 0) gs[r >> 2] = spm; else gs[r >> 2] += spm; }
                    { const float z2 = p1[r] * C2; const float sp = fmaxf(z2, 0.f) + __builtin_amdgcn_logf(1.0f + __builtin_amdgcn_exp2f(-fabsf(z2)));
                      z1[r] = z2; const float spm = ((dq - 1 - c - 32) >= 0) ? sp : 0.f; p1[r] = spm; if ((r & 3) == 0) gs[4 + (r >> 2)] = spm; else gs[4 + (r >> 2)] += spm; } }
                float aft[8]; float run = 0.f;
#pragma unroll
                for (int i2 = 7; i2 >= 0; --i2) { const float pg = __shfl_xor(gs[i2], 32); aft[i2] = run + (hi == 0 ? pg : 0.f); run += gs[i2] + pg; }
#pragma unroll
                for (int i2 = 0; i2 < 8; ++i2) { float suf = Rsum + aft[i2];
#pragma unroll
                    for (int j = 3; j >= 0; --j) { const int r = 4 * (i2 & 3) + j, c = 8 * (i2 & 3) + j + ((i2 >> 2) ? 32 : 0);
                        const bool ok = (dq - 1 - c) >= 0;
                        if (i2 >> 2) { suf += p1[r]; p1[r] = ok ? __builtin_amdgcn_exp2f(z1[r] - suf) : 0.f; }
                        else { suf += p0[r]; p0[r] = ok ? __builtin_amdgcn_exp2f(z0[r] - suf) : 0.f; } } }
                Rsum += run;
                pack_p(p0, p1, pa0, pa1, pa2, pa3);
            }
            SBAR();
            pv_tile(o, vb0 + buf * SHM, pa0, pa1, pa2, pa3);
        }
        SBAR();
        if constexpr (MODE == MODE_SB) { if (!wdone) wdone = __all(Rsum - zbnd > 64.f) != 0; if (lane == 0) dflag[wid * 64 + (i & 1)] = wdone ? 1 : 0; }
        VM_WAIT(); LDS_WAIT(); WG_BAR();
    }
    if constexpr (MODE == MODE_DIL || MODE == MODE_MOBA) { if (hi == 0) li_l[r32] = l_reg; }
    if constexpr (MODE == MODE_ML) { const float dt = pair_sum(den); if (hi == 0) li_l[r32] = fmaxf(fabsf(dt), nmrow); }
    LDS_WAIT();
    LAS char* const Ost = lds + OFF_Q + wid * 8192;
#pragma unroll
    for (int r = 0; r < 16; ++r) { const int orow = crow(r, hi);
        float rl = 1.f; if constexpr (MODE != MODE_SB) rl = __builtin_amdgcn_rcpf(li_l[orow]);
#pragma unroll
        for (int d0 = 0; d0 < 4; ++d0) { const float v = o[d0][r] * rl;
            *(LAS unsigned short*)(Ost + orow * 256 + (((d0 * 32 + r32) * 2) ^ ((orow & 4) << 4))) = (unsigned short)cvtpk(v, v); } }
    LDS_WAIT();
    bf16* Ow = Op + (size_t)qlo * ldo;
#pragma unroll
    for (int j = 0; j < 8; ++j) { const int row = j * 4 + (lane >> 4), cb = (lane & 15) * 16;
        const u32x4 w = *(const LAS u32x4*)(Ost + row * 256 + (cb ^ ((row & 4) << 4)));
        *(u32x4*)((char*)(Ow + (size_t)row * ldo) + cb) = w; }
    LDS_WAIT();
#undef TJ
#undef SLOAD
}
}


struct Frame {
    LAS unsigned char* lds; int tid, lane, wave, vcu, G, gw, NGW;
};

template <bool FOLD>
__device__ __forceinline__ void tr_item(const float* __restrict__ W, int K, int N, bf16* __restrict__ WT, int item, int nblk, LAS unsigned* scr, int lane, int rmode, const float* lg, const float* lb, float* cs, float* bs) {
    const int kb = item / nblk, nb = item - kb * nblk, k0 = kb * 64, n0 = nb * 64;
    const int nq = lane & 15, kr = lane >> 4;
    const bool inb = (n0 + 4 * nq) < N;
    f32x4 a[8], b[8];
#pragma unroll
    for (int s = 0; s < 8; ++s) { const int kp = 4 * s + kr; const float* p = W + (size_t)(k0 + 2 * kp) * N + (inb ? n0 + 4 * nq : 0);
        a[s] = __builtin_nontemporal_load((const f32x4*)p); b[s] = __builtin_nontemporal_load((const f32x4*)(p + N)); }
    if (!inb) {
#pragma unroll
        for (int s = 0; s < 8; ++s) { a[s] = (f32x4){0.f, 0.f, 0.f, 0.f}; b[s] = (f32x4){0.f, 0.f, 0.f, 0.f}; } }
    f32x4 csum = {0.f, 0.f, 0.f, 0.f}, bsum = {0.f, 0.f, 0.f, 0.f};
    if constexpr (FOLD) {
#pragma unroll
        for (int s = 0; s < 8; ++s) { const int k = k0 + 2 * (4 * s + kr); const f32x2 g2 = *(const f32x2*)(lg + k), b2 = *(const f32x2*)(lb + k);
            bsum += a[s] * b2[0] + b[s] * b2[1]; a[s] = a[s] * g2[0]; b[s] = b[s] * g2[1]; }
    }
#pragma unroll
    for (int s = 0; s < 8; ++s) { const int kp = 4 * s + kr;
#pragma unroll
        for (int i = 0; i < 4; ++i) { const unsigned pk = cvtpk(a[s][i], b[s][i]); scr[(4 * nq + i) * 33 + kp] = pk; if constexpr (FOLD) csum[i] += bf_lo(pk) + bf_hi(pk); } }
    LDS_WAIT();
#pragma unroll
    for (int jj = 0; jj < 8; ++jj) { const int n = (lane >> 3) + 8 * jj, c = lane & 7; const LAS unsigned* s = scr + n * 33 + 4 * c;
        u32x4 o; o.x = s[0]; o.y = s[1]; o.z = s[2]; o.w = s[3];
        const int nn = n0 + n, drow = rmode ? (((nn >> 7) << 8) + (nn & 127) + (rmode == 2 ? 128 : 0)) : nn;
        *(u32x4*)(WT + (size_t)drow * K + k0 + 8 * c) = o; }
    LDS_WAIT();
    if constexpr (FOLD) {
#pragma unroll
        for (int i = 0; i < 4; ++i) { csum[i] += __shfl_xor(csum[i], 16); csum[i] += __shfl_xor(csum[i], 32); bsum[i] += __shfl_xor(bsum[i], 16); bsum[i] += __shfl_xor(bsum[i], 32); }
        LAS float* fs = (LAS float*)scr;
        if (kr == 0) { *(LAS f32x4*)(fs + 4 * nq) = csum; *(LAS f32x4*)(fs + 64 + 4 * nq) = bsum; }
        LDS_WAIT();
        const int nn = n0 + lane, drow = rmode ? (((nn >> 7) << 8) + (nn & 127) + (rmode == 2 ? 128 : 0)) : nn;
        if (nn < N) { unsafeAtomicAdd(cs + drow, fs[lane]); unsafeAtomicAdd(bs + drow, fs[64 + lane]); }
        LDS_WAIT();
    }
}

constexpr int I_INAB = 64 * 192, I_OUT = 64 * 64, I_INCD = 64 * 196, I_UP = 64 * 172, I_DN = 172 * 64;
constexpr int Q_OUTAB = I_OUT, Q_UG0 = Q_OUTAB + 2 * I_UP, Q_DN0 = Q_UG0 + I_DN, Q_INCD = Q_DN0 + I_INCD, Q_OUTCD = Q_INCD + I_OUT, Q_UG1 = Q_OUTCD + 2 * I_UP, Q_TOTAL = Q_UG1 + I_DN;
__device__ __forceinline__ void conv_queue_item(const Args& a, int q, LAS unsigned* scr, int lane) {
    unsigned char* ws = a.ws; unsigned char* ctl = ws + WS_CTL;
    int r = q; const float* W; int K, N, nblk; bf16* WT; int rmode = 0; const float* lg = nullptr; const float* lb = nullptr; float* cs = nullptr; float* bs = nullptr;
    if (r < I_OUT) { W = a.in[2]; K = DM; N = DM; nblk = 64; WT = (bf16*)(ws + WS_W_OUTAB); }
    else if ((r -= I_OUT) < I_UP) { W = a.in[9]; K = DM; N = DFF; nblk = 172; WT = (bf16*)(ws + WS_W_UG0); rmode = 1; lg = a.in[14]; lb = a.in[15]; cs = (float*)(ctl + CTL_CS_UG0); bs = (float*)(ctl + CTL_BS_UG0); }
    else if ((r -= I_UP) < I_UP) { W = a.in[10]; K = DM; N = DFF; nblk = 172; WT = (bf16*)(ws + WS_W_UG0); rmode = 2; lg = a.in[14]; lb = a.in[15]; cs = (float*)(ctl + CTL_CS_UG0); bs = (float*)(ctl + CTL_BS_UG0); }
    else if ((r -= I_UP) < I_DN) { W = a.in[13]; K = DFF; N = DM; nblk = 64; WT = (bf16*)(ws + WS_W_DN0); }
    else if ((r -= I_DN) < I_INCD) { W = a.in[3]; K = DM; N = N_CD; nblk = 196; WT = (bf16*)(ws + WS_W_INCD); lg = a.in[14] + DM; lb = a.in[15] + DM; cs = (float*)(ctl + CTL_CS_INCD); bs = (float*)(ctl + CTL_BS_INCD); }
    else if ((r -= I_INCD) < I_OUT) { W = a.in[8]; K = DM; N = DM; nblk = 64; WT = (bf16*)(ws + WS_W_OUTCD); }
    else if ((r -= I_OUT) < I_UP) { W = a.in[9] + (size_t)DM * DFF; K = DM; N = DFF; nblk = 172; WT = (bf16*)(ws + WS_W_UG1); rmode = 1; lg = a.in[14] + 2 * DM; lb = a.in[15] + 2 * DM; cs = (float*)(ctl + CTL_CS_UG1); bs = (float*)(ctl + CTL_BS_UG1); }
    else if ((r -= I_UP) < I_UP) { W = a.in[10] + (size_t)DM * DFF; K = DM; N = DFF; nblk = 172; WT = (bf16*)(ws + WS_W_UG1); rmode = 2; lg = a.in[14] + 2 * DM; lb = a.in[15] + 2 * DM; cs = (float*)(ctl + CTL_CS_UG1); bs = (float*)(ctl + CTL_BS_UG1); }
    else { r -= I_UP; W = a.in[13] + (size_t)DFF * DM; K = DFF; N = DM; nblk = 64; WT = (bf16*)(ws + WS_W_DN1); }
    if (lg) tr_item<true>(W, K, N, WT, r, nblk, scr, lane, rmode, lg, lb, cs, bs); else tr_item<false>(W, K, N, WT, r, nblk, scr, lane, rmode, lg, lb, cs, bs);
}
__device__ __forceinline__ void prologue(const Frame& F_, const Args& a) {
    Frame F = F_; F.tid = tid_of(F.wave); F.lane = F.tid & 63; asm volatile("" : "+v"(F.lane), "+v"(F.tid), "+s"(F.gw), "+s"(F.vcu), "+s"(F.wave));
    unsigned char* ws = a.ws;
    LAS unsigned* scr = (LAS unsigned*)(F.lds + F.wave * 8448);
    for (int it = F.gw; it < I_INAB; it += F.NGW)
        tr_item<false>(a.in[1], DM, N_AB, (bf16*)(ws + WS_W_INAB), it, 192, scr, F.lane, 0, nullptr, nullptr, nullptr, nullptr);
    const f32x4* x4 = (const f32x4*)a.in[0]; u32x2* xb = (u32x2*)(ws + WS_XB);
    for (size_t i = (size_t)F.gw * 64 + F.lane; i < (size_t)M * DM / 4; i += (size_t)F.NGW * 64) { const f32x4 v = __builtin_nontemporal_load(x4 + i); u32x2 o; o.x = cvtpk(v[0], v[1]); o.y = cvtpk(v[2], v[3]); xb[i] = o; }
}
template <int SEAM>
__device__ __forceinline__ void seam_wait(const Frame& F_, const Args& args, const XcdBarrier& bar, unsigned char* ws_, int limit) {
    Frame F = F_; F.tid = tid_of(F.wave); F.lane = F.tid & 63; asm volatile("" : "+v"(F.lane), "+v"(F.tid), "+s"(F.wave));
    unsigned* qw = (unsigned*)(opq_p(ws_) + WS_CTL + CTL_QUEUE);
    volatile LAS unsigned* sh = (volatile LAS unsigned*)(F.lds + CTRL_OFF + 768);
    LAS unsigned* scr = (LAS unsigned*)(F.lds + F.wave * 8448);
    const unsigned G = (unsigned)F.G;
    asm volatile("s_waitcnt vmcnt(0)" ::: "memory");
    __syncthreads();
    unsigned arrived = 0u;
    if (F.tid == 0) arrived = xb_add(&qw[64 * (SEAM + 1)], 1u) + 1u;
    for (;;) {
        if (F.tid == 0) {
            unsigned h = 0xffffffffu;
            const unsigned hp = xb_ld(&qw[0]);
            if (hp < (unsigned)Q_TOTAL) {
                if (arrived < G) arrived = xb_ld(&qw[64 * (SEAM + 1)]);
                if (arrived < G || hp < (unsigned)limit) h = xb_add(&qw[0], 8u);
            }
            sh[0] = h;
        }
        __syncthreads();
        const unsigned h = sh[0];
        __syncthreads();
        if (h >= (unsigned)Q_TOTAL) break;
        const int q = (int)h + F.wave;
        if (q < Q_TOTAL) conv_queue_item(args, q, scr, F.lane);
    }
    xcd_barrier(bar);
}

__device__ __forceinline__ void ln_phase(const Frame& F_, const bf16* zb, float* xo, const float* g, const float* b) {
    Frame F = F_; F.tid = tid_of(F.wave); F.lane = F.tid & 63; asm volatile("" : "+v"(F.lane), "+v"(F.tid), "+s"(F.gw), "+s"(F.vcu), "+s"(F.wave));
    f32x4 gv[8][2], bv[8][2];
#pragma unroll
    for (int j = 0; j < 8; ++j) { const float* gp = g + 8 * (F.lane + 64 * j); const float* bp = b + 8 * (F.lane + 64 * j);
        gv[j][0] = *(const f32x4*)gp; gv[j][1] = *(const f32x4*)(gp + 4); bv[j][0] = *(const f32x4*)bp; bv[j][1] = *(const f32x4*)(bp + 4); }
    for (int m = F.gw; m < M; m += F.NGW) {
        const u32x4* zr = (const u32x4*)(zb + (size_t)m * DM) + F.lane;
        u32x4 w[8];
#pragma unroll
        for (int j = 0; j < 8; ++j) w[j] = __builtin_nontemporal_load(zr + 64 * j);
        f32x4 v[8][2]; float s = 0.f;
#pragma unroll
        for (int j = 0; j < 8; ++j) { v[j][0] = (f32x4){bf_lo(w[j].x), bf_hi(w[j].x), bf_lo(w[j].y), bf_hi(w[j].y)}; v[j][1] = (f32x4){bf_lo(w[j].z), bf_hi(w[j].z), bf_lo(w[j].w), bf_hi(w[j].w)};
            s += ((v[j][0][0] + v[j][0][1]) + (v[j][0][2] + v[j][0][3])) + ((v[j][1][0] + v[j][1][1]) + (v[j][1][2] + v[j][1][3])); }
        const float mean = wave_sum(s) * (1.f / DM); float s2 = 0.f;
#pragma unroll
        for (int j = 0; j < 8; ++j)
#pragma unroll
            for (int h = 0; h < 2; ++h) { v[j][h] = v[j][h] - mean; s2 += (v[j][h][0] * v[j][h][0] + v[j][h][1] * v[j][h][1]) + (v[j][h][2] * v[j][h][2] + v[j][h][3] * v[j][h][3]); }
        const float rstd = 1.f / sqrtf(wave_sum(s2) * (1.f / DM) + LN_EPS);
        float* xr = xo + (size_t)m * DM + 8 * F.lane;
#pragma unroll
        for (int j = 0; j < 8; ++j)
#pragma unroll
            for (int h = 0; h < 2; ++h) __builtin_nontemporal_store(v[j][h] * rstd * gv[j][h] + bv[j][h], (f32x4*)(xr + 512 * j + 4 * h));
    }
}

__device__ __forceinline__ void ffn_fix_phase(const Frame& F_, bf16* H, const float* EG0, const float* EU0, const float* EGL, const float* cw, const float* cb) {
    Frame F = F_; F.tid = tid_of(F.wave); F.lane = F.tid & 63; asm volatile("" : "+v"(F.lane), "+v"(F.tid), "+s"(F.gw), "+s"(F.vcu), "+s"(F.wave));
    constexpr int C4 = DFF / 4;
    for (int idx = F.gw * 64 + F.lane; idx < 64 * C4; idx += F.NGW * 64) {
        const int pm = idx / C4, ch = (idx - pm * C4) * 4;
        f32x4 gl0 = {0.f, 0.f, 0.f, 0.f}, gl1 = gl0;
        if ((pm & 7) != 0) { gl0 = *(const f32x4*)(EGL + (size_t)((pm - 1) * 2) * DFF + ch); gl1 = *(const f32x4*)(EGL + (size_t)((pm - 1) * 2 + 1) * DFF + ch); }
        const f32x4 g0 = *(const f32x4*)(EG0 + (size_t)(pm * 2) * DFF + ch), g1 = *(const f32x4*)(EG0 + (size_t)(pm * 2 + 1) * DFF + ch);
        const f32x4 u0 = *(const f32x4*)(EU0 + (size_t)(pm * 2) * DFF + ch), u1 = *(const f32x4*)(EU0 + (size_t)(pm * 2 + 1) * DFF + ch);
        const f32x4 w0 = *(const f32x4*)(cw + ch), w1 = *(const f32x4*)(cw + DFF + ch), w2 = *(const f32x4*)(cw + 2 * DFF + ch), bb = *(const f32x4*)(cb + ch);
        const f32x4 y0 = w0 * gl0 + w1 * gl1 + w2 * g0 + bb, y1 = w0 * gl1 + w1 * g0 + w2 * g1 + bb;
        u32x2 o0, o1;
        o0.x = cvtpk(silu_f(y0[0]) * u0[0], silu_f(y0[1]) * u0[1]); o0.y = cvtpk(silu_f(y0[2]) * u0[2], silu_f(y0[3]) * u0[3]);
        o1.x = cvtpk(silu_f(y1[0]) * u1[0], silu_f(y1[1]) * u1[1]); o1.y = cvtpk(silu_f(y1[2]) * u1[2], silu_f(y1[3]) * u1[3]);
        *(u32x2*)(H + (size_t)(pm * 256) * DFF + ch) = o0; *(u32x2*)(H + (size_t)(pm * 256 + 1) * DFF + ch) = o1;
    }
}

__device__ __forceinline__ void kmean_phase(const Frame& F_, const bf16* QKV, float* kmean) {
    Frame F = F_; F.tid = tid_of(F.wave); F.lane = F.tid & 63; asm volatile("" : "+v"(F.lane), "+v"(F.tid), "+s"(F.gw), "+s"(F.vcu), "+s"(F.wave));
    LAS float* red = (LAS float*)F.lds;
    for (int it = F.vcu; it < 256; it += F.G) {
        const int b = it >> 5, n = (it >> 2) & 7, cbk = it & 3;
        const bf16* src = QKV + (size_t)(b * SEQ + n * 256 + F.wave * 32) * N_AB + 8192 + cbk * 512 + F.lane * 8;
        float acc[8];
#pragma unroll
        for (int j = 0; j < 8; ++j) acc[j] = 0.f;
        for (int r8 = 0; r8 < 32; r8 += 8) { u32x4 v[8];
#pragma unroll
            for (int r = 0; r < 8; ++r) v[r] = *(const u32x4*)(src + (size_t)(r8 + r) * N_AB);
#pragma unroll
            for (int r = 0; r < 8; ++r)
#pragma unroll
                for (int q = 0; q < 4; ++q) { acc[2 * q] += bf_lo(v[r][q]); acc[2 * q + 1] += bf_hi(v[r][q]); } }
#pragma unroll
        for (int j = 0; j < 8; ++j) red[F.wave * 512 + F.lane * 8 + j] = acc[j];
        LDS_WAIT(); WG_BAR();
        float s = 0.f;
#pragma unroll
        for (int w = 0; w < 8; ++w) s += red[w * 512 + F.tid];
        const int col = cbk * 512 + F.tid, h = col >> 7, d = col & 127;
        kmean[((size_t)(b * 16 + h) * 8 + n) * 128 + d] = s * (1.f / 256.f);
        LDS_WAIT(); WG_BAR();
    }
}

__device__ __forceinline__ void cd_pre_phase(const Frame& F_, const bf16* QKV, bf16* QKDC, const float* cw  , const float* cb, const float* gates, const float* bif, float* A2, float* M2, float* NM, unsigned* kn2) {
    Frame F = F_; F.tid = tid_of(F.wave); F.lane = F.tid & 63; asm volatile("" : "+v"(F.lane), "+v"(F.tid), "+s"(F.gw), "+s"(F.vcu), "+s"(F.wave));
    for (int it = F.gw; it < (M / 32) * 4; it += F.NGW) {
        const int rb = it >> 2, cbk = it & 3, c0 = cbk * 512 + F.lane * 8, r0 = rb * 32;
        float w[4][8], bb[8];
#pragma unroll
        for (int q = 0; q < 2; ++q) { const f32x4 t3 = *(const f32x4*)(cb + c0 + 4 * q);
#pragma unroll
            for (int j = 0; j < 4; ++j) bb[4 * q + j] = t3[j];
#pragma unroll
            for (int k = 0; k < 4; ++k) { const f32x4 t = *(const f32x4*)(cw + k * 2048 + c0 + 4 * q);
#pragma unroll
                for (int j = 0; j < 4; ++j) w[k][4 * q + j] = t[j]; } }
        const bf16* src = QKV + 6144 + c0;
        u32x4 x3 = {0u, 0u, 0u, 0u}, x2 = x3, x1 = x3;
        if ((r0 & (SEQ - 1)) != 0) { x3 = *(const u32x4*)(src + (size_t)(r0 - 3) * N_AB); x2 = *(const u32x4*)(src + (size_t)(r0 - 2) * N_AB); x1 = *(const u32x4*)(src + (size_t)(r0 - 1) * N_AB); }
        for (int t8 = 0; t8 < 32; t8 += 8) {
            u32x4 xv[8];
#pragma unroll
            for (int t = 0; t < 8; ++t) xv[t] = __builtin_nontemporal_load((const u32x4*)(src + (size_t)(r0 + t8 + t) * N_AB));
#pragma unroll
            for (int t = 0; t < 8; ++t) { u32x4 ov;
#pragma unroll
                for (int q = 0; q < 4; ++q) {
                    const float y0 = w[0][2 * q] * bf_lo(x3[q]) + w[1][2 * q] * bf_lo(x2[q]) + w[2][2 * q] * bf_lo(x1[q]) + w[3][2 * q] * bf_lo(xv[t][q]) + bb[2 * q];
                    const float y1 = w[0][2 * q + 1] * bf_hi(x3[q]) + w[1][2 * q + 1] * bf_hi(x2[q]) + w[2][2 * q + 1] * bf_hi(x1[q]) + w[3][2 * q + 1] * bf_hi(xv[t][q]) + bb[2 * q + 1];
                    ov[q] = cvtpk(silu_f(y0), silu_f(y1)); }
                *(u32x4*)(QKDC + (size_t)(r0 + t8 + t) * 2048 + c0) = ov; x3 = x2; x2 = x1; x1 = xv[t]; }
        }
    }
    for (int it = F.gw; it < (M / 64) * 16; it += F.NGW) {
        const int rb = it >> 4, h = it & 15, row = rb * 64 + F.lane;
        const u32x4* kp = (const u32x4*)(QKV + (size_t)row * N_AB + 2048 + h * 128); float s = 0.f;
#pragma unroll
        for (int j = 0; j < 16; ++j) { const u32x4 v = kp[j];
            s = fmaf(bf_lo(v.x), bf_lo(v.x), s); s = fmaf(bf_hi(v.x), bf_hi(v.x), s); s = fmaf(bf_lo(v.y), bf_lo(v.y), s); s = fmaf(bf_hi(v.y), bf_hi(v.y), s);
            s = fmaf(bf_lo(v.z), bf_lo(v.z), s); s = fmaf(bf_hi(v.z), bf_hi(v.z), s); s = fmaf(bf_lo(v.w), bf_lo(v.w), s); s = fmaf(bf_hi(v.w), bf_hi(v.w), s); }
#pragma unroll
        for (int o = 1; o < 64; o <<= 1) s = fmaxf(s, __shfl_xor(s, o));
        if (F.lane == 0) atomicMax(kn2 + (row >> 11) * 16 + h, __float_as_uint(s));
    }
    for (int sq = F.gw; sq < 64; sq += F.NGW) {
        const int b = sq >> 3, h = sq & 7; const float bi = bif[h], bfv = bif[8 + h];
        const float* gp = gates + (size_t)(b * SEQ + F.lane * 32) * 16;
        float lf[32], ai[32]; float run = 0.f;
#pragma unroll
        for (int t = 0; t < 32; ++t) { lf[t] = gp[t * 16 + 8 + h]; ai[t] = gp[t * 16 + h]; }
#pragma unroll
        for (int t = 0; t < 32; ++t) asm volatile("" : "+v"(lf[t]), "+v"(ai[t]));
#pragma unroll
        for (int t = 0; t < 32; ++t) { const float f = lf[t] + bfv; ai[t] += bi;
            const float ls = fminf(f, 0.f) - log1pf(expf(-fabsf(f)));
            run += ls; lf[t] = run; }
        float incl = run;
#pragma unroll
        for (int o = 1; o < 64; o <<= 1) { const float t = __shfl_up(incl, o); if (F.lane >= o) incl += t; }
        const float base = incl - run; float mx = -__builtin_inff();
#pragma unroll
        for (int t = 0; t < 32; ++t) { lf[t] += base; ai[t] -= lf[t]; mx = fmaxf(mx, ai[t]); }
        float minc = mx;
#pragma unroll
        for (int o = 1; o < 64; o <<= 1) { const float t = __shfl_up(minc, o); if (F.lane >= o) minc = fmaxf(minc, t); }
        float mprev = __shfl_up(minc, 1); if (F.lane == 0) mprev = -__builtin_inff();
        float cm = fmaxf(mprev, 0.f);
        float* a2o = A2 + (size_t)sq * SEQ + F.lane * 32; float* m2o = M2 + (size_t)sq * SEQ + F.lane * 32; float* nmo = NM + (size_t)sq * SEQ + F.lane * 32;
#pragma unroll
        for (int t = 0; t < 32; ++t) { cm = fmaxf(cm, ai[t]); a2o[t] = ai[t] * 1.4426950408889634f; m2o[t] = cm * 1.4426950408889634f; nmo[t] = expf(-lf[t] - cm); }
    }
}

__device__ __forceinline__ void cd_post_phase(const Frame& F_, const bf16* HD, const bf16* QKV, bf16* Y, const float* ng) {
    Frame F = F_; F.tid = tid_of(F.wave); F.lane = F.tid & 63; asm volatile("" : "+v"(F.lane), "+v"(F.tid), "+s"(F.gw), "+s"(F.vcu), "+s"(F.wave));
    for (int m = F.gw; m < M; m += F.NGW) {
        u32x2 hv[8], ov[8]; f32x4 g[8];
#pragma unroll
        for (int h = 0; h < 8; ++h) { const int c = h * 256 + F.lane * 4; hv[h] = __builtin_nontemporal_load((const u32x2*)(HD + (size_t)m * 2048 + c)); ov[h] = __builtin_nontemporal_load((const u32x2*)(QKV + (size_t)m * N_AB + 10240 + c)); g[h] = *(const f32x4*)(ng + c); }
        float v[8][4], s1[8], s2[8];
#pragma unroll
        for (int h = 0; h < 8; ++h) { v[h][0] = bf_lo(hv[h].x); v[h][1] = bf_hi(hv[h].x); v[h][2] = bf_lo(hv[h].y); v[h][3] = bf_hi(hv[h].y); s1[h] = (v[h][0] + v[h][1]) + (v[h][2] + v[h][3]); }
#pragma unroll
        for (int o = 1; o < 64; o <<= 1)
#pragma unroll
            for (int h = 0; h < 8; ++h) s1[h] += __shfl_xor(s1[h], o);
#pragma unroll
        for (int h = 0; h < 8; ++h) { const float mean = s1[h] * (1.f / 256.f);
#pragma unroll
            for (int j = 0; j < 4; ++j) v[h][j] -= mean;
            s2[h] = (v[h][0] * v[h][0] + v[h][1] * v[h][1]) + (v[h][2] * v[h][2] + v[h][3] * v[h][3]); }
#pragma unroll
        for (int o = 1; o < 64; o <<= 1)
#pragma unroll
            for (int h = 0; h < 8; ++h) s2[h] += __shfl_xor(s2[h], o);
#pragma unroll
        for (int h = 0; h < 8; ++h) { const float rstd = 1.f / sqrtf(s2[h] * (1.f / 256.f) + LN_EPS);
            const float o0 = bf_lo(ov[h].x), o1 = bf_hi(ov[h].x), o2 = bf_lo(ov[h].y), o3 = bf_hi(ov[h].y);
            const float y0 = v[h][0] * rstd * g[h][0] * __builtin_amdgcn_rcpf(1.f + __builtin_amdgcn_exp2f(-1.4426950408889634f * o0));
            const float y1 = v[h][1] * rstd * g[h][1] * __builtin_amdgcn_rcpf(1.f + __builtin_amdgcn_exp2f(-1.4426950408889634f * o1));
            const float y2 = v[h][2] * rstd * g[h][2] * __builtin_amdgcn_rcpf(1.f + __builtin_amdgcn_exp2f(-1.4426950408889634f * o2));
            const float y3 = v[h][3] * rstd * g[h][3] * __builtin_amdgcn_rcpf(1.f + __builtin_amdgcn_exp2f(-1.4426950408889634f * o3));
            u32x2 w; w.x = cvtpk(y0, y1); w.y = cvtpk(y2, y3);
            *(u32x2*)(Y + (size_t)m * DM + 2048 + h * 256 + F.lane * 4) = w; }
    }
}


#define GRID_BAR() xcd_barrier(bar)
#define PHASE_BEGIN constexpr int L = LAYER; GAS unsigned char* const W = (GAS unsigned char*)opq_p(ws); (void)L; (void)W;
template <int LAYER>
__device__ __forceinline__ void layer_body(const Frame& F, const Args& args, const XcdBarrier& bar, unsigned char* ws) {
    constexpr int layer = LAYER;
        { PHASE_BEGIN
            pg8::Gemm g{(const bf16*)(W + WS_XB), (const bf16*)(W + (L == 0 ? WS_W_INAB : WS_W_INCD)), M, L == 0 ? N_AB : N_CDP, DM};
            pg8::StaticOrder S; S.init(g.M, g.N, F.G, (int)blockIdx.x);
            pg8::EpiBf16 E{(unsigned char*)W, L, F.wave, F.lds};
            PH(2) pg8::gemm_phase<pg8::EpiBf16, pg8::StaticOrder, true, true>(F.lds, g, S, E);
        }
        seam_wait<LAYER * 8 + 0>(F, args, bar, ws, (LAYER == 0 ? 0 : Q_INCD));
        { PHASE_BEGIN
            if (L == 0) { PH(4) kmean_phase(F, (const bf16*)(W + WS_QKV), (float*)(W + WS_KMEAN)); }
            else PH(8) cd_pre_phase(F, (const bf16*)(W + WS_QKV), (bf16*)(W + WS_QKDC), (const float*)ldin(args, 5), (const float*)ldin(args, 6), (const float*)(W + WS_GATES), (const float*)ldin(args, 4), (float*)(W + WS_A2), (float*)(W + WS_M2), (float*)(W + WS_NM), (unsigned*)(W + WS_CTL + CTL_KN2));
        }
        seam_wait<LAYER * 8 + 1>(F, args, bar, ws, (LAYER == 0 ? 0 : Q_INCD));
        { PHASE_BEGIN
            const bf16* QKV = (const bf16*)(W + WS_QKV); bf16* Y = (bf16*)(W + WS_Y);
            if (L == 0) {
                for (int it = F.vcu; it < 512; it += F.G) { const int bh = it >> 2, pr = it & 3, b = bh >> 4, h = bh & 15;
                    const bf16* base = QKV + (size_t)b * SEQ * N_AB + h * 128; bf16* ob = Y + (size_t)b * SEQ * DM + h * 128;
                    for (int ps = 0; ps < 2; ++ps) PH(16) att::attn_block<att::MODE_DIL>(base, N_AB, base + 2048, N_AB, base + 4096, N_AB, ob, DM, ps ? 7 - pr : pr, (LAS char*)F.lds, nullptr, nullptr, nullptr, F.wave); }
                const float* KMEAN = (const float*)(W + WS_KMEAN);
                for (int it = F.vcu; it < 512; it += F.G) { const int bh = it >> 2, pr = it & 3, b = bh >> 4, h = bh & 15;
                    const bf16* base = QKV + (size_t)b * SEQ * N_AB + 6144 + h * 128; bf16* ob = Y + (size_t)b * SEQ * DM + 2048 + h * 128;
                    for (int ps = 0; ps < 2; ++ps) PH(32) att::attn_block<att::MODE_MOBA>(base, N_AB, base + 2048, N_AB, base + 4096, N_AB, ob, DM, ps ? 7 - pr : pr, (LAS char*)F.lds, KMEAN + (size_t)bh * 1024, nullptr, nullptr, F.wave); }
            } else {
                for (int it = F.vcu; it < 512; it += F.G) { const int bh = it >> 2, pr = it & 3, b = bh >> 4, h = bh & 15;
                    const bf16* base = QKV + (size_t)b * SEQ * N_AB + h * 128; bf16* ob = Y + (size_t)b * SEQ * DM + h * 128;
                    for (int ps = 0; ps < 2; ++ps) PH(64) att::attn_block<att::MODE_SB>(base, N_AB, base + 2048, N_AB, base + 4096, N_AB, ob, DM, ps ? 7 - pr : pr, (LAS char*)F.lds, (const float*)(W + WS_CTL + CTL_KN2) + bh, nullptr, nullptr, F.wave); }
                const bf16* QKDC = (const bf16*)(W + WS_QKDC); bf16* HD = (bf16*)(W + WS_HD); const float* A2 = (const float*)(W + WS_A2); const float* M2 = (const float*)(W + WS_M2); const float* NMv = (const float*)(W + WS_NM);
                for (int it = F.vcu; it < 512; it += F.G) { const int bv = it >> 2, pr = it & 3, b = bv >> 4, vh = bv & 15, h = vh >> 1, half = vh & 1;
                    const bf16* qd = QKDC + (size_t)b * SEQ * 2048 + h * 128; const bf16* vd = QKV + (size_t)b * SEQ * N_AB + 8192 + h * 256 + half * 128;
                    bf16* ob = HD + (size_t)b * SEQ * 2048 + h * 256 + half * 128; const size_t so = (size_t)(b * 8 + h) * SEQ;
                    for (int ps = 0; ps < 2; ++ps) PH(128) att::attn_block<att::MODE_ML>(qd, 2048, qd + 1024, 2048, vd, N_AB, ob, 2048, ps ? 7 - pr : pr, (LAS char*)F.lds, A2 + so, M2 + so, NMv + so, F.wave); }
            }
        }
        if (layer == 1) { seam_wait<LAYER * 8 + 2>(F, args, bar, ws, Q_INCD); PHASE_BEGIN PH(256) cd_post_phase(F, (const bf16*)(W + WS_HD), (const bf16*)(W + WS_QKV), (bf16*)(W + WS_Y), (const float*)ldin(args, 7)); }
        seam_wait<LAYER * 8 + 3>(F, args, bar, ws, (LAYER == 0 ? Q_OUTAB : Q_OUTCD));
        { PHASE_BEGIN
            pg8::Gemm g{(const bf16*)(W + WS_Y), (const bf16*)(W + (L == 0 ? WS_W_OUTAB : WS_W_OUTCD)), M, DM, DM};
            pg8::StaticOrder S; S.init(g.M, g.N, F.G, (int)blockIdx.x);
            pg8::EpiResid E{&args, (unsigned char*)W, L, 0, F.lds, F.wave};
            PH(512) pg8::gemm_phase<pg8::EpiResid, pg8::StaticOrder, true, true>(F.lds, g, S, E);
        }
        seam_wait<LAYER * 8 + 4>(F, args, bar, ws, (LAYER == 0 ? Q_UG0 : Q_UG1));
        { PHASE_BEGIN
            pg8::Gemm g{(const bf16*)(W + WS_XB), (const bf16*)(W + (L == 0 ? WS_W_UG0 : WS_W_UG1)), M, 2 * DFF, DM};
            pg8::StaticOrder S; S.init(g.M, g.N, F.G, (int)blockIdx.x);
            pg8::EpiFfnAct E{&args, (unsigned char*)W, L, F.lds, F.wave};
            PH(2048) pg8::gemm_phase<pg8::EpiFfnAct, pg8::StaticOrder, true, true>(F.lds, g, S, E);
        }
        seam_wait<LAYER * 8 + 5>(F, args, bar, ws, (LAYER == 0 ? Q_UG0 : Q_UG1));
        { PHASE_BEGIN PH(4096) ffn_fix_phase(F, (bf16*)(W + WS_U), (const float*)(W + WS_G), (const float*)(W + WS_G + 8 * MiB), (const float*)(W + WS_G + 16 * MiB), (const float*)ldin(args, 11) + (size_t)L * 3 * DFF, (const float*)ldin(args, 12) + (size_t)L * DFF); }
        seam_wait<LAYER * 8 + 6>(F, args, bar, ws, (LAYER == 0 ? Q_DN0 : Q_TOTAL));
        { PHASE_BEGIN
            pg8::Gemm g{(const bf16*)(W + WS_U), (const bf16*)(W + (L == 0 ? WS_W_DN0 : WS_W_DN1)), M, DM, DFF};
            pg8::StaticOrder S; S.init(g.M, g.N, F.G, (int)blockIdx.x, 2);
            pg8::EpiResid E{&args, (unsigned char*)W, L, 1, F.lds, F.wave};
            PH(8192) pg8::gemm_phase<pg8::EpiResid, pg8::StaticOrder, true, true>(F.lds, g, S, E);
        }
        seam_wait<LAYER * 8 + 7>(F, args, bar, ws, (LAYER == 0 ? Q_INCD : Q_TOTAL));
        if (layer == 1) { PHASE_BEGIN
            PH(1024) ln_phase(F, (const bf16*)(W + WS_XB), args.out, (const float*)ldin(args, 14) + (size_t)3 * DM, (const float*)ldin(args, 15) + (size_t)3 * DM); }
}
#undef PHASE_BEGIN

__global__ void __launch_bounds__(NWAVES * 64, 2) mk_fwd(Args args) {
    extern __shared__ __attribute__((aligned(16))) unsigned char lds_raw[];
    Frame F;
    F.lds = (LAS unsigned char*)lds_raw;
    F.tid = threadIdx.x; F.lane = F.tid & 63; F.wave = __builtin_amdgcn_readfirstlane(F.tid >> 6);
    F.G = gridDim.x; { const int bx = blockIdx.x; F.vcu = (F.G % 8 == 0) ? (bx % 8) * (F.G / 8) + bx / 8 : bx; }
    F.gw = F.vcu * NWAVES + F.wave; F.NGW = F.G * NWAVES;
    unsigned char* ws = args.ws;
    volatile LAS unsigned* MISC = (volatile LAS unsigned*)(F.lds + MISC_OFF);
    for (int u = F.tid; u < (LDS_BYTES - CTRL_OFF) / 4; u += NWAVES * 64) ((LAS unsigned*)(F.lds + CTRL_OFF))[u] = 0u;
    __syncthreads();
    XcdBarrier bar = xcd_barrier_post((unsigned*)(ws + WS_CTL) + CW_BAR, MISC + 8, F.wave);

    PH(1) prologue(F, args);
    GRID_BAR();

    layer_body<0>(F, args, bar, ws);
    layer_body<1>(F, args, bar, ws);
}

extern "C" void kernel_launch(void* const* d_in, const int* in_sizes, int n_in, void* d_out, int out_size, void* d_ws, size_t ws_size, hipStream_t stream) {
    static int grid = 0;
    if (grid == 0) {
        if (n_in != 16 || in_sizes[0] != M * DM || out_size != M * DM || ws_size < WS_END) { fprintf(stderr, "kernel_launch: unexpected shapes (n_in %d, in0 %d, out %d, ws %zu < %zu)\n", n_in, n_in > 0 ? in_sizes[0] : -1, out_size, ws_size, (size_t)WS_END); grid = -1; return; }
        int dev = 0, cus = 0;
        if (hipGetDevice(&dev) != hipSuccess || hipDeviceGetAttribute(&cus, hipDeviceAttributeMultiprocessorCount, dev) != hipSuccess) { grid = -1; return; }
        if (hipFuncSetAttribute((const void*)mk_fwd, hipFuncAttributeMaxDynamicSharedMemorySize, LDS_BYTES) != hipSuccess) { fprintf(stderr, "kernel_launch: hipFuncSetAttribute failed\n"); grid = -1; return; }
        int per_cu = 0;
        if (hipOccupancyMaxActiveBlocksPerMultiprocessor(&per_cu, (const void*)mk_fwd, NWAVES * 64, LDS_BYTES) != hipSuccess || per_cu < 1) fprintf(stderr, "kernel_launch: occupancy query says %d\n", per_cu);
        (void)hipGetLastError();
        grid = cus;
    }
    if (grid < 0) return;
    if (hipMemsetAsync((char*)d_ws + WS_CTL, 0, CTL_ZERO_BYTES, stream) != hipSuccess) return;
    Args a{};
    for (int i = 0; i < 16; ++i) a.in[i] = (const float*)d_in[i];
    a.out = (float*)d_out; a.ws = (unsigned char*)d_ws;
    hipLaunchKernelGGL(mk_fwd, dim3(grid), dim3(NWAVES * 64), LDS_BYTES, stream, a);
}
```

```cpp
#include <hip/hip_runtime.h>
#include <cstdio>
#include <cstdint>

#define LAS __attribute__((address_space(3)))
#define GAS __attribute__((address_space(1)))
typedef unsigned short bf16;
typedef short bf16x8 __attribute__((ext_vector_type(8)));
typedef short s16x4 __attribute__((ext_vector_type(4)));
typedef float f32x16 __attribute__((ext_vector_type(16)));
typedef float f32x4 __attribute__((ext_vector_type(4)));
typedef float f32x2 __attribute__((ext_vector_type(2)));
typedef unsigned u32x4 __attribute__((ext_vector_type(4)));
typedef unsigned u32x2 __attribute__((ext_vector_type(2)));

#ifndef PH_MASK
#define PH_MASK 0xFFFF
#endif
#define PH(x) if constexpr ((PH_MASK & (x)) != 0)

constexpr int BATCH = 8, SEQ = 2048, DM = 4096, M = BATCH * SEQ;
constexpr int DFF = 11008, N_AB = 12288, N_CD = 12304, N_CDP = 12544;
constexpr float ALPHA = 1.4142135623730951f;
constexpr float LN_EPS = 1e-5f;
constexpr int NWAVES = 8;

constexpr size_t MiB = 1u << 20;
constexpr size_t WS_CTL = 0, CTL_ZERO_BYTES = 1 * MiB;
constexpr size_t WS_KMEAN = 1 * MiB;
constexpr size_t WS_GATES = 2 * MiB;
constexpr size_t WS_A2 = 3 * MiB;
constexpr size_t WS_M2 = 3 * MiB + 512 * 1024;
constexpr size_t WS_NM = 4 * MiB;
constexpr size_t WS_W_INAB = 8 * MiB, WS_W_OUTAB = 104 * MiB, WS_W_UG0 = 136 * MiB, WS_W_DN0 = 308 * MiB;
constexpr size_t WS_W_INCD = 394 * MiB, WS_W_OUTCD = 492 * MiB, WS_W_UG1 = 524 * MiB, WS_W_DN1 = 696 * MiB;
constexpr size_t WS_XB = 782 * MiB;
constexpr size_t WS_R = 910 * MiB;
constexpr size_t WS_QKV = WS_R, WS_Y = WS_R + 384 * MiB, WS_QKDC = WS_R + 512 * MiB, WS_HD = WS_R + 576 * MiB;
constexpr size_t WS_U = WS_R, WS_G = WS_R + 344 * MiB;
constexpr size_t WS_END = WS_R + 688 * MiB;
static_assert((size_t)M * DFF * 2 == 344 * MiB, "u/g size");
constexpr int CW_BAR = 4096;
constexpr size_t CTL_KN2 = 32768;
constexpr size_t CTL_QUEUE = 45056;
constexpr size_t CTL_STATS = 65536;
constexpr size_t CTL_CS_UG0 = 524288, CTL_BS_UG0 = CTL_CS_UG0 + 88064, CTL_CS_INCD = CTL_BS_UG0 + 88064, CTL_BS_INCD = CTL_CS_INCD + 50176, CTL_CS_UG1 = CTL_BS_INCD + 50176, CTL_BS_UG1 = CTL_CS_UG1 + 88064;
static_assert(CTL_BS_UG1 + 88064 <= CTL_ZERO_BYTES && CTL_STATS + 3 * (size_t)M * 8 <= CTL_CS_UG0, "CTL map");

constexpr int RING_BYTES = 131072;
constexpr int CTRL_OFF = 143360;
constexpr int MISC_OFF = CTRL_OFF + 320;
constexpr int SIDE_OFF = CTRL_OFF + 1024 + 4096;
constexpr int SIDE_BYTES = 6144;
constexpr int SIDE_OFF_R = CTRL_OFF + 1024 + 8192;
constexpr int LDS_BYTES = 163840;

#define LDS_WAIT() asm volatile("s_waitcnt lgkmcnt(0)" ::: "memory")
#define VM_WAIT() asm volatile("s_waitcnt vmcnt(0)" ::: "memory")
#define SBAR() __builtin_amdgcn_sched_barrier(0)
#define WG_BAR() do { asm volatile("" ::: "memory"); __builtin_amdgcn_s_barrier(); asm volatile("" ::: "memory"); } while (0)

__device__ __forceinline__ unsigned cvtpk(float lo, float hi) { unsigned r; asm volatile("v_cvt_pk_bf16_f32 %0, %1, %2" : "=v"(r) : "v"(lo), "v"(hi)); return r; }
__device__ __forceinline__ float bf_lo(unsigned w) { return __uint_as_float(w << 16); }
__device__ __forceinline__ float bf_hi(unsigned w) { return __uint_as_float(w & 0xffff0000u); }
__device__ __forceinline__ float wave_sum(float v) {
#pragma unroll
    for (int o = 1; o < 64; o <<= 1) v += __shfl_xor(v, o);
    return v;
}
__device__ __forceinline__ float silu_f(float y) { return y * __builtin_amdgcn_rcpf(1.0f + __builtin_amdgcn_exp2f(-1.4426950408889634f * y)); }

struct Args { const float* in[16]; float* out; unsigned char* ws; };
static_assert(sizeof(Args) == 18 * 8, "Args has no padding");
__device__ __forceinline__ const GAS float* ldin(const Args& a, int i) { asm volatile("" : "+s"(i)); return (const GAS float*)a.in[i]; }
__device__ __forceinline__ int opq_i(int v) { asm volatile("" : "+s"(v)); return v; }
__device__ __forceinline__ unsigned char* opq_p(unsigned char* p) { asm volatile("" : "+s"(p)); return p; }

__device__ __forceinline__ int tid_of(int wave) { int l; asm volatile("v_mbcnt_lo_u32_b32 %0, -1, 0\n\tv_mbcnt_hi_u32_b32 %0, -1, %0" : "=v"(l)); return (wave << 6) | l; }
namespace pg8 {
typedef unsigned short bf16_t;
constexpr int BM = 256, BK = 64, HALF = 128, HTB = HALF * BK * 2, STAGE_BYTES = 8 * HTB, NXCD = 8, WGM = 8;
__host__ __device__ __forceinline__ int lds_byte(int r, int c) { const int st = (r >> 4) * 2 + (c >> 5), rr = r & 15, cc = c & 31, ob = rr * 64 + cc * 2; return st * 1024 + (ob ^ (((ob >> 9) & 1) << 5)); }
__host__ __device__ __forceinline__ void stage_rc(int b, int& R, int& C) { const int st = b / 1024, sb = b % 1024, swz = sb ^ (((sb >> 9) & 1) << 5); R = (st >> 1) * 16 + swz / 64; C = (st & 1) * 32 + (swz % 64) / 2; }
__host__ __device__ __forceinline__ int perm32(int rho) { const int n = rho >> 4, i = rho & 15; return 8 * (i >> 2) + 4 * n + (i & 3); }
struct Unit { int pm, pn, par; };
struct Gemm { const bf16_t* A; const bf16_t* Bt; int M, N, K; };
struct StaticOrder {
    int nM, nN, nwg, G, c, wgm;
    __host__ __device__ void init(int M_, int N_, int G_, int c_, int wgm_ = WGM) { nM = M_ / BM; nN = N_ / BM; nwg = nM * nN; G = G_; c = c_; wgm = wgm_; }
    __host__ __device__ bool next(int i, Unit& u) const {
        const long L = (long)i * G + c; if (L >= nwg) return false;
        int wgid = (int)L; { const int q = nwg / NXCD, r = nwg % NXCD, xcd = wgid % NXCD, off = wgid / NXCD; wgid = (xcd < r ? xcd * (q + 1) : r * (q + 1) + (xcd - r) * q) + off; }
        const int nig = wgm * nN, gid = wgid / nig, fm = gid * wgm, gsz = (nM - fm) < wgm ? (nM - fm) : wgm;
        u.pm = fm + ((wgid % nig) % gsz); u.pn = (wgid % nig) / gsz; return true;
    }
    __device__ __forceinline__ void a_ready(const Unit&) const {}
    __device__ __forceinline__ void done(const Unit&) const {}
};
struct EpiBf16 {
    static constexpr bool PERM = true, AFTER_DRAIN = false;
    unsigned char* W; int L, wave; LAS unsigned char* lds;
    __device__ __forceinline__ void prefetch(const Unit& u) const {
        if (L == 0) return;
        int tid_ = tid_of(wave); asm volatile("" : "+v"(tid_));
        const int wid = __builtin_amdgcn_readfirstlane(tid_ >> 6), lane = tid_ & 63;
        if (wid >= 4) return;
        GAS unsigned char* const Wg = (GAS unsigned char*)W;
        const GAS float* src;
        if (wid < 2) src = (const GAS float*)(Wg + WS_CTL + CTL_STATS) + (size_t)1 * M * 2 + (size_t)(u.pm * BM + wid * 128) * 2 + lane * 4;
        else src = (const GAS float*)(Wg + WS_CTL + (wid == 2 ? CTL_CS_INCD : CTL_BS_INCD)) + u.pn * BM + lane * 4;
        __builtin_amdgcn_global_load_lds((const unsigned*)src, (LAS unsigned*)(lds + SIDE_OFF + u.par * SIDE_BYTES + wid * 1024), 16, 0, 0);
    }
    __device__ __forceinline__ void operator()(const f32x4 (&acc)[2][2][4][2], const Unit& u, int wr_, int wc_, int fr_, int fq_) const {
        int tid_ = tid_of(wave); asm volatile("" : "+v"(tid_));
        GAS unsigned char* const Wg = (GAS unsigned char*)W;
        GAS bf16_t* const O = (GAS bf16_t*)(Wg + WS_QKV); constexpr int ldc = N_AB; GAS float* const gates = (GAS float*)(Wg + WS_GATES); const int gate_pn = L == 0 ? -1 : 48;
        const bool st = L != 0;
        const int wid = __builtin_amdgcn_readfirstlane(tid_ >> 6), wr = wid >> 2, wc = wid & 3, fr = tid_ & 15, fq = (tid_ & 63) >> 4;
        const int row0 = u.pm * BM + wr * 64 + fr;
        const LAS float* const side = (const LAS float*)(lds + SIDE_OFF + u.par * SIDE_BYTES);
        f32x4 csv[2][2], bsv[2][2]; f32x2 svv[2][4];
        if (st) {
#pragma unroll
            for (int bj = 0; bj < 2; ++bj)
#pragma unroll
                for (int n = 0; n < 2; ++n) { csv[bj][n] = *(const LAS f32x4*)(side + 512 + wc * 32 + 8 * fq + bj * HALF + 4 * n); bsv[bj][n] = *(const LAS f32x4*)(side + 768 + wc * 32 + 8 * fq + bj * HALF + 4 * n); }
#pragma unroll
            for (int ai = 0; ai < 2; ++ai)
#pragma unroll
                for (int m = 0; m < 4; ++m) svv[ai][m] = *(const LAS f32x2*)(side + (wr * 64 + fr + ai * HALF + m * 16) * 2);
        }
        const int col0 = u.pn * BM + wc * 32 + 8 * fq;
#pragma unroll
        for (int ai = 0; ai < 2; ++ai)
#pragma unroll
            for (int m = 0; m < 4; ++m) { const int row = row0 + ai * HALF + m * 16;
                float mu = 0.f, rs = 1.f;
                if (st) { const f32x2 sv = svv[ai][m]; mu = sv[0] * (1.f / DM); rs = __builtin_amdgcn_rsqf(sv[1] * (1.f / DM) - mu * mu + LN_EPS); }
                f32x4 v[2][2];
#pragma unroll
                for (int bj = 0; bj < 2; ++bj)
#pragma unroll
                    for (int n = 0; n < 2; ++n) v[bj][n] = st ? (acc[ai][bj][m][n] - csv[bj][n] * mu) * rs + bsv[bj][n] : acc[ai][bj][m][n];
                if (u.pn == gate_pn) { if (wc == 0 && fq < 2) { GAS float* gp = gates + (size_t)row * 16 + 8 * fq; *(GAS f32x4*)gp = v[0][0]; *(GAS f32x4*)(gp + 4) = v[0][1]; } }
                else { GAS bf16_t* rowp = O + (size_t)row * ldc + col0;
#pragma unroll
                    for (int bj = 0; bj < 2; ++bj) { u32x4 w; w.x = cvtpk(v[bj][0][0], v[bj][0][1]); w.y = cvtpk(v[bj][0][2], v[bj][0][3]); w.z = cvtpk(v[bj][1][0], v[bj][1][1]); w.w = cvtpk(v[bj][1][2], v[bj][1][3]);
                        __builtin_nontemporal_store(w, (GAS u32x4*)(rowp + bj * HALF)); } } }
    }
};
struct EpiResid {
    static constexpr bool PERM = true, AFTER_DRAIN = false;
    const Args* ap; unsigned char* W; int L, which; LAS unsigned char* lds; int wave;
    __device__ __forceinline__ void prefetch(const Unit& u) const {
        if (which == 0 && L == 0) return;
        int tid_ = tid_of(wave); asm volatile("" : "+v"(tid_));
        const int wid = __builtin_amdgcn_readfirstlane(tid_ >> 6), lane = tid_ & 63;
        if (wid >= 4) return;
        GAS unsigned char* const Wg = (GAS unsigned char*)W;
        const int lnoff = which == 0 ? DM : 2 * L * DM;
        const GAS float* src;
        if (wid < 2) src = (const GAS float*)(Wg + WS_CTL + CTL_STATS) + (size_t)(which == 0 ? 1 : (L == 0 ? 0 : 2)) * M * 2 + (size_t)(u.pm * BM + wid * 128) * 2 + lane * 4;
        else src = ldin(*ap, wid == 2 ? 14 : 15) + lnoff + u.pn * BM + lane * 4;
        __builtin_amdgcn_global_load_lds((const unsigned*)src, (LAS unsigned*)(lds + SIDE_OFF_R + u.par * 4096 + wid * 1024), 16, 0, 0);
    }
    __device__ __forceinline__ void operator()(const f32x4 (&acc)[2][2][4][2], const Unit& u, int wr_, int wc_, int fr_, int fq_) const {
        int tid_ = tid_of(wave); asm volatile("" : "+v"(tid_));
        const int wid = __builtin_amdgcn_readfirstlane(tid_ >> 6), wr = wid >> 2, wc = wid & 3, lane = tid_ & 63, fr = tid_ & 15, fq = (tid_ & 63) >> 4;
        GAS unsigned char* const Wg = (GAS unsigned char*)W; GAS float* const STATS = (GAS float*)(Wg + WS_CTL + CTL_STATS);
        const bool lastsub = (which == 1 && L == 1);
        const bool has_in = !(which == 0 && L == 0);
        const GAS bf16_t* const zbin = (const GAS bf16_t*)(Wg + WS_XB); GAS bf16_t* const zb = (GAS bf16_t*)(Wg + WS_XB); GAS float* const out32 = nullptr; (void)lastsub;
        GAS float* const st_out = which == 0 ? STATS + (size_t)(L == 0 ? 0 : 2) * M * 2 : (L == 0 ? STATS + (size_t)1 * M * 2 : nullptr);
        constexpr float alpha = ALPHA; LAS float* const red = (LAS float*)(lds + CTRL_OFF + 1024);
        const LAS float* const side = (const LAS float*)(lds + SIDE_OFF_R + u.par * 4096);
        constexpr int ldc = DM;
        const int row0 = u.pm * BM + wr * 64 + fr, col0 = u.pn * BM + wc * 32 + 8 * fq, cl = wc * 32 + 8 * fq;
        LAS float* myred = red + wid * 256;
        const unsigned boff0 = ((unsigned)row0 * ldc + (unsigned)col0) * 2u;
        u32x4 xr[2][4][2];
#pragma unroll
        for (int ai = 0; ai < 2; ++ai)
#pragma unroll
            for (int m = 0; m < 4; ++m) { const unsigned bo = boff0 + (unsigned)((ai * HALF + m * 16) * ldc * 2);
                xr[ai][m][0] = *(const GAS u32x4*)((const GAS char*)zbin + bo); xr[ai][m][1] = *(const GAS u32x4*)((const GAS char*)zbin + bo + HALF * 2); }
#pragma unroll
        for (int ai = 0; ai < 2; ++ai) { f32x2 s1v[4], s2v[4];
#pragma unroll
            for (int m = 0; m < 4; ++m) { s1v[m] = (f32x2){0.f, 0.f}; s2v[m] = (f32x2){0.f, 0.f}; }
#pragma unroll
            for (int bj = 0; bj < 2; ++bj) {
                f32x4 gv[2], bv[2];
                if (has_in) {
#pragma unroll
                    for (int n = 0; n < 2; ++n) { gv[n] = *(const LAS f32x4*)(side + 512 + cl + bj * HALF + 4 * n); bv[n] = *(const LAS f32x4*)(side + 768 + cl + bj * HALF + 4 * n); } }
#pragma unroll
                for (int m = 0; m < 4; ++m) { float mu = 0.f, rs = 1.f;
                    if (has_in) { const f32x2 sv = *(const LAS f32x2*)(side + (wr * 64 + fr + ai * HALF + m * 16) * 2); mu = sv[0] * (1.f / DM); rs = __builtin_amdgcn_rsqf(sv[1] * (1.f / DM) - mu * mu + LN_EPS); }
                    const u32x4 r = xr[ai][m][bj]; const unsigned bo = boff0 + (unsigned)(((ai * HALF + m * 16) * ldc + bj * HALF) * 2);
                    f32x4 x0 = (f32x4){bf_lo(r.x), bf_hi(r.x), bf_lo(r.y), bf_hi(r.y)}, x1 = (f32x4){bf_lo(r.z), bf_hi(r.z), bf_lo(r.w), bf_hi(r.w)};
                    if (has_in) { x0 = (x0 - mu) * rs * gv[0] + bv[0]; x1 = (x1 - mu) * rs * gv[1] + bv[1]; }
                    const f32x4 z0 = x0 * alpha + acc[ai][bj][m][0];
                    const f32x4 z1 = x1 * alpha + acc[ai][bj][m][1];
                    if (out32) { *(GAS f32x4*)((GAS char*)out32 + 2u * bo) = z0; *(GAS f32x4*)((GAS char*)out32 + 2u * bo + 16) = z1; }
                    if (zb) { u32x4 w; w.x = cvtpk(z0[0], z0[1]); w.y = cvtpk(z0[2], z0[3]); w.z = cvtpk(z1[0], z1[1]); w.w = cvtpk(z1[2], z1[3]); *(GAS u32x4*)((GAS char*)zb + bo) = w; }
                    { const f32x4 t = z0 + z1, q = z0 * z0 + z1 * z1;
                      s1v[m] += __builtin_shufflevector(t, t, 0, 1) + __builtin_shufflevector(t, t, 2, 3);
                      s2v[m] += __builtin_shufflevector(q, q, 0, 1) + __builtin_shufflevector(q, q, 2, 3); } }
            }
            if (st_out) {
#pragma unroll
                for (int m = 0; m < 4; ++m) { float a1 = s1v[m][0] + s1v[m][1], a2 = s2v[m][0] + s2v[m][1]; a1 += __shfl_xor(a1, 16); a1 += __shfl_xor(a1, 32); a2 += __shfl_xor(a2, 16); a2 += __shfl_xor(a2, 32);
                    if (fq == 0) *(LAS f32x2*)(myred + ((ai * 4 + m) * 16 + fr) * 2) = (f32x2){a1, a2}; } }
        }
        if (st_out) {
            asm volatile("s_waitcnt lgkmcnt(0)" ::: "memory"); __builtin_amdgcn_s_barrier(); asm volatile("" ::: "memory");
            const int idx = wid * 64 + lane, r = idx >> 1, c = idx & 1;
            const LAS float* q = red + ((r >> 6) & 1) * 1024 + ((((r >> 7) * 4 + ((r >> 4) & 3)) * 16 + (r & 15)) * 2 + c);
            const float sum = (q[0] + q[256]) + (q[512] + q[768]);
            unsafeAtomicAdd((float*)(st_out + (size_t)(u.pm * BM + r) * 2 + c), sum);
        }
    }
};

__device__ __forceinline__ float dpp_ror1(float x) { return __int_as_float(__builtin_amdgcn_update_dpp(0, __float_as_int(x), 0x121, 0xF, 0xF, false)); }
__device__ __forceinline__ float dpp_ror2(float x) { return __int_as_float(__builtin_amdgcn_update_dpp(0, __float_as_int(x), 0x122, 0xF, 0xF, false)); }
struct EpiFfnAct {
    static constexpr bool PERM = true, AFTER_DRAIN = false;
    const Args* ap; unsigned char* W; int L; LAS unsigned char* lds; int wave;
    __device__ __forceinline__ void prefetch(const Unit& u) const {
        int tid_ = tid_of(wave); asm volatile("" : "+v"(tid_));
        const int wid = __builtin_amdgcn_readfirstlane(tid_ >> 6), lane = tid_ & 63;
        if (wid >= 6) return;
        GAS unsigned char* const Wg = (GAS unsigned char*)W;
        const GAS float* src;
        if (wid < 2) src = (const GAS float*)(Wg + WS_CTL + CTL_STATS) + (size_t)(L == 0 ? 0 : 2) * M * 2 + (size_t)(u.pm * BM + wid * 128) * 2 + lane * 4;
        else if (wid == 2) src = (const GAS float*)(Wg + WS_CTL + (L == 0 ? CTL_CS_UG0 : CTL_CS_UG1)) + u.pn * BM + lane * 4;
        else if (wid == 3) src = (const GAS float*)(Wg + WS_CTL + (L == 0 ? CTL_BS_UG0 : CTL_BS_UG1)) + u.pn * BM + lane * 4;
        else { const int q = (wid - 4) * 2 + (lane >> 5);
            src = (q < 3 ? ldin(*ap, 11) + (size_t)L * 3 * DFF + (size_t)q * DFF : ldin(*ap, 12) + (size_t)L * DFF) + u.pn * 128 + (lane & 31) * 4; }
        __builtin_amdgcn_global_load_lds((const unsigned*)src, (LAS unsigned*)(lds + SIDE_OFF + u.par * SIDE_BYTES + wid * 1024), 16, 0, 0);
    }
    __device__ __forceinline__ void operator()(f32x4 (&acc)[2][2][4][2], const Unit& u, int wr_, int wc_, int fr_, int fq_) const {
        int tid_ = tid_of(wave); asm volatile("" : "+v"(tid_));
        GAS unsigned char* const Wg = (GAS unsigned char*)W;
        GAS bf16_t* const H = (GAS bf16_t*)(Wg + WS_U);
        GAS float* const EG0 = (GAS float*)(Wg + WS_G); GAS float* const EU0 = (GAS float*)(Wg + WS_G + 8 * MiB); GAS float* const EGL = (GAS float*)(Wg + WS_G + 16 * MiB); LAS float* const edge = (LAS float*)(lds + CTRL_OFF + 1024);
        const int wid = __builtin_amdgcn_readfirstlane(tid_ >> 6), wr = wid >> 2, wc = wid & 3, fr = tid_ & 15, fq = (tid_ & 63) >> 4;
        const int ch0 = u.pn * 128 + wc * 32 + fq * 8, row0 = u.pm * BM + wr * 64 + fr;
        const LAS float* const side = (const LAS float*)(lds + SIDE_OFF + u.par * SIDE_BYTES);
        const int cl = wc * 32 + 8 * fq;
        f32x2 sv[2][4]; f32x4 csg[2], bsg[2];
#pragma unroll
        for (int ai = 0; ai < 2; ++ai)
#pragma unroll
            for (int m = 0; m < 4; ++m) sv[ai][m] = *(const LAS f32x2*)(side + (wr * 64 + fr + ai * HALF + m * 16) * 2);
#pragma unroll
        for (int n = 0; n < 2; ++n) { csg[n] = *(const LAS f32x4*)(side + 512 + cl + HALF + 4 * n); bsg[n] = *(const LAS f32x4*)(side + 768 + cl + HALF + 4 * n); }
        float mu[2][4], rs[2][4];
#pragma unroll
        for (int ai = 0; ai < 2; ++ai)
#pragma unroll
            for (int m = 0; m < 4; ++m) { mu[ai][m] = sv[ai][m][0] * (1.f / DM); rs[ai][m] = __builtin_amdgcn_rsqf(sv[ai][m][1] * (1.f / DM) - mu[ai][m] * mu[ai][m] + LN_EPS);
#pragma unroll
                for (int n = 0; n < 2; ++n) acc[ai][1][m][n] = (acc[ai][1][m][n] - csg[n] * mu[ai][m]) * rs[ai][m] + bsg[n];
                asm volatile("" : "+v"(acc[ai][1][m][0]), "+v"(acc[ai][1][m][1])); }
        asm volatile("" ::: "memory");
        f32x4 csu[2], bsu[2], wt[4][2];
#pragma unroll
        for (int n = 0; n < 2; ++n) { csu[n] = *(const LAS f32x4*)(side + 512 + cl + 4 * n); bsu[n] = *(const LAS f32x4*)(side + 768 + cl + 4 * n);
#pragma unroll
            for (int q = 0; q < 4; ++q) wt[q][n] = *(const LAS f32x4*)(side + 1024 + q * 128 + cl + 4 * n); }
#define FFN_G(ai, m, n) (acc[ai][1][m][n])
#define FFN_U(ai, m, n) ((acc[ai][0][m][n] - csu[n] * mu[ai][m]) * rs[ai][m] + bsu[n])
        if (fr >= 14) {
#pragma unroll
            for (int ai = 0; ai < 2; ++ai) { LAS float* e = edge + ((((ai * 2 + wr) * 4 + wc) * 4 + fq) * 2 + (fr - 14)) * 8; *(LAS f32x4*)e = FFN_G(ai, 3, 0); *(LAS f32x4*)(e + 4) = FFN_G(ai, 3, 1); }
            if (wr == 1) { GAS float* p = EGL + (size_t)(u.pm * 2 + (fr - 14)) * DFF + ch0; *(GAS f32x4*)p = FFN_G(1, 3, 0); *(GAS f32x4*)(p + 4) = FFN_G(1, 3, 1); }
        }
        if (wr == 0 && fr < 2) { GAS float* pg = EG0 + (size_t)(u.pm * 2 + fr) * DFF + ch0; GAS float* pu = EU0 + (size_t)(u.pm * 2 + fr) * DFF + ch0;
            *(GAS f32x4*)pg = FFN_G(0, 0, 0); *(GAS f32x4*)(pg + 4) = FFN_G(0, 0, 1); *(GAS f32x4*)pu = FFN_U(0, 0, 0); *(GAS f32x4*)(pu + 4) = FFN_U(0, 0, 1); }
        asm volatile("s_waitcnt lgkmcnt(0)" ::: "memory"); __builtin_amdgcn_s_barrier(); asm volatile("" ::: "memory");
#pragma unroll
        for (int ai = 0; ai < 2; ++ai) {
            f32x4 e14[2] = {(f32x4){0.f, 0.f, 0.f, 0.f}, (f32x4){0.f, 0.f, 0.f, 0.f}}, e15[2] = {(f32x4){0.f, 0.f, 0.f, 0.f}, (f32x4){0.f, 0.f, 0.f, 0.f}};
            if (wr == 1 || ai == 1) { const int sa = (wr == 1) ? ai : 0, sw = (wr == 1) ? 0 : 1; const LAS float* e = edge + (((sa * 2 + sw) * 4 + wc) * 4 + fq) * 16;
                e14[0] = *(const LAS f32x4*)e; e14[1] = *(const LAS f32x4*)(e + 4); e15[0] = *(const LAS f32x4*)(e + 8); e15[1] = *(const LAS f32x4*)(e + 12); }
#pragma unroll
            for (int m = 0; m < 4; ++m) {
                float hv[8];
#pragma unroll
                for (int n = 0; n < 2; ++n) { const f32x4 uu = FFN_U(ai, m, n);
#pragma unroll
                    for (int jp = 0; jp < 2; ++jp) {
                        f32x2 P1, P2, GC;
#pragma unroll
                        for (int t = 0; t < 2; ++t) { const int j = 2 * jp + t; const float gc = acc[ai][1][m][n][j]; const float r1 = dpp_ror1(gc), r2 = dpp_ror2(gc);
                            float q1, q2;
                            if (m == 0) { q1 = e15[n][j]; q2 = (fr == 0) ? e14[n][j] : e15[n][j]; }
                            else { const float gpv = acc[ai][1][m > 0 ? m - 1 : 0][n][j]; q1 = dpp_ror1(gpv); q2 = dpp_ror2(gpv); }
                            P1[t] = (fr == 0) ? q1 : r1; P2[t] = (fr < 2) ? q2 : r2; GC[t] = gc; }
                        const f32x2 W0 = {wt[0][n][2 * jp], wt[0][n][2 * jp + 1]}, W1 = {wt[1][n][2 * jp], wt[1][n][2 * jp + 1]}, W2 = {wt[2][n][2 * jp], wt[2][n][2 * jp + 1]}, BB = {wt[3][n][2 * jp], wt[3][n][2 * jp + 1]};
                        const f32x2 U2 = {uu[2 * jp], uu[2 * jp + 1]};
                        const f32x2 Y = W0 * P2 + W1 * P1 + W2 * GC + BB;
                        const f32x2 T = Y * -1.4426950408889634f;
                        const f32x2 D = (f32x2){__builtin_amdgcn_exp2f(T[0]), __builtin_amdgcn_exp2f(T[1])} + 1.0f;
                        const f32x2 HH = Y * (f32x2){__builtin_amdgcn_rcpf(D[0]), __builtin_amdgcn_rcpf(D[1])} * U2;
                        hv[4 * n + 2 * jp] = HH[0]; hv[4 * n + 2 * jp + 1] = HH[1]; } }
                if (!(ai == 0 && m == 0 && wr == 0 && fr < 2)) { u32x4 w; w.x = cvtpk(hv[0], hv[1]); w.y = cvtpk(hv[2], hv[3]); w.z = cvtpk(hv[4], hv[5]); w.w = cvtpk(hv[6], hv[7]);
                    __builtin_nontemporal_store(w, (GAS u32x4*)(H + (size_t)(row0 + ai * HALF + m * 16) * DFF + ch0)); }
            }
        }
#undef FFN_G
#undef FFN_U
    }
};

template <class Epi, class Sched, bool ALIGN_EPI = false, bool SP2 = false>
__device__ __forceinline__ void gemm_phase(LAS unsigned char* lds, const Gemm g, const Sched& S, const Epi& E) {
    int tid_ = tid_of(E.wave); asm volatile("" : "+v"(tid_));
    const int tid = tid_, wid = __builtin_amdgcn_readfirstlane(tid >> 6), lane = tid & 63, wr = wid >> 2, wc = wid & 3, fr = lane & 15, fq = lane >> 4;
    const int K = g.K, nt = K / BK;
    unsigned voffA[2], voffB[2];
#pragma unroll
    for (int i = 0; i < 2; ++i) { int R, C; stage_rc(tid * 16 + i * 8192, R, C); const int Rb = Epi::PERM ? ((R & ~31) + perm32(R & 31)) : R;
        voffA[i] = (unsigned)(R * K + C) * 2u; voffB[i] = (unsigned)(Rb * K + C) * 2u; }
    const size_t kstep = (size_t)(BK * 2);
    const size_t hstep = (size_t)HALF * K * 2;
    const size_t tstep = 2 * hstep;
    const unsigned ldsw = (unsigned)wid * 1024u;
    const int aoff = lds_byte(wr * 64 + fr, fq * 8), boff = lds_byte(wc * 32 + fr, fq * 8);
#define PG8_SA(b, h) (((b) * 2 + (h)) * HTB)
#define PG8_SB(b, h) ((4 + (b) * 2 + (h)) * HTB)
#define PG8_STAGE(bufoff, gbase, voff) do { _Pragma("unroll") for (int _i = 0; _i < 2; ++_i) \
        __builtin_amdgcn_global_load_lds((const unsigned*)((const char*)(gbase) + (voff)[_i]), (LAS unsigned*)(lds + (bufoff) + ldsw + _i * 8192), 16, 0, 0); } while (0)
#define PG8_LDA(dst, b, h) do { _Pragma("unroll") for (int m = 0; m < 4; ++m) _Pragma("unroll") for (int k = 0; k < 2; ++k) dst[m][k] = *(const LAS bf16x8*)(lds + PG8_SA(b, h) + aoff + m * 2048 + k * 1024); } while (0)
#define PG8_LDB(dst, b, h) do { _Pragma("unroll") for (int n = 0; n < 2; ++n) _Pragma("unroll") for (int k = 0; k < 2; ++k) dst[n][k] = *(const LAS bf16x8*)(lds + PG8_SB(b, h) + boff + n * 2048 + k * 1024); } while (0)
#define PG8_MMA(ai, bj, At, Bt) do { __builtin_amdgcn_s_setprio(1); _Pragma("unroll") for (int m = 0; m < 4; ++m) _Pragma("unroll") for (int n = 0; n < 2; ++n) _Pragma("unroll") for (int k = 0; k < 2; ++k) \
        acc[ai][bj][m][n] = __builtin_amdgcn_mfma_f32_16x16x32_bf16(Bt[n][k], At[m][k], acc[ai][bj][m][n], 0, 0, 0); __builtin_amdgcn_s_setprio(0); } while (0)
#define PG8_WAIT_V(n) asm volatile("s_waitcnt vmcnt(" #n ")" ::: "memory")
#define PG8_WAIT_L(n) asm volatile("s_waitcnt lgkmcnt(" #n ")" ::: "memory")
#define PG8_BAR __builtin_amdgcn_s_barrier()
#define PG8_SCHED __builtin_amdgcn_sched_barrier(0)
    Unit cur, nxt; int ui = 0;
    if (!S.next(0, cur)) return;
    f32x4 acc[2][2][4][2];
#pragma unroll
    for (int a = 0; a < 2; ++a)
#pragma unroll
        for (int b = 0; b < 2; ++b)
#pragma unroll
            for (int m = 0; m < 4; ++m)
#pragma unroll
                for (int n = 0; n < 2; ++n) acc[a][b][m][n] = (f32x4){0.f, 0.f, 0.f, 0.f};
    bf16x8 At[4][2], B0[2][2], B1[2][2];
    const char* cA = (const char*)g.A + (size_t)cur.pm * tstep; const char* cB = (const char*)g.Bt + (size_t)cur.pn * tstep;
    cur.par = 0;
    S.a_ready(cur);
    if constexpr (SP2) {
        PG8_STAGE(PG8_SB(0, 0), cB, voffB); PG8_STAGE(PG8_SB(0, 1), cB + hstep, voffB); PG8_STAGE(PG8_SA(0, 0), cA, voffA); PG8_STAGE(PG8_SA(0, 1), cA + hstep, voffA);
        if (wr == 1) PG8_BAR;
        PG8_WAIT_V(2); PG8_BAR;
        PG8_STAGE(PG8_SB(1, 0), cB + kstep, voffB); PG8_STAGE(PG8_SA(1, 0), cA + kstep, voffA); PG8_STAGE(PG8_SB(1, 1), cB + hstep + kstep, voffB);
        PG8_WAIT_V(6); PG8_BAR;
    } else {
        PG8_STAGE(PG8_SB(0, 0), cB, voffB); PG8_STAGE(PG8_SA(0, 0), cA, voffA); PG8_STAGE(PG8_SB(0, 1), cB + hstep, voffB); PG8_STAGE(PG8_SA(0, 1), cA + hstep, voffA);
        if (wr == 1) PG8_BAR;
        PG8_WAIT_V(4); PG8_BAR;
        PG8_STAGE(PG8_SB(1, 0), cB + kstep, voffB); PG8_STAGE(PG8_SA(1, 0), cA + kstep, voffA); PG8_STAGE(PG8_SB(1, 1), cB + hstep + kstep, voffB);
        PG8_WAIT_V(6); PG8_BAR;
    }
    E.prefetch(cur);
    for (;;) {
        const bool has_next = S.next(ui + 1, nxt);
        const char* nA = has_next ? (const char*)g.A + (size_t)nxt.pm * tstep : cA; const char* nB = has_next ? (const char*)g.Bt + (size_t)nxt.pn * tstep : cB;
        for (int t = 0; t < nt; t += 2) {
            const bool last = (t == nt - 2);
            const char* a1 = cA + (size_t)(t + 1) * kstep;
            const char* a2 = last ? nA : cA + (size_t)(t + 2) * kstep; const char* b2 = last ? nB : cB + (size_t)(t + 2) * kstep;
            const char* a3 = a2 + kstep; const char* b3 = b2 + kstep;
            if (last && has_next) S.a_ready(nxt);
            if constexpr (SP2) {
            PG8_LDB(B0, 0, 0); PG8_LDB(B1, 0, 1); PG8_SCHED; PG8_LDA(At, 0, 0); PG8_STAGE(PG8_SA(1, 1), a1 + hstep, voffA);
            PG8_WAIT_V(8); PG8_WAIT_L(0); PG8_BAR; PG8_MMA(0, 0, At, B0); PG8_MMA(0, 1, At, B1); PG8_BAR; PG8_SCHED;
            PG8_LDA(At, 0, 1); PG8_STAGE(PG8_SB(0, 0), b2, voffB); PG8_STAGE(PG8_SB(0, 1), b2 + hstep, voffB); PG8_STAGE(PG8_SA(0, 0), a2, voffA);
            PG8_WAIT_V(8); PG8_WAIT_L(0); PG8_BAR; PG8_MMA(1, 0, At, B0); PG8_MMA(1, 1, At, B1); PG8_BAR; PG8_SCHED;
            PG8_LDB(B0, 1, 0); PG8_LDB(B1, 1, 1); PG8_SCHED; PG8_LDA(At, 1, 0); PG8_STAGE(PG8_SA(0, 1), a2 + hstep, voffA);
            PG8_WAIT_V(8); PG8_WAIT_L(0); PG8_BAR; PG8_MMA(0, 0, At, B0); PG8_MMA(0, 1, At, B1); PG8_BAR; PG8_SCHED;
            PG8_LDA(At, 1, 1); PG8_STAGE(PG8_SB(1, 0), b3, voffB); PG8_STAGE(PG8_SB(1, 1), b3 + hstep, voffB); PG8_STAGE(PG8_SA(1, 0), a3, voffA);
            PG8_WAIT_V(8); PG8_WAIT_L(0); PG8_BAR; PG8_MMA(1, 0, At, B0); PG8_MMA(1, 1, At, B1); PG8_BAR; PG8_SCHED;
            } else {
            PG8_LDB(B0, 0, 0); PG8_SCHED; PG8_LDA(At, 0, 0); PG8_STAGE(PG8_SA(1, 1), a1 + hstep, voffA);
            PG8_WAIT_L(8); PG8_BAR; PG8_WAIT_L(0); PG8_MMA(0, 0, At, B0); PG8_BAR; PG8_SCHED;
            PG8_LDB(B1, 0, 1); PG8_STAGE(PG8_SB(0, 0), b2, voffB);
            PG8_BAR; PG8_WAIT_L(0); PG8_MMA(0, 1, At, B1); PG8_BAR;
            PG8_LDA(At, 0, 1); PG8_STAGE(PG8_SA(0, 0), a2, voffA);
            PG8_BAR; PG8_WAIT_L(0); PG8_MMA(1, 0, At, B0); PG8_BAR; PG8_SCHED;
            PG8_STAGE(PG8_SB(0, 1), b2 + hstep, voffB);
            PG8_WAIT_V(6); PG8_BAR; PG8_MMA(1, 1, At, B1); PG8_BAR;
            PG8_LDB(B0, 1, 0); PG8_SCHED; PG8_LDA(At, 1, 0); PG8_STAGE(PG8_SA(0, 1), a2 + hstep, voffA);
            PG8_WAIT_L(8); PG8_BAR; PG8_WAIT_L(0); PG8_MMA(0, 0, At, B0); PG8_BAR; PG8_SCHED;
            PG8_LDB(B1, 1, 1); PG8_STAGE(PG8_SB(1, 0), b3, voffB);
            PG8_BAR; PG8_WAIT_L(0); PG8_MMA(0, 1, At, B1); PG8_BAR;
            PG8_LDA(At, 1, 1); PG8_STAGE(PG8_SA(1, 0), a3, voffA);
            PG8_BAR; PG8_WAIT_L(0); PG8_MMA(1, 0, At, B0); PG8_BAR; PG8_SCHED;
            PG8_STAGE(PG8_SB(1, 1), b3 + hstep, voffB);
            PG8_WAIT_V(6); PG8_BAR; PG8_MMA(1, 1, At, B1); PG8_BAR;
            }
        }
        if constexpr (ALIGN_EPI) { if (wr == 0) PG8_BAR; }
        if constexpr (!Epi::AFTER_DRAIN) { E(acc, cur, wr, wc, fr, fq); S.done(cur); }
        if (!has_next) break;
#pragma unroll
        for (int a = 0; a < 2; ++a)
#pragma unroll
            for (int b = 0; b < 2; ++b)
#pragma unroll
                for (int m = 0; m < 4; ++m)
#pragma unroll
                    for (int n = 0; n < 2; ++n) acc[a][b][m][n] = (f32x4){0.f, 0.f, 0.f, 0.f};
        cur = nxt; cA = nA; cB = nB; ++ui; cur.par = ui & 1;
        E.prefetch(cur);
        if constexpr (ALIGN_EPI) { if (wr == 1) PG8_BAR; }
    }
    PG8_WAIT_V(0);
    if constexpr (!ALIGN_EPI) { if (wr == 0) PG8_BAR; }
    PG8_BAR;
#undef PG8_SA
#undef PG8_SB
#undef PG8_STAGE
#undef PG8_LDA
#undef PG8_LDB
#undef PG8_MMA
#undef PG8_WAIT_V
#undef PG8_WAIT_L
#undef PG8_BAR
#undef PG8_SCHED
}
}

#define XB_TMO      128
#define XB_XCNT(j)  (256  + 64 * (j))
#define XB_XSUB(j)  (1280 + 64 * (j))
#define XB_XGEN(j)  (2304 + 64 * (j))
#define XB_TOP      3328
#define XB_TOPGEN   3392
#define XCD_BAR_WORDS 3456
#define XB_SPIN_CAP (1u << 18)
__device__ __forceinline__ unsigned xb_ld(unsigned* p)              { return __hip_atomic_load((GAS unsigned*)p, __ATOMIC_RELAXED, __HIP_MEMORY_SCOPE_AGENT); }
__device__ __forceinline__ unsigned xb_add(unsigned* p, unsigned v) { return __hip_atomic_fetch_add((GAS unsigned*)p, v, __ATOMIC_RELAXED, __HIP_MEMORY_SCOPE_AGENT); }
__device__ __forceinline__ unsigned xb_xcc_id() { return (unsigned)__builtin_amdgcn_s_getreg((3 << 11) | 20) & 0xFu; }
#define XB_SPIN(cond, bar) do { unsigned _sp = 0; while (cond) { __builtin_amdgcn_s_sleep(1); \
    if ((++_sp & 255u) == 0u) { if (xb_ld(&(bar)[XB_TMO])) break; if (_sp > XB_SPIN_CAP) { (void)xb_add(&(bar)[XB_TMO], 1u); break; } } } } while (0)
struct XcdBarrier { unsigned* bar; unsigned x; volatile LAS unsigned* st; int wave; };
__device__ __forceinline__ XcdBarrier xcd_barrier_post(unsigned* bar, volatile LAS unsigned* st, int wave) {
    XcdBarrier b; b.bar = bar; b.x = xb_xcc_id(); b.st = st; b.wave = wave;
    if (tid_of(wave) == 0) (void)xb_add(&bar[XB_XCNT(b.x)], 1u);
    return b;
}
__device__ __forceinline__ void xcd_barrier_complete(unsigned* bar, unsigned x, unsigned& nloc, unsigned& nx) {
    const unsigned G = gridDim.x * gridDim.y * gridDim.z;
    unsigned sum, cnt, mine, sp = 0u;
    for (;;) {
        sum = 0u; cnt = 0u; mine = 0u;
#pragma unroll
        for (unsigned j = 0; j < 16; ++j) { const unsigned c = xb_ld(&bar[XB_XCNT(j)]); sum += c; cnt += (c > 0u) ? 1u : 0u; mine = (j == x) ? c : mine; }
        if (sum == G) break;
        __builtin_amdgcn_s_sleep(1);
        if ((++sp & 255u) == 0u) { if (xb_ld(&bar[XB_TMO])) break; if (sp > XB_SPIN_CAP) { (void)xb_add(&bar[XB_TMO], 1u); break; } }
    }
    nloc = mine > 0u ? mine : 1u; nx = cnt > 0u ? cnt : 1u;
}
__device__ __forceinline__ void xcd_barrier(const XcdBarrier& b) {
    asm volatile("s_waitcnt vmcnt(0)" ::: "memory");
    __syncthreads();
    if (tid_of(b.wave) == 0) {
        unsigned* bar = b.bar; unsigned bx = b.x;
        asm volatile("" : "+s"(bar), "+s"(bx));
        __builtin_amdgcn_s_waitcnt(0);
        unsigned nloc = b.st[0], nx = b.st[1];
        if (nloc == 0u) { xcd_barrier_complete(bar, bx, nloc, nx); b.st[0] = nloc; b.st[1] = nx; }
        const unsigned old = xb_add(&bar[XB_XSUB(bx)], 1u);
        const unsigned gen = old / nloc;
        if (old + 1u == (gen + 1u) * nloc) {
            __builtin_amdgcn_fence(__ATOMIC_RELEASE, "agent");
            asm volatile("s_waitcnt vmcnt(0)" ::: "memory");
            const unsigned og = xb_add(&bar[XB_TOP], 1u);
            const unsigned tg = og / nx;
            if (og + 1u == (tg + 1u) * nx) xb_add(&bar[XB_TOPGEN], 1u);
            else XB_SPIN(xb_ld(&bar[XB_TOPGEN]) == tg, bar);
            __builtin_amdgcn_fence(__ATOMIC_ACQUIRE, "agent");
            xb_add(&bar[XB_XGEN(bx)], 1u);
            asm volatile("s_waitcnt vmcnt(0)" ::: "memory");
        } else {
            XB_SPIN(xb_ld(&bar[XB_XGEN(bx)]) == gen, bar);
            __builtin_amdgcn_fence(__ATOMIC_ACQUIRE, "agent");
            asm volatile("s_waitcnt vmcnt(0)" ::: "memory");
        }
    }
    __syncthreads();
}

namespace att {
constexpr int D = 128, SHM = 16384;
constexpr int OFF_V = 0, OFF_K = 2 * SHM, OFF_WS = 4 * SHM, OFF_AUX = 4 * SHM + 2048, OFF_Q = 4 * SHM + 2048 + 8192  , LDS_USED = OFF_Q + 65536;
static_assert(LDS_USED <= CTRL_OFF, "attention LDS map");
static_assert(SIDE_OFF + 2 * SIDE_BYTES <= LDS_BYTES && SIDE_OFF_R + 2 * 4096 <= LDS_BYTES, "side tables");
constexpr float SCALE = 0.08838834764831845f;
constexpr float C2 = 1.4426950408889634f * SCALE;
constexpr float THR = 8.f;
enum { MODE_DIL = 0, MODE_MOBA = 1, MODE_SB = 2, MODE_ML = 3 };
#define KSWZ(row, colB) ((row) * 256 + ((colB) ^ (((row) & 7) << 4)))
__device__ __forceinline__ int v_st(int k, int c) { const int kk = (k & ~0xC) | ((k & 4) << 1) | ((k & 8) >> 1); return ((kk >> 3) * 4 + (c >> 5)) * 512 + ((kk & 7) * 32 + (c & 31)) * 2; }
__device__ __forceinline__ int v_rd_base(int lane) { return ((lane & 3) << 3) | (((lane >> 2) & 3) << 6) | (((lane >> 4) & 1) << 5) | (((lane >> 5) & 1) << 8); }
__device__ __forceinline__ int crow(int r, int hi) { return (r & 3) + 8 * (r >> 2) + 4 * hi; }
__device__ __forceinline__ void glds16(const void* gsrc, unsigned lds_dst) { unsigned keep;
    asm volatile("s_mov_b32 %0, m0\n\ts_mov_b32 m0, %2\n\ts_nop 0\n\tglobal_load_lds_dwordx4 %1, off\n\ts_mov_b32 m0, %0" : "=&s"(keep) : "v"(gsrc), "s"(lds_dst) : "memory"); }
__device__ __forceinline__ void mask_tile(f32x16& p0, f32x16& p1, int dq) {
    const float NEG = -__builtin_inff();
#pragma unroll
    for (int r = 0; r < 16; ++r) {
        const int c = (r & 3) + 8 * (r >> 2);
        if (dq - c < 0) p0[r] = NEG;
        if (dq - c - 32 < 0) p1[r] = NEG;
    }
}
__device__ __forceinline__ void partialSM(f32x16& p0, f32x16& p1, float& m_reg, float& mn, float& alpha) {
    float pmax = p0[0];
#pragma unroll
    for (int r = 1; r < 16; ++r) pmax = fmaxf(pmax, p0[r]);
#pragma unroll
    for (int r = 0; r < 16; ++r) pmax = fmaxf(pmax, p1[r]);
    { auto rr = __builtin_amdgcn_permlane32_swap(__float_as_uint(pmax), __float_as_uint(pmax), false, false);
      pmax = fmaxf(__uint_as_float(rr[0]), __uint_as_float(rr[1])); }
    if (__builtin_expect(__all((pmax - m_reg) * SCALE <= THR), 1)) { mn = m_reg; alpha = 1.f; }
    else { mn = fmaxf(m_reg, pmax); alpha = __builtin_amdgcn_exp2f((m_reg - mn) * C2); m_reg = mn; }
    const float mnL = -mn * C2;
#pragma unroll
    for (int r = 0; r < 16; ++r) p0[r] = fmaf(p0[r], C2, mnL);
#pragma unroll
    for (int r = 0; r < 16; ++r) p1[r] = fmaf(p1[r], C2, mnL);
#pragma unroll
    for (int r = 0; r < 16; ++r) p0[r] = __builtin_amdgcn_exp2f(p0[r]);
#pragma unroll
    for (int r = 0; r < 16; ++r) p1[r] = __builtin_amdgcn_exp2f(p1[r]);
}
#define ATT_PK4(P, B_, OUT) do { unsigned a0 = cvtpk(P[B_+0], P[B_+1]), a1 = cvtpk(P[B_+2], P[B_+3]);                          \
        unsigned b0 = cvtpk(P[B_+4], P[B_+5]), b1 = cvtpk(P[B_+6], P[B_+7]);                                             \
        auto r0 = __builtin_amdgcn_permlane32_swap(a0, b0, false, false); auto r1 = __builtin_amdgcn_permlane32_swap(a1, b1, false, false); \
        u32x4 w = {r0[0], r1[0], r0[1], r1[1]}; OUT = *reinterpret_cast<bf16x8*>(&w); } while (0)
__device__ __forceinline__ void pack_p(const f32x16& p0, const f32x16& p1, bf16x8& pa0, bf16x8& pa1, bf16x8& pa2, bf16x8& pa3) {
    ATT_PK4(p0, 0, pa0); ATT_PK4(p0, 8, pa1); ATT_PK4(p1, 0, pa2); ATT_PK4(p1, 8, pa3);
}
__device__ __forceinline__ float pair_sum(float v) {
    auto rr = __builtin_amdgcn_permlane32_swap(__float_as_uint(v), __float_as_uint(v), false, false);
    return __uint_as_float(rr[0]) + __uint_as_float(rr[1]);
}
__device__ __forceinline__ void qkt(f32x16& p0, f32x16& p1, const LAS char* Kb, int r32, int hi, const bf16x8* qr) {
#pragma unroll
    for (int r = 0; r < 16; ++r) { p0[r] = 0.f; p1[r] = 0.f; }
    const LAS char* kb[4];
#pragma unroll
    for (int dd = 0; dd < 4; ++dd) kb[dd] = Kb + KSWZ(r32, (dd * 16 + hi * 8) * 2);
#pragma unroll
    for (int d0 = 0; d0 < 8; ++d0) { const LAS char* a = kb[d0 & 3] + (d0 >> 2) * 128;
        const bf16x8 b0 = *reinterpret_cast<const LAS bf16x8*>(a);
        const bf16x8 b1 = *reinterpret_cast<const LAS bf16x8*>(a + 32 * 256);
        p0 = __builtin_amdgcn_mfma_f32_32x32x16_bf16(b0, qr[d0], p0, 0, 0, 0);
        p1 = __builtin_amdgcn_mfma_f32_32x32x16_bf16(b1, qr[d0], p1, 0, 0, 0); }
}
__device__ __forceinline__ void qkt_lq(f32x16& p0, f32x16& p1, const LAS char* Kb, int r32, int hi, const LAS char* Qw) {
#pragma unroll
    for (int r = 0; r < 16; ++r) { p0[r] = 0.f; p1[r] = 0.f; }
    const LAS char* kb[4];
#pragma unroll
    for (int dd = 0; dd < 4; ++dd) kb[dd] = Kb + KSWZ(r32, (dd * 16 + hi * 8) * 2);
#pragma unroll
    for (int d0 = 0; d0 < 8; ++d0) { const LAS char* a = kb[d0 & 3] + (d0 >> 2) * 128;
        const bf16x8 b0 = *reinterpret_cast<const LAS bf16x8*>(a);
        const bf16x8 b1 = *reinterpret_cast<const LAS bf16x8*>(a + 32 * 256);
        const bf16x8 q = *reinterpret_cast<const LAS bf16x8*>(Qw + d0 * 1024);
        p0 = __builtin_amdgcn_mfma_f32_32x32x16_bf16(b0, q, p0, 0, 0, 0);
        p1 = __builtin_amdgcn_mfma_f32_32x32x16_bf16(b1, q, p1, 0, 0, 0); }
}
__device__ __forceinline__ void pv_tile(f32x16* o, int vb0, bf16x8 pa0, bf16x8 pa1, bf16x8 pa2, bf16x8 pa3) {
#define TRRD(dst, off) asm volatile("ds_read_b64_tr_b16 %0, %1 offset:%2" : "=&v"(dst) : "v"(vb0), "i"(off) : "memory")
#define PV_D0(d0) do { s16x4 l0, l1, l2, l3, h0, h1, h2, h3; constexpr int b_ = (d0) * 512; \
        TRRD(l0, b_); TRRD(h0, b_ + 2048); TRRD(l1, b_ + 4096); TRRD(h1, b_ + 6144); TRRD(l2, b_ + 8192); TRRD(h2, b_ + 10240); TRRD(l3, b_ + 12288); TRRD(h3, b_ + 14336); \
        asm volatile("s_waitcnt lgkmcnt(0)" ::: "memory"); SBAR();   \
        o[d0] = __builtin_amdgcn_mfma_f32_32x32x16_bf16(pa0, (bf16x8){l0[0], l0[1], l0[2], l0[3], h0[0], h0[1], h0[2], h0[3]}, o[d0], 0, 0, 0);   \
        o[d0] = __builtin_amdgcn_mfma_f32_32x32x16_bf16(pa1, (bf16x8){l1[0], l1[1], l1[2], l1[3], h1[0], h1[1], h1[2], h1[3]}, o[d0], 0, 0, 0);   \
        o[d0] = __builtin_amdgcn_mfma_f32_32x32x16_bf16(pa2, (bf16x8){l2[0], l2[1], l2[2], l2[3], h2[0], h2[1], h2[2], h2[3]}, o[d0], 0, 0, 0);   \
        o[d0] = __builtin_amdgcn_mfma_f32_32x32x16_bf16(pa3, (bf16x8){l3[0], l3[1], l3[2], l3[3], h3[0], h3[1], h3[2], h3[3]}, o[d0], 0, 0, 0); } while (0)
    PV_D0(0); PV_D0(1); PV_D0(2); PV_D0(3);
#undef PV_D0
#undef TRRD
}


__device__ __forceinline__ void softmax_start(f32x16& p0, f32x16& p1, float& m_reg, float& alpha) {
    float pmax = p0[0];
#pragma unroll
    for (int r = 1; r < 16; ++r) pmax = fmaxf(pmax, p0[r]);
#pragma unroll
    for (int r = 0; r < 16; ++r) pmax = fmaxf(pmax, p1[r]);
    { auto rr = __builtin_amdgcn_permlane32_swap(__float_as_uint(pmax), __float_as_uint(pmax), false, false);
      pmax = fmaxf(__uint_as_float(rr[0]), __uint_as_float(rr[1])); }
    float mn;
    if (__builtin_expect(__all((pmax - m_reg) * SCALE <= THR), 1)) { mn = m_reg; alpha = 1.f; }
    else { mn = fmaxf(m_reg, pmax); alpha = __builtin_amdgcn_exp2f((m_reg - mn) * C2); m_reg = mn; }
    const float mnL = -mn * C2;
#pragma unroll
    for (int r = 0; r < 16; ++r) p0[r] = fmaf(p0[r], C2, mnL);
#pragma unroll
    for (int r = 0; r < 16; ++r) p1[r] = fmaf(p1[r], C2, mnL);
#pragma unroll
    for (int r = 0; r < 16; ++r) p0[r] = __builtin_amdgcn_exp2f(p0[r]);
}
__device__ __forceinline__ void softmax_finish(f32x16& p0, f32x16& p1, float alpha, float& l_reg, bf16x8& pa0, bf16x8& pa1, bf16x8& pa2, bf16x8& pa3) {
#pragma unroll
    for (int r = 0; r < 16; ++r) p1[r] = __builtin_amdgcn_exp2f(p1[r]);
    float ps = 0.f;
#pragma unroll
    for (int r = 0; r < 16; ++r) ps += p0[r];
#pragma unroll
    for (int r = 0; r < 16; ++r) ps += p1[r];
    ps = pair_sum(ps);
    l_reg = l_reg * alpha + ps;
    pack_p(p0, p1, pa0, pa1, pa2, pa3);
}
template <int MODE>
__device__ __forceinline__ void stage_b1(f32x16& p0, f32x16& p1, float& alpha, float& m_reg, int tj, int qb, int qlo, int qpos, int hi, unsigned sel, unsigned m16, unsigned m4, const LAS float* aux, float M2row) {
    const int kb = tj * 64, dq = qpos - kb - 4 * hi;
    if constexpr (MODE == MODE_DIL) {
        const int dlo = qlo - kb - 63, dhi2 = qlo + 31 - kb;
        if (dlo > 512) {
#pragma unroll
            for (int r = 0; r < 16; ++r) { const float t = ((m16 >> r) & 1u) ? 0.f : -__builtin_inff(); p0[r] += t; p1[r] += t; }
        } else if (dlo > 128 && dhi2 <= 512) {
#pragma unroll
            for (int r = 0; r < 16; ++r) { const float t = ((m16 >> r) & 1u) ? (1.0f / C2) : (((m4 >> r) & 1u) ? 0.f : -__builtin_inff()); p0[r] += t; p1[r] += t; }
        } else {
#pragma unroll
            for (int r = 0; r < 16; ++r) { const int c = (r & 3) + 8 * (r >> 2);
                { const unsigned ud = (unsigned)(dq - c); const int cnt = (int)(ud <= 128u) + (int)(((ud & 3u) == 0u) & (ud <= 512u)) + (int)((ud & 0x8000000Fu) == 0u);
                  p0[r] += __builtin_amdgcn_logf((float)cnt) * (1.0f / C2); }
                { const unsigned ud = (unsigned)(dq - c - 32); const int cnt = (int)(ud <= 128u) + (int)(((ud & 3u) == 0u) & (ud <= 512u)) + (int)((ud & 0x8000000Fu) == 0u);
                  p1[r] += __builtin_amdgcn_logf((float)cnt) * (1.0f / C2); } }
        }
        softmax_start(p0, p1, m_reg, alpha);
    } else if constexpr (MODE == MODE_MOBA) {
        const int n = tj >> 2;
        if (n == qb) { if (kb + 63 > qlo) mask_tile(p0, p1, dq); }
        else { const bool keep = ((sel >> n) & 1u) != 0u;
#pragma unroll
            for (int r = 0; r < 16; ++r) { p0[r] = keep ? p0[r] : -__builtin_inff(); p1[r] = keep ? p1[r] : -__builtin_inff(); } }
        softmax_start(p0, p1, m_reg, alpha);
    } else {
#pragma unroll
        for (int r4 = 0; r4 < 4; ++r4) { const f32x4 a0 = *(const LAS f32x4*)(aux + kb + 8 * r4 + 4 * hi);
            const float rf = SCALE * __builtin_amdgcn_exp2f(a0[0] - M2row);
#pragma unroll
            for (int j = 0; j < 4; ++j) { const int r = 4 * r4 + j, c = 8 * r4 + j;
                float s0 = p0[r] * (j == 0 ? rf : rf * a0[j]); s0 = (dq - c < 0) ? 0.f : s0; p0[r] = s0; } }
        alpha = 1.f;
    }
}
template <int MODE>
__device__ __forceinline__ void stage_b2(f32x16& p0, f32x16& p1, float alpha, float& l_reg, float& den, int tj, int qpos, int hi, const LAS float* aux, float M2row, bf16x8& pa0, bf16x8& pa1, bf16x8& pa2, bf16x8& pa3) {
    if constexpr (MODE == MODE_ML) {
        const int kb = tj * 64, dq = qpos - kb - 4 * hi; float dsum = 0.f;
#pragma unroll
        for (int r4 = 0; r4 < 4; ++r4) { const f32x4 a1 = *(const LAS f32x4*)(aux + kb + 32 + 8 * r4 + 4 * hi);
            const float rf = SCALE * __builtin_amdgcn_exp2f(a1[0] - M2row);
#pragma unroll
            for (int j = 0; j < 4; ++j) { const int r = 4 * r4 + j, c = 8 * r4 + j;
                float s1 = p1[r] * (j == 0 ? rf : rf * a1[j]); s1 = (dq - c - 32 < 0) ? 0.f : s1; p1[r] = s1; dsum += p0[r] + s1; } }
        den += dsum;
        pack_p(p0, p1, pa0, pa1, pa2, pa3);
    } else softmax_finish(p0, p1, alpha, l_reg, pa0, pa1, pa2, pa3);
}

template <int MODE>
__device__ __forceinline__ void attn_block(const bf16* __restrict__ Qp, int ldq, const bf16* __restrict__ Kp, int ldk, const bf16* __restrict__ Vp, int ldv, bf16* __restrict__ Op, int ldo,
                                           int qb, LAS char* lds, const float* __restrict__ aux0, const float* __restrict__ aux1, const float* __restrict__ aux2, int wave) {
    int tid_ = tid_of(wave); asm volatile("" : "+v"(tid_));
    const int tid = tid_, wid = __builtin_amdgcn_readfirstlane(tid >> 6), lane = tid & 63, r32 = lane & 31, hi = lane >> 5;
    const int P0 = qb * 256, qlo = P0 + wid * 32, qpos = qlo + r32;
    const int NT = 4 * qb + 4;
    LAS char* V_lds = lds + OFF_V; LAS char* K_lds = lds + OFF_K;
    LAS float* wsf = (LAS float*)(lds + OFF_WS) + wid * 64; LAS float* li_l = wsf; LAS float* al_l = wsf + 32;
    LAS float* aux = (LAS float*)(lds + OFF_AUX);
    bf16x8 qr[8];
#pragma unroll
    for (int d0 = 0; d0 < 8; ++d0) qr[d0] = *reinterpret_cast<const bf16x8*>(Qp + (size_t)qpos * ldq + d0 * 16 + hi * 8);
    unsigned kso[2], vso[2];
#pragma unroll
    for (int i = 0; i < 2; ++i) { const int pc = 2 * wid + i, krow = pc * 4 + (lane >> 4), kch = (lane & 15) ^ (krow & 7);
        kso[i] = (unsigned)(krow * ldk + kch * 8) * 2u;
        const int kk = wid * 8 + ((lane & 31) >> 2), vk = (kk & ~0xC) | ((kk & 4) << 1) | ((kk & 8) >> 1), vc = (2 * i + (lane >> 5)) * 32 + (lane & 3) * 8;
        vso[i] = (unsigned)(vk * ldv + vc) * 2u; }
    const int vb0 = (int)(unsigned)(size_t)V_lds + v_rd_base(lane);
    float m_reg = -1e30f, l_reg = 0.f, Rsum = 0.f, den = 0.f, M2row = 0.f, nmrow = 1.f; unsigned sel = 0u;
    if constexpr (MODE == MODE_ML) {
        for (int i = tid; i < P0 + 256; i += 512) { const float a = aux0[i]; const float base = __shfl(a, lane & ~3); aux[i] = (i & 3) == 0 ? a : __builtin_amdgcn_exp2f(a - base); }
        M2row = aux1[qpos]; nmrow = aux2[qpos]; }
    if constexpr (MODE == MODE_MOBA) { for (int i = tid; i < qb * 128; i += 512) aux[i] = aux0[i]; }
#define TJ(i) ((MODE == MODE_SB) ? (NT - 1 - (i)) : (i))
#define SLOAD(kb_, bf) do { const char* kg_ = (const char*)(Kp + (size_t)(kb_) * ldk); const char* vg_ = (const char*)(Vp + (size_t)(kb_) * ldv); \
        _Pragma("unroll") for (int i_ = 0; i_ < 2; ++i_) { \
            glds16(kg_ + kso[i_], (unsigned)__builtin_amdgcn_readfirstlane((int)(unsigned)(size_t)(K_lds + (bf) * SHM + (2 * wid + i_) * 1024))); \
            glds16(vg_ + vso[i_], (unsigned)__builtin_amdgcn_readfirstlane((int)(unsigned)(size_t)(V_lds + (bf) * SHM + (2 * wid + i_) * 1024))); } } while (0)
    float zbnd = 0.f; bool wdone = false; LAS int* dflag = (LAS int*)(lds + OFF_WS);
    if constexpr (MODE == MODE_SB) { float s = 0.f;
#pragma unroll
        for (int d0 = 0; d0 < 8; ++d0) { const u32x4 qw = *reinterpret_cast<const u32x4*>(&qr[d0]);
            s = fmaf(bf_lo(qw.x), bf_lo(qw.x), s); s = fmaf(bf_hi(qw.x), bf_hi(qw.x), s); s = fmaf(bf_lo(qw.y), bf_lo(qw.y), s); s = fmaf(bf_hi(qw.y), bf_hi(qw.y), s);
            s = fmaf(bf_lo(qw.z), bf_lo(qw.z), s); s = fmaf(bf_hi(qw.z), bf_hi(qw.z), s); s = fmaf(bf_lo(qw.w), bf_lo(qw.w), s); s = fmaf(bf_hi(qw.w), bf_hi(qw.w), s); }
        s = pair_sum(s); zbnd = sqrtf(s * aux0[0]) * (C2 * 1.001f) + 0.01f; }
    unsigned dm16 = 0u, dm4 = 0u;
    if constexpr (MODE == MODE_DIL) {
#pragma unroll
        for (int r = 0; r < 16; ++r) { const unsigned d0 = (unsigned)(qpos - 4 * hi - ((r & 3) + 8 * (r >> 2))); dm16 |= ((d0 & 15u) == 0u ? 1u : 0u) << r; dm4 |= ((d0 & 3u) == 0u ? 1u : 0u) << r; } }
    SLOAD(TJ(0) * 64, 0); VM_WAIT(); LDS_WAIT(); WG_BAR();
#pragma unroll
    for (int d0 = 0; d0 < 8; ++d0) asm volatile("" : "+v"(qr[d0]));
    asm volatile("" : "+v"(M2row), "+v"(nmrow), "+v"(zbnd));
    if constexpr (MODE == MODE_MOBA) {
        if (qb <= 3) sel = (1u << qb) - 1u;
        else {
            float g[7];
#pragma unroll
            for (int n = 0; n < 7; ++n) { g[n] = -__builtin_inff();
                if (n < qb) { float s = 0.f;
#pragma unroll
                    for (int d0 = 0; d0 < 8; ++d0) { const LAS f32x4* kp = (const LAS f32x4*)(aux + n * 128 + d0 * 16 + hi * 8); const f32x4 k0 = kp[0], k1 = kp[1];
                        const u32x4 qw = *reinterpret_cast<const u32x4*>(&qr[d0]);
                        s = fmaf(bf_lo(qw.x), k0[0], s); s = fmaf(bf_hi(qw.x), k0[1], s); s = fmaf(bf_lo(qw.y), k0[2], s); s = fmaf(bf_hi(qw.y), k0[3], s);
                        s = fmaf(bf_lo(qw.z), k1[0], s); s = fmaf(bf_hi(qw.z), k1[1], s); s = fmaf(bf_lo(qw.w), k1[2], s); s = fmaf(bf_hi(qw.w), k1[3], s); }
                    g[n] = pair_sum(s); }
                asm volatile("" ::: "memory"); }
#pragma unroll
            for (int k = 0; k < 3; ++k) { float best = -__builtin_inff(); int bi = 0;
#pragma unroll
                for (int n = 0; n < 7; ++n) if (g[n] > best) { best = g[n]; bi = n; }
                sel |= 1u << bi;
#pragma unroll
                for (int n = 0; n < 7; ++n) g[n] = (bi == n) ? -__builtin_inff() : g[n]; }
        }
    }
    f32x16 o[4];
#pragma unroll
    for (int d_ = 0; d_ < 4; ++d_)
#pragma unroll
        for (int r = 0; r < 16; ++r) o[d_][r] = 0.f;
    if constexpr (MODE == MODE_MOBA || MODE == MODE_ML || MODE == MODE_DIL) {
#define SLOADK(kb_, bf) do { const char* kg_ = (const char*)(Kp + (size_t)(kb_) * ldk); _Pragma("unroll") for (int i_ = 0; i_ < 2; ++i_) \
            glds16(kg_ + kso[i_], (unsigned)__builtin_amdgcn_readfirstlane((int)(unsigned)(size_t)(K_lds + (bf) * SHM + (2 * wid + i_) * 1024))); } while (0)
#define SLOADV(kb_, bf) do { const char* vg_ = (const char*)(Vp + (size_t)(kb_) * ldv); _Pragma("unroll") for (int i_ = 0; i_ < 2; ++i_) \
            glds16(vg_ + vso[i_], (unsigned)__builtin_amdgcn_readfirstlane((int)(unsigned)(size_t)(V_lds + (bf) * SHM + (2 * wid + i_) * 1024))); } while (0)
#define RESC(a) do { if (MODE != MODE_ML) { if (__any((a) < 1.f)) { if (hi == 0) al_l[r32] = (a); LDS_WAIT(); \
            _Pragma("unroll") for (int d_ = 0; d_ < 4; ++d_) _Pragma("unroll") for (int r = 0; r < 16; ++r) o[d_][r] *= al_l[crow(r, hi)]; } } } while (0)
#define HALF_STEP(PX0, PX1, alX, PY0, PY1, alY, t_) do { const int ht_ = (t_); \
            if (ht_ + 1 < NT) SLOADK((ht_ + 1) * 64, (ht_ + 1) & 1); SLOADV(ht_ * 64, ht_ & 1); SBAR(); \
            bf16x8 pa0, pa1, pa2, pa3; \
            qkt_lq(PX0, PX1, K_lds + (ht_ & 1) * SHM, r32, hi, Qw); stage_b2<MODE>(PY0, PY1, alY, l_reg, den, ht_ - 1, qpos, hi, aux, M2row, pa0, pa1, pa2, pa3); \
            SBAR(); \
            RESC(alY); pv_tile(o, vb0 + ((ht_ - 1) & 1) * SHM, pa0, pa1, pa2, pa3); stage_b1<MODE>(PX0, PX1, alX, m_reg, ht_, qb, qlo, qpos, hi, sel, dm16, dm4, aux, M2row); \
            SBAR(); VM_WAIT(); LDS_WAIT(); WG_BAR(); } while (0)
        f32x16 pA0, pA1, pB0, pB1; float alA = 1.f, alB = 1.f;
        LAS char* const Qw = lds + OFF_Q + wid * 8192 + lane * 16;
#pragma unroll
        for (int d0 = 0; d0 < 8; ++d0) *reinterpret_cast<LAS bf16x8*>(Qw + d0 * 1024) = qr[d0];
        SLOADK(64, 1); SBAR();
        qkt_lq(pA0, pA1, K_lds, r32, hi, Qw);
        stage_b1<MODE>(pA0, pA1, alA, m_reg, 0, qb, qlo, qpos, hi, sel, dm16, dm4, aux, M2row);
        SBAR(); VM_WAIT(); LDS_WAIT(); WG_BAR();
        for (int t = 1; t + 1 < NT; t += 2) { HALF_STEP(pB0, pB1, alB, pA0, pA1, alA, t); HALF_STEP(pA0, pA1, alA, pB0, pB1, alB, t + 1); }
        HALF_STEP(pB0, pB1, alB, pA0, pA1, alA, NT - 1);
        { bf16x8 pa0, pa1, pa2, pa3;
            stage_b2<MODE>(pB0, pB1, alB, l_reg, den, NT - 1, qpos, hi, aux, M2row, pa0, pa1, pa2, pa3);
            RESC(alB); pv_tile(o, vb0 + ((NT - 1) & 1) * SHM, pa0, pa1, pa2, pa3); }
        LDS_WAIT(); WG_BAR();
#undef HALF_STEP
#undef RESC
#undef SLOADV
#undef SLOADK
    } else
    for (int i = 0; i < NT; ++i) {
        const int tj = TJ(i), kb = tj * 64, buf = i & 1;
        if constexpr (MODE == MODE_SB) { if (i > 0) { const int f = dflag[(lane & 7) * 64 + ((i - 1) & 1)]; if (__all(f != 0)) break; } }
        if (i + 1 < NT) SLOAD(TJ(i + 1) * 64, buf ^ 1);
        SBAR();
        bool act = (MODE == MODE_SB) ? (kb <= qlo + 30 && !wdone) : (kb <= qlo + 31);
        if constexpr (MODE == MODE_MOBA) { const int n = tj >> 2; if (n != qb) act = act && __any((int)((sel >> n) & 1u)); }
        if (act) {
            f32x16 p0, p1; bf16x8 pa0, pa1, pa2, pa3;
            qkt(p0, p1, K_lds + buf * SHM, r32, hi, qr);
            const int dq = qpos - kb - 4 * hi;
            if constexpr (MODE == MODE_DIL || MODE == MODE_MOBA) {
                if constexpr (MODE == MODE_DIL) {
                  const int dlo = qlo - kb - 63, dhi2 = qlo + 31 - kb;
                  if (dlo > 512) {
#pragma unroll
                    for (int r = 0; r < 16; ++r) { const float t = ((dm16 >> r) & 1u) ? 0.f : -__builtin_inff(); p0[r] += t; p1[r] += t; }
                  } else if (dlo > 128 && dhi2 <= 512) {
#pragma unroll
                    for (int r = 0; r < 16; ++r) { const float t = ((dm16 >> r) & 1u) ? (1.0f / C2) : (((dm4 >> r) & 1u) ? 0.f : -__builtin_inff()); p0[r] += t; p1[r] += t; }
                  } else {
#pragma unroll
                    for (int r = 0; r < 16; ++r) { const int c = (r & 3) + 8 * (r >> 2);
                        { const unsigned ud = (unsigned)(dq - c); const int cnt = (int)(ud <= 128u) + (int)(((ud & 3u) == 0u) & (ud <= 512u)) + (int)((ud & 0x8000000Fu) == 0u);
                          p0[r] += __builtin_amdgcn_logf((float)cnt) * (1.0f / C2); }
                        { const unsigned ud = (unsigned)(dq - c - 32); const int cnt = (int)(ud <= 128u) + (int)(((ud & 3u) == 0u) & (ud <= 512u)) + (int)((ud & 0x8000000Fu) == 0u);
                          p1[r] += __builtin_amdgcn_logf((float)cnt) * (1.0f / C2); } }
                  }
                } else {
                    const int n = tj >> 2;
                    if (n == qb) { if (kb + 63 > qlo) mask_tile(p0, p1, dq); }
                    else if (!((sel >> n) & 1u)) {
#pragma unroll
                        for (int r = 0; r < 16; ++r) { p0[r] = -__builtin_inff(); p1[r] = -__builtin_inff(); } }
                }
                float mn, alpha;
                partialSM(p0, p1, m_reg, mn, alpha);
                float ps = 0.f;
#pragma unroll
                for (int r = 0; r < 16; ++r) ps += p0[r];
#pragma unroll
                for (int r = 0; r < 16; ++r) ps += p1[r];
                ps = pair_sum(ps);
                l_reg = l_reg * alpha + ps;
                pack_p(p0, p1, pa0, pa1, pa2, pa3);
                if (__any(alpha < 1.f)) { if (hi == 0) al_l[r32] = alpha; LDS_WAIT();
#pragma unroll
                    for (int d_ = 0; d_ < 4; ++d_)
#pragma unroll
                        for (int r = 0; r < 16; ++r) o[d_][r] *= al_l[crow(r, hi)]; }
            } else if constexpr (MODE == MODE_ML) {
                float dsum = 0.f;
#pragma unroll
                for (int r4 = 0; r4 < 4; ++r4) {
                    const f32x4 a0 = *(const LAS f32x4*)(aux + kb + 8 * r4 + 4 * hi), a1 = *(const LAS f32x4*)(aux + kb + 32 + 8 * r4 + 4 * hi);
                    const float rf0 = SCALE * __builtin_amdgcn_exp2f(a0[0] - M2row), rf1 = SCALE * __builtin_amdgcn_exp2f(a1[0] - M2row);
#pragma unroll
                    for (int j = 0; j < 4; ++j) { const int r = 4 * r4 + j, c = 8 * r4 + j;
                        float s0 = p0[r] * (j == 0 ? rf0 : rf0 * a0[j]); s0 = (dq - c < 0) ? 0.f : s0;
                        float s1 = p1[r] * (j == 0 ? rf1 : rf1 * a1[j]); s1 = (dq - c - 32 < 0) ? 0.f : s1;
                        p0[r] = s0; p1[r] = s1; dsum += s0 + s1; } }
                den += dsum;
                pack_p(p0, p1, pa0, pa1, pa2, pa3);
            } else {
                f32x16 z0, z1; float gs[8];
#pragma unroll
                for (int r = 0; r < 16; ++r) { const int c = (r & 3) + 8 * (r >> 2);
                    { const float z2 = p0[r] * C2; const float sp = fmaxf(z2, 0.f) + __builtin_amdgcn_logf(1.0f + __builtin_amdgcn_exp2f(-fabsf(z2)));
                      z0[r] = z2; const float spm = ((dq - 1 - c) >= 0) ? sp : 0.f; p0[r] = spm; if ((r & 3) == 0) gs[r >> 2] = spm; else gs[r >> 2] += spm; }
                    { const float z2 = p1[r] * C2; const float sp = fmaxf(z2, 0.f) + __builtin_amdgcn_logf(1.0f + __builtin_amdgcn_exp2f(-fabsf(z2)));
                      z1[r] = z2; const float spm = ((dq - 1 - c - 32) >= 0) ? sp : 0.f; p1[r] = spm; if ((r & 3) == 0) gs[4 + (r >> 2)] = spm; else gs[4 + (r >> 2)] += spm; } }
                float aft[8]; float run = 0.f;
#pragma unroll
                for (int i2 = 7; i2 >= 0; --i2) { const float pg = __shfl_xor(gs[i2], 32); aft[i2] = run + (hi == 0 ? pg : 0.f); run += gs[i2] + pg; }
#pragma unroll
                for (int i2 = 0; i2 < 8; ++i2) { float suf = Rsum + aft[i2];
#pragma unroll
                    for (int j = 3; j >= 0; --j) { const int r = 4 * (i2 & 3) + j, c = 8 * (i2 & 3) + j + ((i2 >> 2) ? 32 : 0);
                        const bool ok = (dq - 1 - c) >= 0;
                        if (i2 >> 2) { suf += p1[r]; p1[r] = ok ? __builtin_amdgcn_exp2f(z1[r] - suf) : 0.f; }
                        else { suf += p0[r]; p0[r] = ok ? __builtin_amdgcn_exp2f(z0[r] - suf) : 0.f; } } }
                Rsum += run;
                pack_p(p0, p1, pa0, pa1, pa2, pa3);
            }
            SBAR();
            pv_tile(o, vb0 + buf * SHM, pa0, pa1, pa2, pa3);
        }
        SBAR();
        if constexpr (MODE == MODE_SB) { if (!wdone) wdone = __all(Rsum - zbnd > 64.f) != 0; if (lane == 0) dflag[wid * 64 + (i & 1)] = wdone ? 1 : 0; }
        VM_WAIT(); LDS_WAIT(); WG_BAR();
    }
    if constexpr (MODE == MODE_DIL || MODE == MODE_MOBA) { if (hi == 0) li_l[r32] = l_reg; }
    if constexpr (MODE == MODE_ML) { const float dt = pair_sum(den); if (hi == 0) li_l[r32] = fmaxf(fabsf(dt), nmrow); }
    LDS_WAIT();
    LAS char* const Ost = lds + OFF_Q + wid * 8192;
#pragma unroll
    for (int r = 0; r < 16; ++r) { const int orow = crow(r, hi);
        float rl = 1.f; if constexpr (MODE != MODE_SB) rl = __builtin_amdgcn_rcpf(li_l[orow]);
#pragma unroll
        for (int d0 = 0; d0 < 4; ++d0) { const float v = o[d0][r] * rl;
            *(LAS unsigned short*)(Ost + orow * 256 + (((d0 * 32 + r32) * 2) ^ ((orow & 4) << 4))) = (unsigned short)cvtpk(v, v); } }
    LDS_WAIT();
    bf16* Ow = Op + (size_t)qlo * ldo;
#pragma unroll
    for (int j = 0; j < 8; ++j) { const int row = j * 4 + (lane >> 4), cb = (lane & 15) * 16;
        const u32x4 w = *(const LAS u32x4*)(Ost + row * 256 + (cb ^ ((row & 4) << 4)));
        *(u32x4*)((char*)(Ow + (size_t)row * ldo) + cb) = w; }
    LDS_WAIT();
#undef TJ
#undef SLOAD
}
}


struct Frame {
    LAS unsigned char* lds; int tid, lane, wave, vcu, G, gw, NGW;
};

template <bool FOLD>
__device__ __forceinline__ void tr_item(const float* __restrict__ W, int K, int N, bf16* __restrict__ WT, int item, int nblk, LAS unsigned* scr, int lane, int rmode, const float* lg, const float* lb, float* cs, float* bs) {
    const int kb = item / nblk, nb = item - kb * nblk, k0 = kb * 64, n0 = nb * 64;
    const int nq = lane & 15, kr = lane >> 4;
    const bool inb = (n0 + 4 * nq) < N;
    f32x4 a[8], b[8];
#pragma unroll
    for (int s = 0; s < 8; ++s) { const int kp = 4 * s + kr; const float* p = W + (size_t)(k0 + 2 * kp) * N + (inb ? n0 + 4 * nq : 0);
        a[s] = __builtin_nontemporal_load((const f32x4*)p); b[s] = __builtin_nontemporal_load((const f32x4*)(p + N)); }
    if (!inb) {
#pragma unroll
        for (int s = 0; s < 8; ++s) { a[s] = (f32x4){0.f, 0.f, 0.f, 0.f}; b[s] = (f32x4){0.f, 0.f, 0.f, 0.f}; } }
    f32x4 csum = {0.f, 0.f, 0.f, 0.f}, bsum = {0.f, 0.f, 0.f, 0.f};
    if constexpr (FOLD) {
#pragma unroll
        for (int s = 0; s < 8; ++s) { const int k = k0 + 2 * (4 * s + kr); const f32x2 g2 = *(const f32x2*)(lg + k), b2 = *(const f32x2*)(lb + k);
            bsum += a[s] * b2[0] + b[s] * b2[1]; a[s] = a[s] * g2[0]; b[s] = b[s] * g2[1]; }
    }
#pragma unroll
    for (int s = 0; s < 8; ++s) { const int kp = 4 * s + kr;
#pragma unroll
        for (int i = 0; i < 4; ++i) { const unsigned pk = cvtpk(a[s][i], b[s][i]); scr[(4 * nq + i) * 33 + kp] = pk; if constexpr (FOLD) csum[i] += bf_lo(pk) + bf_hi(pk); } }
    LDS_WAIT();
#pragma unroll
    for (int jj = 0; jj < 8; ++jj) { const int n = (lane >> 3) + 8 * jj, c = lane & 7; const LAS unsigned* s = scr + n * 33 + 4 * c;
        u32x4 o; o.x = s[0]; o.y = s[1]; o.z = s[2]; o.w = s[3];
        const int nn = n0 + n, drow = rmode ? (((nn >> 7) << 8) + (nn & 127) + (rmode == 2 ? 128 : 0)) : nn;
        *(u32x4*)(WT + (size_t)drow * K + k0 + 8 * c) = o; }
    LDS_WAIT();
    if constexpr (FOLD) {
#pragma unroll
        for (int i = 0; i < 4; ++i) { csum[i] += __shfl_xor(csum[i], 16); csum[i] += __shfl_xor(csum[i], 32); bsum[i] += __shfl_xor(bsum[i], 16); bsum[i] += __shfl_xor(bsum[i], 32); }
        LAS float* fs = (LAS float*)scr;
        if (kr == 0) { *(LAS f32x4*)(fs + 4 * nq) = csum; *(LAS f32x4*)(fs + 64 + 4 * nq) = bsum; }
        LDS_WAIT();
        const int nn = n0 + lane, drow = rmode ? (((nn >> 7) << 8) + (nn & 127) + (rmode == 2 ? 128 : 0)) : nn;
        if (nn < N) { unsafeAtomicAdd(cs + drow, fs[lane]); unsafeAtomicAdd(bs + drow, fs[64 + lane]); }
        LDS_WAIT();
    }
}

constexpr int I_INAB = 64 * 192, I_OUT = 64 * 64, I_INCD = 64 * 196, I_UP = 64 * 172, I_DN = 172 * 64;
constexpr int Q_OUTAB = I_OUT, Q_UG0 = Q_OUTAB + 2 * I_UP, Q_DN0 = Q_UG0 + I_DN, Q_INCD = Q_DN0 + I_INCD, Q_OUTCD = Q_INCD + I_OUT, Q_UG1 = Q_OUTCD + 2 * I_UP, Q_TOTAL = Q_UG1 + I_DN;
__device__ __forceinline__ void conv_queue_item(const Args& a, int q, LAS unsigned* scr, int lane) {
    unsigned char* ws = a.ws; unsigned char* ctl = ws + WS_CTL;
    int r = q; const float* W; int K, N, nblk; bf16* WT; int rmode = 0; const float* lg = nullptr; const float* lb = nullptr; float* cs = nullptr; float* bs = nullptr;
    if (r < I_OUT) { W = a.in[2]; K = DM; N = DM; nblk = 64; WT = (bf16*)(ws + WS_W_OUTAB); }
    else if ((r -= I_OUT) < I_UP) { W = a.in[9]; K = DM; N = DFF; nblk = 172; WT = (bf16*)(ws + WS_W_UG0); rmode = 1; lg = a.in[14]; lb = a.in[15]; cs = (float*)(ctl + CTL_CS_UG0); bs = (float*)(ctl + CTL_BS_UG0); }
    else if ((r -= I_UP) < I_UP) { W = a.in[10]; K = DM; N = DFF; nblk = 172; WT = (bf16*)(ws + WS_W_UG0); rmode = 2; lg = a.in[14]; lb = a.in[15]; cs = (float*)(ctl + CTL_CS_UG0); bs = (float*)(ctl + CTL_BS_UG0); }
    else if ((r -= I_UP) < I_DN) { W = a.in[13]; K = DFF; N = DM; nblk = 64; WT = (bf16*)(ws + WS_W_DN0); }
    else if ((r -= I_DN) < I_INCD) { W = a.in[3]; K = DM; N = N_CD; nblk = 196; WT = (bf16*)(ws + WS_W_INCD); lg = a.in[14] + DM; lb = a.in[15] + DM; cs = (float*)(ctl + CTL_CS_INCD); bs = (float*)(ctl + CTL_BS_INCD); }
    else if ((r -= I_INCD) < I_OUT) { W = a.in[8]; K = DM; N = DM; nblk = 64; WT = (bf16*)(ws + WS_W_OUTCD); }
    else if ((r -= I_OUT) < I_UP) { W = a.in[9] + (size_t)DM * DFF; K = DM; N = DFF; nblk = 172; WT = (bf16*)(ws + WS_W_UG1); rmode = 1; lg = a.in[14] + 2 * DM; lb = a.in[15] + 2 * DM; cs = (float*)(ctl + CTL_CS_UG1); bs = (float*)(ctl + CTL_BS_UG1); }
    else if ((r -= I_UP) < I_UP) { W = a.in[10] + (size_t)DM * DFF; K = DM; N = DFF; nblk = 172; WT = (bf16*)(ws + WS_W_UG1); rmode = 2; lg = a.in[14] + 2 * DM; lb = a.in[15] + 2 * DM; cs = (float*)(ctl + CTL_CS_UG1); bs = (float*)(ctl + CTL_BS_UG1); }
    else { r -= I_UP; W = a.in[13] + (size_t)DFF * DM; K = DFF; N = DM; nblk = 64; WT = (bf16*)(ws + WS_W_DN1); }
    if (lg) tr_item<true>(W, K, N, WT, r, nblk, scr, lane, rmode, lg, lb, cs, bs); else tr_item<false>(W, K, N, WT, r, nblk, scr, lane, rmode, lg, lb, cs, bs);
}
__device__ __forceinline__ void prologue(const Frame& F_, const Args& a) {
    Frame F = F_; F.tid = tid_of(F.wave); F.lane = F.tid & 63; asm volatile("" : "+v"(F.lane), "+v"(F.tid), "+s"(F.gw), "+s"(F.vcu), "+s"(F.wave));
    unsigned char* ws = a.ws;
    LAS unsigned* scr = (LAS unsigned*)(F.lds + F.wave * 8448);
    for (int it = F.gw; it < I_INAB; it += F.NGW)
        tr_item<false>(a.in[1], DM, N_AB, (bf16*)(ws + WS_W_INAB), it, 192, scr, F.lane, 0, nullptr, nullptr, nullptr, nullptr);
    const f32x4* x4 = (const f32x4*)a.in[0]; u32x2* xb = (u32x2*)(ws + WS_XB);
    for (size_t i = (size_t)F.gw * 64 + F.lane; i < (size_t)M * DM / 4; i += (size_t)F.NGW * 64) { const f32x4 v = __builtin_nontemporal_load(x4 + i); u32x2 o; o.x = cvtpk(v[0], v[1]); o.y = cvtpk(v[2], v[3]); xb[i] = o; }
}
template <int SEAM>
__device__ __forceinline__ void seam_wait(const Frame& F_, const Args& args, const XcdBarrier& bar, unsigned char* ws_, int limit) {
    Frame F = F_; F.tid = tid_of(F.wave); F.lane = F.tid & 63; asm volatile("" : "+v"(F.lane), "+v"(F.tid), "+s"(F.wave));
    unsigned* qw = (unsigned*)(opq_p(ws_) + WS_CTL + CTL_QUEUE);
    volatile LAS unsigned* sh = (volatile LAS unsigned*)(F.lds + CTRL_OFF + 768);
    LAS unsigned* scr = (LAS unsigned*)(F.lds + F.wave * 8448);
    const unsigned G = (unsigned)F.G;
    asm volatile("s_waitcnt vmcnt(0)" ::: "memory");
    __syncthreads();
    unsigned arrived = 0u;
    if (F.tid == 0) arrived = xb_add(&qw[64 * (SEAM + 1)], 1u) + 1u;
    for (;;) {
        if (F.tid == 0) {
            unsigned h = 0xffffffffu;
            const unsigned hp = xb_ld(&qw[0]);
            if (hp < (unsigned)Q_TOTAL) {
                if (arrived < G) arrived = xb_ld(&qw[64 * (SEAM + 1)]);
                if (arrived < G || hp < (unsigned)limit) h = xb_add(&qw[0], 8u);
            }
            sh[0] = h;
        }
        __syncthreads();
        const unsigned h = sh[0];
        __syncthreads();
        if (h >= (unsigned)Q_TOTAL) break;
        const int q = (int)h + F.wave;
        if (q < Q_TOTAL) conv_queue_item(args, q, scr, F.lane);
    }
    xcd_barrier(bar);
}

__device__ __forceinline__ void ln_phase(const Frame& F_, const bf16* zb, float* xo, const float* g, const float* b) {
    Frame F = F_; F.tid = tid_of(F.wave); F.lane = F.tid & 63; asm volatile("" : "+v"(F.lane), "+v"(F.tid), "+s"(F.gw), "+s"(F.vcu), "+s"(F.wave));
    f32x4 gv[8][2], bv[8][2];
#pragma unroll
    for (int j = 0; j < 8; ++j) { const float* gp = g + 8 * (F.lane + 64 * j); const float* bp = b + 8 * (F.lane + 64 * j);
        gv[j][0] = *(const f32x4*)gp; gv[j][1] = *(const f32x4*)(gp + 4); bv[j][0] = *(const f32x4*)bp; bv[j][1] = *(const f32x4*)(bp + 4); }
    for (int m = F.gw; m < M; m += F.NGW) {
        const u32x4* zr = (const u32x4*)(zb + (size_t)m * DM) + F.lane;
        u32x4 w[8];
#pragma unroll
        for (int j = 0; j < 8; ++j) w[j] = __builtin_nontemporal_load(zr + 64 * j);
        f32x4 v[8][2]; float s = 0.f;
#pragma unroll
        for (int j = 0; j < 8; ++j) { v[j][0] = (f32x4){bf_lo(w[j].x), bf_hi(w[j].x), bf_lo(w[j].y), bf_hi(w[j].y)}; v[j][1] = (f32x4){bf_lo(w[j].z), bf_hi(w[j].z), bf_lo(w[j].w), bf_hi(w[j].w)};
            s += ((v[j][0][0] + v[j][0][1]) + (v[j][0][2] + v[j][0][3])) + ((v[j][1][0] + v[j][1][1]) + (v[j][1][2] + v[j][1][3])); }
        const float mean = wave_sum(s) * (1.f / DM); float s2 = 0.f;
#pragma unroll
        for (int j = 0; j < 8; ++j)
#pragma unroll
            for (int h = 0; h < 2; ++h) { v[j][h] = v[j][h] - mean; s2 += (v[j][h][0] * v[j][h][0] + v[j][h][1] * v[j][h][1]) + (v[j][h][2] * v[j][h][2] + v[j][h][3] * v[j][h][3]); }
        const float rstd = 1.f / sqrtf(wave_sum(s2) * (1.f / DM) + LN_EPS);
        float* xr = xo + (size_t)m * DM + 8 * F.lane;
#pragma unroll
        for (int j = 0; j < 8; ++j)
#pragma unroll
            for (int h = 0; h < 2; ++h) __builtin_nontemporal_store(v[j][h] * rstd * gv[j][h] + bv[j][h], (f32x4*)(xr + 512 * j + 4 * h));
    }
}

__device__ __forceinline__ void ffn_fix_phase(const Frame& F_, bf16* H, const float* EG0, const float* EU0, const float* EGL, const float* cw, const float* cb) {
    Frame F = F_; F.tid = tid_of(F.wave); F.lane = F.tid & 63; asm volatile("" : "+v"(F.lane), "+v"(F.tid), "+s"(F.gw), "+s"(F.vcu), "+s"(F.wave));
    constexpr int C4 = DFF / 4;
    for (int idx = F.gw * 64 + F.lane; idx < 64 * C4; idx += F.NGW * 64) {
        const int pm = idx / C4, ch = (idx - pm * C4) * 4;
        f32x4 gl0 = {0.f, 0.f, 0.f, 0.f}, gl1 = gl0;
        if ((pm & 7) != 0) { gl0 = *(const f32x4*)(EGL + (size_t)((pm - 1) * 2) * DFF + ch); gl1 = *(const f32x4*)(EGL + (size_t)((pm - 1) * 2 + 1) * DFF + ch); }
        const f32x4 g0 = *(const f32x4*)(EG0 + (size_t)(pm * 2) * DFF + ch), g1 = *(const f32x4*)(EG0 + (size_t)(pm * 2 + 1) * DFF + ch);
        const f32x4 u0 = *(const f32x4*)(EU0 + (size_t)(pm * 2) * DFF + ch), u1 = *(const f32x4*)(EU0 + (size_t)(pm * 2 + 1) * DFF + ch);
        const f32x4 w0 = *(const f32x4*)(cw + ch), w1 = *(const f32x4*)(cw + DFF + ch), w2 = *(const f32x4*)(cw + 2 * DFF + ch), bb = *(const f32x4*)(cb + ch);
        const f32x4 y0 = w0 * gl0 + w1 * gl1 + w2 * g0 + bb, y1 = w0 * gl1 + w1 * g0 + w2 * g1 + bb;
        u32x2 o0, o1;
        o0.x = cvtpk(silu_f(y0[0]) * u0[0], silu_f(y0[1]) * u0[1]); o0.y = cvtpk(silu_f(y0[2]) * u0[2], silu_f(y0[3]) * u0[3]);
        o1.x = cvtpk(silu_f(y1[0]) * u1[0], silu_f(y1[1]) * u1[1]); o1.y = cvtpk(silu_f(y1[2]) * u1[2], silu_f(y1[3]) * u1[3]);
        *(u32x2*)(H + (size_t)(pm * 256) * DFF + ch) = o0; *(u32x2*)(H + (size_t)(pm * 256 + 1) * DFF + ch) = o1;
    }
}

__device__ __forceinline__ void kmean_phase(const Frame& F_, const bf16* QKV, float* kmean) {
    Frame F = F_; F.tid = tid_of(F.wave); F.lane = F.tid & 63; asm volatile("" : "+v"(F.lane), "+v"(F.tid), "+s"(F.gw), "+s"(F.vcu), "+s"(F.wave));
    LAS float* red = (LAS float*)F.lds;
    for (int it = F.vcu; it < 256; it += F.G) {
        const int b = it >> 5, n = (it >> 2) & 7, cbk = it & 3;
        const bf16* src = QKV + (size_t)(b * SEQ + n * 256 + F.wave * 32) * N_AB + 8192 + cbk * 512 + F.lane * 8;
        float acc[8];
#pragma unroll
        for (int j = 0; j < 8; ++j) acc[j] = 0.f;
        for (int r8 = 0; r8 < 32; r8 += 8) { u32x4 v[8];
#pragma unroll
            for (int r = 0; r < 8; ++r) v[r] = *(const u32x4*)(src + (size_t)(r8 + r) * N_AB);
#pragma unroll
            for (int r = 0; r < 8; ++r)
#pragma unroll
                for (int q = 0; q < 4; ++q) { acc[2 * q] += bf_lo(v[r][q]); acc[2 * q + 1] += bf_hi(v[r][q]); } }
#pragma unroll
        for (int j = 0; j < 8; ++j) red[F.wave * 512 + F.lane * 8 + j] = acc[j];
        LDS_WAIT(); WG_BAR();
        float s = 0.f;
#pragma unroll
        for (int w = 0; w < 8; ++w) s += red[w * 512 + F.tid];
        const int col = cbk * 512 + F.tid, h = col >> 7, d = col & 127;
        kmean[((size_t)(b * 16 + h) * 8 + n) * 128 + d] = s * (1.f / 256.f);
        LDS_WAIT(); WG_BAR();
    }
}

__device__ __forceinline__ void cd_pre_phase(const Frame& F_, const bf16* QKV, bf16* QKDC, const float* cw  , const float* cb, const float* gates, const float* bif, float* A2, float* M2, float* NM, unsigned* kn2) {
    Frame F = F_; F.tid = tid_of(F.wave); F.lane = F.tid & 63; asm volatile("" : "+v"(F.lane), "+v"(F.tid), "+s"(F.gw), "+s"(F.vcu), "+s"(F.wave));
    for (int it = F.gw; it < (M / 32) * 4; it += F.NGW) {
        const int rb = it >> 2, cbk = it & 3, c0 = cbk * 512 + F.lane * 8, r0 = rb * 32;
        float w[4][8], bb[8];
#pragma unroll
        for (int q = 0; q < 2; ++q) { const f32x4 t3 = *(const f32x4*)(cb + c0 + 4 * q);
#pragma unroll
            for (int j = 0; j < 4; ++j) bb[4 * q + j] = t3[j];
#pragma unroll
            for (int k = 0; k < 4; ++k) { const f32x4 t = *(const f32x4*)(cw + k * 2048 + c0 + 4 * q);
#pragma unroll
                for (int j = 0; j < 4; ++j) w[k][4 * q + j] = t[j]; } }
        const bf16* src = QKV + 6144 + c0;
        u32x4 x3 = {0u, 0u, 0u, 0u}, x2 = x3, x1 = x3;
        if ((r0 & (SEQ - 1)) != 0) { x3 = *(const u32x4*)(src + (size_t)(r0 - 3) * N_AB); x2 = *(const u32x4*)(src + (size_t)(r0 - 2) * N_AB); x1 = *(const u32x4*)(src + (size_t)(r0 - 1) * N_AB); }
        for (int t8 = 0; t8 < 32; t8 += 8) {
            u32x4 xv[8];
#pragma unroll
            for (int t = 0; t < 8; ++t) xv[t] = *(const u32x4*)(src + (size_t)(r0 + t8 + t) * N_AB);
#pragma unroll
            for (int t = 0; t < 8; ++t) { u32x4 ov;
#pragma unroll
                for (int q = 0; q < 4; ++q) {
                    const float y0 = w[0][2 * q] * bf_lo(x3[q]) + w[1][2 * q] * bf_lo(x2[q]) + w[2][2 * q] * bf_lo(x1[q]) + w[3][2 * q] * bf_lo(xv[t][q]) + bb[2 * q];
                    const float y1 = w[0][2 * q + 1] * bf_hi(x3[q]) + w[1][2 * q + 1] * bf_hi(x2[q]) + w[2][2 * q + 1] * bf_hi(x1[q]) + w[3][2 * q + 1] * bf_hi(xv[t][q]) + bb[2 * q + 1];
                    ov[q] = cvtpk(silu_f(y0), silu_f(y1)); }
                *(u32x4*)(QKDC + (size_t)(r0 + t8 + t) * 2048 + c0) = ov; x3 = x2; x2 = x1; x1 = xv[t]; }
        }
    }
    for (int it = F.gw; it < (M / 64) * 16; it += F.NGW) {
        const int rb = it >> 4, h = it & 15, row = rb * 64 + F.lane;
        const u32x4* kp = (const u32x4*)(QKV + (size_t)row * N_AB + 2048 + h * 128); float s = 0.f;
#pragma unroll
        for (int j = 0; j < 16; ++j) { const u32x4 v = kp[j];
            s = fmaf(bf_lo(v.x), bf_lo(v.x), s); s = fmaf(bf_hi(v.x), bf_hi(v.x), s); s = fmaf(bf_lo(v.y), bf_lo(v.y), s); s = fmaf(bf_hi(v.y), bf_hi(v.y), s);
            s = fmaf(bf_lo(v.z), bf_lo(v.z), s); s = fmaf(bf_hi(v.z), bf_hi(v.z), s); s = fmaf(bf_lo(v.w), bf_lo(v.w), s); s = fmaf(bf_hi(v.w), bf_hi(v.w), s); }
#pragma unroll
        for (int o = 1; o < 64; o <<= 1) s = fmaxf(s, __shfl_xor(s, o));
        if (F.lane == 0) atomicMax(kn2 + (row >> 11) * 16 + h, __float_as_uint(s));
    }
    for (int sq = F.gw; sq < 64; sq += F.NGW) {
        const int b = sq >> 3, h = sq & 7; const float bi = bif[h], bfv = bif[8 + h];
        const float* gp = gates + (size_t)(b * SEQ + F.lane * 32) * 16;
        float lf[32], ai[32]; float run = 0.f;
#pragma unroll
        for (int t = 0; t < 32; ++t) { lf[t] = gp[t * 16 + 8 + h]; ai[t] = gp[t * 16 + h]; }
#pragma unroll
        for (int t = 0; t < 32; ++t) asm volatile("" : "+v"(lf[t]), "+v"(ai[t]));
#pragma unroll
        for (int t = 0; t < 32; ++t) { const float f = lf[t] + bfv; ai[t] += bi;
            const float ls = fminf(f, 0.f) - log1pf(expf(-fabsf(f)));
            run += ls; lf[t] = run; }
        float incl = run;
#pragma unroll
        for (int o = 1; o < 64; o <<= 1) { const float t = __shfl_up(incl, o); if (F.lane >= o) incl += t; }
        const float base = incl - run; float mx = -__builtin_inff();
#pragma unroll
        for (int t = 0; t < 32; ++t) { lf[t] += base; ai[t] -= lf[t]; mx = fmaxf(mx, ai[t]); }
        float minc = mx;
#pragma unroll
        for (int o = 1; o < 64; o <<= 1) { const float t = __shfl_up(minc, o); if (F.lane >= o) minc = fmaxf(minc, t); }
        float mprev = __shfl_up(minc, 1); if (F.lane == 0) mprev = -__builtin_inff();
        float cm = fmaxf(mprev, 0.f);
        float* a2o = A2 + (size_t)sq * SEQ + F.lane * 32; float* m2o = M2 + (size_t)sq * SEQ + F.lane * 32; float* nmo = NM + (size_t)sq * SEQ + F.lane * 32;
#pragma unroll
        for (int t = 0; t < 32; ++t) { cm = fmaxf(cm, ai[t]); a2o[t] = ai[t] * 1.4426950408889634f; m2o[t] = cm * 1.4426950408889634f; nmo[t] = expf(-lf[t] - cm); }
    }
}

__device__ __forceinline__ void cd_post_phase(const Frame& F_, const bf16* HD, const bf16* QKV, bf16* Y, const float* ng) {
    Frame F = F_; F.tid = tid_of(F.wave); F.lane = F.tid & 63; asm volatile("" : "+v"(F.lane), "+v"(F.tid), "+s"(F.gw), "+s"(F.vcu), "+s"(F.wave));
    for (int m = F.gw; m < M; m += F.NGW) {
        u32x2 hv[8], ov[8]; f32x4 g[8];
#pragma unroll
        for (int h = 0; h < 8; ++h) { const int c = h * 256 + F.lane * 4; hv[h] = *(const u32x2*)(HD + (size_t)m * 2048 + c); ov[h] = *(const u32x2*)(QKV + (size_t)m * N_AB + 10240 + c); g[h] = *(const f32x4*)(ng + c); }
        float v[8][4], s1[8], s2[8];
#pragma unroll
        for (int h = 0; h < 8; ++h) { v[h][0] = bf_lo(hv[h].x); v[h][1] = bf_hi(hv[h].x); v[h][2] = bf_lo(hv[h].y); v[h][3] = bf_hi(hv[h].y); s1[h] = (v[h][0] + v[h][1]) + (v[h][2] + v[h][3]); }
#pragma unroll
        for (int o = 1; o < 64; o <<= 1)
#pragma unroll
            for (int h = 0; h < 8; ++h) s1[h] += __shfl_xor(s1[h], o);
#pragma unroll
        for (int h = 0; h < 8; ++h) { const float mean = s1[h] * (1.f / 256.f);
#pragma unroll
            for (int j = 0; j < 4; ++j) v[h][j] -= mean;
            s2[h] = (v[h][0] * v[h][0] + v[h][1] * v[h][1]) + (v[h][2] * v[h][2] + v[h][3] * v[h][3]); }
#pragma unroll
        for (int o = 1; o < 64; o <<= 1)
#pragma unroll
            for (int h = 0; h < 8; ++h) s2[h] += __shfl_xor(s2[h], o);
#pragma unroll
        for (int h = 0; h < 8; ++h) { const float rstd = 1.f / sqrtf(s2[h] * (1.f / 256.f) + LN_EPS);
            const float o0 = bf_lo(ov[h].x), o1 = bf_hi(ov[h].x), o2 = bf_lo(ov[h].y), o3 = bf_hi(ov[h].y);
            const float y0 = v[h][0] * rstd * g[h][0] * __builtin_amdgcn_rcpf(1.f + __builtin_amdgcn_exp2f(-1.4426950408889634f * o0));
            const float y1 = v[h][1] * rstd * g[h][1] * __builtin_amdgcn_rcpf(1.f + __builtin_amdgcn_exp2f(-1.4426950408889634f * o1));
            const float y2 = v[h][2] * rstd * g[h][2] * __builtin_amdgcn_rcpf(1.f + __builtin_amdgcn_exp2f(-1.4426950408889634f * o2));
            const float y3 = v[h][3] * rstd * g[h][3] * __builtin_amdgcn_rcpf(1.f + __builtin_amdgcn_exp2f(-1.4426950408889634f * o3));
            u32x2 w; w.x = cvtpk(y0, y1); w.y = cvtpk(y2, y3);
            *(u32x2*)(Y + (size_t)m * DM + 2048 + h * 256 + F.lane * 4) = w; }
    }
}


#define GRID_BAR() xcd_barrier(bar)
#define PHASE_BEGIN constexpr int L = LAYER; GAS unsigned char* const W = (GAS unsigned char*)opq_p(ws); (void)L; (void)W;
template <int LAYER>
__device__ __forceinline__ void layer_body(const Frame& F, const Args& args, const XcdBarrier& bar, unsigned char* ws) {
    constexpr int layer = LAYER;
        { PHASE_BEGIN
            pg8::Gemm g{(const bf16*)(W + WS_XB), (const bf16*)(W + (L == 0 ? WS_W_INAB : WS_W_INCD)), M, L == 0 ? N_AB : N_CDP, DM};
            pg8::StaticOrder S; S.init(g.M, g.N, F.G, (int)blockIdx.x);
            pg8::EpiBf16 E{(unsigned char*)W, L, F.wave, F.lds};
            PH(2) pg8::gemm_phase<pg8::EpiBf16, pg8::StaticOrder, true, true>(F.lds, g, S, E);
        }
        seam_wait<LAYER * 8 + 0>(F, args, bar, ws, (LAYER == 0 ? 0 : Q_INCD));
        { PHASE_BEGIN
            if (L == 0) { PH(4) kmean_phase(F, (const bf16*)(W + WS_QKV), (float*)(W + WS_KMEAN)); }
            else PH(8) cd_pre_phase(F, (const bf16*)(W + WS_QKV), (bf16*)(W + WS_QKDC), (const float*)ldin(args, 5), (const float*)ldin(args, 6), (const float*)(W + WS_GATES), (const float*)ldin(args, 4), (float*)(W + WS_A2), (float*)(W + WS_M2), (float*)(W + WS_NM), (unsigned*)(W + WS_CTL + CTL_KN2));
        }
        seam_wait<LAYER * 8 + 1>(F, args, bar, ws, (LAYER == 0 ? 0 : Q_INCD));
        { PHASE_BEGIN
            const bf16* QKV = (const bf16*)(W + WS_QKV); bf16* Y = (bf16*)(W + WS_Y);
            if (L == 0) {
                for (int it = F.vcu; it < 512; it += F.G) { const int bh = it >> 2, pr = it & 3, b = bh >> 4, h = bh & 15;
                    const bf16* base = QKV + (size_t)b * SEQ * N_AB + h * 128; bf16* ob = Y + (size_t)b * SEQ * DM + h * 128;
                    for (int ps = 0; ps < 2; ++ps) PH(16) att::attn_block<att::MODE_DIL>(base, N_AB, base + 2048, N_AB, base + 4096, N_AB, ob, DM, ps ? 7 - pr : pr, (LAS char*)F.lds, nullptr, nullptr, nullptr, F.wave); }
                const float* KMEAN = (const float*)(W + WS_KMEAN);
                for (int it = F.vcu; it < 512; it += F.G) { const int bh = it >> 2, pr = it & 3, b = bh >> 4, h = bh & 15;
                    const bf16* base = QKV + (size_t)b * SEQ * N_AB + 6144 + h * 128; bf16* ob = Y + (size_t)b * SEQ * DM + 2048 + h * 128;
                    for (int ps = 0; ps < 2; ++ps) PH(32) att::attn_block<att::MODE_MOBA>(base, N_AB, base + 2048, N_AB, base + 4096, N_AB, ob, DM, ps ? 7 - pr : pr, (LAS char*)F.lds, KMEAN + (size_t)bh * 1024, nullptr, nullptr, F.wave); }
            } else {
                for (int it = F.vcu; it < 512; it += F.G) { const int bh = it >> 2, pr = it & 3, b = bh >> 4, h = bh & 15;
                    const bf16* base = QKV + (size_t)b * SEQ * N_AB + h * 128; bf16* ob = Y + (size_t)b * SEQ * DM + h * 128;
                    for (int ps = 0; ps < 2; ++ps) PH(64) att::attn_block<att::MODE_SB>(base, N_AB, base + 2048, N_AB, base + 4096, N_AB, ob, DM, ps ? 7 - pr : pr, (LAS char*)F.lds, (const float*)(W + WS_CTL + CTL_KN2) + bh, nullptr, nullptr, F.wave); }
                const bf16* QKDC = (const bf16*)(W + WS_QKDC); bf16* HD = (bf16*)(W + WS_HD); const float* A2 = (const float*)(W + WS_A2); const float* M2 = (const float*)(W + WS_M2); const float* NMv = (const float*)(W + WS_NM);
                for (int it = F.vcu; it < 512; it += F.G) { const int bv = it >> 2, pr = it & 3, b = bv >> 4, vh = bv & 15, h = vh >> 1, half = vh & 1;
                    const bf16* qd = QKDC + (size_t)b * SEQ * 2048 + h * 128; const bf16* vd = QKV + (size_t)b * SEQ * N_AB + 8192 + h * 256 + half * 128;
                    bf16* ob = HD + (size_t)b * SEQ * 2048 + h * 256 + half * 128; const size_t so = (size_t)(b * 8 + h) * SEQ;
                    for (int ps = 0; ps < 2; ++ps) PH(128) att::attn_block<att::MODE_ML>(qd, 2048, qd + 1024, 2048, vd, N_AB, ob, 2048, ps ? 7 - pr : pr, (LAS char*)F.lds, A2 + so, M2 + so, NMv + so, F.wave); }
            }
        }
        if (layer == 1) { seam_wait<LAYER * 8 + 2>(F, args, bar, ws, Q_INCD); PHASE_BEGIN PH(256) cd_post_phase(F, (const bf16*)(W + WS_HD), (const bf16*)(W + WS_QKV), (bf16*)(W + WS_Y), (const float*)ldin(args, 7)); }
        seam_wait<LAYER * 8 + 3>(F, args, bar, ws, (LAYER == 0 ? Q_OUTAB : Q_OUTCD));
        { PHASE_BEGIN
            pg8::Gemm g{(const bf16*)(W + WS_Y), (const bf16*)(W + (L == 0 ? WS_W_OUTAB : WS_W_OUTCD)), M, DM, DM};
            pg8::StaticOrder S; S.init(g.M, g.N, F.G, (int)blockIdx.x);
            pg8::EpiResid E{&args, (unsigned char*)W, L, 0, F.lds, F.wave};
            PH(512) pg8::gemm_phase<pg8::EpiResid, pg8::StaticOrder, true, true>(F.lds, g, S, E);
        }
        seam_wait<LAYER * 8 + 4>(F, args, bar, ws, (LAYER == 0 ? Q_UG0 : Q_UG1));
        { PHASE_BEGIN
            pg8::Gemm g{(const bf16*)(W + WS_XB), (const bf16*)(W + (L == 0 ? WS_W_UG0 : WS_W_UG1)), M, 2 * DFF, DM};
            pg8::StaticOrder S; S.init(g.M, g.N, F.G, (int)blockIdx.x);
            pg8::EpiFfnAct E{&args, (unsigned char*)W, L, F.lds, F.wave};
            PH(2048) pg8::gemm_phase<pg8::EpiFfnAct, pg8::StaticOrder, true, true>(F.lds, g, S, E);
        }
        seam_wait<LAYER * 8 + 5>(F, args, bar, ws, (LAYER == 0 ? Q_UG0 : Q_UG1));
        { PHASE_BEGIN PH(4096) ffn_fix_phase(F, (bf16*)(W + WS_U), (const float*)(W + WS_G), (const float*)(W + WS_G + 8 * MiB), (const float*)(W + WS_G + 16 * MiB), (const float*)ldin(args, 11) + (size_t)L * 3 * DFF, (const float*)ldin(args, 12) + (size_t)L * DFF); }
        seam_wait<LAYER * 8 + 6>(F, args, bar, ws, (LAYER == 0 ? Q_DN0 : Q_TOTAL));
        { PHASE_BEGIN
            pg8::Gemm g{(const bf16*)(W + WS_U), (const bf16*)(W + (L == 0 ? WS_W_DN0 : WS_W_DN1)), M, DM, DFF};
            pg8::StaticOrder S; S.init(g.M, g.N, F.G, (int)blockIdx.x, 2);
            pg8::EpiResid E{&args, (unsigned char*)W, L, 1, F.lds, F.wave};
            PH(8192) pg8::gemm_phase<pg8::EpiResid, pg8::StaticOrder, true, true>(F.lds, g, S, E);
        }
        seam_wait<LAYER * 8 + 7>(F, args, bar, ws, (LAYER == 0 ? Q_INCD : Q_TOTAL));
        if (layer == 1) { PHASE_BEGIN
            PH(1024) ln_phase(F, (const bf16*)(W + WS_XB), args.out, (const float*)ldin(args, 14) + (size_t)3 * DM, (const float*)ldin(args, 15) + (size_t)3 * DM); }
}
#undef PHASE_BEGIN

__global__ void __launch_bounds__(NWAVES * 64, 2) mk_fwd(Args args) {
    extern __shared__ __attribute__((aligned(16))) unsigned char lds_raw[];
    Frame F;
    F.lds = (LAS unsigned char*)lds_raw;
    F.tid = threadIdx.x; F.lane = F.tid & 63; F.wave = __builtin_amdgcn_readfirstlane(F.tid >> 6);
    F.G = gridDim.x; { const int bx = blockIdx.x; F.vcu = (F.G % 8 == 0) ? (bx % 8) * (F.G / 8) + bx / 8 : bx; }
    F.gw = F.vcu * NWAVES + F.wave; F.NGW = F.G * NWAVES;
    unsigned char* ws = args.ws;
    volatile LAS unsigned* MISC = (volatile LAS unsigned*)(F.lds + MISC_OFF);
    for (int u = F.tid; u < (LDS_BYTES - CTRL_OFF) / 4; u += NWAVES * 64) ((LAS unsigned*)(F.lds + CTRL_OFF))[u] = 0u;
    __syncthreads();
    XcdBarrier bar = xcd_barrier_post((unsigned*)(ws + WS_CTL) + CW_BAR, MISC + 8, F.wave);

    PH(1) prologue(F, args);
    GRID_BAR();

    layer_body<0>(F, args, bar, ws);
    layer_body<1>(F, args, bar, ws);
}

extern "C" void kernel_launch(void* const* d_in, const int* in_sizes, int n_in, void* d_out, int out_size, void* d_ws, size_t ws_size, hipStream_t stream) {
    static int grid = 0;
    if (grid == 0) {
        if (n_in != 16 || in_sizes[0] != M * DM || out_size != M * DM || ws_size < WS_END) { fprintf(stderr, "kernel_launch: unexpected shapes (n_in %d, in0 %d, out %d, ws %zu < %zu)\n", n_in, n_in > 0 ? in_sizes[0] : -1, out_size, ws_size, (size_t)WS_END); grid = -1; return; }
        int dev = 0, cus = 0;
        if (hipGetDevice(&dev) != hipSuccess || hipDeviceGetAttribute(&cus, hipDeviceAttributeMultiprocessorCount, dev) != hipSuccess) { grid = -1; return; }
        if (hipFuncSetAttribute((const void*)mk_fwd, hipFuncAttributeMaxDynamicSharedMemorySize, LDS_BYTES) != hipSuccess) { fprintf(stderr, "kernel_launch: hipFuncSetAttribute failed\n"); grid = -1; return; }
        int per_cu = 0;
        if (hipOccupancyMaxActiveBlocksPerMultiprocessor(&per_cu, (const void*)mk_fwd, NWAVES * 64, LDS_BYTES) != hipSuccess || per_cu < 1) fprintf(stderr, "kernel_launch: occupancy query says %d\n", per_cu);
        (void)hipGetLastError();
        grid = cus;
    }
    if (grid < 0) return;
    if (hipMemsetAsync((char*)d_ws + WS_CTL, 0, CTL_ZERO_BYTES, stream) != hipSuccess) return;
    Args a{};
    for (int i = 0; i < 16; ++i) a.in[i] = (const float*)d_in[i];
    a.out = (float*)d_out; a.ws = (unsigned char*)d_ws;
    hipLaunchKernelGGL(mk_fwd, dim3(grid), dim3(NWAVES * 64), LDS_BYTES, stream, a);
}
```
